# Optimizing an MI355X kernel written in HIP

```python
import math
import jax
import jax.numpy as jnp
from jax import lax
import numpy as np


D_MODEL = 1024
BATCH = 16
SEQ = 256
DEPTH = 2
DEC_BATCH = 4
DEC_SEQ = 1024
PAST_LEN = 512

F32 = jnp.float32
GRID_W = 64
EPS = 1e-6
S5_WIDTH = 512
S5_GROUP = 16
S5_GROUPS = S5_WIDTH // S5_GROUP
S5_STATE = 64
DA_HEADS = 4
DA_HEAD = 64
DA_VDIM = 2 * DA_HEAD
DA_WIDTH = DA_HEADS * DA_VDIM
Q_BLOCK = 128
ROPE_BASE = 10000.0
DN_HEADS = 4
DN_HEAD = 128
DN_WIDTH = DN_HEADS * DN_HEAD
DN_CONV = 5
DN_CHUNK = 64
N_BRANCH = 3
BRANCH_WIDTH = 512
IN_SIZES = (S5_WIDTH, S5_WIDTH,
            DA_HEADS * 2 * DA_HEAD, DA_HEADS * 2 * DA_HEAD, DA_WIDTH, DA_WIDTH,
            DN_WIDTH, DN_WIDTH, DN_WIDTH, DN_WIDTH, 2 * DN_HEADS, 2 * DN_HEADS,
            N_BRANCH * D_MODEL)
N_IN = sum(IN_SIZES)

kernel_name = 'hybrid_s5_diffattn_deltanet_prefix_flow_step'


def rmsnorm(x, g):
    xf = x.astype(F32)
    y = xf * lax.rsqrt(jnp.mean(xf * xf, axis=-1, keepdims=True) + EPS)
    return (y * g.astype(F32)).astype(x.dtype)


def l2norm(x):
    xf = x.astype(F32)
    return xf * lax.rsqrt(jnp.sum(xf * xf, axis=-1, keepdims=True) + EPS)


def split_in(proj):
    parts, start = [], 0
    for size in IN_SIZES:
        parts.append(proj[..., start:start + size])
        start += size
    return parts


def rope_2d(x, n_tokens):
    rows = n_tokens // GRID_W
    row = jnp.repeat(jnp.arange(rows), GRID_W).astype(F32)
    col = jnp.tile(jnp.arange(GRID_W), rows).astype(F32)
    half = x.shape[-1] // 2
    nf = half // 2
    inv = ROPE_BASE ** (-jnp.arange(nf, dtype=F32) / nf)

    def rot(xa, pos):
        ang = pos[:, None] * inv[None, :]
        cos = jnp.cos(ang)[None, :, None, None, :]
        sin = jnp.sin(ang)[None, :, None, None, :]
        x1, x2 = xa[..., :nf].astype(F32), xa[..., nf:].astype(F32)
        return jnp.concatenate([x1 * cos - x2 * sin, x1 * sin + x2 * cos], axis=-1)

    out = jnp.concatenate([rot(x[..., :half], row), rot(x[..., half:], col)], axis=-1)
    return out.astype(x.dtype)


def s5_scan(u, lam_re, lam_im, log_step, b_re, b_im, h0_re, h0_im):
    lam_re, lam_im = lam_re.astype(F32), lam_im.astype(F32)
    b_re, b_im = b_re.astype(F32), b_im.astype(F32)
    step = jnp.exp(log_step.astype(F32))[:, None]
    mag = jnp.exp(lam_re * step)
    ar, ai = mag * jnp.cos(lam_im * step), mag * jnp.sin(lam_im * step)
    den = lam_re * lam_re + lam_im * lam_im
    fr = ((ar - 1.0) * lam_re + ai * lam_im) / den
    fi = (ai * lam_re - (ar - 1.0) * lam_im) / den
    bbr = fr[..., None] * b_re - fi[..., None] * b_im
    bbi = fr[..., None] * b_im + fi[..., None] * b_re
    bu_re = jnp.einsum('btgi,gpi->btgp', u, bbr)
    bu_im = jnp.einsum('btgi,gpi->btgp', u, bbi)
    h0_re, h0_im = h0_re.astype(F32), h0_im.astype(F32)
    bu_re = bu_re.at[:, 0].add(ar * h0_re - ai * h0_im)
    bu_im = bu_im.at[:, 0].add(ar * h0_im + ai * h0_re)
    a_re = jnp.broadcast_to(ar, bu_re.shape)
    a_im = jnp.broadcast_to(ai, bu_im.shape)

    def combine(e1, e2):
        a1r, a1i, b1r, b1i = e1
        a2r, a2i, b2r, b2i = e2
        return (a2r * a1r - a2i * a1i, a2r * a1i + a2i * a1r,
                a2r * b1r - a2i * b1i + b2r, a2r * b1i + a2i * b1r + b2i)

    _, _, hr, hi = lax.associative_scan(combine, (a_re, a_im, bu_re, bu_im), axis=1)
    return hr, hi


def diff_attention(q, k, v, lam):
    b, s, h, _, d = q.shape
    nq = s // Q_BLOCK
    qb = jnp.moveaxis(q.reshape(b, nq, Q_BLOCK, h, 2, d), 1, 0)
    scale = d ** -0.5

    def one(qc):
        sc = jnp.einsum('bqhmd,bkhmd->bhmqk', qc, k).astype(F32) * scale
        a = jax.nn.softmax(sc, axis=-1)
        a = a[:, :, 0] - lam * a[:, :, 1]
        return jnp.einsum('bhqk,bkhe->bqhe', a.astype(v.dtype), v)

    o = lax.map(one, qb)
    return jnp.moveaxis(o, 0, 1).reshape(b, s, h, -1)


def short_conv(x, w):
    return lax.conv_general_dilated(
        x, w[:, None, :].astype(x.dtype), window_strides=(1,),
        padding=[(DN_CONV // 2, DN_CONV // 2)],
        dimension_numbers=('NWC', 'WIO', 'NWC'), feature_group_count=x.shape[-1])


def gated_delta_rule(q, k, v, beta, g, s0):
    b, t, h, _ = q.shape
    n = t // DN_CHUNK

    def chunk(a):
        a = a.astype(F32).reshape((b, n, DN_CHUNK) + a.shape[2:])
        return jnp.moveaxis(a, 3, 2)

    q, k, v, beta, g = chunk(q), chunk(k), chunk(v), chunk(beta), chunk(g)
    g = jnp.cumsum(g, axis=-1)
    i = jnp.arange(DN_CHUNK)
    incl = i[:, None] >= i[None, :]
    strict = i[:, None] > i[None, :]
    gdiff = g[..., :, None] - g[..., None, :]
    decay = jnp.where(incl, jnp.exp(jnp.where(incl, gdiff, 0.0)), 0.0)
    kb = k * beta[..., None]
    m = jnp.where(strict, jnp.einsum('bnhik,bnhjk->bnhij', kb, k) * decay, 0.0)
    eye = jnp.eye(DN_CHUNK, dtype=F32)
    tinv = lax.linalg.triangular_solve(eye + m, jnp.broadcast_to(eye, m.shape), left_side=True, lower=True)
    u = tinv @ (v * beta[..., None])
    w = tinv @ (kb * jnp.exp(g)[..., None])
    qk = jnp.einsum('bnhik,bnhjk->bnhij', q, k) * decay

    def step(s, xs):
        q_c, k_c, u_c, w_c, g_c, qk_c = xs
        v_new = u_c - w_c @ s
        o_c = (q_c * jnp.exp(g_c)[..., None]) @ s + qk_c @ v_new
        g_last = g_c[..., -1:]
        s = s * jnp.exp(g_last)[..., None] + jnp.einsum(
            'bhck,bhcv->bhkv', k_c * jnp.exp(g_last - g_c)[..., None], v_new)
        return s, o_c

    xs = tuple(jnp.moveaxis(a, 1, 0) for a in (q, k, u, w, g, qk))
    s, o = lax.scan(step, s0.astype(F32), xs)
    o = jnp.moveaxis(jnp.moveaxis(o, 0, 1), 2, 3).reshape(b, t, h, -1)
    return o, s


def mixer(h, lp, lam_init, ctx):
    b, t, _ = h.shape
    dt = h.dtype
    (u_a, z_a, q_b, k_b, v_b, z_b, q_c, k_c, v_c, z_c,
     beta_c, alpha_c, gates) = split_in(h @ lp['w_in'])
    if ctx is None:
        s5_h0_re = jnp.zeros((b, 2, S5_GROUPS, S5_STATE), F32)
        s5_h0_im = jnp.zeros((b, 2, S5_GROUPS, S5_STATE), F32)
        dn_s0 = jnp.zeros((b, 2, DN_HEADS, DN_HEAD, DN_HEAD), F32)
    else:
        k_ctx, v_ctx, s5_h0_re, s5_h0_im, dn_s0 = ctx

    u = u_a.astype(F32).reshape(b, t, S5_GROUPS, S5_GROUP)
    y_a = lp['s5_d'].astype(F32) * u_a.astype(F32)
    s5_fin_re, s5_fin_im = [], []
    for d in range(2):
        ud = u if d == 0 else u[:, ::-1]
        hr, hi = s5_scan(ud, lp['s5_lam_re'][d], lp['s5_lam_im'][d], lp['s5_log_step'][d],
                         lp['s5_b_re'][d], lp['s5_b_im'][d], s5_h0_re[:, d], s5_h0_im[:, d])
        yd = (jnp.einsum('btgp,gip->btgi', hr, lp['s5_c_re'][d].astype(F32))
              - jnp.einsum('btgp,gip->btgi', hi, lp['s5_c_im'][d].astype(F32)))
        if d == 1:
            yd = yd[:, ::-1]
        y_a = y_a + yd.reshape(b, t, S5_WIDTH)
        s5_fin_re.append(hr[:, -1])
        s5_fin_im.append(hi[:, -1])
    y_a = jax.nn.gelu(y_a)
    y_a = y_a * jax.nn.sigmoid(y_a @ lp['s5_w_glu'].astype(F32))
    out_a = (y_a * jax.nn.silu(z_a.astype(F32))).astype(dt)

    q = q_b.reshape(b, t, DA_HEADS, 2, DA_HEAD)
    k = k_b.reshape(b, t, DA_HEADS, 2, DA_HEAD)
    v = v_b.reshape(b, t, DA_HEADS, DA_VDIM)
    if ctx is None:
        k_all, v_all = k, v
    else:
        q = rope_2d(q, t)
        k_all = jnp.concatenate([rope_2d(k, t), k_ctx.astype(dt)], axis=1)
        v_all = jnp.concatenate([v, v_ctx.astype(dt)], axis=1)
    lp_lam = lp['da_lam'].astype(F32)
    lam = (jnp.exp(jnp.sum(lp_lam[0] * lp_lam[1])) - jnp.exp(jnp.sum(lp_lam[2] * lp_lam[3])) + lam_init)
    o_b = diff_attention(q, k_all, v_all, lam)
    o_b = rmsnorm(o_b, lp['da_norm_g']).astype(F32) * (1.0 - lam_init)
    out_b = (o_b.reshape(b, t, DA_WIDTH) * jax.nn.silu(z_b.astype(F32))).astype(dt)

    qkv = jax.nn.silu(short_conv(jnp.concatenate([q_c, k_c, v_c], axis=-1), lp['dn_conv']))
    qd = l2norm(qkv[..., :DN_WIDTH].reshape(b, t, DN_HEADS, DN_HEAD)) * (DN_HEAD ** -0.5)
    kd = l2norm(qkv[..., DN_WIDTH:2 * DN_WIDTH].reshape(b, t, DN_HEADS, DN_HEAD))
    vd = qkv[..., 2 * DN_WIDTH:].astype(F32).reshape(b, t, DN_HEADS, DN_HEAD)
    beta = jax.nn.sigmoid(beta_c.astype(F32)).reshape(b, t, 2, DN_HEADS)
    g = -jnp.exp(lp['dn_a_log'].astype(F32)) * jax.nn.softplus(
        alpha_c.astype(F32).reshape(b, t, 2, DN_HEADS) + lp['dn_dt_bias'].astype(F32))
    o_f, s_f = gated_delta_rule(qd, kd, vd, beta[:, :, 0], g[:, :, 0], dn_s0[:, 0])
    o_r, s_r = gated_delta_rule(qd[:, ::-1], kd[:, ::-1], vd[:, ::-1], beta[:, ::-1, 1], g[:, ::-1, 1], dn_s0[:, 1])
    o_c = rmsnorm(o_f + o_r[:, ::-1], lp['dn_norm_g'])
    out_c = (o_c.reshape(b, t, DN_WIDTH) * jax.nn.silu(z_c.astype(F32))).astype(dt)

    branches = jnp.stack([out_a, out_b, out_c], axis=2)
    pr = jnp.einsum('btnw,nwd->btnd', branches, lp['w_branch'])
    gt = jax.nn.sigmoid(gates.reshape(b, t, N_BRANCH, D_MODEL))
    y = jnp.sum(gt * pr, axis=2) @ lp['w_out']
    if ctx is None:
        return y, (k, v, jnp.stack(s5_fin_re, axis=1), jnp.stack(s5_fin_im, axis=1),
                   jnp.stack([s_f, s_r], axis=1))
    return y, None


def layer(x, cond, params, l, ctx):
    lp = {name: arr[l] for name, arr in params.items()}
    mod = jax.nn.silu(cond.astype(F32)) @ lp['w_ada'].astype(F32) + lp['b_ada'].astype(F32)
    shift, scale, gate = jnp.split(mod, 3, axis=-1)
    hn = (rmsnorm(x, lp['norm_g']).astype(F32) * (1.0 + scale[:, None]) + shift[:, None]).astype(x.dtype)
    y, st = mixer(hn, lp, 0.8 - 0.6 * math.exp(-0.3 * l), ctx)
    return x + gate[:, None].astype(x.dtype) * y.astype(x.dtype), st


def setup_inputs(seed: int = 0) -> dict:
    key = jax.random.key(seed)
    k = jax.random.split(key, 32)

    def nrm(i, shape, scale=1.0):
        return scale * jax.random.normal(k[i], shape, F32)

    def uni(i, shape, lo, hi):
        return jax.random.uniform(k[i], shape, F32, lo, hi)

    dt0 = jnp.exp(uni(26, (DEPTH, 2, DN_HEADS), math.log(1e-3), math.log(1e-1)))
    return {
        'x_prompt': nrm(0, (BATCH, SEQ, D_MODEL)),
        'x_sample': nrm(1, (DEC_BATCH, DEC_SEQ, D_MODEL)),
        'cache_k': nrm(2, (DEC_BATCH, DEPTH, PAST_LEN, DA_HEADS, 2, DA_HEAD)),
        'cache_v': nrm(3, (DEC_BATCH, DEPTH, PAST_LEN, DA_HEADS, DA_VDIM)),
        'state_s5_re': nrm(4, (DEC_BATCH, DEPTH, 2, S5_GROUPS, S5_STATE), 0.1),
        'state_s5_im': nrm(5, (DEC_BATCH, DEPTH, 2, S5_GROUPS, S5_STATE), 0.1),
        'state_dn': nrm(6, (DEC_BATCH, DEPTH, 2, DN_HEADS, DN_HEAD, DN_HEAD), 0.1),
        'c': nrm(7, (DEC_BATCH, D_MODEL)),
        'c_ctx': nrm(8, (D_MODEL,)),
        'norm_g': 1.0 + nrm(9, (DEPTH, D_MODEL), 0.01),
        'w_ada': nrm(10, (DEPTH, D_MODEL, 3 * D_MODEL), 0.5 * D_MODEL ** -0.5),
        'b_ada': nrm(11, (DEPTH, 3 * D_MODEL), 0.01),
        'w_in': nrm(12, (DEPTH, D_MODEL, N_IN), D_MODEL ** -0.5),
        's5_lam_re': -0.5 + nrm(13, (DEPTH, 2, S5_GROUPS, S5_STATE), 0.01),
        's5_lam_im': math.pi * jnp.arange(S5_STATE, dtype=F32) + nrm(14, (DEPTH, 2, S5_GROUPS, S5_STATE), 0.01),
        's5_log_step': uni(15, (DEPTH, 2, S5_GROUPS), math.log(1e-3), math.log(1e-1)),
        's5_b_re': nrm(16, (DEPTH, 2, S5_GROUPS, S5_STATE, S5_GROUP), 0.7 * S5_GROUP ** -0.5),
        's5_b_im': nrm(17, (DEPTH, 2, S5_GROUPS, S5_STATE, S5_GROUP), 0.7 * S5_GROUP ** -0.5),
        's5_c_re': nrm(18, (DEPTH, 2, S5_GROUPS, S5_GROUP, S5_STATE), 0.7 * S5_STATE ** -0.5),
        's5_c_im': nrm(19, (DEPTH, 2, S5_GROUPS, S5_GROUP, S5_STATE), 0.7 * S5_STATE ** -0.5),
        's5_d': nrm(20, (DEPTH, S5_WIDTH)),
        's5_w_glu': nrm(21, (DEPTH, S5_WIDTH, S5_WIDTH), S5_WIDTH ** -0.5),
        'da_lam': nrm(22, (DEPTH, 4, DA_HEAD), 0.1),
        'da_norm_g': 1.0 + nrm(23, (DEPTH, DA_VDIM), 0.01),
        'dn_conv': nrm(24, (DEPTH, DN_CONV, 3 * DN_WIDTH), DN_CONV ** -0.5),
        'dn_a_log': jnp.log(uni(25, (DEPTH, 2, DN_HEADS), 1.0, 16.0)),
        'dn_dt_bias': dt0 + jnp.log(-jnp.expm1(-dt0)),
        'dn_norm_g': 1.0 + nrm(27, (DEPTH, DN_HEAD), 0.01),
        'w_branch': nrm(28, (DEPTH, N_BRANCH, BRANCH_WIDTH, D_MODEL), BRANCH_WIDTH ** -0.5),
        'w_out': nrm(29, (DEPTH, D_MODEL, D_MODEL), D_MODEL ** -0.5),
        'final_norm_g': 1.0 + nrm(30, (D_MODEL,), 0.01),
    }


def reference(x_prompt, x_sample, cache_k, cache_v, state_s5_re, state_s5_im, state_dn, c, c_ctx,
              norm_g, w_ada, b_ada, w_in, s5_lam_re, s5_lam_im, s5_log_step, s5_b_re, s5_b_im,
              s5_c_re, s5_c_im, s5_d, s5_w_glu, da_lam, da_norm_g, dn_conv, dn_a_log, dn_dt_bias,
              dn_norm_g, w_branch, w_out, final_norm_g):
    params = {
        'norm_g': norm_g, 'w_ada': w_ada, 'b_ada': b_ada, 'w_in': w_in,
        's5_lam_re': s5_lam_re, 's5_lam_im': s5_lam_im, 's5_log_step': s5_log_step,
        's5_b_re': s5_b_re, 's5_b_im': s5_b_im, 's5_c_re': s5_c_re, 's5_c_im': s5_c_im,
        's5_d': s5_d, 's5_w_glu': s5_w_glu, 'da_lam': da_lam, 'da_norm_g': da_norm_g,
        'dn_conv': dn_conv, 'dn_a_log': dn_a_log, 'dn_dt_bias': dn_dt_bias, 'dn_norm_g': dn_norm_g,
        'w_branch': w_branch, 'w_out': w_out,
    }
    x = x_prompt
    states = []
    for l in range(DEPTH):
        x, st = layer(x, c_ctx[None, :], params, l, None)
        states.append(st)
    y_prompt = rmsnorm(x, final_norm_g)
    new_cache_k = jnp.stack([s[0] for s in states], axis=1)
    new_cache_v = jnp.stack([s[1] for s in states], axis=1)
    new_state_s5_re = jnp.stack([s[2] for s in states], axis=1)
    new_state_s5_im = jnp.stack([s[3] for s in states], axis=1)
    new_state_dn = jnp.stack([s[4] for s in states], axis=1)

    x = x_sample
    for l in range(DEPTH):
        ctx = (cache_k[:, l], cache_v[:, l], state_s5_re[:, l], state_s5_im[:, l], state_dn[:, l])
        x, _ = layer(x, c, params, l, ctx)
    y_sample = rmsnorm(x, final_norm_g)
    return (y_prompt, y_sample, new_cache_k, new_cache_v, new_state_s5_re, new_state_s5_im, new_state_dn)
```

```cpp
#define ONE_LAUNCH 1
#include <hip/hip_runtime.h>
#include <stdint.h>
#include <stdio.h>

#define DI __device__ __forceinline__
typedef unsigned short bf16_t;
using bf16x8 = __attribute__((ext_vector_type(8))) short;
using s16x4  = __attribute__((ext_vector_type(4))) short;
using f32x4  = __attribute__((ext_vector_type(4))) float;
using f32x16 = __attribute__((ext_vector_type(16))) float;
using u32x4  = __attribute__((ext_vector_type(4))) unsigned;
using u32x2  = __attribute__((ext_vector_type(2))) unsigned;
typedef __bf16 bf16x2_t __attribute__((ext_vector_type(2)));
typedef float f32x2_t __attribute__((ext_vector_type(2)));
#define LAS __attribute__((address_space(3)))

#define MFMA16(a, b, c) __builtin_amdgcn_mfma_f32_16x16x32_bf16((a), (b), (c), 0, 0, 0)
#define MFMA32(a, b, c) __builtin_amdgcn_mfma_f32_32x32x16_bf16((a), (b), (c), 0, 0, 0)

constexpr int NT = 512;
constexpr int DM = 1024;
constexpr int MROWS = 8192;
constexpr int NP = 8192;
constexpr int NIN = 8208;
constexpr float EPS = 1e-6f;
constexpr int C_UA = 0, C_ZA = 512, C_QB = 1024, C_KB = 1536, C_VB = 2048, C_ZB = 2560;
constexpr int C_QC = 3072, C_KC = 3584, C_VC = 4096, C_ZC = 4608, C_GT = 5120;
constexpr size_t O_Y = 0;
constexpr size_t O_CK = 8388608;
constexpr size_t O_CV = O_CK + 4194304;
constexpr size_t O_SR = O_CV + 4194304;
constexpr size_t O_SI = O_SR + 131072;
constexpr size_t O_DN = O_SI + 131072;

constexpr size_t WS_BAR   = 0;
constexpr size_t WS_Q     = 16384;
constexpr size_t WS_ZERO_BYTES = 16384 + 1024;
constexpr size_t WS_MOD   = 32768;
constexpr size_t WS_S5AR  = WS_MOD + 122880;
constexpr size_t WS_S5AI  = WS_S5AR + 32768;
constexpr size_t WS_S5BB  = WS_S5AI + 32768;
constexpr size_t WS_S5CT  = WS_S5BB + 524288;
constexpr size_t WS_ROPE  = WS_S5CT + 524288;
constexpr size_t WS_LAM   = WS_ROPE + 8192;
constexpr size_t WS_WBA   = WS_LAM + 256;
constexpr size_t WS_BETAG = WS_WBA + 131072;
constexpr size_t WS_EGL   = WS_BETAG + 524288;
constexpr size_t WS_WTGLU = WS_EGL + 4096;
constexpr size_t WS_WTBR  = WS_WTGLU + 1048576;
constexpr size_t WS_WTOUT = WS_WTBR + 6291456;
constexpr size_t WS_R1    = WS_WTOUT + 4194304;
constexpr size_t WS_R2    = WS_R1 + 16777216;
constexpr size_t WS_PROJ  = WS_R2 + 16777216;
constexpr size_t WS_DNP   = WS_PROJ + 134217728;
constexpr size_t DNP_SLOT = 73728;
constexpr size_t WS_END   = WS_DNP + 1024 * DNP_SLOT;
constexpr int SL_W = 0, SL_QG = 16384, SL_KGT = 32768, SL_QK = 49152, SL_U = 57344;

constexpr int LDS_BYTES = 147456;

struct Params {
  const float* in[31];
  float* out;
  unsigned char* ws;
  int ph_lo, ph_hi;
  int use_bar, pad;
};
typedef const __attribute__((address_space(4))) Params& PR;
#define NI __device__ __noinline__
extern __shared__ __attribute__((aligned(16))) char smem[];
#define GAS __attribute__((address_space(1)))
DI unsigned char* lws(PR p) { GAS unsigned char* w = (GAS unsigned char*)p.ws; asm volatile("" : "+s"(w)); return (unsigned char*)w; }
DI const float* lin(PR p, int k) { GAS const float* w = (GAS const float*)p.in[k]; asm volatile("" : "+s"(w)); return (const float*)w; }
DI int ltid() { int t = threadIdx.x; asm volatile("" : "+v"(t)); return t; }
DI float* lout(PR p) { GAS float* w = (GAS float*)p.out; asm volatile("" : "+s"(w)); return (float*)w; }

DI float bf2f(unsigned short h) { return __uint_as_float(((unsigned)h) << 16); }
DI unsigned pack2(float lo, float hi) { f32x2_t f = {lo, hi}; bf16x2_t v = __builtin_convertvector(f, bf16x2_t); return __builtin_bit_cast(unsigned, v); }
DI unsigned short f2bf(float x) { return (unsigned short)(pack2(x, 0.f) & 0xffffu); }
DI float lo_f(unsigned u) { return __uint_as_float(u << 16); }
DI float hi_f(unsigned u) { return __uint_as_float(u & 0xffff0000u); }
DI float sigmoidf_(float x) { return 1.f / (1.f + __expf(-x)); }
DI float siluf_(float x) { return x / (1.f + __expf(-x)); }
DI float wave_sum(float v) {
#pragma unroll
  for (int o = 32; o >= 1; o >>= 1) v += __shfl_xor(v, o);
  return v;
}
DI bf16x8 mk8(unsigned a, unsigned b, unsigned c, unsigned d) { u32x4 u = {a, b, c, d}; return __builtin_bit_cast(bf16x8, u); }

#define XB_TMO      128
#define XB_XCNT(j)  (256  + 64 * (j))
#define XB_XSUB(j)  (1280 + 64 * (j))
#define XB_XGEN(j)  (2304 + 64 * (j))
#define XB_TOP      3328
#define XB_TOPGEN   3392
#define XCD_BAR_WORDS 3456
#define XB_SPIN_CAP (1u << 22)
DI unsigned xb_ld(unsigned* p)              { return __hip_atomic_load(p, __ATOMIC_RELAXED, __HIP_MEMORY_SCOPE_AGENT); }
DI unsigned xb_add(unsigned* p, unsigned v) { return __hip_atomic_fetch_add(p, v, __ATOMIC_RELAXED, __HIP_MEMORY_SCOPE_AGENT); }
DI unsigned xb_xcc_id() { return (unsigned)__builtin_amdgcn_s_getreg((3 << 11) | 20) & 0xFu; }
#define XB_SPIN(cond, bar) do { unsigned _sp = 0; while (cond) { __builtin_amdgcn_s_sleep(1); \
    if ((++_sp & 255u) == 0u) { if (xb_ld(&(bar)[XB_TMO])) break; if (_sp > XB_SPIN_CAP) { atomicAdd(&(bar)[XB_TMO], 1u); break; } } } } while (0)
struct XcdBarrier { unsigned* bar; unsigned x; volatile LAS unsigned* st; };
DI XcdBarrier xcd_barrier_post(unsigned* bar, volatile LAS unsigned* st) {
  XcdBarrier b; b.bar = bar; b.x = xb_xcc_id(); b.st = st;
  if (threadIdx.x == 0) (void)xb_add(&bar[XB_XCNT(b.x)], 1u);
  return b;
}
DI void xcd_barrier_complete(unsigned* bar, unsigned x, unsigned& nloc, unsigned& nx) {
  const unsigned G = gridDim.x;
  unsigned sum, cnt, mine, sp = 0u;
  for (;;) {
    sum = 0u; cnt = 0u; mine = 0u;
#pragma unroll
    for (unsigned j = 0; j < 16; ++j) { const unsigned c = xb_ld(&bar[XB_XCNT(j)]); sum += c; cnt += (c > 0u) ? 1u : 0u; mine = (j == x) ? c : mine; }
    if (sum == G) break;
    __builtin_amdgcn_s_sleep(1);
    if ((++sp & 255u) == 0u) { if (xb_ld(&bar[XB_TMO])) break; if (sp > XB_SPIN_CAP) { atomicAdd(&bar[XB_TMO], 1u); break; } }
  }
  nloc = mine > 0u ? mine : 1u; nx = cnt > 0u ? cnt : 1u;
}
DI void xcd_barrier(const XcdBarrier& b) {
  asm volatile("s_waitcnt vmcnt(0)" ::: "memory");
  __syncthreads();
  if (threadIdx.x == 0) {
    unsigned* bar = b.bar;
    __builtin_amdgcn_s_waitcnt(0);
    unsigned nloc = b.st[0], nx = b.st[1];
    if (nloc == 0u) { xcd_barrier_complete(bar, b.x, nloc, nx); b.st[0] = nloc; b.st[1] = nx; }
    const unsigned old = xb_add(&bar[XB_XSUB(b.x)], 1u);
    const unsigned gen = old / nloc;
    if (old + 1u == (gen + 1u) * nloc) {
      __builtin_amdgcn_fence(__ATOMIC_RELEASE, "agent");
      asm volatile("s_waitcnt vmcnt(0)" ::: "memory");
      const unsigned og = xb_add(&bar[XB_TOP], 1u);
      const unsigned tg = og / nx;
      if (og + 1u == (tg + 1u) * nx) xb_add(&bar[XB_TOPGEN], 1u);
      else XB_SPIN(xb_ld(&bar[XB_TOPGEN]) == tg, bar);
      __builtin_amdgcn_fence(__ATOMIC_ACQUIRE, "agent");
      xb_add(&bar[XB_XGEN(b.x)], 1u);
      asm volatile("s_waitcnt vmcnt(0)" ::: "memory");
    } else {
      XB_SPIN(xb_ld(&bar[XB_XGEN(b.x)]) == gen, bar);
      __builtin_amdgcn_fence(__ATOMIC_ACQUIRE, "agent");
      asm volatile("s_waitcnt vmcnt(0)" ::: "memory");
    }
  }
  __syncthreads();
}

DI int queue_pull(unsigned* q, volatile int* sh) {
  __syncthreads();
  if (threadIdx.x == 0) *sh = (int)xb_add(q, 1u);
  __syncthreads();
  return *sh;
}

DI int seq_row0(int s) { return s < 16 ? s * 256 : 4096 + (s - 16) * 1024; }
DI int seq_len(int s) { return s < 16 ? 256 : 1024; }
DI int row_cond(int r) { return r < 4096 ? 0 : 1 + ((r - 4096) >> 10); }
DI const float* x_in_row(PR p, int l, int r) {
  if (l == 0) return r < 4096 ? lin(p, 0) + (size_t)r * DM : lin(p, 1) + (size_t)(r - 4096) * DM;
  return lout(p) + O_Y + (size_t)r * DM;
}

DI void ph0_adaln(PR p, int a, char* lds) {
  const int l = a / 96, cb = a % 96, tid = ltid();
  float* scond = (float*)lds;
  float* red = scond + 5 * 1024;
  for (int i = tid; i < 5 * 1024; i += NT) {
    const int ci = i >> 10, k = i & 1023;
    const float c = ci == 0 ? lin(p, 8)[k] : lin(p, 7)[(ci - 1) * 1024 + k];
    scond[i] = c / (1.f + expf(-c));
  }
  __syncthreads();
  const int tx = tid & 31, ty = tid >> 5;
  const float* w = lin(p, 10) + (size_t)l * 1024 * 3072 + cb * 32 + tx;
  float acc[5] = {0.f, 0.f, 0.f, 0.f, 0.f};
  for (int kk = 0; kk < 64; ++kk) {
    const int k = ty * 64 + kk;
    const float wv = w[(size_t)k * 3072];
#pragma unroll
    for (int ci = 0; ci < 5; ++ci) acc[ci] += scond[ci * 1024 + k] * wv;
  }
#pragma unroll
  for (int ci = 0; ci < 5; ++ci) red[(ty * 5 + ci) * 32 + tx] = acc[ci];
  __syncthreads();
  if (tid < 160) {
    const int ci = tid >> 5, x = tid & 31;
    float s = 0.f;
    for (int y = 0; y < 16; ++y) s += red[(y * 5 + ci) * 32 + x];
    const int col = cb * 32 + x;
    float* mod = (float*)(lws(p) + WS_MOD);
    mod[(l * 5 + ci) * 3072 + col] = s + lin(p, 11)[l * 3072 + col];
  }
  __syncthreads();
}

DI void ph0_s5(PR p, int t) {
  const int idx = t * NT + threadIdx.x;
  const int ldg = idx >> 6, pp = idx & 63;
  const float lre = lin(p, 13)[idx], lim = lin(p, 14)[idx], ls = lin(p, 15)[ldg];
  const float step = expf(ls);
  const float mag = expf(lre * step);
  float sn, cs; sincosf(lim * step, &sn, &cs);
  const float ar = mag * cs, ai = mag * sn;
  const float den = lre * lre + lim * lim;
  const float fr = ((ar - 1.f) * lre + ai * lim) / den;
  const float fi = (ai * lre - (ar - 1.f) * lim) / den;
  ((float*)(lws(p) + WS_S5AR))[idx] = ar;
  ((float*)(lws(p) + WS_S5AI))[idx] = ai;
  bf16_t* bb = (bf16_t*)(lws(p) + WS_S5BB) + (size_t)ldg * 128 * 16;
  bf16_t* ct = (bf16_t*)(lws(p) + WS_S5CT) + (size_t)ldg * 16 * 128;
  const float* bre = lin(p, 16) + (size_t)idx * 16;
  const float* bim = lin(p, 17) + (size_t)idx * 16;
#pragma unroll
  for (int i = 0; i < 16; ++i) {
    const float br = bre[i], bi = bim[i];
    bb[pp * 16 + i] = f2bf(fr * br - fi * bi);
    bb[(64 + pp) * 16 + i] = f2bf(fr * bi + fi * br);
    const float cr = lin(p, 18)[((size_t)ldg * 16 + i) * 64 + pp];
    const float cim = lin(p, 19)[((size_t)ldg * 16 + i) * 64 + pp];
    ct[i * 128 + pp] = f2bf(cr);
    ct[i * 128 + 64 + pp] = f2bf(-cim);
  }
}

DI void ph0_misc(PR p) {
  const int tid = threadIdx.x;
  float* rc = (float*)(lws(p) + WS_ROPE);
  for (int i = tid; i < 1024; i += NT) {
    const int pos = i >> 4, f = i & 15;
    const float inv = powf(10000.f, -(float)f / 16.f);
    const float ang = (float)pos * inv;
    float sn, cs; sincosf(ang, &sn, &cs);
    rc[i] = cs; rc[1024 + i] = sn;
  }
  if (tid < 2) {
    const int l = tid;
    const float* dl = lin(p, 22) + l * 256;
    float s0 = 0.f, s1 = 0.f;
    for (int i = 0; i < 64; ++i) { s0 += dl[i] * dl[64 + i]; s1 += dl[128 + i] * dl[192 + i]; }
    const float lam_init = 0.8f - 0.6f * expf(-0.3f * (float)l);
    ((float*)(lws(p) + WS_LAM))[l] = expf(s0) - expf(s1) + lam_init;
  }
  float* wba = (float*)(lws(p) + WS_WBA);
  for (int i = tid; i < 2 * 16 * 1024; i += NT) {
    const int l = i >> 14, j = (i >> 10) & 15, k = i & 1023;
    wba[i] = lin(p, 12)[((size_t)l * 1024 + k) * NIN + 5120 + j];
  }
}

DI void cvt_tile(const float* src, size_t ld_src, bf16_t* dst, size_t ld_dst, char* lds) {
  float* t = (float*)lds;
  const int tid = ltid();
  const int r = tid >> 4, c4 = (tid & 15) * 4;
#pragma unroll
  for (int ps = 0; ps < 2; ++ps) {
    const int k = r + 32 * ps;
    const f32x4 v = *(const f32x4*)(src + (size_t)k * ld_src + c4);
    t[k * 65 + c4 + 0] = v[0]; t[k * 65 + c4 + 1] = v[1]; t[k * 65 + c4 + 2] = v[2]; t[k * 65 + c4 + 3] = v[3];
  }
  __syncthreads();
  const int n = tid >> 3, kc = tid & 7;
  float v[8];
#pragma unroll
  for (int j = 0; j < 8; ++j) v[j] = t[(kc * 8 + j) * 65 + n];
  u32x4 o = {pack2(v[0], v[1]), pack2(v[2], v[3]), pack2(v[4], v[5]), pack2(v[6], v[7])};
  *(u32x4*)(dst + (size_t)n * ld_dst + kc * 8) = o;
  __syncthreads();
}

DI void cvt_win_tile(PR p, int l, int t, char* lds) {
  const int kt = t & 15, nt = t >> 4;
  const int n0 = nt * 64, nsrc = n0 < 5120 ? n0 : n0 + 16;
  cvt_tile(lin(p, 12) + ((size_t)l * 1024 + kt * 64) * NIN + nsrc, NIN,
           (bf16_t*)(lws(p) + WS_R1) + (size_t)n0 * 1024 + kt * 64, 1024, lds);
}
DI void cvt_other_tile(PR p, int t, char* lds) {
  if (t < 128) {
    const int l = t >> 6, q = t & 63, kt = q & 7, nt = q >> 3;
    cvt_tile(lin(p, 21) + ((size_t)l * 512 + kt * 64) * 512 + nt * 64, 512,
             (bf16_t*)(lws(p) + WS_WTGLU) + ((size_t)l * 512 + nt * 64) * 512 + kt * 64, 512, lds);
  } else if (t < 896) {
    const int u = t - 128, ln = u >> 7, q = u & 127, kt = q & 7, nt = q >> 3;
    cvt_tile(lin(p, 28) + ((size_t)ln * 512 + kt * 64) * 1024 + nt * 64, 1024,
             (bf16_t*)(lws(p) + WS_WTBR) + ((size_t)ln * 1024 + nt * 64) * 512 + kt * 64, 512, lds);
  } else {
    const int u = t - 896, l = u >> 8, q = u & 255, kt = q & 15, nt = q >> 4;
    cvt_tile(lin(p, 29) + ((size_t)l * 1024 + kt * 64) * 1024 + nt * 64, 1024,
             (bf16_t*)(lws(p) + WS_WTOUT) + ((size_t)l * 1024 + nt * 64) * 1024 + kt * 64, 1024, lds);
  }
}

DI void ph1_norm_rows(PR p, int l, int rb) {
  const int lane = ltid() & 63;
  const int r0 = rb * 2, ci = row_cond(r0);
  const float* mod = (const float*)(lws(p) + WS_MOD) + (size_t)(l * 5 + ci) * 3072;
  const float* ng = lin(p, 9) + l * 1024;
  const float* wba = (const float*)(lws(p) + WS_WBA) + (size_t)l * 16 * 1024;
  bf16_t* hn = (bf16_t*)(lws(p) + WS_R2);
  float h[2][16];
#pragma unroll
  for (int ri = 0; ri < 2; ++ri) {
    const float* x = x_in_row(p, l, r0 + ri);
    float ss = 0.f;
#pragma unroll
    for (int i = 0; i < 4; ++i) {
      const f32x4 v = *(const f32x4*)(x + (i * 64 + lane) * 4);
#pragma unroll
      for (int e = 0; e < 4; ++e) { h[ri][i * 4 + e] = v[e]; ss += v[e] * v[e]; }
    }
    ss = wave_sum(ss);
    const float rstd = rsqrtf(ss * (1.f / 1024.f) + EPS);
#pragma unroll
    for (int i = 0; i < 4; ++i) {
      const int k = (i * 64 + lane) * 4;
      const f32x4 g = *(const f32x4*)(ng + k);
      const f32x4 sh = *(const f32x4*)(mod + k);
      const f32x4 sc = *(const f32x4*)(mod + 1024 + k);
#pragma unroll
      for (int e = 0; e < 4; ++e) h[ri][i * 4 + e] = h[ri][i * 4 + e] * rstd * g[e] * (1.f + sc[e]) + sh[e];
      u32x2 o = {pack2(h[ri][i * 4 + 0], h[ri][i * 4 + 1]), pack2(h[ri][i * 4 + 2], h[ri][i * 4 + 3])};
      *(u32x2*)(hn + (size_t)(r0 + ri) * 1024 + k) = o;
    }
  }
  float pt[32];
#pragma unroll
  for (int j = 0; j < 16; ++j) {
    float a0 = 0.f, a1 = 0.f;
#pragma unroll
    for (int i = 0; i < 4; ++i) {
      const f32x4 w = *(const f32x4*)(wba + j * 1024 + (i * 64 + lane) * 4);
#pragma unroll
      for (int e = 0; e < 4; ++e) { a0 += h[0][i * 4 + e] * w[e]; a1 += h[1][i * 4 + e] * w[e]; }
    }
    pt[j] = a0; pt[16 + j] = a1;
    if ((j & 3) == 3) asm volatile("" ::: "memory");
  }
#pragma unroll
  for (int n = 16; n >= 1; n >>= 1) {
    const bool up = (lane & n) != 0;
#pragma unroll
    for (int i = 0; i < n; ++i) {
      const float keep = up ? pt[i + n] : pt[i];
      const float send = up ? pt[i] : pt[i + n];
      pt[i] = keep + __shfl_xor(send, n);
    }
  }
  const float v = pt[0] + __shfl_xor(pt[0], 32);
  if (lane < 32) {
    const int ri = lane >> 4, j = lane & 15;
    float res;
    if (j < 8) res = 1.f / (1.f + expf(-v));
    else {
      const int jj = j - 8;
      const float xx = v + lin(p, 26)[l * 8 + jj];
      const float sp = xx > 20.f ? xx : log1pf(expf(xx));
      res = -expf(lin(p, 25)[l * 8 + jj]) * sp;
    }
    ((float*)(lws(p) + WS_BETAG))[(size_t)(r0 + ri) * 16 + j] = res;
  }
}

constexpr int G_STAGE = 49152;
DI void gemm_gload(int tid, const bf16_t* A, size_t lda, const bf16_t* B, size_t ldb, int k0, u32x4 (&ra)[4], u32x4 (&rb)[2]) {
#pragma unroll
  for (int i = 0; i < 4; ++i) { const int id = tid + NT * i, row = id >> 3, ch = id & 7; ra[i] = *(const u32x4*)(A + (size_t)row * lda + k0 + ch * 8); }
#pragma unroll
  for (int i = 0; i < 2; ++i) { const int id = tid + NT * i, row = id >> 3, ch = id & 7; rb[i] = *(const u32x4*)(B + (size_t)row * ldb + k0 + ch * 8); }
}
DI void gemm_lstore(int tid, char* st, const u32x4 (&ra)[4], const u32x4 (&rb)[2]) {
#pragma unroll
  for (int i = 0; i < 4; ++i) { const int id = tid + NT * i, row = id >> 3, ch = id & 7; *(u32x4*)(st + row * 128 + ((ch ^ ((row >> 1) & 7)) << 4)) = ra[i]; }
#pragma unroll
  for (int i = 0; i < 2; ++i) { const int id = tid + NT * i, row = id >> 3, ch = id & 7; *(u32x4*)(st + 32768 + row * 128 + ((ch ^ ((row >> 1) & 7)) << 4)) = rb[i]; }
}
DI void gemm_compute(const char* st, f32x16 (&acc)[2][2], int wm, int wn, int lane) {
  const int r = lane & 31, h = lane >> 5, sw = (r >> 1) & 7;
#pragma unroll
  for (int s = 0; s < 4; ++s) {
    const int ch = ((2 * s + h) ^ sw) << 4;
    bf16x8 a[2], b[2];
#pragma unroll
    for (int mi = 0; mi < 2; ++mi) a[mi] = *(const bf16x8*)(st + (wm * 64 + mi * 32 + r) * 128 + ch);
#pragma unroll
    for (int ni = 0; ni < 2; ++ni) b[ni] = *(const bf16x8*)(st + 32768 + (wn * 64 + ni * 32 + r) * 128 + ch);
#pragma unroll
    for (int mi = 0; mi < 2; ++mi)
#pragma unroll
      for (int ni = 0; ni < 2; ++ni) acc[mi][ni] = MFMA32(a[mi], b[ni], acc[mi][ni]);
  }
}
DI void gemm_mainloop(int tid, const bf16_t* A, size_t lda, const bf16_t* B, size_t ldb, int K, f32x16 (&acc)[2][2], char* lds) {
  const int wave = tid >> 6, lane = tid & 63, wm = wave >> 1, wn = wave & 1;
  u32x4 ra[4], rb[2];
  gemm_gload(tid, A, lda, B, ldb, 0, ra, rb);
  gemm_lstore(tid, lds, ra, rb);
  __syncthreads();
  const int KT = K >> 6;
  for (int kt = 0; kt < KT; ++kt) {
    char* cur = lds + (kt & 1) * G_STAGE;
    char* nxt = lds + ((kt + 1) & 1) * G_STAGE;
    if (kt + 1 < KT) gemm_gload(tid, A, lda, B, ldb, (kt + 1) * 64, ra, rb);
    gemm_compute(cur, acc, wm, wn, lane);
    if (kt + 1 < KT) gemm_lstore(tid, nxt, ra, rb);
    __syncthreads();
  }
}
DI void acc_zero(f32x16 (&acc)[2][2]) {
#pragma unroll
  for (int a = 0; a < 2; ++a)
#pragma unroll
    for (int b = 0; b < 2; ++b)
#pragma unroll
      for (int i = 0; i < 16; ++i) acc[a][b][i] = 0.f;
}
DI void tile_store_bf16(int tid, const f32x16 (&acc)[2][2], bf16_t* dst, size_t ldd, char* lds) {
  const int wave = tid >> 6, lane = tid & 63, wm = wave >> 1, wn = wave & 1;
  const int cl = lane & 31, h = lane >> 5;
#pragma unroll
  for (int mi = 0; mi < 2; ++mi)
#pragma unroll
    for (int ni = 0; ni < 2; ++ni)
#pragma unroll
      for (int i = 0; i < 16; ++i) {
        const int row = wm * 64 + mi * 32 + (i & 3) + 8 * (i >> 2) + 4 * h;
        const int col = wn * 64 + ni * 32 + cl;
        *(bf16_t*)(lds + row * 272 + col * 2) = f2bf(acc[mi][ni][i]);
      }
  __syncthreads();
#pragma unroll
  for (int i = 0; i < 8; ++i) {
    const int id = tid + NT * i, row = id >> 4, ch = id & 15;
    const u32x4 v = *(const u32x4*)(lds + row * 272 + ch * 16);
    *(u32x4*)(dst + (size_t)row * ldd + ch * 8) = v;
  }
  __syncthreads();
}

DI void ph2_inproj_tile(PR p, int l, int t, char* lds) {
  const int tid = ltid();
  const int nt = t & 63, mt = t >> 6;
  const int m0 = mt * 256, n0 = nt * 128;
  const bf16_t* A = (const bf16_t*)(lws(p) + WS_R2) + (size_t)m0 * 1024;
  const bf16_t* B = (const bf16_t*)(lws(p) + WS_R1) + (size_t)n0 * 1024;
  f32x16 acc[2][2];
  acc_zero(acc);
  gemm_mainloop(tid, A, 1024, B, 1024, 1024, acc, lds);
  if (m0 < 4096 && n0 >= C_KB && n0 < C_ZB) {
    const int wave = tid >> 6, lane = tid & 63, wm = wave >> 1, wn = wave & 1;
    float* base = lout(p) + (n0 < C_VB ? O_CK : O_CV);
    const int cb = (n0 < C_VB ? n0 - C_KB : n0 - C_VB);
#pragma unroll
    for (int mi = 0; mi < 2; ++mi)
#pragma unroll
      for (int ni = 0; ni < 2; ++ni)
#pragma unroll
        for (int i = 0; i < 16; ++i) {
          const int row = m0 + wm * 64 + mi * 32 + (i & 3) + 8 * (i >> 2) + 4 * (lane >> 5);
          const int col = cb + wn * 64 + ni * 32 + (lane & 31);
          const int b = row >> 8, tt = row & 255;
          base[((size_t)(b * 2 + l) * 256 + tt) * 512 + col] = acc[mi][ni][i];
        }
  }
  tile_store_bf16(tid, acc, (bf16_t*)(lws(p) + WS_PROJ) + (size_t)m0 * NP + n0, NP, lds);
}

DI void ph6_merge_tile(PR p, int l, int t, char* lds) {
  const int tid = ltid();
  const int nt = t & 7, mt = t >> 3;
  const int m0 = mt * 256, n0 = nt * 128;
  const int wave = tid >> 6, lane = tid & 63, wm = wave >> 1, wn = wave & 1;
  const bf16_t* proj = (const bf16_t*)(lws(p) + WS_PROJ);
  f32x16 tot[2][2];
  acc_zero(tot);
#pragma unroll 1
  for (int n = 0; n < 3; ++n) {
    const int acol = n == 0 ? C_UA : (n == 1 ? C_QB : C_QC);
    const bf16_t* A = proj + (size_t)m0 * NP + acol;
    const bf16_t* B = (const bf16_t*)(lws(p) + WS_WTBR) + ((size_t)(l * 3 + n) * 1024 + n0) * 512;
    f32x16 acc[2][2];
    acc_zero(acc);
    gemm_mainloop(tid, A, NP, B, 512, 512, acc, lds);
#pragma unroll
    for (int mi = 0; mi < 2; ++mi)
#pragma unroll
      for (int ni = 0; ni < 2; ++ni)
#pragma unroll
        for (int i = 0; i < 16; ++i) {
          const int row = m0 + wm * 64 + mi * 32 + (i & 3) + 8 * (i >> 2) + 4 * (lane >> 5);
          const int col = n0 + wn * 64 + ni * 32 + (lane & 31);
          const float g = bf2f(proj[(size_t)row * NP + C_GT + n * 1024 + col]);
          tot[mi][ni][i] += sigmoidf_(g) * acc[mi][ni][i];
          if (i == 15) asm volatile("" ::: "memory");
        }
  }
  tile_store_bf16(tid, tot, (bf16_t*)(lws(p) + WS_R2) + (size_t)m0 * 1024 + n0, 1024, lds);
}

DI void ph7_out_tile(PR p, int l, int t, char* lds) {
  const int tid = ltid();
  const int nt = t & 7, mt = t >> 3;
  const int m0 = mt * 256, n0 = nt * 128;
  const int wave = tid >> 6, lane = tid & 63, wm = wave >> 1, wn = wave & 1;
  const bf16_t* A = (const bf16_t*)(lws(p) + WS_R2) + (size_t)m0 * 1024;
  const bf16_t* B = (const bf16_t*)(lws(p) + WS_WTOUT) + ((size_t)l * 1024 + n0) * 1024;
  f32x16 acc[2][2];
  acc_zero(acc);
  gemm_mainloop(tid, A, 1024, B, 1024, 1024, acc, lds);
  float* ct = (float*)lds;
#pragma unroll
  for (int mi = 0; mi < 2; ++mi)
#pragma unroll
    for (int ni = 0; ni < 2; ++ni)
#pragma unroll
      for (int i = 0; i < 16; ++i) {
        const int row = wm * 64 + mi * 32 + (i & 3) + 8 * (i >> 2) + 4 * (lane >> 5);
        const int col = wn * 64 + ni * 32 + (lane & 31);
        ct[row * 132 + col] = acc[mi][ni][i];
      }
  __syncthreads();
  const float* mod = (const float*)(lws(p) + WS_MOD) + (size_t)l * 5 * 3072;
#pragma unroll 4
  for (int i = 0; i < 16; ++i) {
    const int id = tid + NT * i, row = id >> 5, c4 = (id & 31) * 4;
    const int grow = m0 + row, gcol = n0 + c4;
    const f32x4 y = *(const f32x4*)(ct + row * 132 + c4);
    const f32x4 gate = *(const f32x4*)(mod + row_cond(grow) * 3072 + 2048 + gcol);
    const f32x4 xo = *(const f32x4*)(x_in_row(p, l, grow) + gcol);
    f32x4 o;
#pragma unroll
    for (int e = 0; e < 4; ++e) o[e] = xo[e] + gate[e] * y[e];
    *(f32x4*)(lout(p) + O_Y + (size_t)grow * DM + gcol) = o;
  }
  __syncthreads();
}

DI void ph_final_row(PR p, int r) {
  const int lane = ltid() & 63;
  float* x = lout(p) + O_Y + (size_t)r * DM;
  f32x4 v[4];
  float ss = 0.f;
#pragma unroll
  for (int i = 0; i < 4; ++i) { v[i] = *(const f32x4*)(x + (i * 64 + lane) * 4); ss += v[i][0] * v[i][0] + v[i][1] * v[i][1] + v[i][2] * v[i][2] + v[i][3] * v[i][3]; }
  ss = wave_sum(ss);
  const float rstd = rsqrtf(ss * (1.f / 1024.f) + EPS);
#pragma unroll
  for (int i = 0; i < 4; ++i) {
    const f32x4 g = *(const f32x4*)(lin(p, 30) + (i * 64 + lane) * 4);
    f32x4 o;
#pragma unroll
    for (int e = 0; e < 4; ++e) o[e] = v[i][e] * rstd * g[e];
    *(f32x4*)(x + (i * 64 + lane) * 4) = o;
  }
}

constexpr int S5_WLDS = 8192 + 4352;
DI void s5_task(PR p, int l, int s, int d, int g, char* wl) {
  const int lane = ltid() & 63, q = lane >> 4, c = lane & 15;
  const int ldg = (l * 2 + d) * 32 + g;
  const int R0 = seq_row0(s), T = seq_len(s);
  float* BU = (float*)wl;
  char* H = wl + 8192;
  const bf16_t* proj = (const bf16_t*)(lws(p) + WS_PROJ);
  bf16_t* yd = (bf16_t*)(lws(p) + WS_R2) + (size_t)d * MROWS * 512;
  const bf16_t* bb = (const bf16_t*)(lws(p) + WS_S5BB) + (size_t)ldg * 128 * 16;
  const bf16_t* ct = (const bf16_t*)(lws(p) + WS_S5CT) + (size_t)ldg * 16 * 128;
  bf16x8 bfr[8], cfr[4];
  const bf16x8 zero8 = {0, 0, 0, 0, 0, 0, 0, 0};
#pragma unroll
  for (int nt = 0; nt < 8; ++nt) bfr[nt] = q < 2 ? *(const bf16x8*)(bb + (nt * 16 + c) * 16 + 8 * q) : zero8;
#pragma unroll
  for (int ks = 0; ks < 4; ++ks) cfr[ks] = *(const bf16x8*)(ct + c * 128 + 32 * ks + 8 * q);
  const float ar = ((const float*)(lws(p) + WS_S5AR))[ldg * 64 + lane];
  const float ai = ((const float*)(lws(p) + WS_S5AI))[ldg * 64 + lane];
  float hr = 0.f, hi = 0.f;
  if (s >= 16) {
    const size_t si = ((((size_t)(s - 16) * 2 + l) * 2 + d) * 32 + g) * 64 + lane;
    hr = lin(p, 4)[si]; hi = lin(p, 5)[si];
  }
  const int nb = T >> 4;
  auto load_u = [&](int blk) -> bf16x8 {
    const int n = blk * 16 + c;
    const int t = d ? (T - 1 - n) : n;
    if (q < 2) return *(const bf16x8*)(proj + (size_t)(R0 + t) * NP + C_UA + g * 16 + 8 * q);
    return zero8;
  };
  bf16x8 ucur = load_u(0);
#pragma unroll 1
  for (int blk = 0; blk < nb; ++blk) {
    bf16x8 unext = zero8;
    if (blk + 1 < nb) unext = load_u(blk + 1);
#pragma unroll
    for (int nt = 0; nt < 8; ++nt) {
      f32x4 z = {0.f, 0.f, 0.f, 0.f};
      const f32x4 dv = MFMA16(ucur, bfr[nt], z);
#pragma unroll
      for (int r = 0; r < 4; ++r) BU[(4 * q + r) * 128 + nt * 16 + c] = dv[r];
    }
#pragma unroll
    for (int i = 0; i < 16; ++i) {
      const float br = BU[i * 128 + lane], bi = BU[i * 128 + 64 + lane];
      const float nr = ar * hr - ai * hi + br;
      const float ni = ar * hi + ai * hr + bi;
      hr = nr; hi = ni;
      *(bf16_t*)(H + i * 272 + lane * 2) = f2bf(hr);
      *(bf16_t*)(H + i * 272 + 128 + lane * 2) = f2bf(hi);
    }
    f32x4 y = {0.f, 0.f, 0.f, 0.f};
#pragma unroll
    for (int ks = 0; ks < 4; ++ks) {
      const bf16x8 a = *(const bf16x8*)(H + c * 272 + (32 * ks + 8 * q) * 2);
      y = MFMA16(a, cfr[ks], y);
    }
#pragma unroll
    for (int r = 0; r < 4; ++r) {
      const int n = blk * 16 + 4 * q + r;
      const int t = d ? (T - 1 - n) : n;
      yd[(size_t)(R0 + t) * 512 + g * 16 + c] = f2bf(y[r]);
    }
    ucur = unext;
  }
  if (s < 16) {
    const size_t so = ((((size_t)s * 2 + l) * 2 + d) * 32 + g) * 64 + lane;
    lout(p)[O_SR + so] = hr; lout(p)[O_SI + so] = hi;
  }
}

DI float gelu_tanh(float x) {
  const float z = 0.7978845608028654f * (x + 0.044715f * x * x * x);
  const float e = __expf(2.f * z);
  const float th = 1.f - 2.f / (e + 1.f);
  return 0.5f * x * (1.f + th);
}
DI void glu_tile(PR p, int l, int t, char* lds) {
  const int tid = ltid(), wave = tid >> 6, lane = tid & 63;
  const int m0 = t * 32;
  float* Yf = (float*)lds;
  char* Ya = lds + 66048;
  bf16_t* proj = (bf16_t*)(lws(p) + WS_PROJ);
  const bf16_t* yd0 = (const bf16_t*)(lws(p) + WS_R2);
  const bf16_t* yd1 = yd0 + (size_t)MROWS * 512;
  const float* s5d = lin(p, 20) + l * 512;
  {
    const int row = tid >> 4;
#pragma unroll
    for (int i = 0; i < 4; ++i) {
      const int c0 = (tid & 15) * 8 + 128 * i;
      const u32x4 uu = *(const u32x4*)(proj + (size_t)(m0 + row) * NP + C_UA + c0);
      const u32x4 a0 = *(const u32x4*)(yd0 + (size_t)(m0 + row) * 512 + c0);
      const u32x4 a1 = *(const u32x4*)(yd1 + (size_t)(m0 + row) * 512 + c0);
      float y[8];
#pragma unroll
      for (int e = 0; e < 4; ++e) {
        y[2 * e]     = gelu_tanh(s5d[c0 + 2 * e] * lo_f(uu[e]) + lo_f(a0[e]) + lo_f(a1[e]));
        y[2 * e + 1] = gelu_tanh(s5d[c0 + 2 * e + 1] * hi_f(uu[e]) + hi_f(a0[e]) + hi_f(a1[e]));
      }
#pragma unroll
      for (int e = 0; e < 8; ++e) Yf[row * 516 + c0 + e] = y[e];
      const u32x4 o = {pack2(y[0], y[1]), pack2(y[2], y[3]), pack2(y[4], y[5]), pack2(y[6], y[7])};
      const int ch = c0 >> 3;
      *(u32x4*)(Ya + row * 1024 + ((ch ^ (row & 15)) << 4)) = o;
    }
  }
  __syncthreads();
  const int r = lane & 31, h = lane >> 5;
  const bf16_t* W = (const bf16_t*)(lws(p) + WS_WTGLU) + (size_t)l * 512 * 512;
  f32x16 acc[2];
#pragma unroll
  for (int i = 0; i < 16; ++i) { acc[0][i] = 0.f; acc[1][i] = 0.f; }
#pragma unroll 4
  for (int s = 0; s < 32; ++s) {
    const int ch = 2 * s + h;
    const bf16x8 a = *(const bf16x8*)(Ya + r * 1024 + ((ch ^ (r & 15)) << 4));
#pragma unroll
    for (int ni = 0; ni < 2; ++ni) {
      const bf16x8 b = *(const bf16x8*)(W + (size_t)(wave * 64 + ni * 32 + r) * 512 + ch * 8);
      acc[ni] = MFMA32(a, b, acc[ni]);
    }
  }
#pragma unroll
  for (int ni = 0; ni < 2; ++ni)
#pragma unroll
    for (int i = 0; i < 16; ++i) {
      const int row = (i & 3) + 8 * (i >> 2) + 4 * h;
      const int col = wave * 64 + ni * 32 + r;
      const float y = Yf[row * 516 + col];
      const float z = bf2f(proj[(size_t)(m0 + row) * NP + C_ZA + col]);
      proj[(size_t)(m0 + row) * NP + C_UA + col] = f2bf(y * sigmoidf_(acc[ni][i]) * siluf_(z));
    }
  __syncthreads();
}

DI void ph5_row(PR p, int l, int r) {
  const int lane = ltid() & 63;
  const int c0 = lane * 8;
  bf16_t* proj = (bf16_t*)(lws(p) + WS_PROJ);
  const bf16_t* o0 = (const bf16_t*)(lws(p) + WS_R1);
  const bf16_t* o1 = o0 + (size_t)MROWS * 512;
  const u32x4 a = *(const u32x4*)(o0 + (size_t)r * 512 + c0);
  const u32x4 b = *(const u32x4*)(o1 + (size_t)r * 512 + c0);
  const u32x4 zz = *(const u32x4*)(proj + (size_t)r * NP + C_ZC + c0);
  float o[8];
  float ss = 0.f;
#pragma unroll
  for (int e = 0; e < 4; ++e) {
    o[2 * e] = lo_f(a[e]) + lo_f(b[e]); o[2 * e + 1] = hi_f(a[e]) + hi_f(b[e]);
    ss += o[2 * e] * o[2 * e] + o[2 * e + 1] * o[2 * e + 1];
  }
#pragma unroll
  for (int off = 1; off <= 8; off <<= 1) ss += __shfl_xor(ss, off);
  const float rstd = rsqrtf(ss * (1.f / 128.f) + EPS);
  const float* g = lin(p, 27) + l * 128 + (c0 & 127);
  float v[8];
#pragma unroll
  for (int e = 0; e < 4; ++e) {
    v[2 * e] = o[2 * e] * rstd * g[2 * e] * siluf_(lo_f(zz[e]));
    v[2 * e + 1] = o[2 * e + 1] * rstd * g[2 * e + 1] * siluf_(hi_f(zz[e]));
  }
  const u32x4 w = {pack2(v[0], v[1]), pack2(v[2], v[3]), pack2(v[4], v[5]), pack2(v[6], v[7])};
  *(u32x4*)(proj + (size_t)r * NP + C_QC + c0) = w;
}

constexpr int AT_K = 8192, AT_STAGE = 16384;
DI void att_gload(int tid, PR p, int l, int s, int h, int kt, u32x4& ka, u32x4& kb, u32x4& va, u32x4& vb) {
  const int key = tid >> 4, ch = tid & 15;
  const int j = kt * 32 + key;
  const int R0 = seq_row0(s);
  const bf16_t* proj = (const bf16_t*)(lws(p) + WS_PROJ);
  if (s < 16 || j < 1024) {
    const bf16_t* kr = proj + (size_t)(R0 + j) * NP + C_KB + h * 128;
    ka = *(const u32x4*)(kr + ch * 8);
    kb = *(const u32x4*)(kr + (ch ^ 2) * 8);
    va = *(const u32x4*)(proj + (size_t)(R0 + j) * NP + C_VB + h * 128 + ch * 8);
    vb = va;
  } else {
    const int b = s - 16, jc = j - 1024;
    const float* kc = lin(p, 2) + (((size_t)(b * 2 + l) * 512 + jc) * 4 + h) * 128 + ch * 8;
    const float* vc = lin(p, 3) + (((size_t)(b * 2 + l) * 512 + jc) * 4 + h) * 128 + ch * 8;
    ka = *(const u32x4*)kc; kb = *(const u32x4*)(kc + 4);
    va = *(const u32x4*)vc; vb = *(const u32x4*)(vc + 4);
  }
}
DI void att_lstore(int tid, PR p, int s, int kt, const u32x4& ka, const u32x4& kb, const u32x4& va, const u32x4& vb, char* stage) {
  const int key = tid >> 4, ch = tid & 15;
  const int j = kt * 32 + key;
  u32x4 ko, vo;
  if (s < 16) { ko = ka; vo = va; }
  else if (j < 1024) {
    const int pos = (ch & 4) ? (j & 63) : (j >> 6);
    const float* rc = (const float*)(lws(p) + WS_ROPE) + pos * 16 + (ch & 1) * 8;
    const float sg = (ch & 2) ? 1.f : -1.f;
    float o[8];
#pragma unroll
    for (int e = 0; e < 4; ++e) {
      const float c0 = rc[2 * e], c1 = rc[2 * e + 1], s0 = rc[1024 + 2 * e], s1 = rc[1024 + 2 * e + 1];
      o[2 * e]     = lo_f(ka[e]) * c0 + sg * lo_f(kb[e]) * s0;
      o[2 * e + 1] = hi_f(ka[e]) * c1 + sg * hi_f(kb[e]) * s1;
    }
    ko = u32x4{pack2(o[0], o[1]), pack2(o[2], o[3]), pack2(o[4], o[5]), pack2(o[6], o[7])};
    vo = va;
  } else {
    ko = u32x4{pack2(__uint_as_float(ka[0]), __uint_as_float(ka[1])), pack2(__uint_as_float(ka[2]), __uint_as_float(ka[3])),
               pack2(__uint_as_float(kb[0]), __uint_as_float(kb[1])), pack2(__uint_as_float(kb[2]), __uint_as_float(kb[3]))};
    vo = u32x4{pack2(__uint_as_float(va[0]), __uint_as_float(va[1])), pack2(__uint_as_float(va[2]), __uint_as_float(va[3])),
               pack2(__uint_as_float(vb[0]), __uint_as_float(vb[1])), pack2(__uint_as_float(vb[2]), __uint_as_float(vb[3]))};
  }
  *(u32x4*)(stage + key * 256 + ((ch ^ (key & 15)) << 4)) = ko;
  const int et = ch >> 1, hf = ch & 1;
  *(u32x4*)(stage + AT_K + key * 256 + ((((et ^ (key & 7)) << 1) | hf) << 4)) = vo;
}

DI void att_task(PR p, int l, int s, int h, int qb, char* lds) {
  const int tid = ltid(), wave = tid >> 6, lane = tid & 63, q = lane >> 4, c = lane & 15;
  const int R0 = seq_row0(s), T = seq_len(s);
  const int nkeys = s < 16 ? 256 : 1536, nkt = nkeys >> 5;
  bf16_t* proj = (bf16_t*)(lws(p) + WS_PROJ);
  const int tq = qb * 128 + wave * 16 + c;
  const size_t qrow = (size_t)(R0 + tq) * NP;
  bf16x8 qf[2][2];
#pragma unroll
  for (int m = 0; m < 2; ++m)
#pragma unroll
    for (int ks = 0; ks < 2; ++ks) {
      const int d0 = 32 * ks + 8 * q;
      const u32x4 own = *(const u32x4*)(proj + qrow + C_QB + h * 128 + m * 64 + d0);
      float o[8];
      if (s >= 16) {
        const u32x4 par = *(const u32x4*)(proj + qrow + C_QB + h * 128 + m * 64 + (d0 ^ 16));
        const int pos = ks ? (tq & 63) : (tq >> 6);
        const float* rc = (const float*)(lws(p) + WS_ROPE) + pos * 16 + (q & 1) * 8;
        const float sg = (q & 2) ? 1.f : -1.f;
#pragma unroll
        for (int e = 0; e < 4; ++e) {
          o[2 * e]     = lo_f(own[e]) * rc[2 * e] + sg * lo_f(par[e]) * rc[1024 + 2 * e];
          o[2 * e + 1] = hi_f(own[e]) * rc[2 * e + 1] + sg * hi_f(par[e]) * rc[1024 + 2 * e + 1];
        }
      } else {
#pragma unroll
        for (int e = 0; e < 4; ++e) { o[2 * e] = lo_f(own[e]); o[2 * e + 1] = hi_f(own[e]); }
      }
      qf[m][ks] = mk8(pack2(o[0] * 0.125f, o[1] * 0.125f), pack2(o[2] * 0.125f, o[3] * 0.125f),
                      pack2(o[4] * 0.125f, o[5] * 0.125f), pack2(o[6] * 0.125f, o[7] * 0.125f));
    }
  f32x4 O[2][8];
#pragma unroll
  for (int m = 0; m < 2; ++m)
#pragma unroll
    for (int et = 0; et < 8; ++et) O[m][et] = f32x4{0.f, 0.f, 0.f, 0.f};
  float mx[2] = {-1e30f, -1e30f}, lsum[2] = {0.f, 0.f};

  u32x4 ska, skb, sva, svb;
  att_gload(tid, p, l, s, h, 0, ska, skb, sva, svb);
  __syncthreads();
  att_lstore(tid, p, s, 0, ska, skb, sva, svb, lds);
  __syncthreads();
#pragma unroll 1
  for (int kt = 0; kt < nkt; ++kt) {
    const char* cur = lds + (kt & 1) * AT_STAGE;
    if (kt + 1 < nkt) att_gload(tid, p, l, s, h, kt + 1, ska, skb, sva, svb);
    f32x4 S[2][2];
#pragma unroll
    for (int m = 0; m < 2; ++m)
#pragma unroll
      for (int k2 = 0; k2 < 2; ++k2) {
        f32x4 acc = {0.f, 0.f, 0.f, 0.f};
#pragma unroll
        for (int ks = 0; ks < 2; ++ks) {
          const int key = k2 * 16 + c;
          const bf16x8 a = *(const bf16x8*)(cur + key * 256 + (((m * 8 + ks * 4 + q) ^ (key & 15)) << 4));
          acc = MFMA16(a, qf[m][ks], acc);
        }
        S[m][k2] = acc;
      }
    bf16x8 pf[2];
#pragma unroll
    for (int m = 0; m < 2; ++m) {
      float tm = fmaxf(fmaxf(fmaxf(S[m][0][0], S[m][0][1]), fmaxf(S[m][0][2], S[m][0][3])),
                       fmaxf(fmaxf(S[m][1][0], S[m][1][1]), fmaxf(S[m][1][2], S[m][1][3])));
      tm = fmaxf(tm, __shfl_xor(tm, 16));
      tm = fmaxf(tm, __shfl_xor(tm, 32));
      const float mn = fmaxf(mx[m], tm);
      const float alpha = __expf(mx[m] - mn);
      mx[m] = mn;
      float pv[8], ps = 0.f;
#pragma unroll
      for (int k2 = 0; k2 < 2; ++k2)
#pragma unroll
        for (int r = 0; r < 4; ++r) { pv[k2 * 4 + r] = __expf(S[m][k2][r] - mn); ps += pv[k2 * 4 + r]; }
      lsum[m] = lsum[m] * alpha + ps;
#pragma unroll
      for (int et = 0; et < 8; ++et) O[m][et] *= alpha;
      pf[m] = mk8(pack2(pv[0], pv[1]), pack2(pv[2], pv[3]), pack2(pv[4], pv[5]), pack2(pv[6], pv[7]));
    }
    {
      const int qq = c >> 2, pp = c & 3;
      const int kA = 4 * q + qq, kB = 16 + 4 * q + qq;
#pragma unroll
      for (int et = 0; et < 8; ++et) {
        const char* aA = cur + AT_K + kA * 256 + (((et ^ (kA & 7)) << 5)) + pp * 8;
        const char* aB = cur + AT_K + kB * 256 + (((et ^ (kB & 7)) << 5)) + pp * 8;
        const s16x4 lo = __builtin_amdgcn_ds_read_tr16_b64_v4i16((s16x4 LAS*)(const LAS char*)aA);
        const s16x4 hi = __builtin_amdgcn_ds_read_tr16_b64_v4i16((s16x4 LAS*)(const LAS char*)aB);
        const bf16x8 vf = __builtin_shufflevector(lo, hi, 0, 1, 2, 3, 4, 5, 6, 7);
        O[0][et] = MFMA16(vf, pf[0], O[0][et]);
        O[1][et] = MFMA16(vf, pf[1], O[1][et]);
      }
    }
    if (kt + 1 < nkt) att_lstore(tid, p, s, kt + 1, ska, skb, sva, svb, lds + ((kt + 1) & 1) * AT_STAGE);
    __syncthreads();
  }
#pragma unroll
  for (int m = 0; m < 2; ++m) { lsum[m] += __shfl_xor(lsum[m], 16); lsum[m] += __shfl_xor(lsum[m], 32); }
  const float lam = ((const float*)(lws(p) + WS_LAM))[l];
  const float lam_init = 0.8f - 0.6f * expf(-0.3f * (float)l);
  const float i0 = 1.f / lsum[0], i1 = lam / lsum[1];
  float ss = 0.f;
#pragma unroll
  for (int et = 0; et < 8; ++et)
#pragma unroll
    for (int r = 0; r < 4; ++r) { const float o = O[0][et][r] * i0 - O[1][et][r] * i1; O[0][et][r] = o; ss += o * o; }
  ss += __shfl_xor(ss, 16); ss += __shfl_xor(ss, 32);
  const float rstd = rsqrtf(ss * (1.f / 128.f) + EPS) * (1.f - lam_init);
  const float* g = lin(p, 23) + l * 128;
#pragma unroll
  for (int et = 0; et < 8; ++et) {
    const int e0 = 16 * et + 4 * q;
    const u32x2 zz = *(const u32x2*)(proj + qrow + C_ZB + h * 128 + e0);
    const float v0 = O[0][et][0] * rstd * g[e0 + 0] * siluf_(lo_f(zz[0]));
    const float v1 = O[0][et][1] * rstd * g[e0 + 1] * siluf_(hi_f(zz[0]));
    const float v2 = O[0][et][2] * rstd * g[e0 + 2] * siluf_(lo_f(zz[1]));
    const float v3 = O[0][et][3] * rstd * g[e0 + 3] * siluf_(hi_f(zz[1]));
    const u32x2 w = {pack2(v0, v1), pack2(v2, v3)};
    *(u32x2*)(proj + qrow + C_QB + h * 128 + e0) = w;
  }
}

constexpr int DP_QF = 0, DP_KF = 33792, DP_VF = 67584, DP_MT = 101376, DP_SM = 134144;
DI int kmap8(int ks, int q, int j) { return 32 * ks + 4 * q + (j & 3) + 16 * (j >> 2); }

DI void dn_prep_task(PR p, int l, int gc, int h, char* lds) {
  const int tid = ltid(), lane = tid & 63, q = lane >> 4, c = lane & 15;
  int s, oc;
  if (gc < 64) { s = gc >> 2; oc = gc & 3; } else { s = 16 + ((gc - 64) >> 4); oc = (gc - 64) & 15; }
  const int R0 = seq_row0(s), T = seq_len(s), t0 = oc * 64;
  const bf16_t* proj = (const bf16_t*)(lws(p) + WS_PROJ);
  float* qf = (float*)(lds + DP_QF);
  float* kf = (float*)(lds + DP_KF);
  float* vf = (float*)(lds + DP_VF);
  float* mT = (float*)(lds + DP_MT);
  float* sm = (float*)(lds + DP_SM);
  __syncthreads();
  if (tid < 384) {
    const int cg = tid % 48, rg = tid / 48;
    const int which = cg >> 4, ch0 = (cg & 15) * 8;
    const int col = C_QC + which * 512 + h * 128 + ch0;
    const float* cw = lin(p, 24) + (size_t)l * 5 * 1536 + which * 512 + h * 128 + ch0;
    float w[5][8];
#pragma unroll
    for (int j = 0; j < 5; ++j)
#pragma unroll
      for (int e = 0; e < 8; ++e) w[j][e] = cw[j * 1536 + e];
    float xin[12][8];
#pragma unroll
    for (int i = 0; i < 12; ++i) {
      const int t = t0 + rg * 8 + i - 2;
      u32x4 v = {0u, 0u, 0u, 0u};
      if (t >= 0 && t < T) v = *(const u32x4*)(proj + (size_t)(R0 + t) * NP + col);
#pragma unroll
      for (int e = 0; e < 4; ++e) { xin[i][2 * e] = lo_f(v[e]); xin[i][2 * e + 1] = hi_f(v[e]); }
    }
    float* dst = which == 0 ? qf : (which == 1 ? kf : vf);
#pragma unroll
    for (int i = 0; i < 8; ++i) {
#pragma unroll
      for (int e = 0; e < 8; ++e) {
        float a = 0.f;
#pragma unroll
        for (int j = 0; j < 5; ++j) a += w[j][e] * xin[i + j][e];
        dst[(rg * 8 + i) * 132 + ch0 + e] = siluf_(a);
      }
    }
  }
  if ((tid & 255) < 64) {
    const int d = tid >> 8;
    const int io = d ? 63 - lane : lane;
    const float* bg = (const float*)(lws(p) + WS_BETAG) + (size_t)(R0 + t0 + io) * 16;
    const float beta = bg[d * 4 + h];
    float g = bg[8 + d * 4 + h];
#pragma unroll
    for (int o = 1; o < 64; o <<= 1) { const float n = __shfl_up(g, o); if (lane >= o) g += n; }
    sm[d * 64 + lane] = beta;
    sm[128 + d * 64 + lane] = g;
    sm[256 + d * 64 + lane] = __expf(g);
  }
  __syncthreads();
  {
    const int wave = tid >> 6;
#pragma unroll 1
    for (int i = 0; i < 16; ++i) {
      const int id = wave * 16 + i, row = id & 63, which = id >> 6;
      float* a = (which ? kf : qf) + row * 132;
      const float v0 = a[lane], v1 = a[64 + lane];
      const float ss = wave_sum(v0 * v0 + v1 * v1);
      const float sc = rsqrtf(ss + EPS) * (which ? 1.f : 0.08838834764831845f);
      a[lane] = v0 * sc; a[64 + lane] = v1 * sc;
    }
  }
  __syncthreads();
  const int d = tid >> 8, w4 = (tid >> 6) & 3;
  const float* beta_s = sm + d * 64;
  const float* gc_s = sm + 128 + d * 64;
  const float* eg_s = sm + 256 + d * 64;
  unsigned char* slot = lws(p) + WS_DNP + (size_t)((gc * 4 + h) * 2 + d) * DNP_SLOT;
  auto orow = [&](int i) -> int { return d ? 63 - i : i; };
  auto ldfrag = [&](const float* base, int row, int ks) -> bf16x8 {
    const f32x4 a = *(const f32x4*)(base + row * 132 + 32 * ks + 8 * q);
    const f32x4 b = *(const f32x4*)(base + row * 132 + 32 * ks + 8 * q + 4);
    return mk8(pack2(a[0], a[1]), pack2(a[2], a[3]), pack2(b[0], b[1]), pack2(b[2], b[3]));
  };
  {
    const int it = w4;
    bf16x8 kfr_i[4], qfr_i[4];
#pragma unroll
    for (int ks = 0; ks < 4; ++ks) { kfr_i[ks] = ldfrag(kf, orow(16 * it + c), ks); qfr_i[ks] = ldfrag(qf, orow(16 * it + c), ks); }
    f32x4 kq[4];
#pragma unroll
    for (int jt = 0; jt < 4; ++jt) {
      f32x4 kk = {0.f, 0.f, 0.f, 0.f}, kq_ = {0.f, 0.f, 0.f, 0.f};
#pragma unroll
      for (int ks = 0; ks < 4; ++ks) {
        const bf16x8 kfr_j = ldfrag(kf, orow(16 * jt + c), ks);
        kk = MFMA16(kfr_i[ks], kfr_j, kk);
        kq_ = MFMA16(kfr_j, qfr_i[ks], kq_);
      }
      {
        const int j = 16 * jt + c;
        const float gj = gc_s[j];
#pragma unroll
        for (int r = 0; r < 4; ++r) {
          const int i = 16 * it + 4 * q + r;
          const float v = i > j ? beta_s[i] * kk[r] * __expf(gc_s[i] - gj) : 0.f;
          mT[d * 4096 + j * 64 + i] = v;
        }
      }
      {
        const int i = 16 * it + c;
        const float gi = gc_s[i];
#pragma unroll
        for (int r = 0; r < 4; ++r) {
          const int j = 16 * jt + 4 * q + r;
          kq_[r] = i >= j ? kq_[r] * __expf(gi - gc_s[j]) : 0.f;
        }
      }
      kq[jt] = kq_;
    }
#pragma unroll
    for (int ks2 = 0; ks2 < 2; ++ks2) {
      const f32x4 a = kq[2 * ks2], b = kq[2 * ks2 + 1];
      const u32x4 o = {pack2(a[0], a[1]), pack2(a[2], a[3]), pack2(b[0], b[1]), pack2(b[2], b[3])};
      *(u32x4*)(slot + SL_QK + ((it * 2 + ks2) * 64 + lane) * 16) = o;
    }
    {
      const int i = 16 * it + c, io = orow(i);
      const float egi = eg_s[i];
#pragma unroll
      for (int ks = 0; ks < 4; ++ks) {
        const f32x4 a = *(const f32x4*)(qf + io * 132 + 32 * ks + 4 * q);
        const f32x4 b = *(const f32x4*)(qf + io * 132 + 32 * ks + 16 + 4 * q);
        const u32x4 o = {pack2(a[0] * egi, a[1] * egi), pack2(a[2] * egi, a[3] * egi), pack2(b[0] * egi, b[1] * egi), pack2(b[2] * egi, b[3] * egi)};
        *(u32x4*)(slot + SL_QG + ((it * 4 + ks) * 64 + lane) * 16) = o;
      }
    }
    {
      const float gl = gc_s[63];
#pragma unroll
      for (int mm = 0; mm < 2; ++mm) {
        const int mt8 = 2 * w4 + mm, dk = 16 * mt8 + c;
#pragma unroll
        for (int ks2 = 0; ks2 < 2; ++ks2) {
          float v[8];
#pragma unroll
          for (int j = 0; j < 8; ++j) {
            const int i = kmap8(ks2, q, j);
            v[j] = kf[orow(i) * 132 + dk] * __expf(gl - gc_s[i]);
          }
          const u32x4 o = {pack2(v[0], v[1]), pack2(v[2], v[3]), pack2(v[4], v[5]), pack2(v[6], v[7])};
          *(u32x4*)(slot + SL_KGT + ((mt8 * 2 + ks2) * 64 + lane) * 16) = o;
        }
      }
      if (w4 == 0 && lane == 0) ((float*)(lws(p) + WS_EGL))[(gc * 4 + h) * 2 + d] = __expf(gl);
    }
  }
  bf16_t* XA = (bf16_t*)(lds + DP_QF) + d * 32 * 260;
  bf16_t* XB = (bf16_t*)(lds + DP_KF) + d * 32 * 260;
  const int col = tid & 255;
  const float* rsrc = col < 128 ? vf + col : kf + (col - 128);
  const float* mcol = mT + d * 4096;
  float x[32];
#pragma unroll
  for (int i = 0; i < 32; ++i) {
    const float sc = col < 128 ? beta_s[i] : beta_s[i] * eg_s[i];
    x[i] = rsrc[orow(i) * 132] * sc;
  }
  __syncthreads();
#pragma unroll
  for (int j = 0; j < 31; ++j) {
    const float xj = x[j];
#pragma unroll
    for (int i4 = ((j + 1) & ~3); i4 < 32; i4 += 4) {
      const f32x4 mm = *(const f32x4*)(mcol + j * 64 + i4);
      if (i4 + 0 > j) x[i4 + 0] -= mm[0] * xj;
      if (i4 + 1 > j) x[i4 + 1] -= mm[1] * xj;
      if (i4 + 2 > j) x[i4 + 2] -= mm[2] * xj;
      if (i4 + 3 > j) x[i4 + 3] -= mm[3] * xj;
    }
  }
#pragma unroll
  for (int i = 0; i < 32; ++i) XA[i * 260 + col] = f2bf(x[i]);
  __syncthreads();
#pragma unroll
  for (int i = 0; i < 32; ++i) {
    const float sc = col < 128 ? beta_s[32 + i] : beta_s[32 + i] * eg_s[32 + i];
    x[i] = rsrc[orow(32 + i) * 132] * sc;
  }
#pragma unroll 4
  for (int j = 0; j < 32; ++j) {
    const float xj = bf2f(XA[j * 260 + col]);
#pragma unroll
    for (int i4 = 0; i4 < 8; ++i4) {
      const f32x4 mm = *(const f32x4*)(mcol + j * 64 + 32 + i4 * 4);
      x[i4 * 4 + 0] -= mm[0] * xj; x[i4 * 4 + 1] -= mm[1] * xj; x[i4 * 4 + 2] -= mm[2] * xj; x[i4 * 4 + 3] -= mm[3] * xj;
    }
  }
#pragma unroll
  for (int j = 0; j < 31; ++j) {
    const float xj = x[j];
#pragma unroll
    for (int i4 = ((j + 1) & ~3); i4 < 32; i4 += 4) {
      const f32x4 mm = *(const f32x4*)(mcol + (32 + j) * 64 + 32 + i4);
      if (i4 + 0 > j) x[i4 + 0] -= mm[0] * xj;
      if (i4 + 1 > j) x[i4 + 1] -= mm[1] * xj;
      if (i4 + 2 > j) x[i4 + 2] -= mm[2] * xj;
      if (i4 + 3 > j) x[i4 + 3] -= mm[3] * xj;
    }
  }
  __syncthreads();
#pragma unroll
  for (int i = 0; i < 32; ++i) XB[i * 260 + col] = f2bf(x[i]);
  __syncthreads();
  {
    auto Xrow = [&](int i) -> const bf16_t* { return (i < 32 ? XA + i * 260 : XB + (i - 32) * 260); };
#pragma unroll
    for (int ks = 0; ks < 4; ++ks) {
      const bf16_t* xr = Xrow(16 * w4 + c);
      const u32x2 a = *(const u32x2*)(xr + 128 + 32 * ks + 4 * q);
      const u32x2 b = *(const u32x2*)(xr + 128 + 32 * ks + 16 + 4 * q);
      const u32x4 o = {a[0] ^ 0x80008000u, a[1] ^ 0x80008000u, b[0] ^ 0x80008000u, b[1] ^ 0x80008000u};
      *(u32x4*)(slot + SL_W + ((w4 * 4 + ks) * 64 + lane) * 16) = o;
    }
#pragma unroll
    for (int cc = 0; cc < 2; ++cc) {
      const int cs = 2 * w4 + cc;
#pragma unroll
      for (int mt = 0; mt < 4; ++mt) {
        unsigned short v[4];
#pragma unroll
        for (int r = 0; r < 4; ++r) v[r] = Xrow(16 * mt + 4 * q + r)[16 * cs + c];
        const u32x2 o = {(unsigned)v[0] | ((unsigned)v[1] << 16), (unsigned)v[2] | ((unsigned)v[3] << 16)};
        *(u32x2*)(slot + SL_U + ((cs * 4 + mt) * 64 + lane) * 8) = o;
      }
    }
  }
}

constexpr int CH_STAGE = 57344;
DI void dn_chain_task(PR p, int l, int s, int h, int d, char* lds) {
  const int tid = ltid(), cs = tid >> 6, lane = tid & 63, q = lane >> 4, c = lane & 15;
  const int R0 = seq_row0(s), T = seq_len(s), nc = T >> 6;
  const int gc0 = s < 16 ? s * 4 : 64 + (s - 16) * 16;
  bf16_t* odir = (bf16_t*)(lws(p) + WS_R1) + (size_t)d * MROWS * 512;
  const float* egl = (const float*)(lws(p) + WS_EGL);
  f32x4 S[8];
  if (s >= 16) {
    const float* s0 = lin(p, 6) + ((((size_t)(s - 16) * 2 + l) * 2 + d) * 4 + h) * 16384;
#pragma unroll
    for (int i = 0; i < 8; ++i)
#pragma unroll
      for (int r = 0; r < 4; ++r) S[i][r] = s0[(16 * i + 4 * q + r) * 128 + 16 * cs + c];
  } else {
#pragma unroll
    for (int i = 0; i < 8; ++i) S[i] = f32x4{0.f, 0.f, 0.f, 0.f};
  }
  auto slot_of = [&](int step) -> const unsigned char* {
    const int oc = d ? nc - 1 - step : step;
    return lws(p) + WS_DNP + (size_t)(((gc0 + oc) * 4 + h) * 2 + d) * DNP_SLOT;
  };
  u32x4 stg[7];
  auto gload = [&](int step) {
    const unsigned char* sl = slot_of(step);
#pragma unroll
    for (int i = 0; i < 7; ++i) stg[i] = *(const u32x4*)(sl + (size_t)(tid + NT * i) * 16);
  };
  auto lstore = [&](char* st) {
#pragma unroll
    for (int i = 0; i < 7; ++i) *(u32x4*)(st + (tid + NT * i) * 16) = stg[i];
  };
  gload(0);
  __syncthreads();
  lstore(lds);
  __syncthreads();
#pragma unroll 1
  for (int step = 0; step < nc; ++step) {
    const char* cur = lds + (step & 1) * CH_STAGE;
    if (step + 1 < nc) gload(step + 1);
    const unsigned char* sl = slot_of(step);
    const int oc = d ? nc - 1 - step : step;
    const float gl = egl[((gc0 + oc) * 4 + h) * 2 + d];
    bf16x8 Sb[4];
#pragma unroll
    for (int ks = 0; ks < 4; ++ks)
      Sb[ks] = mk8(pack2(S[2 * ks][0], S[2 * ks][1]), pack2(S[2 * ks][2], S[2 * ks][3]),
                   pack2(S[2 * ks + 1][0], S[2 * ks + 1][1]), pack2(S[2 * ks + 1][2], S[2 * ks + 1][3]));
    f32x4 av[4], ao[4];
#pragma unroll
    for (int mt = 0; mt < 4; ++mt) {
      const u32x2 u = *(const u32x2*)(sl + SL_U + ((cs * 4 + mt) * 64 + lane) * 8);
      av[mt] = f32x4{lo_f(u[0]), hi_f(u[0]), lo_f(u[1]), hi_f(u[1])};
      ao[mt] = f32x4{0.f, 0.f, 0.f, 0.f};
    }
#pragma unroll
    for (int ks = 0; ks < 4; ++ks)
#pragma unroll
      for (int mt = 0; mt < 4; ++mt) {
        const bf16x8 wf = *(const bf16x8*)(cur + SL_W + ((mt * 4 + ks) * 64 + lane) * 16);
        av[mt] = MFMA16(wf, Sb[ks], av[mt]);
        const bf16x8 gf = *(const bf16x8*)(cur + SL_QG + ((mt * 4 + ks) * 64 + lane) * 16);
        ao[mt] = MFMA16(gf, Sb[ks], ao[mt]);
      }
    bf16x8 Vb[2];
#pragma unroll
    for (int k2 = 0; k2 < 2; ++k2)
      Vb[k2] = mk8(pack2(av[2 * k2][0], av[2 * k2][1]), pack2(av[2 * k2][2], av[2 * k2][3]),
                   pack2(av[2 * k2 + 1][0], av[2 * k2 + 1][1]), pack2(av[2 * k2 + 1][2], av[2 * k2 + 1][3]));
#pragma unroll
    for (int k2 = 0; k2 < 2; ++k2)
#pragma unroll
      for (int mt = 0; mt < 4; ++mt) {
        const bf16x8 f = *(const bf16x8*)(cur + SL_QK + ((mt * 2 + k2) * 64 + lane) * 16);
        ao[mt] = MFMA16(f, Vb[k2], ao[mt]);
      }
#pragma unroll
    for (int i = 0; i < 8; ++i) {
      S[i] *= gl;
#pragma unroll
      for (int k2 = 0; k2 < 2; ++k2) {
        const bf16x8 f = *(const bf16x8*)(cur + SL_KGT + ((i * 2 + k2) * 64 + lane) * 16);
        S[i] = MFMA16(f, Vb[k2], S[i]);
      }
    }
#pragma unroll
    for (int mt = 0; mt < 4; ++mt)
#pragma unroll
      for (int r = 0; r < 4; ++r) {
        const int i = 16 * mt + 4 * q + r;
        const int t = oc * 64 + (d ? 63 - i : i);
        odir[(size_t)(R0 + t) * 512 + h * 128 + 16 * cs + c] = f2bf(ao[mt][r]);
      }
    if (step + 1 < nc) lstore(lds + ((step + 1) & 1) * CH_STAGE);
    __syncthreads();
  }
  if (s < 16) {
    float* so = lout(p) + O_DN + ((((size_t)s * 2 + l) * 2 + d) * 4 + h) * 16384;
#pragma unroll
    for (int i = 0; i < 8; ++i)
#pragma unroll
      for (int r = 0; r < 4; ++r) so[(16 * i + 4 * q + r) * 128 + 16 * cs + c] = S[i][r];
  }
}

constexpr int N_PHASES = 16;
constexpr int LDS_QSH = LDS_BYTES - 16;
constexpr int LDS_BST = LDS_BYTES - 32;

DI void run_prep(PR p) {
  const int G = gridDim.x, bid = blockIdx.x;
  for (int t = bid; t < 192; t += G) ph0_adaln(p, t, smem);
  for (int t = bid; t < 16; t += G) ph0_s5(p, t);
  if (bid == G - 1) ph0_misc(p);
  for (int t = bid; t < 2048; t += G) cvt_win_tile(p, 0, t, smem);
  for (int t = bid; t < 1408; t += G) cvt_other_tile(p, t, smem);
}
DI void run_final(PR p) {
  const int G = gridDim.x, bid = blockIdx.x, wave = threadIdx.x >> 6;
  for (int r = bid * 8 + wave; r < MROWS; r += G * 8) ph_final_row(p, r);
}
DI void run_norm(PR p, int l) {
  const int G = gridDim.x, bid = blockIdx.x, wave = threadIdx.x >> 6;
  for (int rb = bid * 8 + wave; rb < 4096; rb += G * 8) ph1_norm_rows(p, l, rb);
}
DI void run_cvt1(PR p) {
  const int G = gridDim.x, bid = blockIdx.x;
  for (int t = bid; t < 2048; t += G) cvt_win_tile(p, 1, t, smem);
}
DI void run_inproj(PR p, int l) {
  const int G = gridDim.x, bid = blockIdx.x;
  for (int t = bid; t < 2048; t += G) ph2_inproj_tile(p, l, t, smem);
}
DI void run_s5(PR p, int l) {
  const int G = gridDim.x, bid = blockIdx.x, wave = threadIdx.x >> 6;
  for (int b = bid; b < 256; b += G) {
    if (wave == 0) {
      const int s = 16 + (b >> 6), d = (b >> 5) & 1, g = b & 31;
      s5_task(p, l, s, d, g, smem + wave * S5_WLDS);
    } else if (wave < 5) {
      const int i = b * 4 + (wave - 1);
      const int s = i >> 6, d = (i >> 5) & 1, g = i & 31;
      s5_task(p, l, s, d, g, smem + wave * S5_WLDS);
    }
  }
}
DI void run_att(PR p, int l, int t) {
  if (t < 128) { const int s = 16 + (t >> 5), h = (t >> 3) & 3, qb = t & 7; att_task(p, l, s, h, qb, smem); }
  else { const int u = t - 128, s = u >> 3, h = (u >> 1) & 3, qb = u & 1; att_task(p, l, s, h, qb, smem); }
}
DI void run_prep_dn(PR p, int l, int u) { dn_prep_task(p, l, u >> 2, u & 3, smem); }
DI void run_chain(PR p, int l) {
  const int G = gridDim.x, bid = blockIdx.x;
  for (int b = bid; b < 160; b += G) {
    const int s = b < 32 ? 16 + (b >> 3) : (b - 32) >> 3;
    const int h = (b >> 1) & 3, d = b & 1;
    dn_chain_task(p, l, s, h, d, smem);
  }
}
DI void run_glu(PR p, int l, int t) { glu_tile(p, l, t, smem); }
DI void run_ph5(PR p, int l) {
  const int G = gridDim.x, bid = blockIdx.x, wave = threadIdx.x >> 6;
  for (int r = bid * 8 + wave; r < MROWS; r += G * 8) ph5_row(p, l, r);
}
DI void run_merge(PR p, int l) {
  const int G = gridDim.x, bid = blockIdx.x;
  for (int t = bid; t < 256; t += G) ph6_merge_tile(p, l, t, smem);
}
DI void run_out(PR p, int l) {
  const int G = gridDim.x, bid = blockIdx.x;
  for (int t = bid; t < 256; t += G) ph7_out_tile(p, l, t, smem);
}
DI void run_barrier(PR p, unsigned x) {
  XcdBarrier xb; xb.bar = (unsigned*)(p.ws + WS_BAR); xb.x = x; xb.st = (volatile LAS unsigned*)(LAS char*)(smem + LDS_BST);
  xcd_barrier(xb);
}

template <int PH> DI void run_phase(PR p, volatile int* qsh, unsigned* qw) {
  if constexpr (PH == 0) run_prep(p);
  else if constexpr (PH == 15) run_final(p);
  else {
    constexpr int l = (PH - 1) / 7, sub = (PH - 1) % 7;
    if constexpr (sub == 0) { run_norm(p, l); if constexpr (l == 1) run_cvt1(p); }
    else if constexpr (sub == 1) run_inproj(p, l);
    else if constexpr (sub == 2) {
      run_s5(p, l);
      for (;;) {
        const int t = queue_pull(&qw[l * 8 + 0], qsh);
        if (t >= 256) break;
        run_att(p, l, t);
      }
      for (;;) {
        const int t = queue_pull(&qw[l * 8 + 2], qsh);
        if (t >= 512) break;
        run_prep_dn(p, l, t);
      }
    } else if constexpr (sub == 3) {
      run_chain(p, l);
      for (;;) {
        const int t = queue_pull(&qw[l * 8 + 1], qsh);
        if (t >= 256) break;
        run_glu(p, l, t);
      }
    }
    else if constexpr (sub == 4) run_ph5(p, l);
    else if constexpr (sub == 5) run_merge(p, l);
    else run_out(p, l);
  }
}

__global__ void __launch_bounds__(NT) fwd_kernel(Params p_by_value) {
  PR p = *(const __attribute__((address_space(4))) Params*)__builtin_amdgcn_kernarg_segment_ptr();
  volatile int* qsh = (volatile int*)(smem + LDS_QSH);
  unsigned* qw = (unsigned*)(p.ws + WS_Q);
#ifndef ONE_LAUNCH
  switch (p.ph_lo) {
#define PHC(n) case n: run_phase<n>(p, qsh, qw); break;
    PHC(0) PHC(1) PHC(2) PHC(3) PHC(4) PHC(5) PHC(6) PHC(7) PHC(8) PHC(9) PHC(10) PHC(11) PHC(12) PHC(13) PHC(14) PHC(15)
#undef PHC
    default: break;
  }
#else
  volatile LAS unsigned* bst = (volatile LAS unsigned*)(LAS char*)(smem + LDS_BST);
  if (threadIdx.x == 0) { bst[0] = 0u; bst[1] = 0u; }
  __syncthreads();
  const XcdBarrier xb = xcd_barrier_post((unsigned*)(p.ws + WS_BAR), bst);
  const unsigned xcc = xb.x;
#define PHB(n) run_phase<n>(p, qsh, qw); run_barrier(p, xcc);
  PHB(0) PHB(1) PHB(2) PHB(3) PHB(4) PHB(5) PHB(6) PHB(7) PHB(8) PHB(9) PHB(10) PHB(11) PHB(12) PHB(13) PHB(14)
#undef PHB
  run_phase<15>(p, qsh, qw);
#endif
}

extern "C" void kernel_launch(void* const* d_in, const int* in_sizes, int n_in, void* d_out, int out_size,
                              void* d_ws, size_t ws_size, hipStream_t stream) {
  static int grid = 0;
  if (grid == 0) {
    int dev = 0, cus = 0, per_cu = 0;
    if (hipGetDevice(&dev) != hipSuccess || hipDeviceGetAttribute(&cus, hipDeviceAttributeMultiprocessorCount, dev) != hipSuccess) { fprintf(stderr, "kernel_launch: device query failed\n"); grid = -1; return; }
    if (hipFuncSetAttribute((const void*)fwd_kernel, hipFuncAttributeMaxDynamicSharedMemorySize, LDS_BYTES) != hipSuccess) { fprintf(stderr, "kernel_launch: hipFuncSetAttribute failed\n"); grid = -1; return; }
    if (hipOccupancyMaxActiveBlocksPerMultiprocessor(&per_cu, (const void*)fwd_kernel, NT, LDS_BYTES) != hipSuccess || per_cu < 1) { fprintf(stderr, "kernel_launch: occupancy query reports %d\n", per_cu); per_cu = 1; }
    (void)hipGetLastError();
    grid = cus;
    if (ws_size < WS_END) { fprintf(stderr, "kernel_launch: workspace too small (%zu < %zu)\n", ws_size, (size_t)WS_END); grid = -1; return; }
  }
  if (grid < 0) return;
  (void)hipMemsetAsync((char*)d_ws + WS_BAR, 0, WS_ZERO_BYTES, stream);
  Params p{};
  for (int i = 0; i < 31; ++i) p.in[i] = (const float*)d_in[i];
  p.out = (float*)d_out; p.ws = (unsigned char*)d_ws;
#ifndef ONE_LAUNCH
  p.use_bar = 0;
  for (int ph = 0; ph < N_PHASES; ++ph) {
    p.ph_lo = ph; p.ph_hi = ph + 1;
    hipLaunchKernelGGL(fwd_kernel, dim3(grid), dim3(NT), LDS_BYTES, stream, p);
  }
#else
  p.use_bar = 1; p.ph_lo = 0; p.ph_hi = N_PHASES;
  void* args[] = {&p};
  hipError_t e = hipLaunchCooperativeKernel((const void*)fwd_kernel, dim3(grid), dim3(NT), args, LDS_BYTES, stream);
  if (e != hipSuccess) fprintf(stderr, "kernel_launch: cooperative launch failed: %s (grid %d)\n", hipGetErrorString(e), grid);
#endif
}
```

```cpp
#define ONE_LAUNCH 1
#include <hip/hip_runtime.h>
#include <stdint.h>
#include <stdio.h>

#define DI __device__ __forceinline__
typedef unsigned short bf16_t;
using bf16x8 = __attribute__((ext_vector_type(8))) short;
using s16x4  = __attribute__((ext_vector_type(4))) short;
using f32x4  = __attribute__((ext_vector_type(4))) float;
using f32x16 = __attribute__((ext_vector_type(16))) float;
using u32x4  = __attribute__((ext_vector_type(4))) unsigned;
using u32x2  = __attribute__((ext_vector_type(2))) unsigned;
typedef __bf16 bf16x2_t __attribute__((ext_vector_type(2)));
typedef float f32x2_t __attribute__((ext_vector_type(2)));
#define LAS __attribute__((address_space(3)))

#define MFMA16(a, b, c) __builtin_amdgcn_mfma_f32_16x16x32_bf16((a), (b), (c), 0, 0, 0)
#define MFMA32(a, b, c) __builtin_amdgcn_mfma_f32_32x32x16_bf16((a), (b), (c), 0, 0, 0)

constexpr int NT = 512;
constexpr int DM = 1024;
constexpr int MROWS = 8192;
constexpr int NP = 8192;
constexpr int NIN = 8208;
constexpr float EPS = 1e-6f;
constexpr int C_UA = 0, C_ZA = 512, C_QB = 1024, C_KB = 1536, C_VB = 2048, C_ZB = 2560;
constexpr int C_QC = 3072, C_KC = 3584, C_VC = 4096, C_ZC = 4608, C_GT = 5120;
constexpr size_t O_Y = 0;
constexpr size_t O_CK = 8388608;
constexpr size_t O_CV = O_CK + 4194304;
constexpr size_t O_SR = O_CV + 4194304;
constexpr size_t O_SI = O_SR + 131072;
constexpr size_t O_DN = O_SI + 131072;

constexpr size_t WS_BAR   = 0;
constexpr size_t WS_Q     = 16384;
constexpr size_t WS_ZERO_BYTES = 16384 + 1024;
constexpr size_t WS_MOD   = 32768;
constexpr size_t WS_S5AR  = WS_MOD + 122880;
constexpr size_t WS_S5AI  = WS_S5AR + 32768;
constexpr size_t WS_S5BB  = WS_S5AI + 32768;
constexpr size_t WS_S5CT  = WS_S5BB + 524288;
constexpr size_t WS_ROPE  = WS_S5CT + 524288;
constexpr size_t WS_LAM   = WS_ROPE + 8192;
constexpr size_t WS_WBA   = WS_LAM + 256;
constexpr size_t WS_BETAG = WS_WBA + 131072;
constexpr size_t WS_EGL   = WS_BETAG + 524288;
constexpr size_t WS_WTGLU = WS_EGL + 4096;
constexpr size_t WS_WTBR  = WS_WTGLU + 1048576;
constexpr size_t WS_WTOUT = WS_WTBR + 6291456;
constexpr size_t WS_R1    = WS_WTOUT + 4194304;
constexpr size_t WS_R2    = WS_R1 + 16777216;
constexpr size_t WS_PROJ  = WS_R2 + 16777216;
constexpr size_t WS_DNP   = WS_PROJ + 134217728;
constexpr size_t DNP_SLOT = 73728;
constexpr size_t WS_END   = WS_DNP + 1024 * DNP_SLOT;
constexpr int SL_W = 0, SL_QG = 16384, SL_KGT = 32768, SL_QK = 49152, SL_U = 57344;

constexpr int LDS_BYTES = 147456;

struct Params {
  const float* in[31];
  float* out;
  unsigned char* ws;
  int ph_lo, ph_hi;
  int use_bar, pad;
};
typedef const __attribute__((address_space(4))) Params& PR;
#define NI __device__ __noinline__
extern __shared__ __attribute__((aligned(16))) char smem[];
#define GAS __attribute__((address_space(1)))
DI unsigned char* lws(PR p) { GAS unsigned char* w = (GAS unsigned char*)p.ws; asm volatile("" : "+s"(w)); return (unsigned char*)w; }
DI const float* lin(PR p, int k) { GAS const float* w = (GAS const float*)p.in[k]; asm volatile("" : "+s"(w)); return (const float*)w; }
DI int ltid() {
  const int w = __builtin_amdgcn_readfirstlane((int)(threadIdx.x >> 6));
  int t = (w << 6) | (int)__builtin_amdgcn_mbcnt_hi(~0u, __builtin_amdgcn_mbcnt_lo(~0u, 0u));
  asm volatile("" : "+v"(t));
  return t;
}
DI float* lout(PR p) { GAS float* w = (GAS float*)p.out; asm volatile("" : "+s"(w)); return (float*)w; }

DI float bf2f(unsigned short h) { return __uint_as_float(((unsigned)h) << 16); }
DI unsigned pack2(float lo, float hi) { f32x2_t f = {lo, hi}; bf16x2_t v = __builtin_convertvector(f, bf16x2_t); return __builtin_bit_cast(unsigned, v); }
DI unsigned short f2bf(float x) { return (unsigned short)(pack2(x, 0.f) & 0xffffu); }
DI float lo_f(unsigned u) { return __uint_as_float(u << 16); }
DI float hi_f(unsigned u) { return __uint_as_float(u & 0xffff0000u); }
DI float sigmoidf_(float x) { return 1.f / (1.f + __expf(-x)); }
DI float siluf_(float x) { return x / (1.f + __expf(-x)); }
DI float wave_sum(float v) {
#pragma unroll
  for (int o = 32; o >= 1; o >>= 1) v += __shfl_xor(v, o);
  return v;
}
DI bf16x8 mk8(unsigned a, unsigned b, unsigned c, unsigned d) { u32x4 u = {a, b, c, d}; return __builtin_bit_cast(bf16x8, u); }

#define XB_TMO      128
#define XB_XCNT(j)  (256  + 64 * (j))
#define XB_XSUB(j)  (1280 + 64 * (j))
#define XB_XGEN(j)  (2304 + 64 * (j))
#define XB_TOP      3328
#define XB_TOPGEN   3392
#define XCD_BAR_WORDS 3456
#define XB_SPIN_CAP (1u << 22)
DI unsigned xb_ld(unsigned* p)              { return __hip_atomic_load(p, __ATOMIC_RELAXED, __HIP_MEMORY_SCOPE_AGENT); }
DI unsigned xb_add(unsigned* p, unsigned v) { return __hip_atomic_fetch_add(p, v, __ATOMIC_RELAXED, __HIP_MEMORY_SCOPE_AGENT); }
DI unsigned xb_xcc_id() { return (unsigned)__builtin_amdgcn_s_getreg((3 << 11) | 20) & 0xFu; }
#define XB_SPIN(cond, bar) do { unsigned _sp = 0; while (cond) { __builtin_amdgcn_s_sleep(1); \
    if ((++_sp & 255u) == 0u) { if (xb_ld(&(bar)[XB_TMO])) break; if (_sp > XB_SPIN_CAP) { atomicAdd(&(bar)[XB_TMO], 1u); break; } } } } while (0)
struct XcdBarrier { unsigned* bar; unsigned x; volatile LAS unsigned* st; };
DI XcdBarrier xcd_barrier_post(unsigned* bar, volatile LAS unsigned* st) {
  XcdBarrier b; b.bar = bar; b.x = xb_xcc_id(); b.st = st;
  if (threadIdx.x == 0) (void)xb_add(&bar[XB_XCNT(b.x)], 1u);
  return b;
}
DI void xcd_barrier_complete(unsigned* bar, unsigned x, unsigned& nloc, unsigned& nx) {
  const unsigned G = gridDim.x;
  unsigned sum, cnt, mine, sp = 0u;
  for (;;) {
    sum = 0u; cnt = 0u; mine = 0u;
#pragma unroll
    for (unsigned j = 0; j < 16; ++j) { const unsigned c = xb_ld(&bar[XB_XCNT(j)]); sum += c; cnt += (c > 0u) ? 1u : 0u; mine = (j == x) ? c : mine; }
    if (sum == G) break;
    __builtin_amdgcn_s_sleep(1);
    if ((++sp & 255u) == 0u) { if (xb_ld(&bar[XB_TMO])) break; if (sp > XB_SPIN_CAP) { atomicAdd(&bar[XB_TMO], 1u); break; } }
  }
  nloc = mine > 0u ? mine : 1u; nx = cnt > 0u ? cnt : 1u;
}
DI void xcd_barrier(const XcdBarrier& b) {
  asm volatile("s_waitcnt vmcnt(0)" ::: "memory");
  __syncthreads();
  if (threadIdx.x == 0) {
    unsigned* bar = b.bar;
    __builtin_amdgcn_s_waitcnt(0);
    unsigned nloc = b.st[0], nx = b.st[1];
    if (nloc == 0u) { xcd_barrier_complete(bar, b.x, nloc, nx); b.st[0] = nloc; b.st[1] = nx; }
    const unsigned old = xb_add(&bar[XB_XSUB(b.x)], 1u);
    const unsigned gen = old / nloc;
    if (old + 1u == (gen + 1u) * nloc) {
      __builtin_amdgcn_fence(__ATOMIC_RELEASE, "agent");
      asm volatile("s_waitcnt vmcnt(0)" ::: "memory");
      const unsigned og = xb_add(&bar[XB_TOP], 1u);
      const unsigned tg = og / nx;
      if (og + 1u == (tg + 1u) * nx) xb_add(&bar[XB_TOPGEN], 1u);
      else XB_SPIN(xb_ld(&bar[XB_TOPGEN]) == tg, bar);
      __builtin_amdgcn_fence(__ATOMIC_ACQUIRE, "agent");
      xb_add(&bar[XB_XGEN(b.x)], 1u);
      asm volatile("s_waitcnt vmcnt(0)" ::: "memory");
    } else {
      XB_SPIN(xb_ld(&bar[XB_XGEN(b.x)]) == gen, bar);
      __builtin_amdgcn_fence(__ATOMIC_ACQUIRE, "agent");
      asm volatile("s_waitcnt vmcnt(0)" ::: "memory");
    }
  }
  __syncthreads();
}

DI int queue_pull(unsigned* q, volatile int* sh) {
  __syncthreads();
  if (ltid() == 0) *sh = (int)xb_add(q, 1u);
  __syncthreads();
  return *sh;
}

DI int seq_row0(int s) { return s < 16 ? s * 256 : 4096 + (s - 16) * 1024; }
DI int seq_len(int s) { return s < 16 ? 256 : 1024; }
DI int row_cond(int r) { return r < 4096 ? 0 : 1 + ((r - 4096) >> 10); }
DI const float* x_in_row(PR p, int l, int r) {
  if (l == 0) return r < 4096 ? lin(p, 0) + (size_t)r * DM : lin(p, 1) + (size_t)(r - 4096) * DM;
  return lout(p) + O_Y + (size_t)r * DM;
}

DI void ph0_adaln(PR p, int a, char* lds) {
  const int l = a / 96, cb = a % 96, tid = ltid();
  float* scond = (float*)lds;
  float* red = scond + 5 * 1024;
  for (int i = tid; i < 5 * 1024; i += NT) {
    const int ci = i >> 10, k = i & 1023;
    const float c = ci == 0 ? lin(p, 8)[k] : lin(p, 7)[(ci - 1) * 1024 + k];
    scond[i] = c / (1.f + expf(-c));
  }
  __syncthreads();
  const int tx = tid & 31, ty = tid >> 5;
  const float* w = lin(p, 10) + (size_t)l * 1024 * 3072 + cb * 32 + tx;
  float acc[5] = {0.f, 0.f, 0.f, 0.f, 0.f};
  for (int kk = 0; kk < 64; ++kk) {
    const int k = ty * 64 + kk;
    const float wv = w[(size_t)k * 3072];
#pragma unroll
    for (int ci = 0; ci < 5; ++ci) acc[ci] += scond[ci * 1024 + k] * wv;
  }
#pragma unroll
  for (int ci = 0; ci < 5; ++ci) red[(ty * 5 + ci) * 32 + tx] = acc[ci];
  __syncthreads();
  if (tid < 160) {
    const int ci = tid >> 5, x = tid & 31;
    float s = 0.f;
    for (int y = 0; y < 16; ++y) s += red[(y * 5 + ci) * 32 + x];
    const int col = cb * 32 + x;
    float* mod = (float*)(lws(p) + WS_MOD);
    mod[(l * 5 + ci) * 3072 + col] = s + lin(p, 11)[l * 3072 + col];
  }
  __syncthreads();
}

DI void ph0_s5(PR p, int t) {
  const int idx = t * NT + threadIdx.x;
  const int ldg = idx >> 6, pp = idx & 63;
  const float lre = lin(p, 13)[idx], lim = lin(p, 14)[idx], ls = lin(p, 15)[ldg];
  const float step = expf(ls);
  const float mag = expf(lre * step);
  float sn, cs; sincosf(lim * step, &sn, &cs);
  const float ar = mag * cs, ai = mag * sn;
  const float den = lre * lre + lim * lim;
  const float fr = ((ar - 1.f) * lre + ai * lim) / den;
  const float fi = (ai * lre - (ar - 1.f) * lim) / den;
  ((float*)(lws(p) + WS_S5AR))[idx] = ar;
  ((float*)(lws(p) + WS_S5AI))[idx] = ai;
  bf16_t* bb = (bf16_t*)(lws(p) + WS_S5BB) + (size_t)ldg * 128 * 16;
  bf16_t* ct = (bf16_t*)(lws(p) + WS_S5CT) + (size_t)ldg * 16 * 128;
  const float* bre = lin(p, 16) + (size_t)idx * 16;
  const float* bim = lin(p, 17) + (size_t)idx * 16;
#pragma unroll
  for (int i = 0; i < 16; ++i) {
    const float br = bre[i], bi = bim[i];
    bb[pp * 16 + i] = f2bf(fr * br - fi * bi);
    bb[(64 + pp) * 16 + i] = f2bf(fr * bi + fi * br);
    const float cr = lin(p, 18)[((size_t)ldg * 16 + i) * 64 + pp];
    const float cim = lin(p, 19)[((size_t)ldg * 16 + i) * 64 + pp];
    ct[i * 128 + pp] = f2bf(cr);
    ct[i * 128 + 64 + pp] = f2bf(-cim);
  }
}

DI void ph0_misc(PR p) {
  const int tid = threadIdx.x;
  float* rc = (float*)(lws(p) + WS_ROPE);
  for (int i = tid; i < 1024; i += NT) {
    const int pos = i >> 4, f = i & 15;
    const float inv = powf(10000.f, -(float)f / 16.f);
    const float ang = (float)pos * inv;
    float sn, cs; sincosf(ang, &sn, &cs);
    rc[i] = cs; rc[1024 + i] = sn;
  }
  if (tid < 2) {
    const int l = tid;
    const float* dl = lin(p, 22) + l * 256;
    float s0 = 0.f, s1 = 0.f;
    for (int i = 0; i < 64; ++i) { s0 += dl[i] * dl[64 + i]; s1 += dl[128 + i] * dl[192 + i]; }
    const float lam_init = 0.8f - 0.6f * expf(-0.3f * (float)l);
    ((float*)(lws(p) + WS_LAM))[l] = expf(s0) - expf(s1) + lam_init;
  }
  float* wba = (float*)(lws(p) + WS_WBA);
  for (int i = tid; i < 2 * 16 * 1024; i += NT) {
    const int l = i >> 14, j = (i >> 10) & 15, k = i & 1023;
    wba[i] = lin(p, 12)[((size_t)l * 1024 + k) * NIN + 5120 + j];
  }
}

DI void cvt_tile(const float* src, size_t ld_src, bf16_t* dst, size_t ld_dst, char* lds) {
  float* t = (float*)lds;
  const int tid = ltid();
  const int r = tid >> 4, c4 = (tid & 15) * 4;
#pragma unroll
  for (int ps = 0; ps < 2; ++ps) {
    const int k = r + 32 * ps;
    const f32x4 v = *(const f32x4*)(src + (size_t)k * ld_src + c4);
    t[k * 65 + c4 + 0] = v[0]; t[k * 65 + c4 + 1] = v[1]; t[k * 65 + c4 + 2] = v[2]; t[k * 65 + c4 + 3] = v[3];
  }
  __syncthreads();
  const int n = tid >> 3, kc = tid & 7;
  float v[8];
#pragma unroll
  for (int j = 0; j < 8; ++j) v[j] = t[(kc * 8 + j) * 65 + n];
  u32x4 o = {pack2(v[0], v[1]), pack2(v[2], v[3]), pack2(v[4], v[5]), pack2(v[6], v[7])};
  *(u32x4*)(dst + (size_t)n * ld_dst + kc * 8) = o;
  __syncthreads();
}

DI void cvt_win_tile(PR p, int l, int t, char* lds) {
  const int kt = t & 15, nt = t >> 4;
  const int n0 = nt * 64, nsrc = n0 < 5120 ? n0 : n0 + 16;
  cvt_tile(lin(p, 12) + ((size_t)l * 1024 + kt * 64) * NIN + nsrc, NIN,
           (bf16_t*)(lws(p) + WS_R1) + (size_t)n0 * 1024 + kt * 64, 1024, lds);
}
DI void cvt_other_tile(PR p, int t, char* lds) {
  if (t < 128) {
    const int l = t >> 6, q = t & 63, kt = q & 7, nt = q >> 3;
    cvt_tile(lin(p, 21) + ((size_t)l * 512 + kt * 64) * 512 + nt * 64, 512,
             (bf16_t*)(lws(p) + WS_WTGLU) + ((size_t)l * 512 + nt * 64) * 512 + kt * 64, 512, lds);
  } else if (t < 896) {
    const int u = t - 128, ln = u >> 7, q = u & 127, kt = q & 7, nt = q >> 3;
    cvt_tile(lin(p, 28) + ((size_t)ln * 512 + kt * 64) * 1024 + nt * 64, 1024,
             (bf16_t*)(lws(p) + WS_WTBR) + ((size_t)ln * 1024 + nt * 64) * 512 + kt * 64, 512, lds);
  } else {
    const int u = t - 896, l = u >> 8, q = u & 255, kt = q & 15, nt = q >> 4;
    cvt_tile(lin(p, 29) + ((size_t)l * 1024 + kt * 64) * 1024 + nt * 64, 1024,
             (bf16_t*)(lws(p) + WS_WTOUT) + ((size_t)l * 1024 + nt * 64) * 1024 + kt * 64, 1024, lds);
  }
}

DI void ph1_norm_rows(PR p, int l, int rb) {
  const int lane = ltid() & 63;
  const int r0 = rb * 2, ci = row_cond(r0);
  const float* mod = (const float*)(lws(p) + WS_MOD) + (size_t)(l * 5 + ci) * 3072;
  const float* ng = lin(p, 9) + l * 1024;
  const float* wba = (const float*)(lws(p) + WS_WBA) + (size_t)l * 16 * 1024;
  bf16_t* hn = (bf16_t*)(lws(p) + WS_R2);
  float h[2][16];
#pragma unroll
  for (int ri = 0; ri < 2; ++ri) {
    const float* x = x_in_row(p, l, r0 + ri);
    float ss = 0.f;
#pragma unroll
    for (int i = 0; i < 4; ++i) {
      const f32x4 v = *(const f32x4*)(x + (i * 64 + lane) * 4);
#pragma unroll
      for (int e = 0; e < 4; ++e) { h[ri][i * 4 + e] = v[e]; ss += v[e] * v[e]; }
    }
    ss = wave_sum(ss);
    const float rstd = rsqrtf(ss * (1.f / 1024.f) + EPS);
#pragma unroll
    for (int i = 0; i < 4; ++i) {
      const int k = (i * 64 + lane) * 4;
      const f32x4 g = *(const f32x4*)(ng + k);
      const f32x4 sh = *(const f32x4*)(mod + k);
      const f32x4 sc = *(const f32x4*)(mod + 1024 + k);
#pragma unroll
      for (int e = 0; e < 4; ++e) h[ri][i * 4 + e] = h[ri][i * 4 + e] * rstd * g[e] * (1.f + sc[e]) + sh[e];
      u32x2 o = {pack2(h[ri][i * 4 + 0], h[ri][i * 4 + 1]), pack2(h[ri][i * 4 + 2], h[ri][i * 4 + 3])};
      *(u32x2*)(hn + (size_t)(r0 + ri) * 1024 + k) = o;
    }
  }
  float pt[32];
#pragma unroll
  for (int j = 0; j < 16; ++j) {
    float a0 = 0.f, a1 = 0.f;
#pragma unroll
    for (int i = 0; i < 4; ++i) {
      const f32x4 w = *(const f32x4*)(wba + j * 1024 + (i * 64 + lane) * 4);
#pragma unroll
      for (int e = 0; e < 4; ++e) { a0 += h[0][i * 4 + e] * w[e]; a1 += h[1][i * 4 + e] * w[e]; }
    }
    pt[j] = a0; pt[16 + j] = a1;
    if ((j & 3) == 3) asm volatile("" ::: "memory");
  }
#pragma unroll
  for (int n = 16; n >= 1; n >>= 1) {
    const bool up = (lane & n) != 0;
#pragma unroll
    for (int i = 0; i < n; ++i) {
      const float keep = up ? pt[i + n] : pt[i];
      const float send = up ? pt[i] : pt[i + n];
      pt[i] = keep + __shfl_xor(send, n);
    }
  }
  const float v = pt[0] + __shfl_xor(pt[0], 32);
  if (lane < 32) {
    const int ri = lane >> 4, j = lane & 15;
    float res;
    if (j < 8) res = 1.f / (1.f + expf(-v));
    else {
      const int jj = j - 8;
      const float xx = v + lin(p, 26)[l * 8 + jj];
      const float sp = xx > 20.f ? xx : log1pf(expf(xx));
      res = -expf(lin(p, 25)[l * 8 + jj]) * sp;
    }
    ((float*)(lws(p) + WS_BETAG))[(size_t)(r0 + ri) * 16 + j] = res;
  }
}

constexpr int G_STAGE = 49152;
DI void gemm_gload(int tid, const bf16_t* A, size_t lda, const bf16_t* B, size_t ldb, int k0, u32x4 (&ra)[4], u32x4 (&rb)[2]) {
#pragma unroll
  for (int i = 0; i < 4; ++i) { const int id = tid + NT * i, row = id >> 3, ch = id & 7; ra[i] = *(const u32x4*)(A + (size_t)row * lda + k0 + ch * 8); }
#pragma unroll
  for (int i = 0; i < 2; ++i) { const int id = tid + NT * i, row = id >> 3, ch = id & 7; rb[i] = *(const u32x4*)(B + (size_t)row * ldb + k0 + ch * 8); }
}
DI void gemm_lstore(int tid, char* st, const u32x4 (&ra)[4], const u32x4 (&rb)[2]) {
#pragma unroll
  for (int i = 0; i < 4; ++i) { const int id = tid + NT * i, row = id >> 3, ch = id & 7; *(u32x4*)(st + row * 128 + ((ch ^ ((row >> 1) & 7)) << 4)) = ra[i]; }
#pragma unroll
  for (int i = 0; i < 2; ++i) { const int id = tid + NT * i, row = id >> 3, ch = id & 7; *(u32x4*)(st + 32768 + row * 128 + ((ch ^ ((row >> 1) & 7)) << 4)) = rb[i]; }
}
DI void gemm_compute(const char* st, f32x16 (&acc)[2][2], int wm, int wn, int lane) {
  const int r = lane & 31, h = lane >> 5, sw = (r >> 1) & 7;
#pragma unroll
  for (int s = 0; s < 4; ++s) {
    const int ch = ((2 * s + h) ^ sw) << 4;
    bf16x8 a[2], b[2];
#pragma unroll
    for (int mi = 0; mi < 2; ++mi) a[mi] = *(const bf16x8*)(st + (wm * 64 + mi * 32 + r) * 128 + ch);
#pragma unroll
    for (int ni = 0; ni < 2; ++ni) b[ni] = *(const bf16x8*)(st + 32768 + (wn * 64 + ni * 32 + r) * 128 + ch);
#pragma unroll
    for (int mi = 0; mi < 2; ++mi)
#pragma unroll
      for (int ni = 0; ni < 2; ++ni) acc[mi][ni] = MFMA32(a[mi], b[ni], acc[mi][ni]);
  }
}
DI void gemm_mainloop(int tid, const bf16_t* A, size_t lda, const bf16_t* B, size_t ldb, int K, f32x16 (&acc)[2][2], char* lds) {
  const int wave = tid >> 6, lane = tid & 63, wm = wave >> 1, wn = wave & 1;
  u32x4 ra[4], rb[2];
  gemm_gload(tid, A, lda, B, ldb, 0, ra, rb);
  gemm_lstore(tid, lds, ra, rb);
  __syncthreads();
  const int KT = K >> 6;
  for (int kt = 0; kt < KT; ++kt) {
    char* cur = lds + (kt & 1) * G_STAGE;
    char* nxt = lds + ((kt + 1) & 1) * G_STAGE;
    if (kt + 1 < KT) gemm_gload(tid, A, lda, B, ldb, (kt + 1) * 64, ra, rb);
    gemm_compute(cur, acc, wm, wn, lane);
    if (kt + 1 < KT) gemm_lstore(tid, nxt, ra, rb);
    __syncthreads();
  }
}
DI void acc_zero(f32x16 (&acc)[2][2]) {
#pragma unroll
  for (int a = 0; a < 2; ++a)
#pragma unroll
    for (int b = 0; b < 2; ++b)
#pragma unroll
      for (int i = 0; i < 16; ++i) acc[a][b][i] = 0.f;
}
DI void tile_store_bf16(int tid, const f32x16 (&acc)[2][2], bf16_t* dst, size_t ldd, char* lds) {
  const int wave = tid >> 6, lane = tid & 63, wm = wave >> 1, wn = wave & 1;
  const int cl = lane & 31, h = lane >> 5;
#pragma unroll
  for (int mi = 0; mi < 2; ++mi)
#pragma unroll
    for (int ni = 0; ni < 2; ++ni)
#pragma unroll
      for (int i = 0; i < 16; ++i) {
        const int row = wm * 64 + mi * 32 + (i & 3) + 8 * (i >> 2) + 4 * h;
        const int col = wn * 64 + ni * 32 + cl;
        *(bf16_t*)(lds + row * 272 + col * 2) = f2bf(acc[mi][ni][i]);
      }
  __syncthreads();
#pragma unroll
  for (int i = 0; i < 8; ++i) {
    const int id = tid + NT * i, row = id >> 4, ch = id & 15;
    const u32x4 v = *(const u32x4*)(lds + row * 272 + ch * 16);
    *(u32x4*)(dst + (size_t)row * ldd + ch * 8) = v;
  }
  __syncthreads();
}

DI void ph2_inproj_tile(PR p, int l, int t, char* lds) {
  const int tid = ltid();
  const int nt = t & 63, mt = t >> 6;
  const int m0 = mt * 256, n0 = nt * 128;
  const bf16_t* A = (const bf16_t*)(lws(p) + WS_R2) + (size_t)m0 * 1024;
  const bf16_t* B = (const bf16_t*)(lws(p) + WS_R1) + (size_t)n0 * 1024;
  f32x16 acc[2][2];
  acc_zero(acc);
  gemm_mainloop(tid, A, 1024, B, 1024, 1024, acc, lds);
  if (m0 < 4096 && n0 >= C_KB && n0 < C_ZB) {
    const int wave = tid >> 6, lane = tid & 63, wm = wave >> 1, wn = wave & 1;
    float* base = lout(p) + (n0 < C_VB ? O_CK : O_CV);
    const int cb = (n0 < C_VB ? n0 - C_KB : n0 - C_VB);
#pragma unroll
    for (int mi = 0; mi < 2; ++mi)
#pragma unroll
      for (int ni = 0; ni < 2; ++ni)
#pragma unroll
        for (int i = 0; i < 16; ++i) {
          const int row = m0 + wm * 64 + mi * 32 + (i & 3) + 8 * (i >> 2) + 4 * (lane >> 5);
          const int col = cb + wn * 64 + ni * 32 + (lane & 31);
          const int b = row >> 8, tt = row & 255;
          base[((size_t)(b * 2 + l) * 256 + tt) * 512 + col] = acc[mi][ni][i];
        }
  }
  tile_store_bf16(tid, acc, (bf16_t*)(lws(p) + WS_PROJ) + (size_t)m0 * NP + n0, NP, lds);
}

DI void ph6_merge_tile(PR p, int l, int t, char* lds) {
  const int tid = ltid();
  const int nt = t & 7, mt = t >> 3;
  const int m0 = mt * 256, n0 = nt * 128;
  const int wave = tid >> 6, lane = tid & 63, wm = wave >> 1, wn = wave & 1;
  const bf16_t* proj = (const bf16_t*)(lws(p) + WS_PROJ);
  unsigned tot[2][2][8];
#pragma unroll
  for (int a = 0; a < 2; ++a)
#pragma unroll
    for (int b = 0; b < 2; ++b)
#pragma unroll
      for (int i = 0; i < 8; ++i) tot[a][b][i] = 0u;
#pragma unroll 1
  for (int n = 0; n < 3; ++n) {
    const int acol = n == 0 ? C_UA : (n == 1 ? C_QB : C_QC);
    const bf16_t* A = proj + (size_t)m0 * NP + acol;
    const bf16_t* B = (const bf16_t*)(lws(p) + WS_WTBR) + ((size_t)(l * 3 + n) * 1024 + n0) * 512;
    f32x16 acc[2][2];
    acc_zero(acc);
    gemm_mainloop(tid, A, NP, B, 512, 512, acc, lds);
#pragma unroll
    for (int mi = 0; mi < 2; ++mi)
#pragma unroll
      for (int ni = 0; ni < 2; ++ni) {
#pragma unroll
        for (int i2 = 0; i2 < 8; ++i2) {
          const int i = 2 * i2;
          const int row = m0 + wm * 64 + mi * 32 + (i & 3) + 8 * (i >> 2) + 4 * (lane >> 5);
          const int col = n0 + wn * 64 + ni * 32 + (lane & 31);
          const float g0 = bf2f(proj[(size_t)row * NP + C_GT + n * 1024 + col]);
          const float g1 = bf2f(proj[(size_t)(row + 1) * NP + C_GT + n * 1024 + col]);
          const unsigned o = tot[mi][ni][i2];
          tot[mi][ni][i2] = pack2(lo_f(o) + sigmoidf_(g0) * acc[mi][ni][i], hi_f(o) + sigmoidf_(g1) * acc[mi][ni][i + 1]);
        }
        asm volatile("" ::: "memory");
      }
  }
  bf16_t* dst = (bf16_t*)(lws(p) + WS_R2) + (size_t)m0 * 1024 + n0;
#pragma unroll
  for (int mi = 0; mi < 2; ++mi)
#pragma unroll
    for (int ni = 0; ni < 2; ++ni)
#pragma unroll
      for (int i2 = 0; i2 < 8; ++i2) {
        const int i = 2 * i2;
        const int row = wm * 64 + mi * 32 + (i & 3) + 8 * (i >> 2) + 4 * (lane >> 5);
        const int col = wn * 64 + ni * 32 + (lane & 31);
        *(bf16_t*)(lds + row * 272 + col * 2) = (bf16_t)(tot[mi][ni][i2] & 0xffffu);
        *(bf16_t*)(lds + (row + 1) * 272 + col * 2) = (bf16_t)(tot[mi][ni][i2] >> 16);
      }
  __syncthreads();
#pragma unroll
  for (int i = 0; i < 8; ++i) {
    const int id = tid + NT * i, row = id >> 4, ch = id & 15;
    const u32x4 v = *(const u32x4*)(lds + row * 272 + ch * 16);
    *(u32x4*)(dst + (size_t)row * 1024 + ch * 8) = v;
  }
  __syncthreads();
}

DI void ph7_out_tile(PR p, int l, int t, char* lds) {
  const int tid = ltid();
  const int nt = t & 7, mt = t >> 3;
  const int m0 = mt * 256, n0 = nt * 128;
  const int wave = tid >> 6, lane = tid & 63, wm = wave >> 1, wn = wave & 1;
  const bf16_t* A = (const bf16_t*)(lws(p) + WS_R2) + (size_t)m0 * 1024;
  const bf16_t* B = (const bf16_t*)(lws(p) + WS_WTOUT) + ((size_t)l * 1024 + n0) * 1024;
  f32x16 acc[2][2];
  acc_zero(acc);
  gemm_mainloop(tid, A, 1024, B, 1024, 1024, acc, lds);
  float* ct = (float*)lds;
#pragma unroll
  for (int mi = 0; mi < 2; ++mi)
#pragma unroll
    for (int ni = 0; ni < 2; ++ni)
#pragma unroll
      for (int i = 0; i < 16; ++i) {
        const int row = wm * 64 + mi * 32 + (i & 3) + 8 * (i >> 2) + 4 * (lane >> 5);
        const int col = wn * 64 + ni * 32 + (lane & 31);
        ct[row * 132 + col] = acc[mi][ni][i];
      }
  __syncthreads();
  const float* mod = (const float*)(lws(p) + WS_MOD) + (size_t)l * 5 * 3072;
#pragma unroll 4
  for (int i = 0; i < 16; ++i) {
    const int id = tid + NT * i, row = id >> 5, c4 = (id & 31) * 4;
    const int grow = m0 + row, gcol = n0 + c4;
    const f32x4 y = *(const f32x4*)(ct + row * 132 + c4);
    const f32x4 gate = *(const f32x4*)(mod + row_cond(grow) * 3072 + 2048 + gcol);
    const f32x4 xo = *(const f32x4*)(x_in_row(p, l, grow) + gcol);
    f32x4 o;
#pragma unroll
    for (int e = 0; e < 4; ++e) o[e] = xo[e] + gate[e] * y[e];
    *(f32x4*)(lout(p) + O_Y + (size_t)grow * DM + gcol) = o;
  }
  __syncthreads();
}

DI void ph_final_row(PR p, int r) {
  const int lane = ltid() & 63;
  float* x = lout(p) + O_Y + (size_t)r * DM;
  f32x4 v[4];
  float ss = 0.f;
#pragma unroll
  for (int i = 0; i < 4; ++i) { v[i] = *(const f32x4*)(x + (i * 64 + lane) * 4); ss += v[i][0] * v[i][0] + v[i][1] * v[i][1] + v[i][2] * v[i][2] + v[i][3] * v[i][3]; }
  ss = wave_sum(ss);
  const float rstd = rsqrtf(ss * (1.f / 1024.f) + EPS);
#pragma unroll
  for (int i = 0; i < 4; ++i) {
    const f32x4 g = *(const f32x4*)(lin(p, 30) + (i * 64 + lane) * 4);
    f32x4 o;
#pragma unroll
    for (int e = 0; e < 4; ++e) o[e] = v[i][e] * rstd * g[e];
    *(f32x4*)(x + (i * 64 + lane) * 4) = o;
  }
}

constexpr int S5_WLDS = 8192 + 4352;
DI void s5_task(PR p, int l, int s, int d, int g, char* wl) {
  const int lane = ltid() & 63, q = lane >> 4, c = lane & 15;
  const int ldg = (l * 2 + d) * 32 + g;
  const int R0 = seq_row0(s), T = seq_len(s);
  float* BU = (float*)wl;
  char* H = wl + 8192;
  const bf16_t* proj = (const bf16_t*)(lws(p) + WS_PROJ);
  bf16_t* yd = (bf16_t*)(lws(p) + WS_R2) + (size_t)d * MROWS * 512;
  const bf16_t* bb = (const bf16_t*)(lws(p) + WS_S5BB) + (size_t)ldg * 128 * 16;
  const bf16_t* ct = (const bf16_t*)(lws(p) + WS_S5CT) + (size_t)ldg * 16 * 128;
  bf16x8 bfr[8], cfr[4];
  const bf16x8 zero8 = {0, 0, 0, 0, 0, 0, 0, 0};
#pragma unroll
  for (int nt = 0; nt < 8; ++nt) bfr[nt] = q < 2 ? *(const bf16x8*)(bb + (nt * 16 + c) * 16 + 8 * q) : zero8;
#pragma unroll
  for (int ks = 0; ks < 4; ++ks) cfr[ks] = *(const bf16x8*)(ct + c * 128 + 32 * ks + 8 * q);
  const float ar = ((const float*)(lws(p) + WS_S5AR))[ldg * 64 + lane];
  const float ai = ((const float*)(lws(p) + WS_S5AI))[ldg * 64 + lane];
  float hr = 0.f, hi = 0.f;
  if (s >= 16) {
    const size_t si = ((((size_t)(s - 16) * 2 + l) * 2 + d) * 32 + g) * 64 + lane;
    hr = lin(p, 4)[si]; hi = lin(p, 5)[si];
  }
  const int nb = T >> 4;
  auto load_u = [&](int blk) -> bf16x8 {
    const int n = blk * 16 + c;
    const int t = d ? (T - 1 - n) : n;
    if (q < 2) return *(const bf16x8*)(proj + (size_t)(R0 + t) * NP + C_UA + g * 16 + 8 * q);
    return zero8;
  };
  bf16x8 ucur = load_u(0);
#pragma unroll 1
  for (int blk = 0; blk < nb; ++blk) {
    bf16x8 unext = zero8;
    if (blk + 1 < nb) unext = load_u(blk + 1);
#pragma unroll
    for (int nt = 0; nt < 8; ++nt) {
      f32x4 z = {0.f, 0.f, 0.f, 0.f};
      const f32x4 dv = MFMA16(ucur, bfr[nt], z);
#pragma unroll
      for (int r = 0; r < 4; ++r) BU[(4 * q + r) * 128 + nt * 16 + c] = dv[r];
    }
#pragma unroll
    for (int i = 0; i < 16; ++i) {
      const float br = BU[i * 128 + lane], bi = BU[i * 128 + 64 + lane];
      const float nr = ar * hr - ai * hi + br;
      const float ni = ar * hi + ai * hr + bi;
      hr = nr; hi = ni;
      *(bf16_t*)(H + i * 272 + lane * 2) = f2bf(hr);
      *(bf16_t*)(H + i * 272 + 128 + lane * 2) = f2bf(hi);
    }
    f32x4 y = {0.f, 0.f, 0.f, 0.f};
#pragma unroll
    for (int ks = 0; ks < 4; ++ks) {
      const bf16x8 a = *(const bf16x8*)(H + c * 272 + (32 * ks + 8 * q) * 2);
      y = MFMA16(a, cfr[ks], y);
    }
#pragma unroll
    for (int r = 0; r < 4; ++r) {
      const int n = blk * 16 + 4 * q + r;
      const int t = d ? (T - 1 - n) : n;
      yd[(size_t)(R0 + t) * 512 + g * 16 + c] = f2bf(y[r]);
    }
    ucur = unext;
  }
  if (s < 16) {
    const size_t so = ((((size_t)s * 2 + l) * 2 + d) * 32 + g) * 64 + lane;
    lout(p)[O_SR + so] = hr; lout(p)[O_SI + so] = hi;
  }
}

DI float gelu_tanh(float x) {
  const float z = 0.7978845608028654f * (x + 0.044715f * x * x * x);
  const float e = __expf(2.f * z);
  const float th = 1.f - 2.f / (e + 1.f);
  return 0.5f * x * (1.f + th);
}
DI void glu_tile(PR p, int l, int t, char* lds, bool dry) {
  const int tid = ltid(), wave = tid >> 6, lane = tid & 63;
  const int m0 = t * 32;
  float* Yf = (float*)lds;
  char* Ya = lds + 66048;
  bf16_t* proj = (bf16_t*)(lws(p) + WS_PROJ);
  const bf16_t* yd0 = (const bf16_t*)(lws(p) + WS_R2);
  const bf16_t* yd1 = yd0 + (size_t)MROWS * 512;
  const float* s5d = lin(p, 20) + l * 512;
  {
    const int row = tid >> 4;
#pragma unroll
    for (int i = 0; i < 4; ++i) {
      const int c0 = (tid & 15) * 8 + 128 * i;
      const u32x4 uu = *(const u32x4*)(proj + (size_t)(m0 + row) * NP + C_UA + c0);
      const u32x4 a0 = *(const u32x4*)(yd0 + (size_t)(m0 + row) * 512 + c0);
      const u32x4 a1 = *(const u32x4*)(yd1 + (size_t)(m0 + row) * 512 + c0);
      float y[8];
#pragma unroll
      for (int e = 0; e < 4; ++e) {
        y[2 * e]     = gelu_tanh(s5d[c0 + 2 * e] * lo_f(uu[e]) + lo_f(a0[e]) + lo_f(a1[e]));
        y[2 * e + 1] = gelu_tanh(s5d[c0 + 2 * e + 1] * hi_f(uu[e]) + hi_f(a0[e]) + hi_f(a1[e]));
      }
#pragma unroll
      for (int e = 0; e < 8; ++e) Yf[row * 516 + c0 + e] = y[e];
      const u32x4 o = {pack2(y[0], y[1]), pack2(y[2], y[3]), pack2(y[4], y[5]), pack2(y[6], y[7])};
      const int ch = c0 >> 3;
      *(u32x4*)(Ya + row * 1024 + ((ch ^ (row & 15)) << 4)) = o;
    }
  }
  __syncthreads();
  const int r = lane & 31, h = lane >> 5;
  const bf16_t* W = (const bf16_t*)(lws(p) + WS_WTGLU) + (size_t)l * 512 * 512;
  f32x16 acc[2];
#pragma unroll
  for (int i = 0; i < 16; ++i) { acc[0][i] = 0.f; acc[1][i] = 0.f; }
#pragma unroll 4
  for (int s = 0; s < 32; ++s) {
    const int ch = 2 * s + h;
    const bf16x8 a = *(const bf16x8*)(Ya + r * 1024 + ((ch ^ (r & 15)) << 4));
#pragma unroll
    for (int ni = 0; ni < 2; ++ni) {
      const bf16x8 b = *(const bf16x8*)(W + (size_t)(wave * 64 + ni * 32 + r) * 512 + ch * 8);
      acc[ni] = MFMA32(a, b, acc[ni]);
    }
  }
#pragma unroll
  for (int ni = 0; ni < 2; ++ni)
#pragma unroll
    for (int i = 0; i < 16; ++i) {
      const int row = (i & 3) + 8 * (i >> 2) + 4 * h;
      const int col = wave * 64 + ni * 32 + r;
      const float y = Yf[row * 516 + col];
      const float z = bf2f(proj[(size_t)(m0 + row) * NP + C_ZA + col]);
      const bf16_t ov = f2bf(y * sigmoidf_(acc[ni][i]) * siluf_(z));
      if (!dry) proj[(size_t)(m0 + row) * NP + C_UA + col] = ov; else asm volatile("" :: "v"((unsigned)ov));
    }
  __syncthreads();
}

DI void ph5_row(PR p, int l, int r) {
  const int lane = ltid() & 63;
  const int c0 = lane * 8;
  bf16_t* proj = (bf16_t*)(lws(p) + WS_PROJ);
  const bf16_t* o0 = (const bf16_t*)(lws(p) + WS_R1);
  const bf16_t* o1 = o0 + (size_t)MROWS * 512;
  const u32x4 a = *(const u32x4*)(o0 + (size_t)r * 512 + c0);
  const u32x4 b = *(const u32x4*)(o1 + (size_t)r * 512 + c0);
  const u32x4 zz = *(const u32x4*)(proj + (size_t)r * NP + C_ZC + c0);
  float o[8];
  float ss = 0.f;
#pragma unroll
  for (int e = 0; e < 4; ++e) {
    o[2 * e] = lo_f(a[e]) + lo_f(b[e]); o[2 * e + 1] = hi_f(a[e]) + hi_f(b[e]);
    ss += o[2 * e] * o[2 * e] + o[2 * e + 1] * o[2 * e + 1];
  }
#pragma unroll
  for (int off = 1; off <= 8; off <<= 1) ss += __shfl_xor(ss, off);
  const float rstd = rsqrtf(ss * (1.f / 128.f) + EPS);
  const float* g = lin(p, 27) + l * 128 + (c0 & 127);
  float v[8];
#pragma unroll
  for (int e = 0; e < 4; ++e) {
    v[2 * e] = o[2 * e] * rstd * g[2 * e] * siluf_(lo_f(zz[e]));
    v[2 * e + 1] = o[2 * e + 1] * rstd * g[2 * e + 1] * siluf_(hi_f(zz[e]));
  }
  const u32x4 w = {pack2(v[0], v[1]), pack2(v[2], v[3]), pack2(v[4], v[5]), pack2(v[6], v[7])};
  *(u32x4*)(proj + (size_t)r * NP + C_QC + c0) = w;
}

constexpr int AT_K = 8192, AT_STAGE = 16384;
DI void att_gload(int tid, PR p, int l, int s, int h, int kt, u32x4& ka, u32x4& kb, u32x4& va, u32x4& vb) {
  const int key = tid >> 4, ch = tid & 15;
  const int j = kt * 32 + key;
  const int R0 = seq_row0(s);
  const bf16_t* proj = (const bf16_t*)(lws(p) + WS_PROJ);
  if (s < 16 || j < 1024) {
    const bf16_t* kr = proj + (size_t)(R0 + j) * NP + C_KB + h * 128;
    ka = *(const u32x4*)(kr + ch * 8);
    kb = *(const u32x4*)(kr + (ch ^ 2) * 8);
    va = *(const u32x4*)(proj + (size_t)(R0 + j) * NP + C_VB + h * 128 + ch * 8);
    vb = va;
  } else {
    const int b = s - 16, jc = j - 1024;
    const float* kc = lin(p, 2) + (((size_t)(b * 2 + l) * 512 + jc) * 4 + h) * 128 + ch * 8;
    const float* vc = lin(p, 3) + (((size_t)(b * 2 + l) * 512 + jc) * 4 + h) * 128 + ch * 8;
    ka = *(const u32x4*)kc; kb = *(const u32x4*)(kc + 4);
    va = *(const u32x4*)vc; vb = *(const u32x4*)(vc + 4);
  }
}
DI void att_lstore(int tid, PR p, int s, int kt, const u32x4& ka, const u32x4& kb, const u32x4& va, const u32x4& vb, char* stage) {
  const int key = tid >> 4, ch = tid & 15;
  const int j = kt * 32 + key;
  u32x4 ko, vo;
  if (s < 16) { ko = ka; vo = va; }
  else if (j < 1024) {
    const int pos = (ch & 4) ? (j & 63) : (j >> 6);
    const float* rc = (const float*)(lws(p) + WS_ROPE) + pos * 16 + (ch & 1) * 8;
    const float sg = (ch & 2) ? 1.f : -1.f;
    float o[8];
#pragma unroll
    for (int e = 0; e < 4; ++e) {
      const float c0 = rc[2 * e], c1 = rc[2 * e + 1], s0 = rc[1024 + 2 * e], s1 = rc[1024 + 2 * e + 1];
      o[2 * e]     = lo_f(ka[e]) * c0 + sg * lo_f(kb[e]) * s0;
      o[2 * e + 1] = hi_f(ka[e]) * c1 + sg * hi_f(kb[e]) * s1;
    }
    ko = u32x4{pack2(o[0], o[1]), pack2(o[2], o[3]), pack2(o[4], o[5]), pack2(o[6], o[7])};
    vo = va;
  } else {
    ko = u32x4{pack2(__uint_as_float(ka[0]), __uint_as_float(ka[1])), pack2(__uint_as_float(ka[2]), __uint_as_float(ka[3])),
               pack2(__uint_as_float(kb[0]), __uint_as_float(kb[1])), pack2(__uint_as_float(kb[2]), __uint_as_float(kb[3]))};
    vo = u32x4{pack2(__uint_as_float(va[0]), __uint_as_float(va[1])), pack2(__uint_as_float(va[2]), __uint_as_float(va[3])),
               pack2(__uint_as_float(vb[0]), __uint_as_float(vb[1])), pack2(__uint_as_float(vb[2]), __uint_as_float(vb[3]))};
  }
  *(u32x4*)(stage + key * 256 + ((ch ^ (key & 15)) << 4)) = ko;
  const int et = ch >> 1, hf = ch & 1;
  *(u32x4*)(stage + AT_K + key * 256 + ((((et ^ (key & 7)) << 1) | hf) << 4)) = vo;
}

DI void att_task(PR p, int l, int s, int h, int qb, char* lds, bool dry) {
  const int tid = ltid(), wave = tid >> 6, lane = tid & 63, q = lane >> 4, c = lane & 15;
  const int R0 = seq_row0(s), T = seq_len(s);
  const int nkeys = s < 16 ? 256 : 1536, nkt = nkeys >> 5;
  bf16_t* proj = (bf16_t*)(lws(p) + WS_PROJ);
  const int tq = qb * 128 + wave * 16 + c;
  const size_t qrow = (size_t)(R0 + tq) * NP;
  bf16x8 qf[2][2];
#pragma unroll
  for (int m = 0; m < 2; ++m)
#pragma unroll
    for (int ks = 0; ks < 2; ++ks) {
      const int d0 = 32 * ks + 8 * q;
      const u32x4 own = *(const u32x4*)(proj + qrow + C_QB + h * 128 + m * 64 + d0);
      float o[8];
      if (s >= 16) {
        const u32x4 par = *(const u32x4*)(proj + qrow + C_QB + h * 128 + m * 64 + (d0 ^ 16));
        const int pos = ks ? (tq & 63) : (tq >> 6);
        const float* rc = (const float*)(lws(p) + WS_ROPE) + pos * 16 + (q & 1) * 8;
        const float sg = (q & 2) ? 1.f : -1.f;
#pragma unroll
        for (int e = 0; e < 4; ++e) {
          o[2 * e]     = lo_f(own[e]) * rc[2 * e] + sg * lo_f(par[e]) * rc[1024 + 2 * e];
          o[2 * e + 1] = hi_f(own[e]) * rc[2 * e + 1] + sg * hi_f(par[e]) * rc[1024 + 2 * e + 1];
        }
      } else {
#pragma unroll
        for (int e = 0; e < 4; ++e) { o[2 * e] = lo_f(own[e]); o[2 * e + 1] = hi_f(own[e]); }
      }
      qf[m][ks] = mk8(pack2(o[0] * 0.125f, o[1] * 0.125f), pack2(o[2] * 0.125f, o[3] * 0.125f),
                      pack2(o[4] * 0.125f, o[5] * 0.125f), pack2(o[6] * 0.125f, o[7] * 0.125f));
    }
  f32x4 O[2][8];
#pragma unroll
  for (int m = 0; m < 2; ++m)
#pragma unroll
    for (int et = 0; et < 8; ++et) O[m][et] = f32x4{0.f, 0.f, 0.f, 0.f};
  float mx[2] = {-1e30f, -1e30f}, lsum[2] = {0.f, 0.f};

  u32x4 ska, skb, sva, svb;
  att_gload(tid, p, l, s, h, 0, ska, skb, sva, svb);
  __syncthreads();
  att_lstore(tid, p, s, 0, ska, skb, sva, svb, lds);
  __syncthreads();
#pragma unroll 1
  for (int kt = 0; kt < nkt; ++kt) {
    const char* cur = lds + (kt & 1) * AT_STAGE;
    if (kt + 1 < nkt) att_gload(tid, p, l, s, h, kt + 1, ska, skb, sva, svb);
    f32x4 S[2][2];
#pragma unroll
    for (int m = 0; m < 2; ++m)
#pragma unroll
      for (int k2 = 0; k2 < 2; ++k2) {
        f32x4 acc = {0.f, 0.f, 0.f, 0.f};
#pragma unroll
        for (int ks = 0; ks < 2; ++ks) {
          const int key = k2 * 16 + c;
          const bf16x8 a = *(const bf16x8*)(cur + key * 256 + (((m * 8 + ks * 4 + q) ^ (key & 15)) << 4));
          acc = MFMA16(a, qf[m][ks], acc);
        }
        S[m][k2] = acc;
      }
    bf16x8 pf[2];
#pragma unroll
    for (int m = 0; m < 2; ++m) {
      float tm = fmaxf(fmaxf(fmaxf(S[m][0][0], S[m][0][1]), fmaxf(S[m][0][2], S[m][0][3])),
                       fmaxf(fmaxf(S[m][1][0], S[m][1][1]), fmaxf(S[m][1][2], S[m][1][3])));
      tm = fmaxf(tm, __shfl_xor(tm, 16));
      tm = fmaxf(tm, __shfl_xor(tm, 32));
      const float mn = fmaxf(mx[m], tm);
      const float alpha = __expf(mx[m] - mn);
      mx[m] = mn;
      float pv[8], ps = 0.f;
#pragma unroll
      for (int k2 = 0; k2 < 2; ++k2)
#pragma unroll
        for (int r = 0; r < 4; ++r) { pv[k2 * 4 + r] = __expf(S[m][k2][r] - mn); ps += pv[k2 * 4 + r]; }
      lsum[m] = lsum[m] * alpha + ps;
#pragma unroll
      for (int et = 0; et < 8; ++et) O[m][et] *= alpha;
      pf[m] = mk8(pack2(pv[0], pv[1]), pack2(pv[2], pv[3]), pack2(pv[4], pv[5]), pack2(pv[6], pv[7]));
    }
    {
      const int qq = c >> 2, pp = c & 3;
      const int kA = 4 * q + qq, kB = 16 + 4 * q + qq;
#pragma unroll
      for (int et = 0; et < 8; ++et) {
        const char* aA = cur + AT_K + kA * 256 + (((et ^ (kA & 7)) << 5)) + pp * 8;
        const char* aB = cur + AT_K + kB * 256 + (((et ^ (kB & 7)) << 5)) + pp * 8;
        const s16x4 lo = __builtin_amdgcn_ds_read_tr16_b64_v4i16((s16x4 LAS*)(const LAS char*)aA);
        const s16x4 hi = __builtin_amdgcn_ds_read_tr16_b64_v4i16((s16x4 LAS*)(const LAS char*)aB);
        const bf16x8 vf = __builtin_shufflevector(lo, hi, 0, 1, 2, 3, 4, 5, 6, 7);
        O[0][et] = MFMA16(vf, pf[0], O[0][et]);
        O[1][et] = MFMA16(vf, pf[1], O[1][et]);
      }
    }
    if (kt + 1 < nkt) att_lstore(tid, p, s, kt + 1, ska, skb, sva, svb, lds + ((kt + 1) & 1) * AT_STAGE);
    __syncthreads();
  }
#pragma unroll
  for (int m = 0; m < 2; ++m) { lsum[m] += __shfl_xor(lsum[m], 16); lsum[m] += __shfl_xor(lsum[m], 32); }
  const float lam = ((const float*)(lws(p) + WS_LAM))[l];
  const float lam_init = 0.8f - 0.6f * expf(-0.3f * (float)l);
  const float i0 = 1.f / lsum[0], i1 = lam / lsum[1];
  float ss = 0.f;
#pragma unroll
  for (int et = 0; et < 8; ++et)
#pragma unroll
    for (int r = 0; r < 4; ++r) { const float o = O[0][et][r] * i0 - O[1][et][r] * i1; O[0][et][r] = o; ss += o * o; }
  ss += __shfl_xor(ss, 16); ss += __shfl_xor(ss, 32);
  const float rstd = rsqrtf(ss * (1.f / 128.f) + EPS) * (1.f - lam_init);
  const float* g = lin(p, 23) + l * 128;
#pragma unroll
  for (int et = 0; et < 8; ++et) {
    const int e0 = 16 * et + 4 * q;
    const u32x2 zz = *(const u32x2*)(proj + qrow + C_ZB + h * 128 + e0);
    const float v0 = O[0][et][0] * rstd * g[e0 + 0] * siluf_(lo_f(zz[0]));
    const float v1 = O[0][et][1] * rstd * g[e0 + 1] * siluf_(hi_f(zz[0]));
    const float v2 = O[0][et][2] * rstd * g[e0 + 2] * siluf_(lo_f(zz[1]));
    const float v3 = O[0][et][3] * rstd * g[e0 + 3] * siluf_(hi_f(zz[1]));
    const u32x2 w = {pack2(v0, v1), pack2(v2, v3)};
    if (!dry) *(u32x2*)(proj + qrow + C_QB + h * 128 + e0) = w; else asm volatile("" :: "v"(w[0]), "v"(w[1]));
  }
}

constexpr int DP_QF = 0, DP_KF = 33792, DP_VF = 67584, DP_MT = 101376, DP_SM = 134144;
DI int kmap8(int ks, int q, int j) { return 32 * ks + 4 * q + (j & 3) + 16 * (j >> 2); }

DI void dn_prep_task(PR p, int l, int gc, int h, char* lds) {
  const int tid = ltid(), lane = tid & 63, q = lane >> 4, c = lane & 15;
  int s, oc;
  if (gc < 64) { s = gc >> 2; oc = gc & 3; } else { s = 16 + ((gc - 64) >> 4); oc = (gc - 64) & 15; }
  const int R0 = seq_row0(s), T = seq_len(s), t0 = oc * 64;
  const bf16_t* proj = (const bf16_t*)(lws(p) + WS_PROJ);
  float* qf = (float*)(lds + DP_QF);
  float* kf = (float*)(lds + DP_KF);
  float* vf = (float*)(lds + DP_VF);
  float* mT = (float*)(lds + DP_MT);
  float* sm = (float*)(lds + DP_SM);
  __syncthreads();
  if (tid < 384) {
    const int cg = tid % 48, rg = tid / 48;
    const int which = cg >> 4, ch0 = (cg & 15) * 8;
    const int col = C_QC + which * 512 + h * 128 + ch0;
    const float* cw = lin(p, 24) + (size_t)l * 5 * 1536 + which * 512 + h * 128 + ch0;
    float w[5][8];
#pragma unroll
    for (int j = 0; j < 5; ++j)
#pragma unroll
      for (int e = 0; e < 8; ++e) w[j][e] = cw[j * 1536 + e];
    u32x4 raw[12];
#pragma unroll
    for (int i = 0; i < 12; ++i) {
      const int t = t0 + rg * 8 + i - 2;
      raw[i] = u32x4{0u, 0u, 0u, 0u};
      if (t >= 0 && t < T) raw[i] = *(const u32x4*)(proj + (size_t)(R0 + t) * NP + col);
    }
    float* dst = which == 0 ? qf : (which == 1 ? kf : vf);
#pragma unroll
    for (int i = 0; i < 8; ++i) {
#pragma unroll
      for (int e2 = 0; e2 < 4; ++e2) {
        float a0 = 0.f, a1 = 0.f;
#pragma unroll
        for (int j = 0; j < 5; ++j) { a0 += w[j][2 * e2] * lo_f(raw[i + j][e2]); a1 += w[j][2 * e2 + 1] * hi_f(raw[i + j][e2]); }
        dst[(rg * 8 + i) * 132 + ch0 + 2 * e2] = siluf_(a0);
        dst[(rg * 8 + i) * 132 + ch0 + 2 * e2 + 1] = siluf_(a1);
      }
    }
  }
  if ((tid & 255) < 64) {
    const int d = tid >> 8;
    const int io = d ? 63 - lane : lane;
    const float* bg = (const float*)(lws(p) + WS_BETAG) + (size_t)(R0 + t0 + io) * 16;
    const float beta = bg[d * 4 + h];
    float g = bg[8 + d * 4 + h];
#pragma unroll
    for (int o = 1; o < 64; o <<= 1) { const float n = __shfl_up(g, o); if (lane >= o) g += n; }
    sm[d * 64 + lane] = beta;
    sm[128 + d * 64 + lane] = g;
    sm[256 + d * 64 + lane] = __expf(g);
  }
  __syncthreads();
  {
    const int wave = tid >> 6;
#pragma unroll 1
    for (int i = 0; i < 16; ++i) {
      const int id = wave * 16 + i, row = id & 63, which = id >> 6;
      float* a = (which ? kf : qf) + row * 132;
      const float v0 = a[lane], v1 = a[64 + lane];
      const float ss = wave_sum(v0 * v0 + v1 * v1);
      const float sc = rsqrtf(ss + EPS) * (which ? 1.f : 0.08838834764831845f);
      a[lane] = v0 * sc; a[64 + lane] = v1 * sc;
    }
  }
  __syncthreads();
  const int d = tid >> 8, w4 = (tid >> 6) & 3;
  const float* beta_s = sm + d * 64;
  const float* gc_s = sm + 128 + d * 64;
  const float* eg_s = sm + 256 + d * 64;
  unsigned char* slot = lws(p) + WS_DNP + (size_t)((gc * 4 + h) * 2 + d) * DNP_SLOT;
  auto orow = [&](int i) -> int { return d ? 63 - i : i; };
  auto ldfrag = [&](const float* base, int row, int ks) -> bf16x8 {
    const f32x4 a = *(const f32x4*)(base + row * 132 + 32 * ks + 8 * q);
    const f32x4 b = *(const f32x4*)(base + row * 132 + 32 * ks + 8 * q + 4);
    return mk8(pack2(a[0], a[1]), pack2(a[2], a[3]), pack2(b[0], b[1]), pack2(b[2], b[3]));
  };
  {
    const int it = w4;
    bf16x8 kfr_i[4], qfr_i[4];
#pragma unroll
    for (int ks = 0; ks < 4; ++ks) { kfr_i[ks] = ldfrag(kf, orow(16 * it + c), ks); qfr_i[ks] = ldfrag(qf, orow(16 * it + c), ks); }
    f32x4 kq[4];
#pragma unroll
    for (int jt = 0; jt < 4; ++jt) {
      f32x4 kk = {0.f, 0.f, 0.f, 0.f}, kq_ = {0.f, 0.f, 0.f, 0.f};
#pragma unroll
      for (int ks = 0; ks < 4; ++ks) {
        const bf16x8 kfr_j = ldfrag(kf, orow(16 * jt + c), ks);
        kk = MFMA16(kfr_i[ks], kfr_j, kk);
        kq_ = MFMA16(kfr_j, qfr_i[ks], kq_);
      }
      {
        const int j = 16 * jt + c;
        const float gj = gc_s[j];
#pragma unroll
        for (int r = 0; r < 4; ++r) {
          const int i = 16 * it + 4 * q + r;
          const float v = i > j ? beta_s[i] * kk[r] * __expf(gc_s[i] - gj) : 0.f;
          mT[d * 4096 + j * 64 + i] = v;
        }
      }
      {
        const int i = 16 * it + c;
        const float gi = gc_s[i];
#pragma unroll
        for (int r = 0; r < 4; ++r) {
          const int j = 16 * jt + 4 * q + r;
          kq_[r] = i >= j ? kq_[r] * __expf(gi - gc_s[j]) : 0.f;
        }
      }
      kq[jt] = kq_;
      asm volatile("" ::: "memory");
    }
#pragma unroll
    for (int ks2 = 0; ks2 < 2; ++ks2) {
      const f32x4 a = kq[2 * ks2], b = kq[2 * ks2 + 1];
      const u32x4 o = {pack2(a[0], a[1]), pack2(a[2], a[3]), pack2(b[0], b[1]), pack2(b[2], b[3])};
      *(u32x4*)(slot + SL_QK + ((it * 2 + ks2) * 64 + lane) * 16) = o;
    }
    asm volatile("" ::: "memory");
    {
      const int i = 16 * it + c, io = orow(i);
      const float egi = eg_s[i];
#pragma unroll
      for (int ks = 0; ks < 4; ++ks) {
        const f32x4 a = *(const f32x4*)(qf + io * 132 + 32 * ks + 4 * q);
        const f32x4 b = *(const f32x4*)(qf + io * 132 + 32 * ks + 16 + 4 * q);
        const u32x4 o = {pack2(a[0] * egi, a[1] * egi), pack2(a[2] * egi, a[3] * egi), pack2(b[0] * egi, b[1] * egi), pack2(b[2] * egi, b[3] * egi)};
        *(u32x4*)(slot + SL_QG + ((it * 4 + ks) * 64 + lane) * 16) = o;
      }
    }
    asm volatile("" ::: "memory");
    {
      const float gl = gc_s[63];
#pragma unroll
      for (int mm = 0; mm < 2; ++mm) {
        const int mt8 = 2 * w4 + mm, dk = 16 * mt8 + c;
#pragma unroll
        for (int ks2 = 0; ks2 < 2; ++ks2) {
          float v[8];
#pragma unroll
          for (int j = 0; j < 8; ++j) {
            const int i = kmap8(ks2, q, j);
            v[j] = kf[orow(i) * 132 + dk] * __expf(gl - gc_s[i]);
          }
          const u32x4 o = {pack2(v[0], v[1]), pack2(v[2], v[3]), pack2(v[4], v[5]), pack2(v[6], v[7])};
          *(u32x4*)(slot + SL_KGT + ((mt8 * 2 + ks2) * 64 + lane) * 16) = o;
        }
      }
      if (w4 == 0 && lane == 0) ((float*)(lws(p) + WS_EGL))[(gc * 4 + h) * 2 + d] = __expf(gl);
    }
  }
  {
    bf16_t* XA = (bf16_t*)(lds + DP_QF) + d * 32 * 260;
    bf16_t* XC = (bf16_t*)(lds + DP_KF + 16 * 528) + d * 16 * 260;
    bf16_t* XD = (bf16_t*)(lds + DP_VF + 16 * 528) + d * 16 * 260;
    const int col = tid & 255;
    const float* rsrc = col < 128 ? vf + col : kf + (col - 128);
    const float* mcol = mT + d * 4096;
    __syncthreads();
#pragma unroll 1
    for (int b = 0; b < 4; ++b) {
      float x[16];
#pragma unroll
      for (int i = 0; i < 16; ++i) {
        const int ii = 16 * b + i;
        const float sc = col < 128 ? beta_s[ii] : beta_s[ii] * eg_s[ii];
        x[i] = rsrc[orow(ii) * 132] * sc;
      }
      const int nA = b < 2 ? 16 * b : 32;
#pragma unroll 2
      for (int j = 0; j < nA; ++j) {
        const float xj = bf2f(XA[j * 260 + col]);
        const float* mr = mcol + j * 64 + 16 * b;
#pragma unroll
        for (int i4 = 0; i4 < 4; ++i4) {
          const f32x4 mm = *(const f32x4*)(mr + i4 * 4);
          x[i4 * 4 + 0] -= mm[0] * xj; x[i4 * 4 + 1] -= mm[1] * xj; x[i4 * 4 + 2] -= mm[2] * xj; x[i4 * 4 + 3] -= mm[3] * xj;
        }
      }
      if (b == 3) {
#pragma unroll 2
        for (int j = 0; j < 16; ++j) {
          const float xj = bf2f(XC[j * 260 + col]);
          const float* mr = mcol + (32 + j) * 64 + 48;
#pragma unroll
          for (int i4 = 0; i4 < 4; ++i4) {
            const f32x4 mm = *(const f32x4*)(mr + i4 * 4);
            x[i4 * 4 + 0] -= mm[0] * xj; x[i4 * 4 + 1] -= mm[1] * xj; x[i4 * 4 + 2] -= mm[2] * xj; x[i4 * 4 + 3] -= mm[3] * xj;
          }
        }
      }
      const float* md = mcol + (16 * b) * 64 + 16 * b;
#pragma unroll
      for (int j = 0; j < 15; ++j) {
        const float xj = x[j];
#pragma unroll
        for (int i4 = 0; i4 < 16; i4 += 4) {
          if (i4 + 3 > j) {
            const f32x4 mm = *(const f32x4*)(md + j * 64 + i4);
            if (i4 + 0 > j) x[i4 + 0] -= mm[0] * xj;
            if (i4 + 1 > j) x[i4 + 1] -= mm[1] * xj;
            if (i4 + 2 > j) x[i4 + 2] -= mm[2] * xj;
            if (i4 + 3 > j) x[i4 + 3] -= mm[3] * xj;
          }
        }
      }
      if (b == 2) __syncthreads();
      bf16_t* dstx = b < 2 ? XA + (16 * b) * 260 : (b == 2 ? XC : XD);
#pragma unroll
      for (int i = 0; i < 16; ++i) dstx[i * 260 + col] = f2bf(x[i]);
      __syncthreads();
    }
  }
  {
    const int tid4 = ltid(), lane = tid4 & 63, q = lane >> 4, c = lane & 15, w4 = (tid4 >> 6) & 3, d = tid4 >> 8;
    unsigned char* slot = lws(p) + WS_DNP + (size_t)((gc * 4 + h) * 2 + d) * DNP_SLOT;
    const bf16_t* XA = (const bf16_t*)(lds + DP_QF) + d * 32 * 260;
    const bf16_t* XC = (const bf16_t*)(lds + DP_KF + 16 * 528) + d * 16 * 260;
    const bf16_t* XD = (const bf16_t*)(lds + DP_VF + 16 * 528) + d * 16 * 260;
    auto Xrow = [&](int i) -> const bf16_t* { return i < 32 ? XA + i * 260 : (i < 48 ? XC + (i - 32) * 260 : XD + (i - 48) * 260); };
#pragma unroll
    for (int ks = 0; ks < 4; ++ks) {
      const bf16_t* xr = Xrow(16 * w4 + c);
      const u32x2 a = *(const u32x2*)(xr + 128 + 32 * ks + 4 * q);
      const u32x2 b = *(const u32x2*)(xr + 128 + 32 * ks + 16 + 4 * q);
      const u32x4 o = {a[0] ^ 0x80008000u, a[1] ^ 0x80008000u, b[0] ^ 0x80008000u, b[1] ^ 0x80008000u};
      *(u32x4*)(slot + SL_W + ((w4 * 4 + ks) * 64 + lane) * 16) = o;
    }
#pragma unroll
    for (int cc = 0; cc < 2; ++cc) {
      const int cs = 2 * w4 + cc;
#pragma unroll
      for (int mt = 0; mt < 4; ++mt) {
        unsigned short v[4];
#pragma unroll
        for (int r = 0; r < 4; ++r) v[r] = Xrow(16 * mt + 4 * q + r)[16 * cs + c];
        const u32x2 o = {(unsigned)v[0] | ((unsigned)v[1] << 16), (unsigned)v[2] | ((unsigned)v[3] << 16)};
        *(u32x2*)(slot + SL_U + ((cs * 4 + mt) * 64 + lane) * 8) = o;
      }
    }
  }
}

constexpr int CH_STAGE = 57344;
DI void dn_chain_task(PR p, int l, int s, int h, int d, char* lds) {
  const int tid = ltid(), cs = tid >> 6, lane = tid & 63, q = lane >> 4, c = lane & 15;
  const int R0 = seq_row0(s), T = seq_len(s), nc = T >> 6;
  const int gc0 = s < 16 ? s * 4 : 64 + (s - 16) * 16;
  bf16_t* odir = (bf16_t*)(lws(p) + WS_R1) + (size_t)d * MROWS * 512;
  const float* egl = (const float*)(lws(p) + WS_EGL);
  f32x4 S[8];
  if (s >= 16) {
    const float* s0 = lin(p, 6) + ((((size_t)(s - 16) * 2 + l) * 2 + d) * 4 + h) * 16384;
#pragma unroll
    for (int i = 0; i < 8; ++i)
#pragma unroll
      for (int r = 0; r < 4; ++r) S[i][r] = s0[(16 * i + 4 * q + r) * 128 + 16 * cs + c];
  } else {
#pragma unroll
    for (int i = 0; i < 8; ++i) S[i] = f32x4{0.f, 0.f, 0.f, 0.f};
  }
  auto slot_of = [&](int step) -> const unsigned char* {
    const int oc = d ? nc - 1 - step : step;
    return lws(p) + WS_DNP + (size_t)(((gc0 + oc) * 4 + h) * 2 + d) * DNP_SLOT;
  };
  u32x4 stg[7];
  auto gload = [&](int step) {
    const unsigned char* sl = slot_of(step);
#pragma unroll
    for (int i = 0; i < 7; ++i) stg[i] = *(const u32x4*)(sl + (size_t)(tid + NT * i) * 16);
  };
  auto lstore = [&](char* st) {
#pragma unroll
    for (int i = 0; i < 7; ++i) *(u32x4*)(st + (tid + NT * i) * 16) = stg[i];
  };
  gload(0);
  __syncthreads();
  lstore(lds);
  __syncthreads();
#pragma unroll 1
  for (int step = 0; step < nc; ++step) {
    const char* cur = lds + (step & 1) * CH_STAGE;
    if (step + 1 < nc) gload(step + 1);
    const unsigned char* sl = slot_of(step);
    const int oc = d ? nc - 1 - step : step;
    const float gl = egl[((gc0 + oc) * 4 + h) * 2 + d];
    bf16x8 Sb[4];
#pragma unroll
    for (int ks = 0; ks < 4; ++ks)
      Sb[ks] = mk8(pack2(S[2 * ks][0], S[2 * ks][1]), pack2(S[2 * ks][2], S[2 * ks][3]),
                   pack2(S[2 * ks + 1][0], S[2 * ks + 1][1]), pack2(S[2 * ks + 1][2], S[2 * ks + 1][3]));
    f32x4 av[4], ao[4];
#pragma unroll
    for (int mt = 0; mt < 4; ++mt) {
      const u32x2 u = *(const u32x2*)(sl + SL_U + ((cs * 4 + mt) * 64 + lane) * 8);
      av[mt] = f32x4{lo_f(u[0]), hi_f(u[0]), lo_f(u[1]), hi_f(u[1])};
      ao[mt] = f32x4{0.f, 0.f, 0.f, 0.f};
    }
#pragma unroll
    for (int ks = 0; ks < 4; ++ks)
#pragma unroll
      for (int mt = 0; mt < 4; ++mt) {
        const bf16x8 wf = *(const bf16x8*)(cur + SL_W + ((mt * 4 + ks) * 64 + lane) * 16);
        av[mt] = MFMA16(wf, Sb[ks], av[mt]);
        const bf16x8 gf = *(const bf16x8*)(cur + SL_QG + ((mt * 4 + ks) * 64 + lane) * 16);
        ao[mt] = MFMA16(gf, Sb[ks], ao[mt]);
      }
    bf16x8 Vb[2];
#pragma unroll
    for (int k2 = 0; k2 < 2; ++k2)
      Vb[k2] = mk8(pack2(av[2 * k2][0], av[2 * k2][1]), pack2(av[2 * k2][2], av[2 * k2][3]),
                   pack2(av[2 * k2 + 1][0], av[2 * k2 + 1][1]), pack2(av[2 * k2 + 1][2], av[2 * k2 + 1][3]));
#pragma unroll
    for (int k2 = 0; k2 < 2; ++k2)
#pragma unroll
      for (int mt = 0; mt < 4; ++mt) {
        const bf16x8 f = *(const bf16x8*)(cur + SL_QK + ((mt * 2 + k2) * 64 + lane) * 16);
        ao[mt] = MFMA16(f, Vb[k2], ao[mt]);
      }
#pragma unroll
    for (int i = 0; i < 8; ++i) {
      S[i] *= gl;
#pragma unroll
      for (int k2 = 0; k2 < 2; ++k2) {
        const bf16x8 f = *(const bf16x8*)(cur + SL_KGT + ((i * 2 + k2) * 64 + lane) * 16);
        S[i] = MFMA16(f, Vb[k2], S[i]);
      }
    }
#pragma unroll
    for (int mt = 0; mt < 4; ++mt)
#pragma unroll
      for (int r = 0; r < 4; ++r) {
        const int i = 16 * mt + 4 * q + r;
        const int t = oc * 64 + (d ? 63 - i : i);
        odir[(size_t)(R0 + t) * 512 + h * 128 + 16 * cs + c] = f2bf(ao[mt][r]);
      }
    if (step + 1 < nc) lstore(lds + ((step + 1) & 1) * CH_STAGE);
    __syncthreads();
  }
  if (s < 16) {
    float* so = lout(p) + O_DN + ((((size_t)s * 2 + l) * 2 + d) * 4 + h) * 16384;
#pragma unroll
    for (int i = 0; i < 8; ++i)
#pragma unroll
      for (int r = 0; r < 4; ++r) so[(16 * i + 4 * q + r) * 128 + 16 * cs + c] = S[i][r];
  }
}

constexpr int N_PHASES = 16;
constexpr int LDS_QSH = LDS_BYTES - 16;
constexpr int LDS_BST = LDS_BYTES - 32;

DI void run_prep(PR p) {
  const int G = gridDim.x, bid = blockIdx.x;
  for (int t = bid; t < 192; t += G) ph0_adaln(p, t, smem);
  for (int t = bid; t < 16; t += G) ph0_s5(p, t);
  if (bid == G - 1) ph0_misc(p);
  for (int t = bid; t < 2048; t += G) cvt_win_tile(p, 0, t, smem);
  for (int t = bid; t < 1408; t += G) cvt_other_tile(p, t, smem);
}
DI void run_final(PR p) {
  const int G = gridDim.x, bid = blockIdx.x, wave = threadIdx.x >> 6;
  for (int r = bid * 8 + wave; r < MROWS; r += G * 8) ph_final_row(p, r);
}
DI void run_norm(PR p, int l) {
  const int G = gridDim.x, bid = blockIdx.x, wave = threadIdx.x >> 6;
  for (int rb = bid * 8 + wave; rb < 4096; rb += G * 8) ph1_norm_rows(p, l, rb);
}
DI void run_cvt1(PR p) {
  const int G = gridDim.x, bid = blockIdx.x;
  for (int t = bid; t < 2048; t += G) cvt_win_tile(p, 1, t, smem);
}
DI void run_inproj(PR p, int l) {
  const int G = gridDim.x, bid = blockIdx.x;
  for (int t = bid; t < 2048; t += G) ph2_inproj_tile(p, l, t, smem);
}
DI void run_s5(PR p, int l) {
  const int G = gridDim.x, bid = blockIdx.x, wave = threadIdx.x >> 6;
  for (int b = bid; b < 256; b += G) {
    if (wave == 0) {
      const int s = 16 + (b >> 6), d = (b >> 5) & 1, g = b & 31;
      s5_task(p, l, s, d, g, smem + wave * S5_WLDS);
    } else if (wave < 5) {
      const int i = b * 4 + (wave - 1);
      const int s = i >> 6, d = (i >> 5) & 1, g = i & 31;
      s5_task(p, l, s, d, g, smem + wave * S5_WLDS);
    }
  }
}
DI void run_att(PR p, int l, int t, bool dry = false) {
  if (t < 128) { const int s = 16 + (t >> 5), h = (t >> 3) & 3, qb = t & 7; att_task(p, l, s, h, qb, smem, dry); }
  else { const int u = t - 128, s = u >> 3, h = (u >> 1) & 3, qb = u & 1; att_task(p, l, s, h, qb, smem, dry); }
}
DI void run_prep_dn(PR p, int l, int u) { dn_prep_task(p, l, u >> 2, u & 3, smem); }
DI void run_chain(PR p, int l) {
  const int G = gridDim.x, bid = blockIdx.x;
  for (int b = bid; b < 160; b += G) {
    const int s = b < 32 ? 16 + (b >> 3) : (b - 32) >> 3;
    const int h = (b >> 1) & 3, d = b & 1;
    dn_chain_task(p, l, s, h, d, smem);
  }
}
DI void run_glu(PR p, int l, int t, bool dry = false) { glu_tile(p, l, t, smem, dry); }
DI void run_ph5(PR p, int l) {
  const int G = gridDim.x, bid = blockIdx.x, wave = threadIdx.x >> 6;
  for (int r = bid * 8 + wave; r < MROWS; r += G * 8) ph5_row(p, l, r);
}
DI void run_merge(PR p, int l) {
  const int G = gridDim.x, bid = blockIdx.x;
  for (int t = bid; t < 256; t += G) ph6_merge_tile(p, l, t, smem);
}
DI void run_out(PR p, int l) {
  const int G = gridDim.x, bid = blockIdx.x;
  for (int t = bid; t < 256; t += G) ph7_out_tile(p, l, t, smem);
}
DI void run_barrier(PR p, unsigned x) {
  XcdBarrier xb; xb.bar = (unsigned*)(p.ws + WS_BAR); xb.x = x; xb.st = (volatile LAS unsigned*)(LAS char*)(smem + LDS_BST);
  xcd_barrier(xb);
}

#ifndef REP
#define REP 0
#endif
template <int PH> DI void run_phase1(PR p, volatile int* qsh, unsigned* qw) {
  if constexpr (PH == 0) run_prep(p);
  else if constexpr (PH == 15) run_final(p);
  else {
    constexpr int l = (PH - 1) / 7, sub = (PH - 1) % 7;
    if constexpr (sub == 0) { run_norm(p, l); if constexpr (l == 1) run_cvt1(p); }
    else if constexpr (sub == 1) run_inproj(p, l);
    else if constexpr (sub == 2) {
      run_s5(p, l);
      if constexpr ((REP >> 16) & 1) run_s5(p, l);
      if constexpr ((REP >> 17) & 1) for (;;) { const int t = queue_pull(&qw[l * 8 + 3], qsh); if (t >= 256) break; run_att(p, l, t, true); }
      for (;;) {
        const int t = queue_pull(&qw[l * 8 + 0], qsh);
        if (t >= 256) break;
        run_att(p, l, t);
      }
      for (;;) {
        const int t = queue_pull(&qw[l * 8 + 2], qsh);
        if (t >= 512) break;
        run_prep_dn(p, l, t);
      }
      if constexpr ((REP >> 18) & 1) for (;;) { const int t = queue_pull(&qw[l * 8 + 4], qsh); if (t >= 512) break; run_prep_dn(p, l, t); }
    } else if constexpr (sub == 3) {
      run_chain(p, l);
      if constexpr ((REP >> 19) & 1) run_chain(p, l);
      if constexpr ((REP >> 20) & 1) for (;;) { const int t = queue_pull(&qw[l * 8 + 5], qsh); if (t >= 256) break; run_glu(p, l, t, true); }
      for (;;) {
        const int t = queue_pull(&qw[l * 8 + 1], qsh);
        if (t >= 256) break;
        run_glu(p, l, t);
      }
    }
    else if constexpr (sub == 4) run_ph5(p, l);
    else if constexpr (sub == 5) run_merge(p, l);
    else run_out(p, l);
  }
}
template <int PH> DI void run_phase(PR p, volatile int* qsh, unsigned* qw) {
  run_phase1<PH>(p, qsh, qw);
  if constexpr ((REP >> PH) & 1) { __syncthreads(); run_phase1<PH>(p, qsh, qw); }
}

__global__ void __launch_bounds__(NT) fwd_kernel(Params p_by_value) {
  PR p = *(const __attribute__((address_space(4))) Params*)__builtin_amdgcn_kernarg_segment_ptr();
  volatile int* qsh = (volatile int*)(smem + LDS_QSH);
  unsigned* qw = (unsigned*)(p.ws + WS_Q);
#ifndef ONE_LAUNCH
  switch (p.ph_lo) {
#define PHC(n) case n: run_phase<n>(p, qsh, qw); break;
    PHC(0) PHC(1) PHC(2) PHC(3) PHC(4) PHC(5) PHC(6) PHC(7) PHC(8) PHC(9) PHC(10) PHC(11) PHC(12) PHC(13) PHC(14) PHC(15)
#undef PHC
    default: break;
  }
#else
  volatile LAS unsigned* bst = (volatile LAS unsigned*)(LAS char*)(smem + LDS_BST);
  if (threadIdx.x == 0) { bst[0] = 0u; bst[1] = 0u; }
  __syncthreads();
  const XcdBarrier xb = xcd_barrier_post((unsigned*)(p.ws + WS_BAR), bst);
  const unsigned xcc = xb.x;
#define PHB(n) run_phase<n>(p, qsh, qw); run_barrier(p, xcc);
  PHB(0) PHB(1) PHB(2) PHB(3) PHB(4) PHB(5) PHB(6) PHB(7) PHB(8) PHB(9) PHB(10) PHB(11) PHB(12) PHB(13) PHB(14)
#undef PHB
  run_phase<15>(p, qsh, qw);
#endif
}

extern "C" void kernel_launch(void* const* d_in, const int* in_sizes, int n_in, void* d_out, int out_size,
                              void* d_ws, size_t ws_size, hipStream_t stream) {
  static int grid = 0;
  if (grid == 0) {
    int dev = 0, cus = 0, per_cu = 0;
    if (hipGetDevice(&dev) != hipSuccess || hipDeviceGetAttribute(&cus, hipDeviceAttributeMultiprocessorCount, dev) != hipSuccess) { fprintf(stderr, "kernel_launch: device query failed\n"); grid = -1; return; }
    if (hipFuncSetAttribute((const void*)fwd_kernel, hipFuncAttributeMaxDynamicSharedMemorySize, LDS_BYTES) != hipSuccess) { fprintf(stderr, "kernel_launch: hipFuncSetAttribute failed\n"); grid = -1; return; }
    if (hipOccupancyMaxActiveBlocksPerMultiprocessor(&per_cu, (const void*)fwd_kernel, NT, LDS_BYTES) != hipSuccess || per_cu < 1) { fprintf(stderr, "kernel_launch: occupancy query reports %d\n", per_cu); per_cu = 1; }
    (void)hipGetLastError();
    grid = cus;
    if (ws_size < WS_END) { fprintf(stderr, "kernel_launch: workspace too small (%zu < %zu)\n", ws_size, (size_t)WS_END); grid = -1; return; }
  }
  if (grid < 0) return;
  (void)hipMemsetAsync((char*)d_ws + WS_BAR, 0, WS_ZERO_BYTES, stream);
  Params p{};
  for (int i = 0; i < 31; ++i) p.in[i] = (const float*)d_in[i];
  p.out = (float*)d_out; p.ws = (unsigned char*)d_ws;
#ifndef ONE_LAUNCH
  p.use_bar = 0;
  for (int ph = 0; ph < N_PHASES; ++ph) {
    p.ph_lo = ph; p.ph_hi = ph + 1;
    hipLaunchKernelGGL(fwd_kernel, dim3(grid), dim3(NT), LDS_BYTES, stream, p);
  }
#else
  p.use_bar = 1; p.ph_lo = 0; p.ph_hi = N_PHASES;
  void* args[] = {&p};
  hipError_t e = hipLaunchCooperativeKernel((const void*)fwd_kernel, dim3(grid), dim3(NT), args, LDS_BYTES, stream);
  if (e != hipSuccess) fprintf(stderr, "kernel_launch: cooperative launch failed: %s (grid %d)\n", hipGetErrorString(e), grid);
#endif
}
```

```cpp
#define ONE_LAUNCH 1
#include <hip/hip_runtime.h>
#include <stdint.h>
#include <stdio.h>

#define DI __device__ __forceinline__
typedef unsigned short bf16_t;
using bf16x8 = __attribute__((ext_vector_type(8))) short;
using s16x4  = __attribute__((ext_vector_type(4))) short;
using f32x4  = __attribute__((ext_vector_type(4))) float;
using f32x16 = __attribute__((ext_vector_type(16))) float;
using u32x4  = __attribute__((ext_vector_type(4))) unsigned;
using u32x2  = __attribute__((ext_vector_type(2))) unsigned;
typedef __bf16 bf16x2_t __attribute__((ext_vector_type(2)));
typedef float f32x2_t __attribute__((ext_vector_type(2)));
#define LAS __attribute__((address_space(3)))

#define MFMA16(a, b, c) __builtin_amdgcn_mfma_f32_16x16x32_bf16((a), (b), (c), 0, 0, 0)
#define MFMA32(a, b, c) __builtin_amdgcn_mfma_f32_32x32x16_bf16((a), (b), (c), 0, 0, 0)

constexpr int NT = 512;
constexpr int DM = 1024;
constexpr int MROWS = 8192;
constexpr int NP = 8192;
constexpr int NIN = 8208;
constexpr float EPS = 1e-6f;
constexpr int C_UA = 0, C_ZA = 512, C_QB = 1024, C_KB = 1536, C_VB = 2048, C_ZB = 2560;
constexpr int C_QC = 3072, C_KC = 3584, C_VC = 4096, C_ZC = 4608, C_GT = 5120;
constexpr size_t O_Y = 0;
constexpr size_t O_CK = 8388608;
constexpr size_t O_CV = O_CK + 4194304;
constexpr size_t O_SR = O_CV + 4194304;
constexpr size_t O_SI = O_SR + 131072;
constexpr size_t O_DN = O_SI + 131072;

constexpr size_t WS_BAR   = 0;
constexpr size_t WS_Q     = 16384;
constexpr size_t WS_ZERO_BYTES = 16384 + 1024;
constexpr size_t WS_MOD   = 32768;
constexpr size_t WS_S5AR  = WS_MOD + 122880;
constexpr size_t WS_S5AI  = WS_S5AR + 32768;
constexpr size_t WS_S5BB  = WS_S5AI + 32768;
constexpr size_t WS_S5CT  = WS_S5BB + 524288;
constexpr size_t WS_ROPE  = WS_S5CT + 524288;
constexpr size_t WS_LAM   = WS_ROPE + 8192;
constexpr size_t WS_WBA   = WS_LAM + 256;
constexpr size_t WS_BETAG = WS_WBA + 131072;
constexpr size_t WS_EGL   = WS_BETAG + 524288;
constexpr size_t WS_WTGLU = WS_EGL + 4096;
constexpr size_t WS_WTBR  = WS_WTGLU + 1048576;
constexpr size_t WS_WTOUT = WS_WTBR + 6291456;
constexpr size_t WS_R1    = WS_WTOUT + 4194304;
constexpr size_t WS_R2    = WS_R1 + 16777216;
constexpr size_t WS_PROJ  = WS_R2 + 16777216;
constexpr size_t WS_DNP   = WS_PROJ + 134217728;
constexpr size_t DNP_SLOT = 73728;
constexpr size_t WS_END   = WS_DNP + 1024 * DNP_SLOT;
constexpr int SL_W = 0, SL_QG = 16384, SL_KGT = 32768, SL_QK = 49152, SL_U = 57344;

constexpr int LDS_BYTES = 147456;

struct Params {
  const float* in[31];
  float* out;
  unsigned char* ws;
  int ph_lo, ph_hi;
  int use_bar, pad;
};
typedef const __attribute__((address_space(4))) Params& PR;
#define NI __device__ __noinline__
extern __shared__ __attribute__((aligned(16))) char smem[];
#define GAS __attribute__((address_space(1)))
DI unsigned char* lws(PR p) { GAS unsigned char* w = (GAS unsigned char*)p.ws; asm volatile("" : "+s"(w)); return (unsigned char*)w; }
DI const float* lin(PR p, int k) { GAS const float* w = (GAS const float*)p.in[k]; asm volatile("" : "+s"(w)); return (const float*)w; }
DI int ltid() {
  const int w = __builtin_amdgcn_readfirstlane((int)(threadIdx.x >> 6));
  int t = (w << 6) | (int)__builtin_amdgcn_mbcnt_hi(~0u, __builtin_amdgcn_mbcnt_lo(~0u, 0u));
  asm volatile("" : "+v"(t));
  return t;
}
DI float* lout(PR p) { GAS float* w = (GAS float*)p.out; asm volatile("" : "+s"(w)); return (float*)w; }

DI float bf2f(unsigned short h) { return __uint_as_float(((unsigned)h) << 16); }
DI unsigned pack2(float lo, float hi) { f32x2_t f = {lo, hi}; bf16x2_t v = __builtin_convertvector(f, bf16x2_t); return __builtin_bit_cast(unsigned, v); }
DI unsigned short f2bf(float x) { return (unsigned short)(pack2(x, 0.f) & 0xffffu); }
DI float lo_f(unsigned u) { return __uint_as_float(u << 16); }
DI float hi_f(unsigned u) { return __uint_as_float(u & 0xffff0000u); }
DI float sigmoidf_(float x) { return 1.f / (1.f + __expf(-x)); }
DI float siluf_(float x) { return x / (1.f + __expf(-x)); }
DI float wave_sum(float v) {
#pragma unroll
  for (int o = 32; o >= 1; o >>= 1) v += __shfl_xor(v, o);
  return v;
}
DI bf16x8 mk8(unsigned a, unsigned b, unsigned c, unsigned d) { u32x4 u = {a, b, c, d}; return __builtin_bit_cast(bf16x8, u); }

#define XB_TMO      128
#define XB_XCNT(j)  (256  + 64 * (j))
#define XB_XSUB(j)  (1280 + 64 * (j))
#define XB_XGEN(j)  (2304 + 64 * (j))
#define XB_TOP      3328
#define XB_TOPGEN   3392
#define XCD_BAR_WORDS 3456
#define XB_SPIN_CAP (1u << 22)
DI unsigned xb_ld(unsigned* p)              { return __hip_atomic_load(p, __ATOMIC_RELAXED, __HIP_MEMORY_SCOPE_AGENT); }
DI unsigned xb_add(unsigned* p, unsigned v) { return __hip_atomic_fetch_add(p, v, __ATOMIC_RELAXED, __HIP_MEMORY_SCOPE_AGENT); }
DI unsigned xb_xcc_id() { return (unsigned)__builtin_amdgcn_s_getreg((3 << 11) | 20) & 0xFu; }
#define XB_SPIN(cond, bar) do { unsigned _sp = 0; while (cond) { __builtin_amdgcn_s_sleep(1); \
    if ((++_sp & 255u) == 0u) { if (xb_ld(&(bar)[XB_TMO])) break; if (_sp > XB_SPIN_CAP) { atomicAdd(&(bar)[XB_TMO], 1u); break; } } } } while (0)
struct XcdBarrier { unsigned* bar; unsigned x; volatile LAS unsigned* st; };
DI XcdBarrier xcd_barrier_post(unsigned* bar, volatile LAS unsigned* st) {
  XcdBarrier b; b.bar = bar; b.x = xb_xcc_id(); b.st = st;
  if (threadIdx.x == 0) (void)xb_add(&bar[XB_XCNT(b.x)], 1u);
  return b;
}
DI void xcd_barrier_complete(unsigned* bar, unsigned x, unsigned& nloc, unsigned& nx) {
  const unsigned G = gridDim.x;
  unsigned sum, cnt, mine, sp = 0u;
  for (;;) {
    sum = 0u; cnt = 0u; mine = 0u;
#pragma unroll
    for (unsigned j = 0; j < 16; ++j) { const unsigned c = xb_ld(&bar[XB_XCNT(j)]); sum += c; cnt += (c > 0u) ? 1u : 0u; mine = (j == x) ? c : mine; }
    if (sum == G) break;
    __builtin_amdgcn_s_sleep(1);
    if ((++sp & 255u) == 0u) { if (xb_ld(&bar[XB_TMO])) break; if (sp > XB_SPIN_CAP) { atomicAdd(&bar[XB_TMO], 1u); break; } }
  }
  nloc = mine > 0u ? mine : 1u; nx = cnt > 0u ? cnt : 1u;
}
DI void xcd_barrier(const XcdBarrier& b) {
  asm volatile("s_waitcnt vmcnt(0)" ::: "memory");
  __syncthreads();
  if (threadIdx.x == 0) {
    unsigned* bar = b.bar;
    __builtin_amdgcn_s_waitcnt(0);
    unsigned nloc = b.st[0], nx = b.st[1];
    if (nloc == 0u) { xcd_barrier_complete(bar, b.x, nloc, nx); b.st[0] = nloc; b.st[1] = nx; }
    const unsigned old = xb_add(&bar[XB_XSUB(b.x)], 1u);
    const unsigned gen = old / nloc;
    if (old + 1u == (gen + 1u) * nloc) {
      __builtin_amdgcn_fence(__ATOMIC_RELEASE, "agent");
      asm volatile("s_waitcnt vmcnt(0)" ::: "memory");
      const unsigned og = xb_add(&bar[XB_TOP], 1u);
      const unsigned tg = og / nx;
      if (og + 1u == (tg + 1u) * nx) xb_add(&bar[XB_TOPGEN], 1u);
      else XB_SPIN(xb_ld(&bar[XB_TOPGEN]) == tg, bar);
      __builtin_amdgcn_fence(__ATOMIC_ACQUIRE, "agent");
      xb_add(&bar[XB_XGEN(b.x)], 1u);
      asm volatile("s_waitcnt vmcnt(0)" ::: "memory");
    } else {
      XB_SPIN(xb_ld(&bar[XB_XGEN(b.x)]) == gen, bar);
      __builtin_amdgcn_fence(__ATOMIC_ACQUIRE, "agent");
      asm volatile("s_waitcnt vmcnt(0)" ::: "memory");
    }
  }
  __syncthreads();
}

DI int queue_pull(unsigned* q, volatile int* sh) {
  __syncthreads();
  if (ltid() == 0) *sh = (int)xb_add(q, 1u);
  __syncthreads();
  return *sh;
}

DI int seq_row0(int s) { return s < 16 ? s * 256 : 4096 + (s - 16) * 1024; }
DI int seq_len(int s) { return s < 16 ? 256 : 1024; }
DI int row_cond(int r) { return r < 4096 ? 0 : 1 + ((r - 4096) >> 10); }
DI const float* x_in_row(PR p, int l, int r) {
  if (l == 0) return r < 4096 ? lin(p, 0) + (size_t)r * DM : lin(p, 1) + (size_t)(r - 4096) * DM;
  return lout(p) + O_Y + (size_t)r * DM;
}

DI void ph0_adaln(PR p, int a, char* lds) {
  const int l = a / 96, cb = a % 96, tid = ltid();
  float* scond = (float*)lds;
  float* red = scond + 5 * 1024;
  for (int i = tid; i < 5 * 1024; i += NT) {
    const int ci = i >> 10, k = i & 1023;
    const float c = ci == 0 ? lin(p, 8)[k] : lin(p, 7)[(ci - 1) * 1024 + k];
    scond[i] = c / (1.f + expf(-c));
  }
  __syncthreads();
  const int tx = tid & 31, ty = tid >> 5;
  const float* w = lin(p, 10) + (size_t)l * 1024 * 3072 + cb * 32 + tx;
  float acc[5] = {0.f, 0.f, 0.f, 0.f, 0.f};
  for (int kk = 0; kk < 64; ++kk) {
    const int k = ty * 64 + kk;
    const float wv = w[(size_t)k * 3072];
#pragma unroll
    for (int ci = 0; ci < 5; ++ci) acc[ci] += scond[ci * 1024 + k] * wv;
  }
#pragma unroll
  for (int ci = 0; ci < 5; ++ci) red[(ty * 5 + ci) * 32 + tx] = acc[ci];
  __syncthreads();
  if (tid < 160) {
    const int ci = tid >> 5, x = tid & 31;
    float s = 0.f;
    for (int y = 0; y < 16; ++y) s += red[(y * 5 + ci) * 32 + x];
    const int col = cb * 32 + x;
    float* mod = (float*)(lws(p) + WS_MOD);
    mod[(l * 5 + ci) * 3072 + col] = s + lin(p, 11)[l * 3072 + col];
  }
  __syncthreads();
}

DI void ph0_s5(PR p, int t) {
  const int idx = t * NT + threadIdx.x;
  const int ldg = idx >> 6, pp = idx & 63;
  const float lre = lin(p, 13)[idx], lim = lin(p, 14)[idx], ls = lin(p, 15)[ldg];
  const float step = expf(ls);
  const float mag = expf(lre * step);
  float sn, cs; sincosf(lim * step, &sn, &cs);
  const float ar = mag * cs, ai = mag * sn;
  const float den = lre * lre + lim * lim;
  const float fr = ((ar - 1.f) * lre + ai * lim) / den;
  const float fi = (ai * lre - (ar - 1.f) * lim) / den;
  ((float*)(lws(p) + WS_S5AR))[idx] = ar;
  ((float*)(lws(p) + WS_S5AI))[idx] = ai;
  bf16_t* bb = (bf16_t*)(lws(p) + WS_S5BB) + (size_t)ldg * 128 * 16;
  bf16_t* ct = (bf16_t*)(lws(p) + WS_S5CT) + (size_t)ldg * 16 * 128;
  const float* bre = lin(p, 16) + (size_t)idx * 16;
  const float* bim = lin(p, 17) + (size_t)idx * 16;
#pragma unroll
  for (int i = 0; i < 16; ++i) {
    const float br = bre[i], bi = bim[i];
    bb[pp * 16 + i] = f2bf(fr * br - fi * bi);
    bb[(64 + pp) * 16 + i] = f2bf(fr * bi + fi * br);
    const float cr = lin(p, 18)[((size_t)ldg * 16 + i) * 64 + pp];
    const float cim = lin(p, 19)[((size_t)ldg * 16 + i) * 64 + pp];
    ct[i * 128 + pp] = f2bf(cr);
    ct[i * 128 + 64 + pp] = f2bf(-cim);
  }
}

DI void ph0_misc(PR p) {
  const int tid = threadIdx.x;
  float* rc = (float*)(lws(p) + WS_ROPE);
  for (int i = tid; i < 1024; i += NT) {
    const int pos = i >> 4, f = i & 15;
    const float inv = powf(10000.f, -(float)f / 16.f);
    const float ang = (float)pos * inv;
    float sn, cs; sincosf(ang, &sn, &cs);
    rc[i] = cs; rc[1024 + i] = sn;
  }
  if (tid < 2) {
    const int l = tid;
    const float* dl = lin(p, 22) + l * 256;
    float s0 = 0.f, s1 = 0.f;
    for (int i = 0; i < 64; ++i) { s0 += dl[i] * dl[64 + i]; s1 += dl[128 + i] * dl[192 + i]; }
    const float lam_init = 0.8f - 0.6f * expf(-0.3f * (float)l);
    ((float*)(lws(p) + WS_LAM))[l] = expf(s0) - expf(s1) + lam_init;
  }
  float* wba = (float*)(lws(p) + WS_WBA);
  for (int i = tid; i < 2 * 16 * 1024; i += NT) {
    const int l = i >> 14, j = (i >> 10) & 15, k = i & 1023;
    wba[i] = lin(p, 12)[((size_t)l * 1024 + k) * NIN + 5120 + j];
  }
}

DI void cvt_tile(const float* src, size_t ld_src, bf16_t* dst, size_t ld_dst, char* lds) {
  float* t = (float*)lds;
  const int tid = ltid();
  const int r = tid >> 4, c4 = (tid & 15) * 4;
#pragma unroll
  for (int ps = 0; ps < 2; ++ps) {
    const int k = r + 32 * ps;
    const f32x4 v = *(const f32x4*)(src + (size_t)k * ld_src + c4);
    t[k * 65 + c4 + 0] = v[0]; t[k * 65 + c4 + 1] = v[1]; t[k * 65 + c4 + 2] = v[2]; t[k * 65 + c4 + 3] = v[3];
  }
  __syncthreads();
  const int n = tid >> 3, kc = tid & 7;
  float v[8];
#pragma unroll
  for (int j = 0; j < 8; ++j) v[j] = t[(kc * 8 + j) * 65 + n];
  u32x4 o = {pack2(v[0], v[1]), pack2(v[2], v[3]), pack2(v[4], v[5]), pack2(v[6], v[7])};
  *(u32x4*)(dst + (size_t)n * ld_dst + kc * 8) = o;
  __syncthreads();
}

DI void cvt_win_tile(PR p, int l, int t, char* lds) {
  const int kt = t & 15, nt = t >> 4;
  const int n0 = nt * 64, nsrc = n0 < 5120 ? n0 : n0 + 16;
  cvt_tile(lin(p, 12) + ((size_t)l * 1024 + kt * 64) * NIN + nsrc, NIN,
           (bf16_t*)(lws(p) + WS_R1) + (size_t)n0 * 1024 + kt * 64, 1024, lds);
}
DI void cvt_other_tile(PR p, int t, char* lds) {
  if (t < 128) {
    const int l = t >> 6, q = t & 63, kt = q & 7, nt = q >> 3;
    cvt_tile(lin(p, 21) + ((size_t)l * 512 + kt * 64) * 512 + nt * 64, 512,
             (bf16_t*)(lws(p) + WS_WTGLU) + ((size_t)l * 512 + nt * 64) * 512 + kt * 64, 512, lds);
  } else if (t < 896) {
    const int u = t - 128, ln = u >> 7, q = u & 127, kt = q & 7, nt = q >> 3;
    cvt_tile(lin(p, 28) + ((size_t)ln * 512 + kt * 64) * 1024 + nt * 64, 1024,
             (bf16_t*)(lws(p) + WS_WTBR) + ((size_t)ln * 1024 + nt * 64) * 512 + kt * 64, 512, lds);
  } else {
    const int u = t - 896, l = u >> 8, q = u & 255, kt = q & 15, nt = q >> 4;
    cvt_tile(lin(p, 29) + ((size_t)l * 1024 + kt * 64) * 1024 + nt * 64, 1024,
             (bf16_t*)(lws(p) + WS_WTOUT) + ((size_t)l * 1024 + nt * 64) * 1024 + kt * 64, 1024, lds);
  }
}

DI void ph1_norm_rows(PR p, int l, int rb) {
  const int lane = ltid() & 63;
  const int r0 = rb * 2, ci = row_cond(r0);
  const float* mod = (const float*)(lws(p) + WS_MOD) + (size_t)(l * 5 + ci) * 3072;
  const float* ng = lin(p, 9) + l * 1024;
  const float* wba = (const float*)(lws(p) + WS_WBA) + (size_t)l * 16 * 1024;
  bf16_t* hn = (bf16_t*)(lws(p) + WS_R2);
  float h[2][16];
#pragma unroll
  for (int ri = 0; ri < 2; ++ri) {
    const float* x = x_in_row(p, l, r0 + ri);
    float ss = 0.f;
#pragma unroll
    for (int i = 0; i < 4; ++i) {
      const f32x4 v = *(const f32x4*)(x + (i * 64 + lane) * 4);
#pragma unroll
      for (int e = 0; e < 4; ++e) { h[ri][i * 4 + e] = v[e]; ss += v[e] * v[e]; }
    }
    ss = wave_sum(ss);
    const float rstd = rsqrtf(ss * (1.f / 1024.f) + EPS);
#pragma unroll
    for (int i = 0; i < 4; ++i) {
      const int k = (i * 64 + lane) * 4;
      const f32x4 g = *(const f32x4*)(ng + k);
      const f32x4 sh = *(const f32x4*)(mod + k);
      const f32x4 sc = *(const f32x4*)(mod + 1024 + k);
#pragma unroll
      for (int e = 0; e < 4; ++e) h[ri][i * 4 + e] = h[ri][i * 4 + e] * rstd * g[e] * (1.f + sc[e]) + sh[e];
      u32x2 o = {pack2(h[ri][i * 4 + 0], h[ri][i * 4 + 1]), pack2(h[ri][i * 4 + 2], h[ri][i * 4 + 3])};
      *(u32x2*)(hn + (size_t)(r0 + ri) * 1024 + k) = o;
    }
  }
  float pt[32];
#pragma unroll
  for (int j = 0; j < 16; ++j) {
    float a0 = 0.f, a1 = 0.f;
#pragma unroll
    for (int i = 0; i < 4; ++i) {
      const f32x4 w = *(const f32x4*)(wba + j * 1024 + (i * 64 + lane) * 4);
#pragma unroll
      for (int e = 0; e < 4; ++e) { a0 += h[0][i * 4 + e] * w[e]; a1 += h[1][i * 4 + e] * w[e]; }
    }
    pt[j] = a0; pt[16 + j] = a1;
    if ((j & 3) == 3) asm volatile("" ::: "memory");
  }
#pragma unroll
  for (int n = 16; n >= 1; n >>= 1) {
    const bool up = (lane & n) != 0;
#pragma unroll
    for (int i = 0; i < n; ++i) {
      const float keep = up ? pt[i + n] : pt[i];
      const float send = up ? pt[i] : pt[i + n];
      pt[i] = keep + __shfl_xor(send, n);
    }
  }
  const float v = pt[0] + __shfl_xor(pt[0], 32);
  if (lane < 32) {
    const int ri = lane >> 4, j = lane & 15;
    float res;
    if (j < 8) res = 1.f / (1.f + expf(-v));
    else {
      const int jj = j - 8;
      const float xx = v + lin(p, 26)[l * 8 + jj];
      const float sp = xx > 20.f ? xx : log1pf(expf(xx));
      res = -expf(lin(p, 25)[l * 8 + jj]) * sp;
    }
    ((float*)(lws(p) + WS_BETAG))[(size_t)(r0 + ri) * 16 + j] = res;
  }
}

constexpr int G_STAGE = 49152;
DI void gemm_gload(int tid, const bf16_t* A, size_t lda, const bf16_t* B, size_t ldb, int k0, u32x4 (&ra)[4], u32x4 (&rb)[2]) {
#pragma unroll
  for (int i = 0; i < 4; ++i) { const int id = tid + NT * i, row = id >> 3, ch = id & 7; ra[i] = *(const u32x4*)(A + (size_t)row * lda + k0 + ch * 8); }
#pragma unroll
  for (int i = 0; i < 2; ++i) { const int id = tid + NT * i, row = id >> 3, ch = id & 7; rb[i] = *(const u32x4*)(B + (size_t)row * ldb + k0 + ch * 8); }
}
DI void gemm_lstore(int tid, char* st, const u32x4 (&ra)[4], const u32x4 (&rb)[2]) {
#pragma unroll
  for (int i = 0; i < 4; ++i) { const int id = tid + NT * i, row = id >> 3, ch = id & 7; *(u32x4*)(st + row * 128 + ((ch ^ ((row >> 1) & 7)) << 4)) = ra[i]; }
#pragma unroll
  for (int i = 0; i < 2; ++i) { const int id = tid + NT * i, row = id >> 3, ch = id & 7; *(u32x4*)(st + 32768 + row * 128 + ((ch ^ ((row >> 1) & 7)) << 4)) = rb[i]; }
}
DI void gemm_compute(const char* st, f32x16 (&acc)[2][2], int wm, int wn, int lane) {
  const int r = lane & 31, h = lane >> 5, sw = (r >> 1) & 7;
#pragma unroll
  for (int s = 0; s < 4; ++s) {
    const int ch = ((2 * s + h) ^ sw) << 4;
    bf16x8 a[2], b[2];
#pragma unroll
    for (int mi = 0; mi < 2; ++mi) a[mi] = *(const bf16x8*)(st + (wm * 64 + mi * 32 + r) * 128 + ch);
#pragma unroll
    for (int ni = 0; ni < 2; ++ni) b[ni] = *(const bf16x8*)(st + 32768 + (wn * 64 + ni * 32 + r) * 128 + ch);
#pragma unroll
    for (int mi = 0; mi < 2; ++mi)
#pragma unroll
      for (int ni = 0; ni < 2; ++ni) acc[mi][ni] = MFMA32(a[mi], b[ni], acc[mi][ni]);
  }
}
DI void gemm_mainloop(int tid, const bf16_t* A, size_t lda, const bf16_t* B, size_t ldb, int K, f32x16 (&acc)[2][2], char* lds) {
  const int wave = tid >> 6, lane = tid & 63, wm = wave >> 1, wn = wave & 1;
  u32x4 ra[4], rb[2];
  gemm_gload(tid, A, lda, B, ldb, 0, ra, rb);
  gemm_lstore(tid, lds, ra, rb);
  __syncthreads();
  const int KT = K >> 6;
  for (int kt = 0; kt < KT; ++kt) {
    char* cur = lds + (kt & 1) * G_STAGE;
    char* nxt = lds + ((kt + 1) & 1) * G_STAGE;
    if (kt + 1 < KT) gemm_gload(tid, A, lda, B, ldb, (kt + 1) * 64, ra, rb);
    gemm_compute(cur, acc, wm, wn, lane);
    if (kt + 1 < KT) gemm_lstore(tid, nxt, ra, rb);
    __syncthreads();
  }
}
DI void acc_zero(f32x16 (&acc)[2][2]) {
#pragma unroll
  for (int a = 0; a < 2; ++a)
#pragma unroll
    for (int b = 0; b < 2; ++b)
#pragma unroll
      for (int i = 0; i < 16; ++i) acc[a][b][i] = 0.f;
}
DI void tile_store_bf16(int tid, const f32x16 (&acc)[2][2], bf16_t* dst, size_t ldd, char* lds) {
  const int wave = tid >> 6, lane = tid & 63, wm = wave >> 1, wn = wave & 1;
  const int cl = lane & 31, h = lane >> 5;
#pragma unroll
  for (int mi = 0; mi < 2; ++mi)
#pragma unroll
    for (int ni = 0; ni < 2; ++ni)
#pragma unroll
      for (int i = 0; i < 16; ++i) {
        const int row = wm * 64 + mi * 32 + (i & 3) + 8 * (i >> 2) + 4 * h;
        const int col = wn * 64 + ni * 32 + cl;
        *(bf16_t*)(lds + row * 272 + col * 2) = f2bf(acc[mi][ni][i]);
      }
  __syncthreads();
#pragma unroll
  for (int i = 0; i < 8; ++i) {
    const int id = tid + NT * i, row = id >> 4, ch = id & 15;
    const u32x4 v = *(const u32x4*)(lds + row * 272 + ch * 16);
    *(u32x4*)(dst + (size_t)row * ldd + ch * 8) = v;
  }
  __syncthreads();
}

DI void ph2_inproj_tile(PR p, int l, int t, char* lds) {
  const int tid = ltid();
  const int nt = t & 63, mt = t >> 6;
  const int m0 = mt * 256, n0 = nt * 128;
  const bf16_t* A = (const bf16_t*)(lws(p) + WS_R2) + (size_t)m0 * 1024;
  const bf16_t* B = (const bf16_t*)(lws(p) + WS_R1) + (size_t)n0 * 1024;
  f32x16 acc[2][2];
  acc_zero(acc);
  gemm_mainloop(tid, A, 1024, B, 1024, 1024, acc, lds);
  if (m0 < 4096 && n0 >= C_KB && n0 < C_ZB) {
    const int wave = tid >> 6, lane = tid & 63, wm = wave >> 1, wn = wave & 1;
    float* base = lout(p) + (n0 < C_VB ? O_CK : O_CV);
    const int cb = (n0 < C_VB ? n0 - C_KB : n0 - C_VB);
#pragma unroll
    for (int mi = 0; mi < 2; ++mi)
#pragma unroll
      for (int ni = 0; ni < 2; ++ni)
#pragma unroll
        for (int i = 0; i < 16; ++i) {
          const int row = m0 + wm * 64 + mi * 32 + (i & 3) + 8 * (i >> 2) + 4 * (lane >> 5);
          const int col = cb + wn * 64 + ni * 32 + (lane & 31);
          const int b = row >> 8, tt = row & 255;
          base[((size_t)(b * 2 + l) * 256 + tt) * 512 + col] = acc[mi][ni][i];
        }
  }
  tile_store_bf16(tid, acc, (bf16_t*)(lws(p) + WS_PROJ) + (size_t)m0 * NP + n0, NP, lds);
}

DI void ph6_merge_tile(PR p, int l, int t, char* lds) {
  const int tid = ltid();
  const int nt = t & 7, mt = t >> 3;
  const int m0 = mt * 256, n0 = nt * 128;
  const int wave = tid >> 6, lane = tid & 63, wm = wave >> 1, wn = wave & 1;
  const bf16_t* proj = (const bf16_t*)(lws(p) + WS_PROJ);
  unsigned tot[2][2][8];
#pragma unroll
  for (int a = 0; a < 2; ++a)
#pragma unroll
    for (int b = 0; b < 2; ++b)
#pragma unroll
      for (int i = 0; i < 8; ++i) tot[a][b][i] = 0u;
#pragma unroll 1
  for (int n = 0; n < 3; ++n) {
    const int acol = n == 0 ? C_UA : (n == 1 ? C_QB : C_QC);
    const bf16_t* A = proj + (size_t)m0 * NP + acol;
    const bf16_t* B = (const bf16_t*)(lws(p) + WS_WTBR) + ((size_t)(l * 3 + n) * 1024 + n0) * 512;
    f32x16 acc[2][2];
    acc_zero(acc);
    gemm_mainloop(tid, A, NP, B, 512, 512, acc, lds);
#pragma unroll
    for (int mi = 0; mi < 2; ++mi)
#pragma unroll
      for (int ni = 0; ni < 2; ++ni) {
#pragma unroll
        for (int i2 = 0; i2 < 8; ++i2) {
          const int i = 2 * i2;
          const int row = m0 + wm * 64 + mi * 32 + (i & 3) + 8 * (i >> 2) + 4 * (lane >> 5);
          const int col = n0 + wn * 64 + ni * 32 + (lane & 31);
          const float g0 = bf2f(proj[(size_t)row * NP + C_GT + n * 1024 + col]);
          const float g1 = bf2f(proj[(size_t)(row + 1) * NP + C_GT + n * 1024 + col]);
          const unsigned o = tot[mi][ni][i2];
          tot[mi][ni][i2] = pack2(lo_f(o) + sigmoidf_(g0) * acc[mi][ni][i], hi_f(o) + sigmoidf_(g1) * acc[mi][ni][i + 1]);
        }
        asm volatile("" ::: "memory");
      }
  }
  bf16_t* dst = (bf16_t*)(lws(p) + WS_R2) + (size_t)m0 * 1024 + n0;
#pragma unroll
  for (int mi = 0; mi < 2; ++mi)
#pragma unroll
    for (int ni = 0; ni < 2; ++ni)
#pragma unroll
      for (int i2 = 0; i2 < 8; ++i2) {
        const int i = 2 * i2;
        const int row = wm * 64 + mi * 32 + (i & 3) + 8 * (i >> 2) + 4 * (lane >> 5);
        const int col = wn * 64 + ni * 32 + (lane & 31);
        *(bf16_t*)(lds + row * 272 + col * 2) = (bf16_t)(tot[mi][ni][i2] & 0xffffu);
        *(bf16_t*)(lds + (row + 1) * 272 + col * 2) = (bf16_t)(tot[mi][ni][i2] >> 16);
      }
  __syncthreads();
#pragma unroll
  for (int i = 0; i < 8; ++i) {
    const int id = tid + NT * i, row = id >> 4, ch = id & 15;
    const u32x4 v = *(const u32x4*)(lds + row * 272 + ch * 16);
    *(u32x4*)(dst + (size_t)row * 1024 + ch * 8) = v;
  }
  __syncthreads();
}

DI void ph7_out_tile(PR p, int l, int t, char* lds) {
  const int tid = ltid();
  const int nt = t & 7, mt = t >> 3;
  const int m0 = mt * 256, n0 = nt * 128;
  const int wave = tid >> 6, lane = tid & 63, wm = wave >> 1, wn = wave & 1;
  const bf16_t* A = (const bf16_t*)(lws(p) + WS_R2) + (size_t)m0 * 1024;
  const bf16_t* B = (const bf16_t*)(lws(p) + WS_WTOUT) + ((size_t)l * 1024 + n0) * 1024;
  f32x16 acc[2][2];
  acc_zero(acc);
  gemm_mainloop(tid, A, 1024, B, 1024, 1024, acc, lds);
  float* ct = (float*)lds;
#pragma unroll
  for (int mi = 0; mi < 2; ++mi)
#pragma unroll
    for (int ni = 0; ni < 2; ++ni)
#pragma unroll
      for (int i = 0; i < 16; ++i) {
        const int row = wm * 64 + mi * 32 + (i & 3) + 8 * (i >> 2) + 4 * (lane >> 5);
        const int col = wn * 64 + ni * 32 + (lane & 31);
        ct[row * 132 + col] = acc[mi][ni][i];
      }
  __syncthreads();
  const float* mod = (const float*)(lws(p) + WS_MOD) + (size_t)l * 5 * 3072;
#pragma unroll 4
  for (int i = 0; i < 16; ++i) {
    const int id = tid + NT * i, row = id >> 5, c4 = (id & 31) * 4;
    const int grow = m0 + row, gcol = n0 + c4;
    const f32x4 y = *(const f32x4*)(ct + row * 132 + c4);
    const f32x4 gate = *(const f32x4*)(mod + row_cond(grow) * 3072 + 2048 + gcol);
    const f32x4 xo = *(const f32x4*)(x_in_row(p, l, grow) + gcol);
    f32x4 o;
#pragma unroll
    for (int e = 0; e < 4; ++e) o[e] = xo[e] + gate[e] * y[e];
    *(f32x4*)(lout(p) + O_Y + (size_t)grow * DM + gcol) = o;
  }
  __syncthreads();
}

DI void ph_final_row(PR p, int r) {
  const int lane = ltid() & 63;
  float* x = lout(p) + O_Y + (size_t)r * DM;
  f32x4 v[4];
  float ss = 0.f;
#pragma unroll
  for (int i = 0; i < 4; ++i) { v[i] = *(const f32x4*)(x + (i * 64 + lane) * 4); ss += v[i][0] * v[i][0] + v[i][1] * v[i][1] + v[i][2] * v[i][2] + v[i][3] * v[i][3]; }
  ss = wave_sum(ss);
  const float rstd = rsqrtf(ss * (1.f / 1024.f) + EPS);
#pragma unroll
  for (int i = 0; i < 4; ++i) {
    const f32x4 g = *(const f32x4*)(lin(p, 30) + (i * 64 + lane) * 4);
    f32x4 o;
#pragma unroll
    for (int e = 0; e < 4; ++e) o[e] = v[i][e] * rstd * g[e];
    *(f32x4*)(x + (i * 64 + lane) * 4) = o;
  }
}

namespace pg8 {
#define PG8_LAS __attribute__((address_space(3)))
typedef unsigned short bf16_t;
typedef short bf16x8 __attribute__((ext_vector_type(8)));
typedef float f32x4 __attribute__((ext_vector_type(4)));
typedef unsigned u32x4 __attribute__((ext_vector_type(4)));
constexpr int BM = 256, BK = 64, HALF = 128, HTB = HALF * BK * 2  , STAGE_BYTES = 8 * HTB, NXCD = 8, WGM = 8;

__host__ __device__ __forceinline__ int lds_byte(int r, int c) { const int st = (r >> 4) * 2 + (c >> 5), rr = r & 15, cc = c & 31, ob = rr * 64 + cc * 2; return st * 1024 + (ob ^ (((ob >> 9) & 1) << 5)); }
__host__ __device__ __forceinline__ void stage_rc(int b, int& R, int& C) { const int st = b / 1024, sb = b % 1024, swz = sb ^ (((sb >> 9) & 1) << 5); R = (st >> 1) * 16 + swz / 64; C = (st & 1) * 32 + (swz % 64) / 2; }
__host__ __device__ __forceinline__ int perm32(int rho) { const int n = rho >> 4, i = rho & 15; return 8 * (i >> 2) + 4 * n + (i & 3); }

struct Unit { int pm, pn; };
struct Gemm { const bf16_t* A; const bf16_t* Bt; int M, N, K, lda, ldb; };

struct StaticOrder {
    int nM, nN, nwg, G, c;
    __host__ __device__ void init(int M, int N, int G_, int c_) { nM = M / BM; nN = N / BM; nwg = nM * nN; G = G_; c = c_; }
    __host__ __device__ bool next(int i, Unit& u) const {
        const long L = (long)i * G + c; if (L >= nwg) return false;
        int wgid = (int)L; { const int q = nwg / NXCD, r = nwg % NXCD, xcd = wgid % NXCD, off = wgid / NXCD; wgid = (xcd < r ? xcd * (q + 1) : r * (q + 1) + (xcd - r) * q) + off; }
        const int nig = WGM * nN, gid = wgid / nig, fm = gid * WGM, gsz = (nM - fm) < WGM ? (nM - fm) : WGM;
        u.pm = fm + ((wgid % nig) % gsz); u.pn = (wgid % nig) / gsz; return true;
    }
    __device__ __forceinline__ void a_ready(const Unit&) const {}
    __device__ __forceinline__ void done(const Unit&) const {}
};

__device__ __forceinline__ unsigned cvt_pk_bf16(float lo, float hi) { unsigned r; asm volatile("v_cvt_pk_bf16_f32 %0, %1, %2" : "=v"(r) : "v"(lo), "v"(hi)); return r; }

template <class Epi, class Sched, bool STAMP = false>
__device__ __forceinline__ void gemm_phase(PG8_LAS unsigned char* lds, const Gemm g, const Sched& S, const Epi& E, unsigned long long* stamps) {
    const int tid = ltid(), wid = __builtin_amdgcn_readfirstlane(tid >> 6), lane = tid & 63, wr = wid >> 2, wc = wid & 3, fr = lane & 15, fq = lane >> 4;
    const int K = g.K, nt = K / BK;
    int ts_lo = 0, ts_hi = 0, nts = 0; const unsigned long long rt_entry = STAMP ? (unsigned long long)wall_clock64() : 0ull;
#define PG8_STAMP() do { if (STAMP && wid == 0 && nts < 64) { const unsigned long long _c = (unsigned long long)clock64(); \
        ts_lo = (lane == nts) ? (int)(unsigned)_c : ts_lo; ts_hi = (lane == nts) ? (int)(unsigned)(_c >> 32) : ts_hi; ++nts; } } while (0)
    PG8_STAMP();
    unsigned voffA[2], voffB[2];
#pragma unroll
    for (int i = 0; i < 2; ++i) { int R, C; stage_rc(tid * 16 + i * 8192, R, C); const int Rb = Epi::PERM ? ((R & ~31) + perm32(R & 31)) : R;
        voffA[i] = (unsigned)(R * g.lda + C) * 2u; voffB[i] = (unsigned)(Rb * g.ldb + C) * 2u; }
    const size_t kstep = (size_t)(BK * 2);
    const size_t hstepA = (size_t)HALF * g.lda * 2, hstepB = (size_t)HALF * g.ldb * 2;
    const size_t tstepA = 2 * hstepA, tstepB = 2 * hstepB;
    const unsigned ldsw = (unsigned)wid * 1024u;
    const int aoff = lds_byte(wr * 64 + fr, fq * 8), boff = lds_byte(wc * 32 + fr, fq * 8);
#define PG8_SA(b, h) (((b) * 2 + (h)) * HTB)
#define PG8_SB(b, h) ((4 + (b) * 2 + (h)) * HTB)
#define PG8_STAGE(bufoff, gbase, voff) do { _Pragma("unroll") for (int _i = 0; _i < 2; ++_i) \
        __builtin_amdgcn_global_load_lds((const unsigned*)((const char*)(gbase) + (voff)[_i]), (PG8_LAS unsigned*)(lds + (bufoff) + ldsw + _i * 8192), 16, 0, 0); } while (0)
#define PG8_LDA(dst, b, h) do { _Pragma("unroll") for (int m = 0; m < 4; ++m) _Pragma("unroll") for (int k = 0; k < 2; ++k) dst[m][k] = *(const PG8_LAS bf16x8*)(lds + PG8_SA(b, h) + aoff + m * 2048 + k * 1024); } while (0)
#define PG8_LDB(dst, b, h) do { _Pragma("unroll") for (int n = 0; n < 2; ++n) _Pragma("unroll") for (int k = 0; k < 2; ++k) dst[n][k] = *(const PG8_LAS bf16x8*)(lds + PG8_SB(b, h) + boff + n * 2048 + k * 1024); } while (0)
#define PG8_MMA(ai, bj, At, Bt) do { __builtin_amdgcn_s_setprio(1); _Pragma("unroll") for (int m = 0; m < 4; ++m) _Pragma("unroll") for (int n = 0; n < 2; ++n) _Pragma("unroll") for (int k = 0; k < 2; ++k) \
        acc[ai][bj][m][n] = __builtin_amdgcn_mfma_f32_16x16x32_bf16(Bt[n][k], At[m][k], acc[ai][bj][m][n], 0, 0, 0); __builtin_amdgcn_s_setprio(0); } while (0)
#define PG8_WAIT_V(n) asm volatile("s_waitcnt vmcnt(" #n ")" ::: "memory")
#define PG8_WAIT_L(n) asm volatile("s_waitcnt lgkmcnt(" #n ")" ::: "memory")
#define PG8_BAR __builtin_amdgcn_s_barrier()
#define PG8_SCHED __builtin_amdgcn_sched_barrier(0)
    Unit cur, nxt; int ui = 0;
    if (!S.next(0, cur)) return;
    f32x4 acc[2][2][4][2];
#pragma unroll
    for (int a = 0; a < 2; ++a)
#pragma unroll
        for (int b = 0; b < 2; ++b)
#pragma unroll
            for (int m = 0; m < 4; ++m)
#pragma unroll
                for (int n = 0; n < 2; ++n) acc[a][b][m][n] = (f32x4){0.f, 0.f, 0.f, 0.f};
    bf16x8 At[4][2], B0[2][2], B1[2][2];
    const char* cA = (const char*)g.A + (size_t)cur.pm * tstepA; const char* cB = (const char*)g.Bt + (size_t)cur.pn * tstepB;
    S.a_ready(cur);
    PG8_STAGE(PG8_SB(0, 0), cB, voffB); PG8_STAGE(PG8_SA(0, 0), cA, voffA); PG8_STAGE(PG8_SB(0, 1), cB + hstepB, voffB); PG8_STAGE(PG8_SA(0, 1), cA + hstepA, voffA);
    if (wr == 1) PG8_BAR;
    PG8_WAIT_V(4); PG8_BAR;
    PG8_STAGE(PG8_SB(1, 0), cB + kstep, voffB); PG8_STAGE(PG8_SA(1, 0), cA + kstep, voffA); PG8_STAGE(PG8_SB(1, 1), cB + hstepB + kstep, voffB);
    PG8_WAIT_V(6); PG8_BAR;
    PG8_STAMP();
    for (;;) {
        const bool has_next = S.next(ui + 1, nxt);
        const char* nA = has_next ? (const char*)g.A + (size_t)nxt.pm * tstepA : cA; const char* nB = has_next ? (const char*)g.Bt + (size_t)nxt.pn * tstepB : cB;
        for (int t = 0; t < nt; t += 2) {
            const bool last = (t == nt - 2);
            const char* a1 = cA + (size_t)(t + 1) * kstep;
            const char* a2 = last ? nA : cA + (size_t)(t + 2) * kstep; const char* b2 = last ? nB : cB + (size_t)(t + 2) * kstep;
            const char* a3 = a2 + kstep; const char* b3 = b2 + kstep;
            if (last && has_next) S.a_ready(nxt);
            PG8_LDB(B0, 0, 0); PG8_SCHED; PG8_LDA(At, 0, 0); PG8_STAGE(PG8_SA(1, 1), a1 + hstepA, voffA);
            PG8_WAIT_L(8); PG8_BAR; PG8_WAIT_L(0); PG8_MMA(0, 0, At, B0); PG8_BAR; PG8_SCHED;
            PG8_LDB(B1, 0, 1); PG8_STAGE(PG8_SB(0, 0), b2, voffB);
            PG8_BAR; PG8_WAIT_L(0); PG8_MMA(0, 1, At, B1); PG8_BAR;
            PG8_LDA(At, 0, 1); PG8_STAGE(PG8_SA(0, 0), a2, voffA);
            PG8_BAR; PG8_WAIT_L(0); PG8_MMA(1, 0, At, B0); PG8_BAR; PG8_SCHED;
            PG8_STAGE(PG8_SB(0, 1), b2 + hstepB, voffB);
            PG8_WAIT_V(6); PG8_BAR; PG8_MMA(1, 1, At, B1); PG8_BAR;
            PG8_LDB(B0, 1, 0); PG8_SCHED; PG8_LDA(At, 1, 0); PG8_STAGE(PG8_SA(0, 1), a2 + hstepA, voffA);
            PG8_WAIT_L(8); PG8_BAR; PG8_WAIT_L(0); PG8_MMA(0, 0, At, B0); PG8_BAR; PG8_SCHED;
            PG8_LDB(B1, 1, 1); PG8_STAGE(PG8_SB(1, 0), b3, voffB);
            PG8_BAR; PG8_WAIT_L(0); PG8_MMA(0, 1, At, B1); PG8_BAR;
            PG8_LDA(At, 1, 1); PG8_STAGE(PG8_SA(1, 0), a3, voffA);
            PG8_BAR; PG8_WAIT_L(0); PG8_MMA(1, 0, At, B0); PG8_BAR; PG8_SCHED;
            PG8_STAGE(PG8_SB(1, 1), b3 + hstepB, voffB);
            PG8_WAIT_V(6); PG8_BAR; PG8_MMA(1, 1, At, B1); PG8_BAR;
        }
        PG8_STAMP();
        if constexpr (!Epi::AFTER_DRAIN) { E(acc, cur, wr, wc, fr, fq); S.done(cur); }
        PG8_STAMP();
        if (!has_next) break;
#pragma unroll
        for (int a = 0; a < 2; ++a)
#pragma unroll
            for (int b = 0; b < 2; ++b)
#pragma unroll
                for (int m = 0; m < 4; ++m)
#pragma unroll
                    for (int n = 0; n < 2; ++n) acc[a][b][m][n] = (f32x4){0.f, 0.f, 0.f, 0.f};
        cur = nxt; cA = nA; cB = nB; ++ui;
    }
    PG8_WAIT_V(0);
    if (wr == 0) PG8_BAR;
    PG8_BAR;
    if constexpr (Epi::AFTER_DRAIN) { E.fused(acc, cur, wr, wc, fr, fq, lds, wid, lane); S.done(cur); }
    PG8_STAMP();
    if (STAMP && wid == 0) { stamps[lane] = lane < nts ? (((unsigned long long)(unsigned)ts_hi << 32) | (unsigned)ts_lo) : 0ull;
        if (lane == 62) stamps[62] = rt_entry; if (lane == 63) stamps[63] = (unsigned long long)wall_clock64(); }
#undef PG8_STAMP
#undef PG8_SA
#undef PG8_SB
#undef PG8_STAGE
#undef PG8_LDA
#undef PG8_LDB
#undef PG8_MMA
#undef PG8_WAIT_V
#undef PG8_WAIT_L
#undef PG8_BAR
#undef PG8_SCHED
}
}

struct EpiInproj {
  static constexpr bool PERM = true, AFTER_DRAIN = false;
  bf16_t* proj; float* out; int l;
  __device__ __forceinline__ void operator()(const pg8::f32x4 (&acc)[2][2][4][2], const pg8::Unit& u, int wr, int wc, int fr, int fq) const {
    const int row0 = u.pm * 256 + wr * 64 + fr, col0 = u.pn * 256 + wc * 32 + 8 * fq;
    const bool cache = (u.pm < 16) && (u.pn >= 6) && (u.pn < 10);
    float* cbase = out + (u.pn < 8 ? O_CK : O_CV);
    const int ccol0 = col0 - (u.pn < 8 ? C_KB : C_VB);
#pragma unroll
    for (int ai = 0; ai < 2; ++ai)
#pragma unroll
      for (int m = 0; m < 4; ++m) {
        const int row = row0 + ai * 128 + m * 16;
        bf16_t* rowp = proj + (size_t)row * NP + col0;
#pragma unroll
        for (int bj = 0; bj < 2; ++bj) {
          const pg8::f32x4 v0 = acc[ai][bj][m][0], v1 = acc[ai][bj][m][1];
          const u32x4 w = {pack2(v0[0], v0[1]), pack2(v0[2], v0[3]), pack2(v1[0], v1[1]), pack2(v1[2], v1[3])};
          *(u32x4*)(rowp + bj * 128) = w;
          if (cache) {
            const int b = row >> 8, tt = row & 255;
            float* dst = cbase + ((size_t)(b * 2 + l) * 256 + tt) * 512 + ccol0 + bj * 128;
            *(f32x4*)dst = v0; *(f32x4*)(dst + 4) = v1;
          }
        }
      }
  }
};
DI void run_inproj8(PR p, int l) {
  pg8::Gemm g;
  g.A = (const bf16_t*)(lws(p) + WS_R2); g.Bt = (const bf16_t*)(lws(p) + WS_R1); g.M = MROWS; g.N = NP; g.K = 1024; g.lda = 1024; g.ldb = 1024;
  pg8::StaticOrder S; S.init(MROWS, NP, (int)gridDim.x, (int)blockIdx.x);
  EpiInproj E; E.proj = (bf16_t*)(lws(p) + WS_PROJ); E.out = lout(p); E.l = l;
  pg8::gemm_phase<EpiInproj, pg8::StaticOrder, false>((LAS unsigned char*)smem, g, S, E, nullptr);
}

constexpr int S5_WLDS = 8192 + 4352;
DI void s5_task(PR p, int l, int s, int d, int g, char* wl) {
  const int lane = ltid() & 63, q = lane >> 4, c = lane & 15;
  const int ldg = (l * 2 + d) * 32 + g;
  const int R0 = seq_row0(s), T = seq_len(s);
  float* BU = (float*)wl;
  char* H = wl + 8192;
  const bf16_t* proj = (const bf16_t*)(lws(p) + WS_PROJ);
  bf16_t* yd = (bf16_t*)(lws(p) + WS_R2) + (size_t)d * MROWS * 512;
  const bf16_t* bb = (const bf16_t*)(lws(p) + WS_S5BB) + (size_t)ldg * 128 * 16;
  const bf16_t* ct = (const bf16_t*)(lws(p) + WS_S5CT) + (size_t)ldg * 16 * 128;
  bf16x8 bfr[8], cfr[4];
  const bf16x8 zero8 = {0, 0, 0, 0, 0, 0, 0, 0};
#pragma unroll
  for (int nt = 0; nt < 8; ++nt) bfr[nt] = q < 2 ? *(const bf16x8*)(bb + (nt * 16 + c) * 16 + 8 * q) : zero8;
#pragma unroll
  for (int ks = 0; ks < 4; ++ks) cfr[ks] = *(const bf16x8*)(ct + c * 128 + 32 * ks + 8 * q);
  const float ar = ((const float*)(lws(p) + WS_S5AR))[ldg * 64 + lane];
  const float ai = ((const float*)(lws(p) + WS_S5AI))[ldg * 64 + lane];
  float hr = 0.f, hi = 0.f;
  if (s >= 16) {
    const size_t si = ((((size_t)(s - 16) * 2 + l) * 2 + d) * 32 + g) * 64 + lane;
    hr = lin(p, 4)[si]; hi = lin(p, 5)[si];
  }
  const int nb = T >> 4;
  auto load_u = [&](int blk) -> bf16x8 {
    const int n = blk * 16 + c;
    const int t = d ? (T - 1 - n) : n;
    if (q < 2) return *(const bf16x8*)(proj + (size_t)(R0 + t) * NP + C_UA + g * 16 + 8 * q);
    return zero8;
  };
  bf16x8 ucur = load_u(0);
#pragma unroll 1
  for (int blk = 0; blk < nb; ++blk) {
    bf16x8 unext = zero8;
    if (blk + 1 < nb) unext = load_u(blk + 1);
#pragma unroll
    for (int nt = 0; nt < 8; ++nt) {
      f32x4 z = {0.f, 0.f, 0.f, 0.f};
      const f32x4 dv = MFMA16(ucur, bfr[nt], z);
#pragma unroll
      for (int r = 0; r < 4; ++r) BU[(4 * q + r) * 128 + nt * 16 + c] = dv[r];
    }
#pragma unroll
    for (int i = 0; i < 16; ++i) {
      const float br = BU[i * 128 + lane], bi = BU[i * 128 + 64 + lane];
      const float nr = ar * hr - ai * hi + br;
      const float ni = ar * hi + ai * hr + bi;
      hr = nr; hi = ni;
      *(bf16_t*)(H + i * 272 + lane * 2) = f2bf(hr);
      *(bf16_t*)(H + i * 272 + 128 + lane * 2) = f2bf(hi);
    }
    f32x4 y = {0.f, 0.f, 0.f, 0.f};
#pragma unroll
    for (int ks = 0; ks < 4; ++ks) {
      const bf16x8 a = *(const bf16x8*)(H + c * 272 + (32 * ks + 8 * q) * 2);
      y = MFMA16(a, cfr[ks], y);
    }
#pragma unroll
    for (int r = 0; r < 4; ++r) {
      const int n = blk * 16 + 4 * q + r;
      const int t = d ? (T - 1 - n) : n;
      yd[(size_t)(R0 + t) * 512 + g * 16 + c] = f2bf(y[r]);
    }
    ucur = unext;
  }
  if (s < 16) {
    const size_t so = ((((size_t)s * 2 + l) * 2 + d) * 32 + g) * 64 + lane;
    lout(p)[O_SR + so] = hr; lout(p)[O_SI + so] = hi;
  }
}

DI float gelu_tanh(float x) {
  const float z = 0.7978845608028654f * (x + 0.044715f * x * x * x);
  const float e = __expf(2.f * z);
  const float th = 1.f - 2.f / (e + 1.f);
  return 0.5f * x * (1.f + th);
}
DI void glu_tile(PR p, int l, int t, char* lds, bool dry) {
  const int tid = ltid(), wave = tid >> 6, lane = tid & 63;
  const int m0 = t * 32;
  float* Yf = (float*)lds;
  char* Ya = lds + 66048;
  bf16_t* proj = (bf16_t*)(lws(p) + WS_PROJ);
  const bf16_t* yd0 = (const bf16_t*)(lws(p) + WS_R2);
  const bf16_t* yd1 = yd0 + (size_t)MROWS * 512;
  const float* s5d = lin(p, 20) + l * 512;
  {
    const int row = tid >> 4;
#pragma unroll
    for (int i = 0; i < 4; ++i) {
      const int c0 = (tid & 15) * 8 + 128 * i;
      const u32x4 uu = *(const u32x4*)(proj + (size_t)(m0 + row) * NP + C_UA + c0);
      const u32x4 a0 = *(const u32x4*)(yd0 + (size_t)(m0 + row) * 512 + c0);
      const u32x4 a1 = *(const u32x4*)(yd1 + (size_t)(m0 + row) * 512 + c0);
      float y[8];
#pragma unroll
      for (int e = 0; e < 4; ++e) {
        y[2 * e]     = gelu_tanh(s5d[c0 + 2 * e] * lo_f(uu[e]) + lo_f(a0[e]) + lo_f(a1[e]));
        y[2 * e + 1] = gelu_tanh(s5d[c0 + 2 * e + 1] * hi_f(uu[e]) + hi_f(a0[e]) + hi_f(a1[e]));
      }
#pragma unroll
      for (int e = 0; e < 8; ++e) Yf[row * 516 + c0 + e] = y[e];
      const u32x4 o = {pack2(y[0], y[1]), pack2(y[2], y[3]), pack2(y[4], y[5]), pack2(y[6], y[7])};
      const int ch = c0 >> 3;
      *(u32x4*)(Ya + row * 1024 + ((ch ^ (row & 15)) << 4)) = o;
    }
  }
  __syncthreads();
  const int r = lane & 31, h = lane >> 5;
  const bf16_t* W = (const bf16_t*)(lws(p) + WS_WTGLU) + (size_t)l * 512 * 512;
  f32x16 acc[2];
#pragma unroll
  for (int i = 0; i < 16; ++i) { acc[0][i] = 0.f; acc[1][i] = 0.f; }
#pragma unroll 4
  for (int s = 0; s < 32; ++s) {
    const int ch = 2 * s + h;
    const bf16x8 a = *(const bf16x8*)(Ya + r * 1024 + ((ch ^ (r & 15)) << 4));
#pragma unroll
    for (int ni = 0; ni < 2; ++ni) {
      const bf16x8 b = *(const bf16x8*)(W + (size_t)(wave * 64 + ni * 32 + r) * 512 + ch * 8);
      acc[ni] = MFMA32(a, b, acc[ni]);
    }
  }
#pragma unroll
  for (int ni = 0; ni < 2; ++ni)
#pragma unroll
    for (int i = 0; i < 16; ++i) {
      const int row = (i & 3) + 8 * (i >> 2) + 4 * h;
      const int col = wave * 64 + ni * 32 + r;
      const float y = Yf[row * 516 + col];
      const float z = bf2f(proj[(size_t)(m0 + row) * NP + C_ZA + col]);
      const bf16_t ov = f2bf(y * sigmoidf_(acc[ni][i]) * siluf_(z));
      if (!dry) proj[(size_t)(m0 + row) * NP + C_UA + col] = ov; else asm volatile("" :: "v"((unsigned)ov));
    }
  __syncthreads();
}

DI void ph5_row(PR p, int l, int r) {
  const int lane = ltid() & 63;
  const int c0 = lane * 8;
  bf16_t* proj = (bf16_t*)(lws(p) + WS_PROJ);
  const bf16_t* o0 = (const bf16_t*)(lws(p) + WS_R1);
  const bf16_t* o1 = o0 + (size_t)MROWS * 512;
  const u32x4 a = *(const u32x4*)(o0 + (size_t)r * 512 + c0);
  const u32x4 b = *(const u32x4*)(o1 + (size_t)r * 512 + c0);
  const u32x4 zz = *(const u32x4*)(proj + (size_t)r * NP + C_ZC + c0);
  float o[8];
  float ss = 0.f;
#pragma unroll
  for (int e = 0; e < 4; ++e) {
    o[2 * e] = lo_f(a[e]) + lo_f(b[e]); o[2 * e + 1] = hi_f(a[e]) + hi_f(b[e]);
    ss += o[2 * e] * o[2 * e] + o[2 * e + 1] * o[2 * e + 1];
  }
#pragma unroll
  for (int off = 1; off <= 8; off <<= 1) ss += __shfl_xor(ss, off);
  const float rstd = rsqrtf(ss * (1.f / 128.f) + EPS);
  const float* g = lin(p, 27) + l * 128 + (c0 & 127);
  float v[8];
#pragma unroll
  for (int e = 0; e < 4; ++e) {
    v[2 * e] = o[2 * e] * rstd * g[2 * e] * siluf_(lo_f(zz[e]));
    v[2 * e + 1] = o[2 * e + 1] * rstd * g[2 * e + 1] * siluf_(hi_f(zz[e]));
  }
  const u32x4 w = {pack2(v[0], v[1]), pack2(v[2], v[3]), pack2(v[4], v[5]), pack2(v[6], v[7])};
  *(u32x4*)(proj + (size_t)r * NP + C_QC + c0) = w;
}

constexpr int AT_K = 8192, AT_STAGE = 16384;
DI void att_gload(int tid, PR p, int l, int s, int h, int kt, u32x4& ka, u32x4& kb, u32x4& va, u32x4& vb) {
  const int key = tid >> 4, ch = tid & 15;
  const int j = kt * 32 + key;
  const int R0 = seq_row0(s);
  const bf16_t* proj = (const bf16_t*)(lws(p) + WS_PROJ);
  if (s < 16 || j < 1024) {
    const bf16_t* kr = proj + (size_t)(R0 + j) * NP + C_KB + h * 128;
    ka = *(const u32x4*)(kr + ch * 8);
    kb = *(const u32x4*)(kr + (ch ^ 2) * 8);
    va = *(const u32x4*)(proj + (size_t)(R0 + j) * NP + C_VB + h * 128 + ch * 8);
    vb = va;
  } else {
    const int b = s - 16, jc = j - 1024;
    const float* kc = lin(p, 2) + (((size_t)(b * 2 + l) * 512 + jc) * 4 + h) * 128 + ch * 8;
    const float* vc = lin(p, 3) + (((size_t)(b * 2 + l) * 512 + jc) * 4 + h) * 128 + ch * 8;
    ka = *(const u32x4*)kc; kb = *(const u32x4*)(kc + 4);
    va = *(const u32x4*)vc; vb = *(const u32x4*)(vc + 4);
  }
}
DI void att_lstore(int tid, PR p, int s, int kt, const u32x4& ka, const u32x4& kb, const u32x4& va, const u32x4& vb, char* stage) {
  const int key = tid >> 4, ch = tid & 15;
  const int j = kt * 32 + key;
  u32x4 ko, vo;
  if (s < 16) { ko = ka; vo = va; }
  else if (j < 1024) {
    const int pos = (ch & 4) ? (j & 63) : (j >> 6);
    const float* rc = (const float*)(lws(p) + WS_ROPE) + pos * 16 + (ch & 1) * 8;
    const float sg = (ch & 2) ? 1.f : -1.f;
    float o[8];
#pragma unroll
    for (int e = 0; e < 4; ++e) {
      const float c0 = rc[2 * e], c1 = rc[2 * e + 1], s0 = rc[1024 + 2 * e], s1 = rc[1024 + 2 * e + 1];
      o[2 * e]     = lo_f(ka[e]) * c0 + sg * lo_f(kb[e]) * s0;
      o[2 * e + 1] = hi_f(ka[e]) * c1 + sg * hi_f(kb[e]) * s1;
    }
    ko = u32x4{pack2(o[0], o[1]), pack2(o[2], o[3]), pack2(o[4], o[5]), pack2(o[6], o[7])};
    vo = va;
  } else {
    ko = u32x4{pack2(__uint_as_float(ka[0]), __uint_as_float(ka[1])), pack2(__uint_as_float(ka[2]), __uint_as_float(ka[3])),
               pack2(__uint_as_float(kb[0]), __uint_as_float(kb[1])), pack2(__uint_as_float(kb[2]), __uint_as_float(kb[3]))};
    vo = u32x4{pack2(__uint_as_float(va[0]), __uint_as_float(va[1])), pack2(__uint_as_float(va[2]), __uint_as_float(va[3])),
               pack2(__uint_as_float(vb[0]), __uint_as_float(vb[1])), pack2(__uint_as_float(vb[2]), __uint_as_float(vb[3]))};
  }
  *(u32x4*)(stage + key * 256 + ((ch ^ (key & 15)) << 4)) = ko;
  const int et = ch >> 1, hf = ch & 1;
  *(u32x4*)(stage + AT_K + key * 256 + ((((et ^ (key & 7)) << 1) | hf) << 4)) = vo;
}

DI void att_task(PR p, int l, int s, int h, int qb, char* lds, bool dry) {
  const int tid = ltid(), wave = tid >> 6, lane = tid & 63, q = lane >> 4, c = lane & 15;
  const int R0 = seq_row0(s), T = seq_len(s);
  const int nkeys = s < 16 ? 256 : 1536, nkt = nkeys >> 5;
  bf16_t* proj = (bf16_t*)(lws(p) + WS_PROJ);
  const int tq = qb * 128 + wave * 16 + c;
  const size_t qrow = (size_t)(R0 + tq) * NP;
  bf16x8 qf[2][2];
#pragma unroll
  for (int m = 0; m < 2; ++m)
#pragma unroll
    for (int ks = 0; ks < 2; ++ks) {
      const int d0 = 32 * ks + 8 * q;
      const u32x4 own = *(const u32x4*)(proj + qrow + C_QB + h * 128 + m * 64 + d0);
      float o[8];
      if (s >= 16) {
        const u32x4 par = *(const u32x4*)(proj + qrow + C_QB + h * 128 + m * 64 + (d0 ^ 16));
        const int pos = ks ? (tq & 63) : (tq >> 6);
        const float* rc = (const float*)(lws(p) + WS_ROPE) + pos * 16 + (q & 1) * 8;
        const float sg = (q & 2) ? 1.f : -1.f;
#pragma unroll
        for (int e = 0; e < 4; ++e) {
          o[2 * e]     = lo_f(own[e]) * rc[2 * e] + sg * lo_f(par[e]) * rc[1024 + 2 * e];
          o[2 * e + 1] = hi_f(own[e]) * rc[2 * e + 1] + sg * hi_f(par[e]) * rc[1024 + 2 * e + 1];
        }
      } else {
#pragma unroll
        for (int e = 0; e < 4; ++e) { o[2 * e] = lo_f(own[e]); o[2 * e + 1] = hi_f(own[e]); }
      }
      qf[m][ks] = mk8(pack2(o[0] * 0.125f, o[1] * 0.125f), pack2(o[2] * 0.125f, o[3] * 0.125f),
                      pack2(o[4] * 0.125f, o[5] * 0.125f), pack2(o[6] * 0.125f, o[7] * 0.125f));
    }
  f32x4 O[2][8];
#pragma unroll
  for (int m = 0; m < 2; ++m)
#pragma unroll
    for (int et = 0; et < 8; ++et) O[m][et] = f32x4{0.f, 0.f, 0.f, 0.f};
  float mx[2] = {-1e30f, -1e30f}, lsum[2] = {0.f, 0.f};

  u32x4 ska, skb, sva, svb;
  att_gload(tid, p, l, s, h, 0, ska, skb, sva, svb);
  __syncthreads();
  att_lstore(tid, p, s, 0, ska, skb, sva, svb, lds);
  __syncthreads();
#pragma unroll 1
  for (int kt = 0; kt < nkt; ++kt) {
    const char* cur = lds + (kt & 1) * AT_STAGE;
    if (kt + 1 < nkt) att_gload(tid, p, l, s, h, kt + 1, ska, skb, sva, svb);
    f32x4 S[2][2];
#pragma unroll
    for (int m = 0; m < 2; ++m)
#pragma unroll
      for (int k2 = 0; k2 < 2; ++k2) {
        f32x4 acc = {0.f, 0.f, 0.f, 0.f};
#pragma unroll
        for (int ks = 0; ks < 2; ++ks) {
          const int key = k2 * 16 + c;
          const bf16x8 a = *(const bf16x8*)(cur + key * 256 + (((m * 8 + ks * 4 + q) ^ (key & 15)) << 4));
          acc = MFMA16(a, qf[m][ks], acc);
        }
        S[m][k2] = acc;
      }
    bf16x8 pf[2];
#pragma unroll
    for (int m = 0; m < 2; ++m) {
      float tm = fmaxf(fmaxf(fmaxf(S[m][0][0], S[m][0][1]), fmaxf(S[m][0][2], S[m][0][3])),
                       fmaxf(fmaxf(S[m][1][0], S[m][1][1]), fmaxf(S[m][1][2], S[m][1][3])));
      tm = fmaxf(tm, __shfl_xor(tm, 16));
      tm = fmaxf(tm, __shfl_xor(tm, 32));
      const float mn = fmaxf(mx[m], tm);
      const float alpha = __expf(mx[m] - mn);
      mx[m] = mn;
      float pv[8], ps = 0.f;
#pragma unroll
      for (int k2 = 0; k2 < 2; ++k2)
#pragma unroll
        for (int r = 0; r < 4; ++r) { pv[k2 * 4 + r] = __expf(S[m][k2][r] - mn); ps += pv[k2 * 4 + r]; }
      lsum[m] = lsum[m] * alpha + ps;
#pragma unroll
      for (int et = 0; et < 8; ++et) O[m][et] *= alpha;
      pf[m] = mk8(pack2(pv[0], pv[1]), pack2(pv[2], pv[3]), pack2(pv[4], pv[5]), pack2(pv[6], pv[7]));
    }
    {
      const int qq = c >> 2, pp = c & 3;
      const int kA = 4 * q + qq, kB = 16 + 4 * q + qq;
#pragma unroll
      for (int et = 0; et < 8; ++et) {
        const char* aA = cur + AT_K + kA * 256 + (((et ^ (kA & 7)) << 5)) + pp * 8;
        const char* aB = cur + AT_K + kB * 256 + (((et ^ (kB & 7)) << 5)) + pp * 8;
        const s16x4 lo = __builtin_amdgcn_ds_read_tr16_b64_v4i16((s16x4 LAS*)(const LAS char*)aA);
        const s16x4 hi = __builtin_amdgcn_ds_read_tr16_b64_v4i16((s16x4 LAS*)(const LAS char*)aB);
        const bf16x8 vf = __builtin_shufflevector(lo, hi, 0, 1, 2, 3, 4, 5, 6, 7);
        O[0][et] = MFMA16(vf, pf[0], O[0][et]);
        O[1][et] = MFMA16(vf, pf[1], O[1][et]);
      }
    }
    if (kt + 1 < nkt) att_lstore(tid, p, s, kt + 1, ska, skb, sva, svb, lds + ((kt + 1) & 1) * AT_STAGE);
    __syncthreads();
  }
#pragma unroll
  for (int m = 0; m < 2; ++m) { lsum[m] += __shfl_xor(lsum[m], 16); lsum[m] += __shfl_xor(lsum[m], 32); }
  const float lam = ((const float*)(lws(p) + WS_LAM))[l];
  const float lam_init = 0.8f - 0.6f * expf(-0.3f * (float)l);
  const float i0 = 1.f / lsum[0], i1 = lam / lsum[1];
  float ss = 0.f;
#pragma unroll
  for (int et = 0; et < 8; ++et)
#pragma unroll
    for (int r = 0; r < 4; ++r) { const float o = O[0][et][r] * i0 - O[1][et][r] * i1; O[0][et][r] = o; ss += o * o; }
  ss += __shfl_xor(ss, 16); ss += __shfl_xor(ss, 32);
  const float rstd = rsqrtf(ss * (1.f / 128.f) + EPS) * (1.f - lam_init);
  const float* g = lin(p, 23) + l * 128;
#pragma unroll
  for (int et = 0; et < 8; ++et) {
    const int e0 = 16 * et + 4 * q;
    const u32x2 zz = *(const u32x2*)(proj + qrow + C_ZB + h * 128 + e0);
    const float v0 = O[0][et][0] * rstd * g[e0 + 0] * siluf_(lo_f(zz[0]));
    const float v1 = O[0][et][1] * rstd * g[e0 + 1] * siluf_(hi_f(zz[0]));
    const float v2 = O[0][et][2] * rstd * g[e0 + 2] * siluf_(lo_f(zz[1]));
    const float v3 = O[0][et][3] * rstd * g[e0 + 3] * siluf_(hi_f(zz[1]));
    const u32x2 w = {pack2(v0, v1), pack2(v2, v3)};
    if (!dry) *(u32x2*)(proj + qrow + C_QB + h * 128 + e0) = w; else asm volatile("" :: "v"(w[0]), "v"(w[1]));
  }
}

constexpr int DP_QF = 0, DP_KF = 33792, DP_VF = 67584, DP_MT = 101376, DP_SM = 134144;
DI int kmap8(int ks, int q, int j) { return 32 * ks + 4 * q + (j & 3) + 16 * (j >> 2); }

DI void dn_prep_task(PR p, int l, int gc, int h, char* lds) {
  const int tid = ltid(), lane = tid & 63, q = lane >> 4, c = lane & 15;
  int s, oc;
  if (gc < 64) { s = gc >> 2; oc = gc & 3; } else { s = 16 + ((gc - 64) >> 4); oc = (gc - 64) & 15; }
  const int R0 = seq_row0(s), T = seq_len(s), t0 = oc * 64;
  const bf16_t* proj = (const bf16_t*)(lws(p) + WS_PROJ);
  float* qf = (float*)(lds + DP_QF);
  float* kf = (float*)(lds + DP_KF);
  float* vf = (float*)(lds + DP_VF);
  float* mT = (float*)(lds + DP_MT);
  float* sm = (float*)(lds + DP_SM);
  __syncthreads();
  if (tid < 384) {
    const int cg = tid % 48, rg = tid / 48;
    const int which = cg >> 4, ch0 = (cg & 15) * 8;
    const int col = C_QC + which * 512 + h * 128 + ch0;
    const float* cw = lin(p, 24) + (size_t)l * 5 * 1536 + which * 512 + h * 128 + ch0;
    float w[5][8];
#pragma unroll
    for (int j = 0; j < 5; ++j)
#pragma unroll
      for (int e = 0; e < 8; ++e) w[j][e] = cw[j * 1536 + e];
    u32x4 raw[12];
#pragma unroll
    for (int i = 0; i < 12; ++i) {
      const int t = t0 + rg * 8 + i - 2;
      raw[i] = u32x4{0u, 0u, 0u, 0u};
      if (t >= 0 && t < T) raw[i] = *(const u32x4*)(proj + (size_t)(R0 + t) * NP + col);
    }
    float* dst = which == 0 ? qf : (which == 1 ? kf : vf);
#pragma unroll
    for (int i = 0; i < 8; ++i) {
#pragma unroll
      for (int e2 = 0; e2 < 4; ++e2) {
        float a0 = 0.f, a1 = 0.f;
#pragma unroll
        for (int j = 0; j < 5; ++j) { a0 += w[j][2 * e2] * lo_f(raw[i + j][e2]); a1 += w[j][2 * e2 + 1] * hi_f(raw[i + j][e2]); }
        dst[(rg * 8 + i) * 132 + ch0 + 2 * e2] = siluf_(a0);
        dst[(rg * 8 + i) * 132 + ch0 + 2 * e2 + 1] = siluf_(a1);
      }
    }
  }
  if ((tid & 255) < 64) {
    const int d = tid >> 8;
    const int io = d ? 63 - lane : lane;
    const float* bg = (const float*)(lws(p) + WS_BETAG) + (size_t)(R0 + t0 + io) * 16;
    const float beta = bg[d * 4 + h];
    float g = bg[8 + d * 4 + h];
#pragma unroll
    for (int o = 1; o < 64; o <<= 1) { const float n = __shfl_up(g, o); if (lane >= o) g += n; }
    sm[d * 64 + lane] = beta;
    sm[128 + d * 64 + lane] = g;
    sm[256 + d * 64 + lane] = __expf(g);
  }
  __syncthreads();
  {
    const int wave = tid >> 6;
#pragma unroll 1
    for (int i = 0; i < 16; ++i) {
      const int id = wave * 16 + i, row = id & 63, which = id >> 6;
      float* a = (which ? kf : qf) + row * 132;
      const float v0 = a[lane], v1 = a[64 + lane];
      const float ss = wave_sum(v0 * v0 + v1 * v1);
      const float sc = rsqrtf(ss + EPS) * (which ? 1.f : 0.08838834764831845f);
      a[lane] = v0 * sc; a[64 + lane] = v1 * sc;
    }
  }
  __syncthreads();
  const int d = tid >> 8, w4 = (tid >> 6) & 3;
  const float* beta_s = sm + d * 64;
  const float* gc_s = sm + 128 + d * 64;
  const float* eg_s = sm + 256 + d * 64;
  unsigned char* slot = lws(p) + WS_DNP + (size_t)((gc * 4 + h) * 2 + d) * DNP_SLOT;
  auto orow = [&](int i) -> int { return d ? 63 - i : i; };
  auto ldfrag = [&](const float* base, int row, int ks) -> bf16x8 {
    const f32x4 a = *(const f32x4*)(base + row * 132 + 32 * ks + 8 * q);
    const f32x4 b = *(const f32x4*)(base + row * 132 + 32 * ks + 8 * q + 4);
    return mk8(pack2(a[0], a[1]), pack2(a[2], a[3]), pack2(b[0], b[1]), pack2(b[2], b[3]));
  };
  {
    const int it = w4;
    bf16x8 kfr_i[4], qfr_i[4];
#pragma unroll
    for (int ks = 0; ks < 4; ++ks) { kfr_i[ks] = ldfrag(kf, orow(16 * it + c), ks); qfr_i[ks] = ldfrag(qf, orow(16 * it + c), ks); }
    f32x4 kq[4];
#pragma unroll
    for (int jt = 0; jt < 4; ++jt) {
      f32x4 kk = {0.f, 0.f, 0.f, 0.f}, kq_ = {0.f, 0.f, 0.f, 0.f};
#pragma unroll
      for (int ks = 0; ks < 4; ++ks) {
        const bf16x8 kfr_j = ldfrag(kf, orow(16 * jt + c), ks);
        kk = MFMA16(kfr_i[ks], kfr_j, kk);
        kq_ = MFMA16(kfr_j, qfr_i[ks], kq_);
      }
      {
        const int j = 16 * jt + c;
        const float gj = gc_s[j];
#pragma unroll
        for (int r = 0; r < 4; ++r) {
          const int i = 16 * it + 4 * q + r;
          const float v = i > j ? beta_s[i] * kk[r] * __expf(gc_s[i] - gj) : 0.f;
          mT[d * 4096 + j * 64 + i] = v;
        }
      }
      {
        const int i = 16 * it + c;
        const float gi = gc_s[i];
#pragma unroll
        for (int r = 0; r < 4; ++r) {
          const int j = 16 * jt + 4 * q + r;
          kq_[r] = i >= j ? kq_[r] * __expf(gi - gc_s[j]) : 0.f;
        }
      }
      kq[jt] = kq_;
      asm volatile("" ::: "memory");
    }
#pragma unroll
    for (int ks2 = 0; ks2 < 2; ++ks2) {
      const f32x4 a = kq[2 * ks2], b = kq[2 * ks2 + 1];
      const u32x4 o = {pack2(a[0], a[1]), pack2(a[2], a[3]), pack2(b[0], b[1]), pack2(b[2], b[3])};
      *(u32x4*)(slot + SL_QK + ((it * 2 + ks2) * 64 + lane) * 16) = o;
    }
    asm volatile("" ::: "memory");
    {
      const int i = 16 * it + c, io = orow(i);
      const float egi = eg_s[i];
#pragma unroll
      for (int ks = 0; ks < 4; ++ks) {
        const f32x4 a = *(const f32x4*)(qf + io * 132 + 32 * ks + 4 * q);
        const f32x4 b = *(const f32x4*)(qf + io * 132 + 32 * ks + 16 + 4 * q);
        const u32x4 o = {pack2(a[0] * egi, a[1] * egi), pack2(a[2] * egi, a[3] * egi), pack2(b[0] * egi, b[1] * egi), pack2(b[2] * egi, b[3] * egi)};
        *(u32x4*)(slot + SL_QG + ((it * 4 + ks) * 64 + lane) * 16) = o;
      }
    }
    asm volatile("" ::: "memory");
    {
      const float gl = gc_s[63];
#pragma unroll
      for (int mm = 0; mm < 2; ++mm) {
        const int mt8 = 2 * w4 + mm, dk = 16 * mt8 + c;
#pragma unroll
        for (int ks2 = 0; ks2 < 2; ++ks2) {
          float v[8];
#pragma unroll
          for (int j = 0; j < 8; ++j) {
            const int i = kmap8(ks2, q, j);
            v[j] = kf[orow(i) * 132 + dk] * __expf(gl - gc_s[i]);
          }
          const u32x4 o = {pack2(v[0], v[1]), pack2(v[2], v[3]), pack2(v[4], v[5]), pack2(v[6], v[7])};
          *(u32x4*)(slot + SL_KGT + ((mt8 * 2 + ks2) * 64 + lane) * 16) = o;
        }
      }
      if (w4 == 0 && lane == 0) ((float*)(lws(p) + WS_EGL))[(gc * 4 + h) * 2 + d] = __expf(gl);
    }
  }
  {
    bf16_t* XA = (bf16_t*)(lds + DP_QF) + d * 32 * 260;
    bf16_t* XC = (bf16_t*)(lds + DP_KF + 16 * 528) + d * 16 * 260;
    bf16_t* XD = (bf16_t*)(lds + DP_VF + 16 * 528) + d * 16 * 260;
    const int col = tid & 255;
    const float* rsrc = col < 128 ? vf + col : kf + (col - 128);
    const float* mcol = mT + d * 4096;
    __syncthreads();
#pragma unroll 1
    for (int b = 0; b < 4; ++b) {
      float x[16];
#pragma unroll
      for (int i = 0; i < 16; ++i) {
        const int ii = 16 * b + i;
        const float sc = col < 128 ? beta_s[ii] : beta_s[ii] * eg_s[ii];
        x[i] = rsrc[orow(ii) * 132] * sc;
      }
      const int nA = b < 2 ? 16 * b : 32;
#pragma unroll 2
      for (int j = 0; j < nA; ++j) {
        const float xj = bf2f(XA[j * 260 + col]);
        const float* mr = mcol + j * 64 + 16 * b;
#pragma unroll
        for (int i4 = 0; i4 < 4; ++i4) {
          const f32x4 mm = *(const f32x4*)(mr + i4 * 4);
          x[i4 * 4 + 0] -= mm[0] * xj; x[i4 * 4 + 1] -= mm[1] * xj; x[i4 * 4 + 2] -= mm[2] * xj; x[i4 * 4 + 3] -= mm[3] * xj;
        }
      }
      if (b == 3) {
#pragma unroll 2
        for (int j = 0; j < 16; ++j) {
          const float xj = bf2f(XC[j * 260 + col]);
          const float* mr = mcol + (32 + j) * 64 + 48;
#pragma unroll
          for (int i4 = 0; i4 < 4; ++i4) {
            const f32x4 mm = *(const f32x4*)(mr + i4 * 4);
            x[i4 * 4 + 0] -= mm[0] * xj; x[i4 * 4 + 1] -= mm[1] * xj; x[i4 * 4 + 2] -= mm[2] * xj; x[i4 * 4 + 3] -= mm[3] * xj;
          }
        }
      }
      const float* md = mcol + (16 * b) * 64 + 16 * b;
#pragma unroll
      for (int j = 0; j < 15; ++j) {
        const float xj = x[j];
#pragma unroll
        for (int i4 = 0; i4 < 16; i4 += 4) {
          if (i4 + 3 > j) {
            const f32x4 mm = *(const f32x4*)(md + j * 64 + i4);
            if (i4 + 0 > j) x[i4 + 0] -= mm[0] * xj;
            if (i4 + 1 > j) x[i4 + 1] -= mm[1] * xj;
            if (i4 + 2 > j) x[i4 + 2] -= mm[2] * xj;
            if (i4 + 3 > j) x[i4 + 3] -= mm[3] * xj;
          }
        }
      }
      if (b == 2) __syncthreads();
      bf16_t* dstx = b < 2 ? XA + (16 * b) * 260 : (b == 2 ? XC : XD);
#pragma unroll
      for (int i = 0; i < 16; ++i) dstx[i * 260 + col] = f2bf(x[i]);
      __syncthreads();
    }
  }
  {
    const int tid4 = ltid(), lane = tid4 & 63, q = lane >> 4, c = lane & 15, w4 = (tid4 >> 6) & 3, d = tid4 >> 8;
    unsigned char* slot = lws(p) + WS_DNP + (size_t)((gc * 4 + h) * 2 + d) * DNP_SLOT;
    const bf16_t* XA = (const bf16_t*)(lds + DP_QF) + d * 32 * 260;
    const bf16_t* XC = (const bf16_t*)(lds + DP_KF + 16 * 528) + d * 16 * 260;
    const bf16_t* XD = (const bf16_t*)(lds + DP_VF + 16 * 528) + d * 16 * 260;
    auto Xrow = [&](int i) -> const bf16_t* { return i < 32 ? XA + i * 260 : (i < 48 ? XC + (i - 32) * 260 : XD + (i - 48) * 260); };
#pragma unroll
    for (int ks = 0; ks < 4; ++ks) {
      const bf16_t* xr = Xrow(16 * w4 + c);
      const u32x2 a = *(const u32x2*)(xr + 128 + 32 * ks + 4 * q);
      const u32x2 b = *(const u32x2*)(xr + 128 + 32 * ks + 16 + 4 * q);
      const u32x4 o = {a[0] ^ 0x80008000u, a[1] ^ 0x80008000u, b[0] ^ 0x80008000u, b[1] ^ 0x80008000u};
      *(u32x4*)(slot + SL_W + ((w4 * 4 + ks) * 64 + lane) * 16) = o;
    }
#pragma unroll
    for (int cc = 0; cc < 2; ++cc) {
      const int cs = 2 * w4 + cc;
#pragma unroll
      for (int mt = 0; mt < 4; ++mt) {
        unsigned short v[4];
#pragma unroll
        for (int r = 0; r < 4; ++r) v[r] = Xrow(16 * mt + 4 * q + r)[16 * cs + c];
        const u32x2 o = {(unsigned)v[0] | ((unsigned)v[1] << 16), (unsigned)v[2] | ((unsigned)v[3] << 16)};
        *(u32x2*)(slot + SL_U + ((cs * 4 + mt) * 64 + lane) * 8) = o;
      }
    }
  }
}

constexpr int CH_STAGE = 57344;
DI void dn_chain_task(PR p, int l, int s, int h, int d, char* lds) {
  const int tid = ltid(), cs = tid >> 6, lane = tid & 63, q = lane >> 4, c = lane & 15;
  const int R0 = seq_row0(s), T = seq_len(s), nc = T >> 6;
  const int gc0 = s < 16 ? s * 4 : 64 + (s - 16) * 16;
  bf16_t* odir = (bf16_t*)(lws(p) + WS_R1) + (size_t)d * MROWS * 512;
  const float* egl = (const float*)(lws(p) + WS_EGL);
  f32x4 S[8];
  if (s >= 16) {
    const float* s0 = lin(p, 6) + ((((size_t)(s - 16) * 2 + l) * 2 + d) * 4 + h) * 16384;
#pragma unroll
    for (int i = 0; i < 8; ++i)
#pragma unroll
      for (int r = 0; r < 4; ++r) S[i][r] = s0[(16 * i + 4 * q + r) * 128 + 16 * cs + c];
  } else {
#pragma unroll
    for (int i = 0; i < 8; ++i) S[i] = f32x4{0.f, 0.f, 0.f, 0.f};
  }
  auto slot_of = [&](int step) -> const unsigned char* {
    const int oc = d ? nc - 1 - step : step;
    return lws(p) + WS_DNP + (size_t)(((gc0 + oc) * 4 + h) * 2 + d) * DNP_SLOT;
  };
  u32x4 stg[7];
  auto gload = [&](int step) {
    const unsigned char* sl = slot_of(step);
#pragma unroll
    for (int i = 0; i < 7; ++i) stg[i] = *(const u32x4*)(sl + (size_t)(tid + NT * i) * 16);
  };
  auto lstore = [&](char* st) {
#pragma unroll
    for (int i = 0; i < 7; ++i) *(u32x4*)(st + (tid + NT * i) * 16) = stg[i];
  };
  gload(0);
  __syncthreads();
  lstore(lds);
  __syncthreads();
#pragma unroll 1
  for (int step = 0; step < nc; ++step) {
    const char* cur = lds + (step & 1) * CH_STAGE;
    if (step + 1 < nc) gload(step + 1);
    const unsigned char* sl = slot_of(step);
    const int oc = d ? nc - 1 - step : step;
    const float gl = egl[((gc0 + oc) * 4 + h) * 2 + d];
    bf16x8 Sb[4];
#pragma unroll
    for (int ks = 0; ks < 4; ++ks)
      Sb[ks] = mk8(pack2(S[2 * ks][0], S[2 * ks][1]), pack2(S[2 * ks][2], S[2 * ks][3]),
                   pack2(S[2 * ks + 1][0], S[2 * ks + 1][1]), pack2(S[2 * ks + 1][2], S[2 * ks + 1][3]));
    f32x4 av[4], ao[4];
#pragma unroll
    for (int mt = 0; mt < 4; ++mt) {
      const u32x2 u = *(const u32x2*)(sl + SL_U + ((cs * 4 + mt) * 64 + lane) * 8);
      av[mt] = f32x4{lo_f(u[0]), hi_f(u[0]), lo_f(u[1]), hi_f(u[1])};
      ao[mt] = f32x4{0.f, 0.f, 0.f, 0.f};
    }
#pragma unroll
    for (int ks = 0; ks < 4; ++ks)
#pragma unroll
      for (int mt = 0; mt < 4; ++mt) {
        const bf16x8 wf = *(const bf16x8*)(cur + SL_W + ((mt * 4 + ks) * 64 + lane) * 16);
        av[mt] = MFMA16(wf, Sb[ks], av[mt]);
        const bf16x8 gf = *(const bf16x8*)(cur + SL_QG + ((mt * 4 + ks) * 64 + lane) * 16);
        ao[mt] = MFMA16(gf, Sb[ks], ao[mt]);
      }
    bf16x8 Vb[2];
#pragma unroll
    for (int k2 = 0; k2 < 2; ++k2)
      Vb[k2] = mk8(pack2(av[2 * k2][0], av[2 * k2][1]), pack2(av[2 * k2][2], av[2 * k2][3]),
                   pack2(av[2 * k2 + 1][0], av[2 * k2 + 1][1]), pack2(av[2 * k2 + 1][2], av[2 * k2 + 1][3]));
#pragma unroll
    for (int k2 = 0; k2 < 2; ++k2)
#pragma unroll
      for (int mt = 0; mt < 4; ++mt) {
        const bf16x8 f = *(const bf16x8*)(cur + SL_QK + ((mt * 2 + k2) * 64 + lane) * 16);
        ao[mt] = MFMA16(f, Vb[k2], ao[mt]);
      }
#pragma unroll
    for (int i = 0; i < 8; ++i) {
      S[i] *= gl;
#pragma unroll
      for (int k2 = 0; k2 < 2; ++k2) {
        const bf16x8 f = *(const bf16x8*)(cur + SL_KGT + ((i * 2 + k2) * 64 + lane) * 16);
        S[i] = MFMA16(f, Vb[k2], S[i]);
      }
    }
#pragma unroll
    for (int mt = 0; mt < 4; ++mt)
#pragma unroll
      for (int r = 0; r < 4; ++r) {
        const int i = 16 * mt + 4 * q + r;
        const int t = oc * 64 + (d ? 63 - i : i);
        odir[(size_t)(R0 + t) * 512 + h * 128 + 16 * cs + c] = f2bf(ao[mt][r]);
      }
    if (step + 1 < nc) lstore(lds + ((step + 1) & 1) * CH_STAGE);
    __syncthreads();
  }
  if (s < 16) {
    float* so = lout(p) + O_DN + ((((size_t)s * 2 + l) * 2 + d) * 4 + h) * 16384;
#pragma unroll
    for (int i = 0; i < 8; ++i)
#pragma unroll
      for (int r = 0; r < 4; ++r) so[(16 * i + 4 * q + r) * 128 + 16 * cs + c] = S[i][r];
  }
}

constexpr int N_PHASES = 16;
constexpr int LDS_QSH = LDS_BYTES - 16;
constexpr int LDS_BST = LDS_BYTES - 32;

DI void run_prep(PR p) {
  const int G = gridDim.x, bid = blockIdx.x;
  for (int t = bid; t < 192; t += G) ph0_adaln(p, t, smem);
  for (int t = bid; t < 16; t += G) ph0_s5(p, t);
  if (bid == G - 1) ph0_misc(p);
  for (int t = bid; t < 2048; t += G) cvt_win_tile(p, 0, t, smem);
  for (int t = bid; t < 1408; t += G) cvt_other_tile(p, t, smem);
}
DI void run_final(PR p) {
  const int G = gridDim.x, bid = blockIdx.x, wave = threadIdx.x >> 6;
  for (int r = bid * 8 + wave; r < MROWS; r += G * 8) ph_final_row(p, r);
}
DI void run_norm(PR p, int l) {
  const int G = gridDim.x, bid = blockIdx.x, wave = threadIdx.x >> 6;
  for (int rb = bid * 8 + wave; rb < 4096; rb += G * 8) ph1_norm_rows(p, l, rb);
}
DI void run_cvt1(PR p) {
  const int G = gridDim.x, bid = blockIdx.x;
  for (int t = bid; t < 2048; t += G) cvt_win_tile(p, 1, t, smem);
}
DI void run_inproj(PR p, int l) {
  const int G = gridDim.x, bid = blockIdx.x;
  for (int t = bid; t < 2048; t += G) ph2_inproj_tile(p, l, t, smem);
}
DI void run_s5(PR p, int l) {
  const int G = gridDim.x, bid = blockIdx.x, wave = threadIdx.x >> 6;
  for (int b = bid; b < 256; b += G) {
    if (wave == 0) {
      const int s = 16 + (b >> 6), d = (b >> 5) & 1, g = b & 31;
      s5_task(p, l, s, d, g, smem + wave * S5_WLDS);
    } else if (wave < 5) {
      const int i = b * 4 + (wave - 1);
      const int s = i >> 6, d = (i >> 5) & 1, g = i & 31;
      s5_task(p, l, s, d, g, smem + wave * S5_WLDS);
    }
  }
}
DI void run_att(PR p, int l, int t, bool dry = false) {
  if (t < 128) { const int s = 16 + (t >> 5), h = (t >> 3) & 3, qb = t & 7; att_task(p, l, s, h, qb, smem, dry); }
  else { const int u = t - 128, s = u >> 3, h = (u >> 1) & 3, qb = u & 1; att_task(p, l, s, h, qb, smem, dry); }
}
DI void run_prep_dn(PR p, int l, int u) { dn_prep_task(p, l, u >> 2, u & 3, smem); }
DI void run_chain(PR p, int l) {
  const int G = gridDim.x, bid = blockIdx.x;
  for (int b = bid; b < 160; b += G) {
    const int s = b < 32 ? 16 + (b >> 3) : (b - 32) >> 3;
    const int h = (b >> 1) & 3, d = b & 1;
    dn_chain_task(p, l, s, h, d, smem);
  }
}
DI void run_glu(PR p, int l, int t, bool dry = false) { glu_tile(p, l, t, smem, dry); }
DI void run_ph5(PR p, int l) {
  const int G = gridDim.x, bid = blockIdx.x, wave = threadIdx.x >> 6;
  for (int r = bid * 8 + wave; r < MROWS; r += G * 8) ph5_row(p, l, r);
}
DI void run_merge(PR p, int l) {
  const int G = gridDim.x, bid = blockIdx.x;
  for (int t = bid; t < 256; t += G) ph6_merge_tile(p, l, t, smem);
}
DI void run_out(PR p, int l) {
  const int G = gridDim.x, bid = blockIdx.x;
  for (int t = bid; t < 256; t += G) ph7_out_tile(p, l, t, smem);
}
DI void run_barrier(PR p, unsigned x) {
  XcdBarrier xb; xb.bar = (unsigned*)(p.ws + WS_BAR); xb.x = x; xb.st = (volatile LAS unsigned*)(LAS char*)(smem + LDS_BST);
  xcd_barrier(xb);
}

#ifndef REP
#define REP 0
#endif
template <int PH> DI void run_phase1(PR p, volatile int* qsh, unsigned* qw) {
  if constexpr (PH == 0) run_prep(p);
  else if constexpr (PH == 15) run_final(p);
  else {
    constexpr int l = (PH - 1) / 7, sub = (PH - 1) % 7;
    if constexpr (sub == 0) { run_norm(p, l); if constexpr (l == 1) run_cvt1(p); }
    else if constexpr (sub == 1) run_inproj8(p, l);
    else if constexpr (sub == 2) {
      run_s5(p, l);
      if constexpr ((REP >> 16) & 1) run_s5(p, l);
      if constexpr ((REP >> 17) & 1) for (;;) { const int t = queue_pull(&qw[l * 8 + 3], qsh); if (t >= 256) break; run_att(p, l, t, true); }
      for (;;) {
        const int t = queue_pull(&qw[l * 8 + 0], qsh);
        if (t >= 256) break;
        run_att(p, l, t);
      }
      for (;;) {
        const int t = queue_pull(&qw[l * 8 + 2], qsh);
        if (t >= 512) break;
        run_prep_dn(p, l, t);
      }
      if constexpr ((REP >> 18) & 1) for (;;) { const int t = queue_pull(&qw[l * 8 + 4], qsh); if (t >= 512) break; run_prep_dn(p, l, t); }
    } else if constexpr (sub == 3) {
      run_chain(p, l);
      if constexpr ((REP >> 19) & 1) run_chain(p, l);
      if constexpr ((REP >> 20) & 1) for (;;) { const int t = queue_pull(&qw[l * 8 + 5], qsh); if (t >= 256) break; run_glu(p, l, t, true); }
      for (;;) {
        const int t = queue_pull(&qw[l * 8 + 1], qsh);
        if (t >= 256) break;
        run_glu(p, l, t);
      }
    }
    else if constexpr (sub == 4) run_ph5(p, l);
    else if constexpr (sub == 5) run_merge(p, l);
    else run_out(p, l);
  }
}
template <int PH> DI void run_phase(PR p, volatile int* qsh, unsigned* qw) {
  run_phase1<PH>(p, qsh, qw);
  if constexpr ((REP >> PH) & 1) { __syncthreads(); run_phase1<PH>(p, qsh, qw); }
}

__global__ void __launch_bounds__(NT) fwd_kernel(Params p_by_value) {
  PR p = *(const __attribute__((address_space(4))) Params*)__builtin_amdgcn_kernarg_segment_ptr();
  volatile int* qsh = (volatile int*)(smem + LDS_QSH);
  unsigned* qw = (unsigned*)(p.ws + WS_Q);
#ifndef ONE_LAUNCH
  switch (p.ph_lo) {
#define PHC(n) case n: run_phase<n>(p, qsh, qw); break;
    PHC(0) PHC(1) PHC(2) PHC(3) PHC(4) PHC(5) PHC(6) PHC(7) PHC(8) PHC(9) PHC(10) PHC(11) PHC(12) PHC(13) PHC(14) PHC(15)
#undef PHC
    default: break;
  }
#else
  volatile LAS unsigned* bst = (volatile LAS unsigned*)(LAS char*)(smem + LDS_BST);
  if (threadIdx.x == 0) { bst[0] = 0u; bst[1] = 0u; }
  __syncthreads();
  const XcdBarrier xb = xcd_barrier_post((unsigned*)(p.ws + WS_BAR), bst);
  const unsigned xcc = xb.x;
#define PHB(n) run_phase<n>(p, qsh, qw); run_barrier(p, xcc); if constexpr ((REP >> 21) & 1) run_barrier(p, xcc);
  PHB(0) PHB(1) PHB(2) PHB(3) PHB(4) PHB(5) PHB(6) PHB(7) PHB(8) PHB(9) PHB(10) PHB(11) PHB(12) PHB(13) PHB(14)
#undef PHB
  run_phase<15>(p, qsh, qw);
#endif
}

extern "C" void kernel_launch(void* const* d_in, const int* in_sizes, int n_in, void* d_out, int out_size,
                              void* d_ws, size_t ws_size, hipStream_t stream) {
  static int grid = 0;
  if (grid == 0) {
    int dev = 0, cus = 0, per_cu = 0;
    if (hipGetDevice(&dev) != hipSuccess || hipDeviceGetAttribute(&cus, hipDeviceAttributeMultiprocessorCount, dev) != hipSuccess) { fprintf(stderr, "kernel_launch: device query failed\n"); grid = -1; return; }
    if (hipFuncSetAttribute((const void*)fwd_kernel, hipFuncAttributeMaxDynamicSharedMemorySize, LDS_BYTES) != hipSuccess) { fprintf(stderr, "kernel_launch: hipFuncSetAttribute failed\n"); grid = -1; return; }
    if (hipOccupancyMaxActiveBlocksPerMultiprocessor(&per_cu, (const void*)fwd_kernel, NT, LDS_BYTES) != hipSuccess || per_cu < 1) { fprintf(stderr, "kernel_launch: occupancy query reports %d\n", per_cu); per_cu = 1; }
    (void)hipGetLastError();
    grid = cus;
    if (ws_size < WS_END) { fprintf(stderr, "kernel_launch: workspace too small (%zu < %zu)\n", ws_size, (size_t)WS_END); grid = -1; return; }
  }
  if (grid < 0) return;
  (void)hipMemsetAsync((char*)d_ws + WS_BAR, 0, WS_ZERO_BYTES, stream);
  Params p{};
  for (int i = 0; i < 31; ++i) p.in[i] = (const float*)d_in[i];
  p.out = (float*)d_out; p.ws = (unsigned char*)d_ws;
#ifndef ONE_LAUNCH
  p.use_bar = 0;
  for (int ph = 0; ph < N_PHASES; ++ph) {
    p.ph_lo = ph; p.ph_hi = ph + 1;
    hipLaunchKernelGGL(fwd_kernel, dim3(grid), dim3(NT), LDS_BYTES, stream, p);
  }
#else
  p.use_bar = 1; p.ph_lo = 0; p.ph_hi = N_PHASES;
  void* args[] = {&p};
  hipError_t e = hipLaunchCooperativeKernel((const void*)fwd_kernel, dim3(grid), dim3(NT), args, LDS_BYTES, stream);
  if (e != hipSuccess) fprintf(stderr, "kernel_launch: cooperative launch failed: %s (grid %d)\n", hipGetErrorString(e), grid);
#endif
}
```

```cpp
#define ONE_LAUNCH 1
#include <hip/hip_runtime.h>
#include <stdint.h>
#include <stdio.h>

#define DI __device__ __forceinline__
typedef unsigned short bf16_t;
using bf16x8 = __attribute__((ext_vector_type(8))) short;
using s16x4  = __attribute__((ext_vector_type(4))) short;
using f32x4  = __attribute__((ext_vector_type(4))) float;
using f32x16 = __attribute__((ext_vector_type(16))) float;
using u32x4  = __attribute__((ext_vector_type(4))) unsigned;
using u32x2  = __attribute__((ext_vector_type(2))) unsigned;
typedef __bf16 bf16x2_t __attribute__((ext_vector_type(2)));
typedef float f32x2_t __attribute__((ext_vector_type(2)));
#define LAS __attribute__((address_space(3)))

#define MFMA16(a, b, c) __builtin_amdgcn_mfma_f32_16x16x32_bf16((a), (b), (c), 0, 0, 0)
#define MFMA32(a, b, c) __builtin_amdgcn_mfma_f32_32x32x16_bf16((a), (b), (c), 0, 0, 0)

constexpr int NT = 512;
constexpr int DM = 1024;
constexpr int MROWS = 8192;
constexpr int NP = 8192;
constexpr int NIN = 8208;
constexpr float EPS = 1e-6f;
constexpr int C_UA = 0, C_ZA = 512, C_QB = 1024, C_KB = 1536, C_VB = 2048, C_ZB = 2560;
constexpr int C_QC = 3072, C_KC = 3584, C_VC = 4096, C_ZC = 4608, C_GT = 5120;
constexpr size_t O_Y = 0;
constexpr size_t O_CK = 8388608;
constexpr size_t O_CV = O_CK + 4194304;
constexpr size_t O_SR = O_CV + 4194304;
constexpr size_t O_SI = O_SR + 131072;
constexpr size_t O_DN = O_SI + 131072;

constexpr size_t WS_BAR   = 0;
constexpr size_t WS_Q     = 16384;
constexpr size_t WS_ZERO_BYTES = 16384 + 1024;
constexpr size_t WS_MOD   = 32768;
constexpr size_t WS_S5AR  = WS_MOD + 122880;
constexpr size_t WS_S5AI  = WS_S5AR + 32768;
constexpr size_t WS_S5BB  = WS_S5AI + 32768;
constexpr size_t WS_S5CT  = WS_S5BB + 524288;
constexpr size_t WS_ROPE  = WS_S5CT + 524288;
constexpr size_t WS_LAM   = WS_ROPE + 8192;
constexpr size_t WS_WBA   = WS_LAM + 256;
constexpr size_t WS_BETAG = WS_WBA + 131072;
constexpr size_t WS_EGL   = WS_BETAG + 524288;
constexpr size_t WS_WTGLU = WS_EGL + 4096;
constexpr size_t WS_WTBR  = WS_WTGLU + 1048576;
constexpr size_t WS_WTOUT = WS_WTBR + 6291456;
constexpr size_t WS_R1    = WS_WTOUT + 4194304;
constexpr size_t WS_R2    = WS_R1 + 16777216;
constexpr size_t WS_PROJ  = WS_R2 + 16777216;
constexpr size_t WS_DNP   = WS_PROJ + 134217728;
constexpr size_t DNP_SLOT = 73728;
constexpr size_t WS_END   = WS_DNP + 1024 * DNP_SLOT;
constexpr int SL_W = 0, SL_QG = 16384, SL_KGT = 32768, SL_QK = 49152, SL_U = 57344;

constexpr int LDS_BYTES = 147456;

struct Params {
  const float* in[31];
  float* out;
  unsigned char* ws;
  int ph_lo, ph_hi;
  int use_bar, pad;
};
typedef const __attribute__((address_space(4))) Params& PR;
#define NI __device__ __noinline__
extern __shared__ __attribute__((aligned(16))) char smem[];
#define GAS __attribute__((address_space(1)))
DI unsigned char* lws(PR p) { GAS unsigned char* w = (GAS unsigned char*)p.ws; asm volatile("" : "+s"(w)); return (unsigned char*)w; }
DI const float* lin(PR p, int k) { GAS const float* w = (GAS const float*)p.in[k]; asm volatile("" : "+s"(w)); return (const float*)w; }
DI float* lout(PR p) { GAS float* w = (GAS float*)p.out; asm volatile("" : "+s"(w)); return (float*)w; }

DI float bf2f(unsigned short h) { return __uint_as_float(((unsigned)h) << 16); }
DI unsigned pack2(float lo, float hi) { f32x2_t f = {lo, hi}; bf16x2_t v = __builtin_convertvector(f, bf16x2_t); return __builtin_bit_cast(unsigned, v); }
DI unsigned short f2bf(float x) { return (unsigned short)(pack2(x, 0.f) & 0xffffu); }
DI float lo_f(unsigned u) { return __uint_as_float(u << 16); }
DI float hi_f(unsigned u) { return __uint_as_float(u & 0xffff0000u); }
DI float sigmoidf_(float x) { return 1.f / (1.f + __expf(-x)); }
DI float siluf_(float x) { return x / (1.f + __expf(-x)); }
DI float wave_sum(float v) {
#pragma unroll
  for (int o = 32; o >= 1; o >>= 1) v += __shfl_xor(v, o);
  return v;
}
DI bf16x8 mk8(unsigned a, unsigned b, unsigned c, unsigned d) { u32x4 u = {a, b, c, d}; return __builtin_bit_cast(bf16x8, u); }

DI int ltid() {
  const int w = __builtin_amdgcn_readfirstlane((int)(threadIdx.x >> 6));
  int t = (w << 6) | (int)__builtin_amdgcn_mbcnt_hi(~0u, __builtin_amdgcn_mbcnt_lo(~0u, 0u));
  asm volatile("" : "+v"(t));
  return t;
}
#define XB_TMO      128
#define XB_XCNT(j)  (256  + 64 * (j))
#define XB_XSUB(j)  (1280 + 64 * (j))
#define XB_XGEN(j)  (2304 + 64 * (j))
#define XB_TOP      3328
#define XB_TOPGEN   3392
#define XCD_BAR_WORDS 3456
#define XB_SPIN_CAP (1u << 22)
DI unsigned xb_ld(unsigned* p)              { return __hip_atomic_load(p, __ATOMIC_RELAXED, __HIP_MEMORY_SCOPE_AGENT); }
DI unsigned xb_add(unsigned* p, unsigned v) { return __hip_atomic_fetch_add(p, v, __ATOMIC_RELAXED, __HIP_MEMORY_SCOPE_AGENT); }
DI unsigned xb_xcc_id() { return (unsigned)__builtin_amdgcn_s_getreg((3 << 11) | 20) & 0xFu; }
#define XB_SPIN(cond, bar) do { unsigned _sp = 0; while (cond) { __builtin_amdgcn_s_sleep(1); \
    if ((++_sp & 255u) == 0u) { if (xb_ld(&(bar)[XB_TMO])) break; if (_sp > XB_SPIN_CAP) { atomicAdd(&(bar)[XB_TMO], 1u); break; } } } } while (0)
struct XcdBarrier { unsigned* bar; unsigned x; volatile LAS unsigned* st; };
DI XcdBarrier xcd_barrier_post(unsigned* bar, volatile LAS unsigned* st) {
  XcdBarrier b; b.bar = bar; b.x = xb_xcc_id(); b.st = st;
  if (ltid() == 0) (void)xb_add(&bar[XB_XCNT(b.x)], 1u);
  return b;
}
DI void xcd_barrier_complete(unsigned* bar, unsigned x, unsigned& nloc, unsigned& nx) {
  const unsigned G = gridDim.x;
  unsigned sum, cnt, mine, sp = 0u;
  for (;;) {
    sum = 0u; cnt = 0u; mine = 0u;
#pragma unroll
    for (unsigned j = 0; j < 16; ++j) { const unsigned c = xb_ld(&bar[XB_XCNT(j)]); sum += c; cnt += (c > 0u) ? 1u : 0u; mine = (j == x) ? c : mine; }
    if (sum == G) break;
    __builtin_amdgcn_s_sleep(1);
    if ((++sp & 255u) == 0u) { if (xb_ld(&bar[XB_TMO])) break; if (sp > XB_SPIN_CAP) { atomicAdd(&bar[XB_TMO], 1u); break; } }
  }
  nloc = mine > 0u ? mine : 1u; nx = cnt > 0u ? cnt : 1u;
}
DI void xcd_barrier(const XcdBarrier& b) {
  asm volatile("s_waitcnt vmcnt(0)" ::: "memory");
  __syncthreads();
  if (ltid() == 0) {
    unsigned* bar = b.bar;
    __builtin_amdgcn_s_waitcnt(0);
    unsigned nloc = b.st[0], nx = b.st[1];
    if (nloc == 0u) { xcd_barrier_complete(bar, b.x, nloc, nx); b.st[0] = nloc; b.st[1] = nx; }
    const unsigned old = xb_add(&bar[XB_XSUB(b.x)], 1u);
    const unsigned gen = old / nloc;
    if (old + 1u == (gen + 1u) * nloc) {
      __builtin_amdgcn_fence(__ATOMIC_RELEASE, "agent");
      asm volatile("s_waitcnt vmcnt(0)" ::: "memory");
      const unsigned og = xb_add(&bar[XB_TOP], 1u);
      const unsigned tg = og / nx;
      if (og + 1u == (tg + 1u) * nx) xb_add(&bar[XB_TOPGEN], 1u);
      else XB_SPIN(xb_ld(&bar[XB_TOPGEN]) == tg, bar);
      __builtin_amdgcn_fence(__ATOMIC_ACQUIRE, "agent");
      xb_add(&bar[XB_XGEN(b.x)], 1u);
      asm volatile("s_waitcnt vmcnt(0)" ::: "memory");
    } else {
      XB_SPIN(xb_ld(&bar[XB_XGEN(b.x)]) == gen, bar);
      __builtin_amdgcn_fence(__ATOMIC_ACQUIRE, "agent");
      asm volatile("s_waitcnt vmcnt(0)" ::: "memory");
    }
  }
  __syncthreads();
}

#ifndef TIMEREG
#define TIMEREG 0
#endif
__device__ unsigned long long g_sw_acc;
#define SWW_BEGIN(id) unsigned long long _sww_t0 = 0; if constexpr (TIMEREG == (id)) { __builtin_amdgcn_sched_barrier(0); _sww_t0 = __builtin_amdgcn_s_memrealtime(); __builtin_amdgcn_sched_barrier(0); }
#define SWW_END(id) if constexpr (TIMEREG == (id)) { __builtin_amdgcn_sched_barrier(0); const unsigned long long _d = __builtin_amdgcn_s_memrealtime() - _sww_t0; __builtin_amdgcn_sched_barrier(0); if (blockIdx.x == 0 && threadIdx.x == 0) g_sw_acc += _d; }

DI int queue_pull(unsigned* q, volatile int* sh) {
  __syncthreads();
  if (ltid() == 0) *sh = (int)xb_add(q, 1u);
  __syncthreads();
  return *sh;
}

DI int vzero() { int z = 0; asm volatile("" : "+v"(z)); return z; }

#ifndef PROJ_ROWMAJOR
DI size_t pjx(int row, int col) { return ((size_t)(col >> 9) * MROWS + row) * 512 + (col & 511); }
constexpr int PJ_LD = 512;
#else
DI size_t pjx(int row, int col) { return (size_t)row * NP + col; }
constexpr int PJ_LD = NP;
#endif

DI int seq_row0(int s) { return s < 16 ? s * 256 : 4096 + (s - 16) * 1024; }
DI int seq_len(int s) { return s < 16 ? 256 : 1024; }
DI int row_cond(int r) { return r < 4096 ? 0 : 1 + ((r - 4096) >> 10); }
DI const float* x_in_row(PR p, int l, int r) {
  if (l == 0) return r < 4096 ? lin(p, 0) + (size_t)r * DM : lin(p, 1) + (size_t)(r - 4096) * DM;
  return lout(p) + O_Y + (size_t)r * DM;
}

DI void ph0_adaln(PR p, int a, char* lds) {
  const int l = a / 96, cb = a % 96, tid = ltid();
  float* scond = (float*)lds;
  float* red = scond + 5 * 1024;
  for (int i = tid; i < 5 * 1024; i += NT) {
    const int ci = i >> 10, k = i & 1023;
    const float c = ci == 0 ? lin(p, 8)[k] : lin(p, 7)[(ci - 1) * 1024 + k];
    scond[i] = c / (1.f + expf(-c));
  }
  __syncthreads();
  const int tx = tid & 31, ty = tid >> 5;
  const float* w = lin(p, 10) + (size_t)l * 1024 * 3072 + cb * 32 + tx;
  float acc[5] = {0.f, 0.f, 0.f, 0.f, 0.f};
  for (int kk = 0; kk < 64; ++kk) {
    const int k = ty * 64 + kk;
    const float wv = w[(size_t)k * 3072];
#pragma unroll
    for (int ci = 0; ci < 5; ++ci) acc[ci] += scond[ci * 1024 + k] * wv;
  }
#pragma unroll
  for (int ci = 0; ci < 5; ++ci) red[(ty * 5 + ci) * 32 + tx] = acc[ci];
  __syncthreads();
  if (tid < 160) {
    const int ci = tid >> 5, x = tid & 31;
    float s = 0.f;
    for (int y = 0; y < 16; ++y) s += red[(y * 5 + ci) * 32 + x];
    const int col = cb * 32 + x;
    float* mod = (float*)(lws(p) + WS_MOD);
    mod[(l * 5 + ci) * 3072 + col] = s + lin(p, 11)[l * 3072 + col];
  }
  __syncthreads();
}

DI void ph0_s5(PR p, int t) {
  const int idx = t * NT + threadIdx.x;
  const int ldg = idx >> 6, pp = idx & 63;
  const float lre = lin(p, 13)[idx], lim = lin(p, 14)[idx], ls = lin(p, 15)[ldg];
  const float step = expf(ls);
  const float mag = expf(lre * step);
  float sn, cs; sincosf(lim * step, &sn, &cs);
  const float ar = mag * cs, ai = mag * sn;
  const float den = lre * lre + lim * lim;
  const float fr = ((ar - 1.f) * lre + ai * lim) / den;
  const float fi = (ai * lre - (ar - 1.f) * lim) / den;
  ((float*)(lws(p) + WS_S5AR))[idx] = ar;
  ((float*)(lws(p) + WS_S5AI))[idx] = ai;
  bf16_t* bb = (bf16_t*)(lws(p) + WS_S5BB) + (size_t)ldg * 128 * 16;
  bf16_t* ct = (bf16_t*)(lws(p) + WS_S5CT) + (size_t)ldg * 16 * 128;
  const float* bre = lin(p, 16) + (size_t)idx * 16;
  const float* bim = lin(p, 17) + (size_t)idx * 16;
#pragma unroll
  for (int i = 0; i < 16; ++i) {
    const float br = bre[i], bi = bim[i];
    bb[pp * 16 + i] = f2bf(fr * br - fi * bi);
    bb[(64 + pp) * 16 + i] = f2bf(fr * bi + fi * br);
    const float cr = lin(p, 18)[((size_t)ldg * 16 + i) * 64 + pp];
    const float cim = lin(p, 19)[((size_t)ldg * 16 + i) * 64 + pp];
    ct[i * 128 + pp] = f2bf(cr);
    ct[i * 128 + 64 + pp] = f2bf(-cim);
  }
}

DI void ph0_misc(PR p) {
  const int tid = threadIdx.x;
  float* rc = (float*)(lws(p) + WS_ROPE);
  for (int i = tid; i < 1024; i += NT) {
    const int pos = i >> 4, f = i & 15;
    const float inv = powf(10000.f, -(float)f / 16.f);
    const float ang = (float)pos * inv;
    float sn, cs; sincosf(ang, &sn, &cs);
    rc[i] = cs; rc[1024 + i] = sn;
  }
  if (tid < 2) {
    const int l = tid;
    const float* dl = lin(p, 22) + l * 256;
    float s0 = 0.f, s1 = 0.f;
    for (int i = 0; i < 64; ++i) { s0 += dl[i] * dl[64 + i]; s1 += dl[128 + i] * dl[192 + i]; }
    const float lam_init = 0.8f - 0.6f * expf(-0.3f * (float)l);
    ((float*)(lws(p) + WS_LAM))[l] = expf(s0) - expf(s1) + lam_init;
  }
  float* wba = (float*)(lws(p) + WS_WBA);
  for (int i = tid; i < 2 * 16 * 1024; i += NT) {
    const int l = i >> 14, j = (i >> 10) & 15, k = i & 1023;
    wba[i] = lin(p, 12)[((size_t)l * 1024 + k) * NIN + 5120 + j];
  }
}

DI void cvt_tile(const float* src, size_t ld_src, bf16_t* dst, size_t ld_dst, char* lds) {
  float* t = (float*)lds;
  const int tid = ltid();
  const int r = tid >> 4, c4 = (tid & 15) * 4;
#pragma unroll
  for (int ps = 0; ps < 2; ++ps) {
    const int k = r + 32 * ps;
    const f32x4 v = *(const f32x4*)(src + (size_t)k * ld_src + c4);
    t[k * 65 + c4 + 0] = v[0]; t[k * 65 + c4 + 1] = v[1]; t[k * 65 + c4 + 2] = v[2]; t[k * 65 + c4 + 3] = v[3];
  }
  __syncthreads();
  const int n = tid >> 3, kc = tid & 7;
  float v[8];
#pragma unroll
  for (int j = 0; j < 8; ++j) v[j] = t[(kc * 8 + j) * 65 + n];
  u32x4 o = {pack2(v[0], v[1]), pack2(v[2], v[3]), pack2(v[4], v[5]), pack2(v[6], v[7])};
  *(u32x4*)(dst + (size_t)n * ld_dst + kc * 8) = o;
  __syncthreads();
}

DI void cvt_win_tile(PR p, int l, int t, char* lds) {
  const int kt = t & 15, nt = t >> 4;
  const int n0 = nt * 64, nsrc = n0 < 5120 ? n0 : n0 + 16;
  cvt_tile(lin(p, 12) + ((size_t)l * 1024 + kt * 64) * NIN + nsrc, NIN,
           (bf16_t*)(lws(p) + WS_R1) + (size_t)n0 * 1024 + kt * 64, 1024, lds);
}
DI void cvt_other_tile(PR p, int t, char* lds) {
  if (t < 128) {
    const int l = t >> 6, q = t & 63, kt = q & 7, nt = q >> 3;
    cvt_tile(lin(p, 21) + ((size_t)l * 512 + kt * 64) * 512 + nt * 64, 512,
             (bf16_t*)(lws(p) + WS_WTGLU) + ((size_t)l * 512 + nt * 64) * 512 + kt * 64, 512, lds);
  } else if (t < 896) {
    const int u = t - 128, ln = u >> 7, q = u & 127, kt = q & 7, nt = q >> 3;
    cvt_tile(lin(p, 28) + ((size_t)ln * 512 + kt * 64) * 1024 + nt * 64, 1024,
             (bf16_t*)(lws(p) + WS_WTBR) + ((size_t)ln * 1024 + nt * 64) * 512 + kt * 64, 512, lds);
  } else {
    const int u = t - 896, l = u >> 8, q = u & 255, kt = q & 15, nt = q >> 4;
    cvt_tile(lin(p, 29) + ((size_t)l * 1024 + kt * 64) * 1024 + nt * 64, 1024,
             (bf16_t*)(lws(p) + WS_WTOUT) + ((size_t)l * 1024 + nt * 64) * 1024 + kt * 64, 1024, lds);
  }
}

DI void ph1_norm_rows(PR p, int l, int rb) {
  const int lane = ltid() & 63;
  const int r0 = rb * 2, ci = row_cond(r0);
  const float* mod = (const float*)(lws(p) + WS_MOD) + (size_t)(l * 5 + ci) * 3072;
  const float* ng = lin(p, 9) + l * 1024;
  const float* wba = (const float*)(lws(p) + WS_WBA) + (size_t)l * 16 * 1024;
  bf16_t* hn = (bf16_t*)(lws(p) + WS_R2);
  float h[2][16];
#pragma unroll
  for (int ri = 0; ri < 2; ++ri) {
    const float* x = x_in_row(p, l, r0 + ri);
    float ss = 0.f;
#pragma unroll
    for (int i = 0; i < 4; ++i) {
      const f32x4 v = *(const f32x4*)(x + (i * 64 + lane) * 4);
#pragma unroll
      for (int e = 0; e < 4; ++e) { h[ri][i * 4 + e] = v[e]; ss += v[e] * v[e]; }
    }
    ss = wave_sum(ss);
    const float rstd = rsqrtf(ss * (1.f / 1024.f) + EPS);
#pragma unroll
    for (int i = 0; i < 4; ++i) {
      const int k = (i * 64 + lane) * 4;
      const f32x4 g = *(const f32x4*)(ng + k);
      const f32x4 sh = *(const f32x4*)(mod + k);
      const f32x4 sc = *(const f32x4*)(mod + 1024 + k);
#pragma unroll
      for (int e = 0; e < 4; ++e) h[ri][i * 4 + e] = h[ri][i * 4 + e] * rstd * g[e] * (1.f + sc[e]) + sh[e];
      u32x2 o = {pack2(h[ri][i * 4 + 0], h[ri][i * 4 + 1]), pack2(h[ri][i * 4 + 2], h[ri][i * 4 + 3])};
      *(u32x2*)(hn + (size_t)(r0 + ri) * 1024 + k) = o;
    }
  }
  float pt[32];
#pragma unroll
  for (int j = 0; j < 16; ++j) {
    float a0 = 0.f, a1 = 0.f;
#pragma unroll
    for (int i = 0; i < 4; ++i) {
      const f32x4 w = *(const f32x4*)(wba + j * 1024 + (i * 64 + lane) * 4);
#pragma unroll
      for (int e = 0; e < 4; ++e) { a0 += h[0][i * 4 + e] * w[e]; a1 += h[1][i * 4 + e] * w[e]; }
    }
    pt[j] = a0; pt[16 + j] = a1;
    if ((j & 3) == 3) asm volatile("" ::: "memory");
  }
#pragma unroll
  for (int n = 16; n >= 1; n >>= 1) {
    const bool up = (lane & n) != 0;
#pragma unroll
    for (int i = 0; i < n; ++i) {
      const float keep = up ? pt[i + n] : pt[i];
      const float send = up ? pt[i] : pt[i + n];
      pt[i] = keep + __shfl_xor(send, n);
    }
  }
  const float v = pt[0] + __shfl_xor(pt[0], 32);
  if (lane < 32) {
    const int ri = lane >> 4, j = lane & 15;
    float res;
    if (j < 8) res = 1.f / (1.f + expf(-v));
    else {
      const int jj = j - 8;
      const float xx = v + lin(p, 26)[l * 8 + jj];
      const float sp = xx > 20.f ? xx : log1pf(expf(xx));
      res = -expf(lin(p, 25)[l * 8 + jj]) * sp;
    }
    ((float*)(lws(p) + WS_BETAG))[(size_t)(r0 + ri) * 16 + j] = res;
  }
}

constexpr int G_STAGE = 49152;
DI void gemm_gload(int tid, const bf16_t* A, size_t lda, const bf16_t* B, size_t ldb, int k0, u32x4 (&ra)[4], u32x4 (&rb)[2]) {
#pragma unroll
  for (int i = 0; i < 4; ++i) { const int id = tid + NT * i, row = id >> 3, ch = id & 7; ra[i] = *(const u32x4*)(A + (size_t)row * lda + k0 + ch * 8); }
#pragma unroll
  for (int i = 0; i < 2; ++i) { const int id = tid + NT * i, row = id >> 3, ch = id & 7; rb[i] = *(const u32x4*)(B + (size_t)row * ldb + k0 + ch * 8); }
}
DI void gemm_lstore(int tid, char* st, const u32x4 (&ra)[4], const u32x4 (&rb)[2]) {
#pragma unroll
  for (int i = 0; i < 4; ++i) { const int id = tid + NT * i, row = id >> 3, ch = id & 7; *(u32x4*)(st + row * 128 + ((ch ^ ((row >> 1) & 7)) << 4)) = ra[i]; }
#pragma unroll
  for (int i = 0; i < 2; ++i) { const int id = tid + NT * i, row = id >> 3, ch = id & 7; *(u32x4*)(st + 32768 + row * 128 + ((ch ^ ((row >> 1) & 7)) << 4)) = rb[i]; }
}
DI void gemm_compute(const char* st, f32x16 (&acc)[2][2], int wm, int wn, int lane) {
  const int r = lane & 31, h = lane >> 5, sw = (r >> 1) & 7;
#pragma unroll
  for (int s = 0; s < 4; ++s) {
    const int ch = ((2 * s + h) ^ sw) << 4;
    bf16x8 a[2], b[2];
#pragma unroll
    for (int mi = 0; mi < 2; ++mi) a[mi] = *(const bf16x8*)(st + (wm * 64 + mi * 32 + r) * 128 + ch);
#pragma unroll
    for (int ni = 0; ni < 2; ++ni) b[ni] = *(const bf16x8*)(st + 32768 + (wn * 64 + ni * 32 + r) * 128 + ch);
#pragma unroll
    for (int mi = 0; mi < 2; ++mi)
#pragma unroll
      for (int ni = 0; ni < 2; ++ni) acc[mi][ni] = MFMA32(a[mi], b[ni], acc[mi][ni]);
  }
}
DI void gemm_mainloop(int tid, const bf16_t* A, size_t lda, const bf16_t* B, size_t ldb, int K, f32x16 (&acc)[2][2], char* lds) {
  const int wave = tid >> 6, lane = tid & 63, wm = wave >> 1, wn = wave & 1;
  u32x4 ra[4], rb[2];
  gemm_gload(tid, A, lda, B, ldb, 0, ra, rb);
  gemm_lstore(tid, lds, ra, rb);
  __syncthreads();
  const int KT = K >> 6;
  for (int kt = 0; kt < KT; ++kt) {
    char* cur = lds + (kt & 1) * G_STAGE;
    char* nxt = lds + ((kt + 1) & 1) * G_STAGE;
    if (kt + 1 < KT) gemm_gload(tid, A, lda, B, ldb, (kt + 1) * 64, ra, rb);
    gemm_compute(cur, acc, wm, wn, lane);
    if (kt + 1 < KT) gemm_lstore(tid, nxt, ra, rb);
    __syncthreads();
  }
}
DI void acc_zero(f32x16 (&acc)[2][2]) {
#pragma unroll
  for (int a = 0; a < 2; ++a)
#pragma unroll
    for (int b = 0; b < 2; ++b)
#pragma unroll
      for (int i = 0; i < 16; ++i) acc[a][b][i] = 0.f;
}
DI void tile_store_bf16(int tid, const f32x16 (&acc)[2][2], bf16_t* dst, size_t ldd, char* lds) {
  const int wave = tid >> 6, lane = tid & 63, wm = wave >> 1, wn = wave & 1;
  const int cl = lane & 31, h = lane >> 5;
#pragma unroll
  for (int mi = 0; mi < 2; ++mi)
#pragma unroll
    for (int ni = 0; ni < 2; ++ni)
#pragma unroll
      for (int i = 0; i < 16; ++i) {
        const int row = wm * 64 + mi * 32 + (i & 3) + 8 * (i >> 2) + 4 * h;
        const int col = wn * 64 + ni * 32 + cl;
        *(bf16_t*)(lds + row * 272 + col * 2) = f2bf(acc[mi][ni][i]);
      }
  __syncthreads();
#pragma unroll
  for (int i = 0; i < 8; ++i) {
    const int id = tid + NT * i, row = id >> 4, ch = id & 15;
    const u32x4 v = *(const u32x4*)(lds + row * 272 + ch * 16);
    *(u32x4*)(dst + (size_t)row * ldd + ch * 8) = v;
  }
  __syncthreads();
}

DI void ph2_inproj_tile(PR p, int l, int t, char* lds) {
  const int tid = ltid();
  const int nt = t & 63, mt = t >> 6;
  const int m0 = mt * 256, n0 = nt * 128;
  const bf16_t* A = (const bf16_t*)(lws(p) + WS_R2) + (size_t)m0 * 1024;
  const bf16_t* B = (const bf16_t*)(lws(p) + WS_R1) + (size_t)n0 * 1024;
  f32x16 acc[2][2];
  acc_zero(acc);
  gemm_mainloop(tid, A, 1024, B, 1024, 1024, acc, lds);
  if (m0 < 4096 && n0 >= C_KB && n0 < C_ZB) {
    const int wave = tid >> 6, lane = tid & 63, wm = wave >> 1, wn = wave & 1;
    float* base = lout(p) + (n0 < C_VB ? O_CK : O_CV);
    const int cb = (n0 < C_VB ? n0 - C_KB : n0 - C_VB);
#pragma unroll
    for (int mi = 0; mi < 2; ++mi)
#pragma unroll
      for (int ni = 0; ni < 2; ++ni)
#pragma unroll
        for (int i = 0; i < 16; ++i) {
          const int row = m0 + wm * 64 + mi * 32 + (i & 3) + 8 * (i >> 2) + 4 * (lane >> 5);
          const int col = cb + wn * 64 + ni * 32 + (lane & 31);
          const int b = row >> 8, tt = row & 255;
          base[((size_t)(b * 2 + l) * 256 + tt) * 512 + col] = acc[mi][ni][i];
        }
  }
  tile_store_bf16(tid, acc, (bf16_t*)(lws(p) + WS_PROJ) + (size_t)m0 * NP + n0, NP, lds);
}

DI void ph6_merge_tile(PR p, int l, int t, char* lds) {
  const int tid = ltid();
  const int nt = t & 7, mt = t >> 3;
  const int m0 = mt * 256, n0 = nt * 128;
  const int wave = tid >> 6, lane = tid & 63, wm = wave >> 1, wn = wave & 1;
  const bf16_t* proj = (const bf16_t*)(lws(p) + WS_PROJ);
  unsigned tot[2][2][8];
#pragma unroll
  for (int a = 0; a < 2; ++a)
#pragma unroll
    for (int b = 0; b < 2; ++b)
#pragma unroll
      for (int i = 0; i < 8; ++i) tot[a][b][i] = 0u;
#pragma unroll 1
  for (int n = 0; n < 3; ++n) {
    const int acol = n == 0 ? C_UA : (n == 1 ? C_QB : C_QC);
    const bf16_t* A = proj + pjx(m0, acol);
    const bf16_t* B = (const bf16_t*)(lws(p) + WS_WTBR) + ((size_t)(l * 3 + n) * 1024 + n0) * 512;
    f32x16 acc[2][2];
    acc_zero(acc);
    gemm_mainloop(tid, A, PJ_LD, B, 512, 512, acc, lds);
#pragma unroll
    for (int mi = 0; mi < 2; ++mi)
#pragma unroll
      for (int ni = 0; ni < 2; ++ni) {
#pragma unroll
        for (int i2 = 0; i2 < 8; ++i2) {
          const int i = 2 * i2;
          const int row = m0 + wm * 64 + mi * 32 + (i & 3) + 8 * (i >> 2) + 4 * (lane >> 5);
          const int col = n0 + wn * 64 + ni * 32 + (lane & 31);
          const float g0 = bf2f(proj[pjx(row, C_GT + n * 1024 + col)]);
          const float g1 = bf2f(proj[pjx(row + 1, C_GT + n * 1024 + col)]);
          const unsigned o = tot[mi][ni][i2];
          tot[mi][ni][i2] = pack2(lo_f(o) + sigmoidf_(g0) * acc[mi][ni][i], hi_f(o) + sigmoidf_(g1) * acc[mi][ni][i + 1]);
        }
        asm volatile("" ::: "memory");
      }
  }
  bf16_t* dst = (bf16_t*)(lws(p) + WS_R2) + (size_t)m0 * 1024 + n0;
#pragma unroll
  for (int mi = 0; mi < 2; ++mi)
#pragma unroll
    for (int ni = 0; ni < 2; ++ni)
#pragma unroll
      for (int i2 = 0; i2 < 8; ++i2) {
        const int i = 2 * i2;
        const int row = wm * 64 + mi * 32 + (i & 3) + 8 * (i >> 2) + 4 * (lane >> 5);
        const int col = wn * 64 + ni * 32 + (lane & 31);
        *(bf16_t*)(lds + row * 272 + col * 2) = (bf16_t)(tot[mi][ni][i2] & 0xffffu);
        *(bf16_t*)(lds + (row + 1) * 272 + col * 2) = (bf16_t)(tot[mi][ni][i2] >> 16);
      }
  __syncthreads();
#pragma unroll
  for (int i = 0; i < 8; ++i) {
    const int id = tid + NT * i, row = id >> 4, ch = id & 15;
    const u32x4 v = *(const u32x4*)(lds + row * 272 + ch * 16);
    *(u32x4*)(dst + (size_t)row * 1024 + ch * 8) = v;
  }
  __syncthreads();
}

DI void ph7_out_tile(PR p, int l, int t, char* lds) {
  const int tid = ltid();
  const int nt = t & 7, mt = t >> 3;
  const int m0 = mt * 256, n0 = nt * 128;
  const int wave = tid >> 6, lane = tid & 63, wm = wave >> 1, wn = wave & 1;
  const bf16_t* A = (const bf16_t*)(lws(p) + WS_R2) + (size_t)m0 * 1024;
  const bf16_t* B = (const bf16_t*)(lws(p) + WS_WTOUT) + ((size_t)l * 1024 + n0) * 1024;
  f32x16 acc[2][2];
  acc_zero(acc);
  gemm_mainloop(tid, A, 1024, B, 1024, 1024, acc, lds);
  float* ct = (float*)lds;
#pragma unroll
  for (int mi = 0; mi < 2; ++mi)
#pragma unroll
    for (int ni = 0; ni < 2; ++ni)
#pragma unroll
      for (int i = 0; i < 16; ++i) {
        const int row = wm * 64 + mi * 32 + (i & 3) + 8 * (i >> 2) + 4 * (lane >> 5);
        const int col = wn * 64 + ni * 32 + (lane & 31);
        ct[row * 132 + col] = acc[mi][ni][i];
      }
  __syncthreads();
  const float* mod = (const float*)(lws(p) + WS_MOD) + (size_t)l * 5 * 3072;
#pragma unroll 4
  for (int i = 0; i < 16; ++i) {
    const int id = tid + NT * i, row = id >> 5, c4 = (id & 31) * 4;
    const int grow = m0 + row, gcol = n0 + c4;
    const f32x4 y = *(const f32x4*)(ct + row * 132 + c4);
    const f32x4 gate = *(const f32x4*)(mod + row_cond(grow) * 3072 + 2048 + gcol);
    const f32x4 xo = *(const f32x4*)(x_in_row(p, l, grow) + gcol);
    f32x4 o;
#pragma unroll
    for (int e = 0; e < 4; ++e) o[e] = xo[e] + gate[e] * y[e];
    *(f32x4*)(lout(p) + O_Y + (size_t)grow * DM + gcol) = o;
  }
  __syncthreads();
}

DI void ph_final_row(PR p, int r) {
  const int lane = ltid() & 63;
  float* x = lout(p) + O_Y + (size_t)r * DM;
  f32x4 v[4];
  float ss = 0.f;
#pragma unroll
  for (int i = 0; i < 4; ++i) { v[i] = *(const f32x4*)(x + (i * 64 + lane) * 4); ss += v[i][0] * v[i][0] + v[i][1] * v[i][1] + v[i][2] * v[i][2] + v[i][3] * v[i][3]; }
  ss = wave_sum(ss);
  const float rstd = rsqrtf(ss * (1.f / 1024.f) + EPS);
#pragma unroll
  for (int i = 0; i < 4; ++i) {
    const f32x4 g = *(const f32x4*)(lin(p, 30) + (i * 64 + lane) * 4);
    f32x4 o;
#pragma unroll
    for (int e = 0; e < 4; ++e) o[e] = v[i][e] * rstd * g[e];
    *(f32x4*)(x + (i * 64 + lane) * 4) = o;
  }
}

namespace pg8 {
#define PG8_LAS __attribute__((address_space(3)))
typedef unsigned short bf16_t;
typedef short bf16x8 __attribute__((ext_vector_type(8)));
typedef float f32x4 __attribute__((ext_vector_type(4)));
typedef unsigned u32x4 __attribute__((ext_vector_type(4)));
constexpr int BM = 256, BK = 64, HALF = 128, HTB = HALF * BK * 2  , STAGE_BYTES = 8 * HTB, NXCD = 8, WGM = 8;

__host__ __device__ __forceinline__ int lds_byte(int r, int c) { const int st = (r >> 4) * 2 + (c >> 5), rr = r & 15, cc = c & 31, ob = rr * 64 + cc * 2; return st * 1024 + (ob ^ (((ob >> 9) & 1) << 5)); }
__host__ __device__ __forceinline__ void stage_rc(int b, int& R, int& C) { const int st = b / 1024, sb = b % 1024, swz = sb ^ (((sb >> 9) & 1) << 5); R = (st >> 1) * 16 + swz / 64; C = (st & 1) * 32 + (swz % 64) / 2; }
__host__ __device__ __forceinline__ int perm32(int rho) { const int n = rho >> 4, i = rho & 15; return 8 * (i >> 2) + 4 * n + (i & 3); }

struct Unit { int pm, pn, grp; };
struct Gemm { const bf16_t* A; const bf16_t* Bt; int M, N, K, lda, ldb; };

struct StaticOrder {
    int nM, nN, nwg, G, c;
    __host__ __device__ void init(int M, int N, int G_, int c_) { nM = M / BM; nN = N / BM; nwg = nM * nN; G = G_; c = c_; }
    __host__ __device__ bool next(int i, Unit& u) const {
        const long L = (long)i * G + c; if (L >= nwg) return false;
        int wgid = (int)L; { const int q = nwg / NXCD, r = nwg % NXCD, xcd = wgid % NXCD, off = wgid / NXCD; wgid = (xcd < r ? xcd * (q + 1) : r * (q + 1) + (xcd - r) * q) + off; }
        const int nig = WGM * nN, gid = wgid / nig, fm = gid * WGM, gsz = (nM - fm) < WGM ? (nM - fm) : WGM;
        u.pm = fm + ((wgid % nig) % gsz); u.pn = (wgid % nig) / gsz; u.grp = 0; return true;
    }
    __device__ __forceinline__ void a_ready(const Unit&) const {}
    __device__ __forceinline__ void done(const Unit&) const {}
    __device__ __forceinline__ const char* a_base(const Gemm& g, const Unit& u, size_t tstepA) const { return (const char*)g.A + (size_t)u.pm * tstepA; }
    __device__ __forceinline__ const char* b_base(const Gemm& g, const Unit& u, size_t tstepB) const { return (const char*)g.Bt + (size_t)u.pn * tstepB; }
};

__device__ __forceinline__ unsigned cvt_pk_bf16(float lo, float hi) { unsigned r; asm volatile("v_cvt_pk_bf16_f32 %0, %1, %2" : "=v"(r) : "v"(lo), "v"(hi)); return r; }

template <class Epi, class Sched, bool STAMP = false>
__device__ __forceinline__ void gemm_phase(PG8_LAS unsigned char* lds, const Gemm g, const Sched& S, const Epi& E, unsigned long long* stamps) {
    const int tid = ltid(), wid = __builtin_amdgcn_readfirstlane(tid >> 6), lane = tid & 63, wr = wid >> 2, wc = wid & 3, fr = lane & 15, fq = lane >> 4;
    const int K = g.K, nt = K / BK;
    int ts_lo = 0, ts_hi = 0, nts = 0; const unsigned long long rt_entry = STAMP ? (unsigned long long)wall_clock64() : 0ull;
#define PG8_STAMP() do { if (STAMP && wid == 0 && nts < 64) { const unsigned long long _c = (unsigned long long)clock64(); \
        ts_lo = (lane == nts) ? (int)(unsigned)_c : ts_lo; ts_hi = (lane == nts) ? (int)(unsigned)(_c >> 32) : ts_hi; ++nts; } } while (0)
    PG8_STAMP();
    unsigned voffA[2], voffB[2];
#pragma unroll
    for (int i = 0; i < 2; ++i) { int R, C; stage_rc(tid * 16 + i * 8192, R, C); const int Rb = Epi::PERM ? ((R & ~31) + perm32(R & 31)) : R;
        voffA[i] = (unsigned)(R * g.lda + C) * 2u; voffB[i] = (unsigned)(Rb * g.ldb + C) * 2u; }
    const size_t kstep = (size_t)(BK * 2);
    const size_t hstepA = (size_t)HALF * g.lda * 2, hstepB = (size_t)HALF * g.ldb * 2;
    const size_t tstepA = 2 * hstepA, tstepB = 2 * hstepB;
    const unsigned ldsw = (unsigned)wid * 1024u;
    const int aoff = lds_byte(wr * 64 + fr, fq * 8), boff = lds_byte(wc * 32 + fr, fq * 8);
#define PG8_SA(b, h) (((b) * 2 + (h)) * HTB)
#define PG8_SB(b, h) ((4 + (b) * 2 + (h)) * HTB)
#define PG8_STAGE(bufoff, gbase, voff) do { _Pragma("unroll") for (int _i = 0; _i < 2; ++_i) \
        __builtin_amdgcn_global_load_lds((const unsigned*)((const char*)(gbase) + (voff)[_i]), (PG8_LAS unsigned*)(lds + (bufoff) + ldsw + _i * 8192), 16, 0, 0); } while (0)
#define PG8_LDA(dst, b, h) do { _Pragma("unroll") for (int m = 0; m < 4; ++m) _Pragma("unroll") for (int k = 0; k < 2; ++k) dst[m][k] = *(const PG8_LAS bf16x8*)(lds + PG8_SA(b, h) + aoff + m * 2048 + k * 1024); } while (0)
#define PG8_LDB(dst, b, h) do { _Pragma("unroll") for (int n = 0; n < 2; ++n) _Pragma("unroll") for (int k = 0; k < 2; ++k) dst[n][k] = *(const PG8_LAS bf16x8*)(lds + PG8_SB(b, h) + boff + n * 2048 + k * 1024); } while (0)
#define PG8_MMA(ai, bj, At, Bt) do { __builtin_amdgcn_s_setprio(1); _Pragma("unroll") for (int m = 0; m < 4; ++m) _Pragma("unroll") for (int n = 0; n < 2; ++n) _Pragma("unroll") for (int k = 0; k < 2; ++k) \
        acc[ai][bj][m][n] = __builtin_amdgcn_mfma_f32_16x16x32_bf16(Bt[n][k], At[m][k], acc[ai][bj][m][n], 0, 0, 0); __builtin_amdgcn_s_setprio(0); } while (0)
#define PG8_WAIT_V(n) asm volatile("s_waitcnt vmcnt(" #n ")" ::: "memory")
#define PG8_WAIT_L(n) asm volatile("s_waitcnt lgkmcnt(" #n ")" ::: "memory")
#define PG8_BAR __builtin_amdgcn_s_barrier()
#define PG8_SCHED __builtin_amdgcn_sched_barrier(0)
    Unit cur, nxt; int ui = 0;
    if (!S.next(0, cur)) return;
    f32x4 acc[2][2][4][2];
#pragma unroll
    for (int a = 0; a < 2; ++a)
#pragma unroll
        for (int b = 0; b < 2; ++b)
#pragma unroll
            for (int m = 0; m < 4; ++m)
#pragma unroll
                for (int n = 0; n < 2; ++n) acc[a][b][m][n] = (f32x4){0.f, 0.f, 0.f, 0.f};
    bf16x8 At[4][2], B0[2][2], B1[2][2];
    const char* cA = S.a_base(g, cur, tstepA); const char* cB = S.b_base(g, cur, tstepB);
    S.a_ready(cur);
    PG8_STAGE(PG8_SB(0, 0), cB, voffB); PG8_STAGE(PG8_SA(0, 0), cA, voffA); PG8_STAGE(PG8_SB(0, 1), cB + hstepB, voffB); PG8_STAGE(PG8_SA(0, 1), cA + hstepA, voffA);
    if (wr == 1) PG8_BAR;
    PG8_WAIT_V(4); PG8_BAR;
    PG8_STAGE(PG8_SB(1, 0), cB + kstep, voffB); PG8_STAGE(PG8_SA(1, 0), cA + kstep, voffA); PG8_STAGE(PG8_SB(1, 1), cB + hstepB + kstep, voffB);
    PG8_WAIT_V(6); PG8_BAR;
    PG8_STAMP();
    for (;;) {
        const bool has_next = S.next(ui + 1, nxt);
        const char* nA = has_next ? S.a_base(g, nxt, tstepA) : cA; const char* nB = has_next ? S.b_base(g, nxt, tstepB) : cB;
        for (int t = 0; t < nt; t += 2) {
            const bool last = (t == nt - 2);
            const char* a1 = cA + (size_t)(t + 1) * kstep;
            const char* a2 = last ? nA : cA + (size_t)(t + 2) * kstep; const char* b2 = last ? nB : cB + (size_t)(t + 2) * kstep;
            const char* a3 = a2 + kstep; const char* b3 = b2 + kstep;
            if (last && has_next) S.a_ready(nxt);
            PG8_LDB(B0, 0, 0); PG8_SCHED; PG8_LDA(At, 0, 0); PG8_STAGE(PG8_SA(1, 1), a1 + hstepA, voffA);
            PG8_WAIT_L(8); PG8_BAR; PG8_WAIT_L(0); PG8_MMA(0, 0, At, B0); PG8_BAR; PG8_SCHED;
            PG8_LDB(B1, 0, 1); PG8_STAGE(PG8_SB(0, 0), b2, voffB);
            PG8_BAR; PG8_WAIT_L(0); PG8_MMA(0, 1, At, B1); PG8_BAR;
            PG8_LDA(At, 0, 1); PG8_STAGE(PG8_SA(0, 0), a2, voffA);
            PG8_BAR; PG8_WAIT_L(0); PG8_MMA(1, 0, At, B0); PG8_BAR; PG8_SCHED;
            PG8_STAGE(PG8_SB(0, 1), b2 + hstepB, voffB);
            PG8_WAIT_V(6); PG8_BAR; PG8_MMA(1, 1, At, B1); PG8_BAR;
            PG8_LDB(B0, 1, 0); PG8_SCHED; PG8_LDA(At, 1, 0); PG8_STAGE(PG8_SA(0, 1), a2 + hstepA, voffA);
            PG8_WAIT_L(8); PG8_BAR; PG8_WAIT_L(0); PG8_MMA(0, 0, At, B0); PG8_BAR; PG8_SCHED;
            PG8_LDB(B1, 1, 1); PG8_STAGE(PG8_SB(1, 0), b3, voffB);
            PG8_BAR; PG8_WAIT_L(0); PG8_MMA(0, 1, At, B1); PG8_BAR;
            PG8_LDA(At, 1, 1); PG8_STAGE(PG8_SA(1, 0), a3, voffA);
            PG8_BAR; PG8_WAIT_L(0); PG8_MMA(1, 0, At, B0); PG8_BAR; PG8_SCHED;
            PG8_STAGE(PG8_SB(1, 1), b3 + hstepB, voffB);
            PG8_WAIT_V(6); PG8_BAR; PG8_MMA(1, 1, At, B1); PG8_BAR;
        }
        PG8_STAMP();
        if constexpr (!Epi::AFTER_DRAIN) { E(acc, cur, wr, wc, fr, fq); S.done(cur); }
        PG8_STAMP();
        if (!has_next) break;
#pragma unroll
        for (int a = 0; a < 2; ++a)
#pragma unroll
            for (int b = 0; b < 2; ++b)
#pragma unroll
                for (int m = 0; m < 4; ++m)
#pragma unroll
                    for (int n = 0; n < 2; ++n) acc[a][b][m][n] = (f32x4){0.f, 0.f, 0.f, 0.f};
        cur = nxt; cA = nA; cB = nB; ++ui;
    }
    PG8_WAIT_V(0);
    if (wr == 0) PG8_BAR;
    PG8_BAR;
    if constexpr (Epi::AFTER_DRAIN) { E.fused(acc, cur, wr, wc, fr, fq, lds, wid, lane); S.done(cur); }
    PG8_STAMP();
    if (STAMP && wid == 0) { stamps[lane] = lane < nts ? (((unsigned long long)(unsigned)ts_hi << 32) | (unsigned)ts_lo) : 0ull;
        if (lane == 62) stamps[62] = rt_entry; if (lane == 63) stamps[63] = (unsigned long long)wall_clock64(); }
#undef PG8_STAMP
#undef PG8_SA
#undef PG8_SB
#undef PG8_STAGE
#undef PG8_LDA
#undef PG8_LDB
#undef PG8_MMA
#undef PG8_WAIT_V
#undef PG8_WAIT_L
#undef PG8_BAR
#undef PG8_SCHED
}
}

struct EpiInproj {
  static constexpr bool PERM = true, AFTER_DRAIN = false;
  bf16_t* proj; float* out; int l;
  __device__ __forceinline__ void operator()(const pg8::f32x4 (&acc)[2][2][4][2], const pg8::Unit& u, int wr, int wc, int fr, int fq) const {
    int row0 = u.pm * 256 + wr * 64 + fr, col0 = u.pn * 256 + wc * 32 + 8 * fq;
    asm volatile("" : "+v"(row0), "+v"(col0));
    const bool cache = (u.pm < 16) && (u.pn >= 6) && (u.pn < 10);
    float* cbase = out + (u.pn < 8 ? O_CK : O_CV);
    const int ccol0 = col0 - (u.pn < 8 ? C_KB : C_VB);
#pragma unroll
    for (int ai = 0; ai < 2; ++ai)
#pragma unroll
      for (int m = 0; m < 4; ++m) {
        const int row = row0 + ai * 128 + m * 16;
        bf16_t* rowp = proj + pjx(row, col0);
#pragma unroll
        for (int bj = 0; bj < 2; ++bj) {
          const pg8::f32x4 v0 = acc[ai][bj][m][0], v1 = acc[ai][bj][m][1];
          const u32x4 w = {pack2(v0[0], v0[1]), pack2(v0[2], v0[3]), pack2(v1[0], v1[1]), pack2(v1[2], v1[3])};
          *(u32x4*)(rowp + bj * 128) = w;
          if (cache) {
            const int b = row >> 8, tt = row & 255;
            float* dst = cbase + ((size_t)(b * 2 + l) * 256 + tt) * 512 + ccol0 + bj * 128;
            *(f32x4*)dst = v0; *(f32x4*)(dst + 4) = v1;
          }
        }
      }
  }
};
DI void run_inproj8(PR p, int l) {
  pg8::Gemm g;
  g.A = (const bf16_t*)(lws(p) + WS_R2); g.Bt = (const bf16_t*)(lws(p) + WS_R1); g.M = MROWS; g.N = NP; g.K = 1024; g.lda = 1024; g.ldb = 1024;
  pg8::StaticOrder S; S.init(MROWS, NP, (int)gridDim.x, (int)blockIdx.x);
  EpiInproj E; E.proj = (bf16_t*)(lws(p) + WS_PROJ); E.out = lout(p); E.l = l;
  pg8::gemm_phase<EpiInproj, pg8::StaticOrder, false>((LAS unsigned char*)smem, g, S, E, nullptr);
}

struct MergeOrder {
  int c;
  const bf16_t* proj; const bf16_t* wbr;
  __device__ __forceinline__ bool next(int i, pg8::Unit& u) const {
    if (c >= 128 || i >= 3) return false;
    u.pm = c >> 2; u.pn = c & 3; u.grp = i; return true;
  }
  __device__ __forceinline__ void a_ready(const pg8::Unit&) const {}
  __device__ __forceinline__ void done(const pg8::Unit&) const {}
  __device__ __forceinline__ const char* a_base(const pg8::Gemm&, const pg8::Unit& u, size_t tstepA) const {
    const int acol = u.grp == 0 ? C_UA : (u.grp == 1 ? C_QB : C_QC);
    return (const char*)(proj + pjx(0, acol)) + (size_t)u.pm * tstepA;
  }
  __device__ __forceinline__ const char* b_base(const pg8::Gemm&, const pg8::Unit& u, size_t tstepB) const {
    return (const char*)(wbr + (size_t)u.grp * 1024 * 512) + (size_t)u.pn * tstepB;
  }
};
struct EpiMerge {
  static constexpr bool PERM = true, AFTER_DRAIN = false;
  const bf16_t* proj; bf16_t* mixed;
  __device__ __forceinline__ void operator()(const pg8::f32x4 (&acc)[2][2][4][2], const pg8::Unit& u, int wr, int wc, int fr, int fq) const {
    int row0 = u.pm * 256 + wr * 64 + fr, col0 = u.pn * 256 + wc * 32 + 8 * fq;
    asm volatile("" : "+v"(row0), "+v"(col0));
#pragma unroll
    for (int ai = 0; ai < 2; ++ai)
#pragma unroll
      for (int m = 0; m < 4; ++m) {
        const int row = row0 + ai * 128 + m * 16;
#pragma unroll
        for (int bj = 0; bj < 2; ++bj) {
          const int col = col0 + bj * 128;
          const u32x4 gg = *(const u32x4*)(proj + pjx(row, C_GT + u.grp * 1024 + col));
          bf16_t* mp = mixed + (size_t)row * 1024 + col;
          u32x4 prev = {0u, 0u, 0u, 0u};
          if (u.grp > 0) {
            const unsigned long long p0 = __hip_atomic_load((const unsigned long long*)mp, __ATOMIC_RELAXED, __HIP_MEMORY_SCOPE_AGENT);
            const unsigned long long p1 = __hip_atomic_load((const unsigned long long*)mp + 1, __ATOMIC_RELAXED, __HIP_MEMORY_SCOPE_AGENT);
            prev = u32x4{(unsigned)p0, (unsigned)(p0 >> 32), (unsigned)p1, (unsigned)(p1 >> 32)};
          }
          const pg8::f32x4 v0 = acc[ai][bj][m][0], v1 = acc[ai][bj][m][1];
          u32x4 w;
          w[0] = pack2(lo_f(prev[0]) + sigmoidf_(lo_f(gg[0])) * v0[0], hi_f(prev[0]) + sigmoidf_(hi_f(gg[0])) * v0[1]);
          w[1] = pack2(lo_f(prev[1]) + sigmoidf_(lo_f(gg[1])) * v0[2], hi_f(prev[1]) + sigmoidf_(hi_f(gg[1])) * v0[3]);
          w[2] = pack2(lo_f(prev[2]) + sigmoidf_(lo_f(gg[2])) * v1[0], hi_f(prev[2]) + sigmoidf_(hi_f(gg[2])) * v1[1]);
          w[3] = pack2(lo_f(prev[3]) + sigmoidf_(lo_f(gg[3])) * v1[2], hi_f(prev[3]) + sigmoidf_(hi_f(gg[3])) * v1[3]);
          *(u32x4*)mp = w;
        }
        asm volatile("" ::: "memory");
      }
  }
};
DI void run_merge8(PR p, int l) {
  pg8::Gemm g;
  g.A = (const bf16_t*)(lws(p) + WS_PROJ); g.Bt = (const bf16_t*)(lws(p) + WS_WTBR) + (size_t)l * 3 * 1024 * 512;
  g.M = MROWS; g.N = 1024; g.K = 512; g.lda = PJ_LD; g.ldb = 512;
  MergeOrder S; S.c = (int)blockIdx.x; S.proj = g.A; S.wbr = g.Bt;
  EpiMerge E; E.proj = g.A; E.mixed = (bf16_t*)(lws(p) + WS_R2);
  pg8::gemm_phase<EpiMerge, MergeOrder, false>((LAS unsigned char*)smem, g, S, E, nullptr);
}
struct OutOrder {
  int c;
  __device__ __forceinline__ bool next(int i, pg8::Unit& u) const { if (c >= 128 || i >= 1) return false; u.pm = c >> 2; u.pn = c & 3; u.grp = 0; return true; }
  __device__ __forceinline__ void a_ready(const pg8::Unit&) const {}
  __device__ __forceinline__ void done(const pg8::Unit&) const {}
  __device__ __forceinline__ const char* a_base(const pg8::Gemm& g, const pg8::Unit& u, size_t tstepA) const { return (const char*)g.A + (size_t)u.pm * tstepA; }
  __device__ __forceinline__ const char* b_base(const pg8::Gemm& g, const pg8::Unit& u, size_t tstepB) const { return (const char*)g.Bt + (size_t)u.pn * tstepB; }
};
struct EpiOut {
  static constexpr bool PERM = false, AFTER_DRAIN = false;
  const float* x0; const float* x1; const float* xo; float* out; const float* mod; int l;
  __device__ __forceinline__ void operator()(const pg8::f32x4 (&acc)[2][2][4][2], const pg8::Unit& u, int wr, int wc, int fr, int fq) const {
    int row0 = u.pm * 256 + wr * 64 + fr, col0 = u.pn * 256 + wc * 32 + 4 * fq;
    asm volatile("" : "+v"(row0), "+v"(col0));
#pragma unroll
    for (int ai = 0; ai < 2; ++ai)
#pragma unroll
      for (int m = 0; m < 4; ++m) {
        const int row = row0 + ai * 128 + m * 16;
        const float* xr = l == 0 ? (row < 4096 ? x0 + (size_t)row * DM : x1 + (size_t)(row - 4096) * DM) : xo + (size_t)row * DM;
        const float* gr = mod + row_cond(row) * 3072 + 2048;
        float* orow_ = out + (size_t)row * DM;
#pragma unroll
        for (int bj = 0; bj < 2; ++bj)
#pragma unroll
          for (int n = 0; n < 2; ++n) {
            const int col = col0 + bj * 128 + n * 16;
            const pg8::f32x4 xv = *(const pg8::f32x4*)(xr + col), gv = *(const pg8::f32x4*)(gr + col);
            *(pg8::f32x4*)(orow_ + col) = xv + gv * acc[ai][bj][m][n];
          }
      }
  }
};
DI void run_out8(PR p, int l) {
  pg8::Gemm g;
  g.A = (const bf16_t*)(lws(p) + WS_R2); g.Bt = (const bf16_t*)(lws(p) + WS_WTOUT) + (size_t)l * 1024 * 1024;
  g.M = MROWS; g.N = 1024; g.K = 1024; g.lda = 1024; g.ldb = 1024;
  OutOrder S; S.c = (int)blockIdx.x;
  EpiOut E; E.x0 = lin(p, 0); E.x1 = lin(p, 1); E.xo = lout(p) + O_Y; E.out = lout(p) + O_Y; E.mod = (const float*)(lws(p) + WS_MOD) + (size_t)l * 5 * 3072; E.l = l;
  pg8::gemm_phase<EpiOut, OutOrder, false>((LAS unsigned char*)smem, g, S, E, nullptr);
}

constexpr int S5_WLDS = 8192 + 4352;
DI void s5_wg_task(PR p, int l, int s, int d, int g, char* lds) {
  const int tid = ltid(), wave = tid >> 6, lane = tid & 63, q = lane >> 4, c = lane & 15;
  const int ldg = (l * 2 + d) * 32 + g;
  const int R0 = seq_row0(s), T = seq_len(s);
  const int seg = T >> 3, nb = seg >> 4, n0 = wave * seg;
  char* wl = lds + wave * S5_WLDS;
  float* BU = (float*)wl;
  char* H = wl + 8192;
  float* xch = (float*)(lds + 8 * S5_WLDS);
  const bf16_t* proj = (const bf16_t*)(lws(p) + WS_PROJ);
  bf16_t* yd = (bf16_t*)(lws(p) + WS_R2) + (size_t)d * MROWS * 512;
  const bf16_t* bb = (const bf16_t*)(lws(p) + WS_S5BB) + (size_t)ldg * 128 * 16;
  const bf16_t* ct = (const bf16_t*)(lws(p) + WS_S5CT) + (size_t)ldg * 16 * 128;
  bf16x8 bfr[8], cfr[4];
  const bf16x8 zero8 = {0, 0, 0, 0, 0, 0, 0, 0};
#pragma unroll
  for (int nt = 0; nt < 8; ++nt) bfr[nt] = q < 2 ? *(const bf16x8*)(bb + (nt * 16 + c) * 16 + 8 * q) : zero8;
#pragma unroll
  for (int ks = 0; ks < 4; ++ks) cfr[ks] = *(const bf16x8*)(ct + c * 128 + 32 * ks + 8 * q);
  const float ar = ((const float*)(lws(p) + WS_S5AR))[ldg * 64 + lane];
  const float ai = ((const float*)(lws(p) + WS_S5AI))[ldg * 64 + lane];
  float h0r = 0.f, h0i = 0.f;
  if (s >= 16) {
    const size_t si = ((((size_t)(s - 16) * 2 + l) * 2 + d) * 32 + g) * 64 + lane;
    h0r = lin(p, 4)[si]; h0i = lin(p, 5)[si];
  }
  auto load_u = [&](int blk) -> bf16x8 {
    const int n = n0 + blk * 16 + c;
    const int t = d ? (T - 1 - n) : n;
    if (q < 2) return *(const bf16x8*)(proj + pjx(R0 + t, C_UA + g * 16 + 8 * q));
    return zero8;
  };
  float hr = 0.f, hi = 0.f;
  auto bu_block = [&](const bf16x8& u) {
#pragma unroll
    for (int nt = 0; nt < 8; ++nt) {
      f32x4 z = {0.f, 0.f, 0.f, 0.f};
      const f32x4 dv = MFMA16(u, bfr[nt], z);
#pragma unroll
      for (int r = 0; r < 4; ++r) BU[(4 * q + r) * 128 + nt * 16 + c] = dv[r];
    }
  };
  {
    bf16x8 ucur = load_u(0);
#pragma unroll 1
    for (int blk = 0; blk < nb; ++blk) {
      bf16x8 unext = zero8;
      if (blk + 1 < nb) unext = load_u(blk + 1);
      bu_block(ucur);
#pragma unroll
      for (int i = 0; i < 16; ++i) {
        const float br = BU[i * 128 + lane], bi = BU[i * 128 + 64 + lane];
        const float nr = ar * hr - ai * hi + br;
        const float ni = ar * hi + ai * hr + bi;
        hr = nr; hi = ni;
      }
      ucur = unext;
    }
  }
  xch[(wave * 2 + 0) * 64 + lane] = hr;
  xch[(wave * 2 + 1) * 64 + lane] = hi;
  float pr = ar, pi = ai;
  const int nsq = T == 1024 ? 7 : 5;
  for (int k = 0; k < nsq; ++k) { const float t0 = pr * pr - pi * pi, t1 = 2.f * pr * pi; pr = t0; pi = t1; }
  __syncthreads();
  hr = h0r; hi = h0i;
  for (int v = 0; v < wave; ++v) {
    const float er = xch[(v * 2 + 0) * 64 + lane], ei = xch[(v * 2 + 1) * 64 + lane];
    const float nr = pr * hr - pi * hi + er, ni = pr * hi + pi * hr + ei;
    hr = nr; hi = ni;
  }
  {
    bf16x8 ucur = load_u(0);
#pragma unroll 1
    for (int blk = 0; blk < nb; ++blk) {
      bf16x8 unext = zero8;
      if (blk + 1 < nb) unext = load_u(blk + 1);
      bu_block(ucur);
#pragma unroll
      for (int i = 0; i < 16; ++i) {
        const float br = BU[i * 128 + lane], bi = BU[i * 128 + 64 + lane];
        const float nr = ar * hr - ai * hi + br;
        const float ni = ar * hi + ai * hr + bi;
        hr = nr; hi = ni;
        *(bf16_t*)(H + i * 272 + lane * 2) = f2bf(hr);
        *(bf16_t*)(H + i * 272 + 128 + lane * 2) = f2bf(hi);
      }
      f32x4 y = {0.f, 0.f, 0.f, 0.f};
#pragma unroll
      for (int ks = 0; ks < 4; ++ks) {
        const bf16x8 a = *(const bf16x8*)(H + c * 272 + (32 * ks + 8 * q) * 2);
        y = MFMA16(a, cfr[ks], y);
      }
#pragma unroll
      for (int r = 0; r < 4; ++r) {
        const int n = n0 + blk * 16 + 4 * q + r;
        const int t = d ? (T - 1 - n) : n;
        yd[(size_t)(R0 + t) * 512 + g * 16 + c] = f2bf(y[r]);
      }
      ucur = unext;
    }
  }
  if (s < 16 && wave == 7) {
    const size_t so = ((((size_t)s * 2 + l) * 2 + d) * 32 + g) * 64 + lane;
    lout(p)[O_SR + so] = hr; lout(p)[O_SI + so] = hi;
  }
  __syncthreads();
}

DI float gelu_tanh(float x) {
  const float z = 0.7978845608028654f * (x + 0.044715f * x * x * x);
  const float e = __expf(2.f * z);
  const float th = 1.f - 2.f / (e + 1.f);
  return 0.5f * x * (1.f + th);
}
DI void glu_tile(PR p, int l, int t, char* lds, bool dry) {
  const int tid = ltid(), wave = tid >> 6, lane = tid & 63;
  const int m0 = t * 32;
  float* Yf = (float*)lds;
  char* Ya = lds + 66048;
  bf16_t* proj = (bf16_t*)(lws(p) + WS_PROJ);
  const bf16_t* yd0 = (const bf16_t*)(lws(p) + WS_R2);
  const bf16_t* yd1 = yd0 + (size_t)MROWS * 512;
  const float* s5d = lin(p, 20) + l * 512;
  {
    const int row = tid >> 4;
#pragma unroll
    for (int i = 0; i < 4; ++i) {
      const int c0 = (tid & 15) * 8 + 128 * i;
      const u32x4 uu = *(const u32x4*)(proj + pjx(m0 + row, C_UA + c0));
      const u32x4 a0 = *(const u32x4*)(yd0 + (size_t)(m0 + row) * 512 + c0);
      const u32x4 a1 = *(const u32x4*)(yd1 + (size_t)(m0 + row) * 512 + c0);
      float y[8];
#pragma unroll
      for (int e = 0; e < 4; ++e) {
        y[2 * e]     = gelu_tanh(s5d[c0 + 2 * e] * lo_f(uu[e]) + lo_f(a0[e]) + lo_f(a1[e]));
        y[2 * e + 1] = gelu_tanh(s5d[c0 + 2 * e + 1] * hi_f(uu[e]) + hi_f(a0[e]) + hi_f(a1[e]));
      }
#pragma unroll
      for (int e = 0; e < 8; ++e) Yf[row * 516 + c0 + e] = y[e];
      const u32x4 o = {pack2(y[0], y[1]), pack2(y[2], y[3]), pack2(y[4], y[5]), pack2(y[6], y[7])};
      const int ch = c0 >> 3;
      *(u32x4*)(Ya + row * 1024 + ((ch ^ (row & 15)) << 4)) = o;
    }
  }
  __syncthreads();
  const int r = lane & 31, h = lane >> 5;
  const bf16_t* W = (const bf16_t*)(lws(p) + WS_WTGLU) + (size_t)l * 512 * 512;
  f32x16 acc[2];
#pragma unroll
  for (int i = 0; i < 16; ++i) { acc[0][i] = 0.f; acc[1][i] = 0.f; }
#pragma unroll 4
  for (int s = 0; s < 32; ++s) {
    const int ch = 2 * s + h;
    const bf16x8 a = *(const bf16x8*)(Ya + r * 1024 + ((ch ^ (r & 15)) << 4));
#pragma unroll
    for (int ni = 0; ni < 2; ++ni) {
      const bf16x8 b = *(const bf16x8*)(W + (size_t)(wave * 64 + ni * 32 + r) * 512 + ch * 8);
      acc[ni] = MFMA32(a, b, acc[ni]);
    }
  }
#pragma unroll
  for (int ni = 0; ni < 2; ++ni)
#pragma unroll
    for (int i = 0; i < 16; ++i) {
      const int row = (i & 3) + 8 * (i >> 2) + 4 * h;
      const int col = wave * 64 + ni * 32 + r;
      const float y = Yf[row * 516 + col];
      const float z = bf2f(proj[pjx(m0 + row, C_ZA + col)]);
      const bf16_t ov = f2bf(y * sigmoidf_(acc[ni][i]) * siluf_(z));
      if (!dry) proj[pjx(m0 + row, C_UA + col)] = ov; else asm volatile("" :: "v"((unsigned)ov));
    }
  __syncthreads();
}

DI void ph5_row(PR p, int l, int r) {
  const int lane = ltid() & 63;
  const int c0 = lane * 8;
  bf16_t* proj = (bf16_t*)(lws(p) + WS_PROJ);
  const bf16_t* o0 = (const bf16_t*)(lws(p) + WS_R1);
  const bf16_t* o1 = o0 + (size_t)MROWS * 512;
  const u32x4 a = *(const u32x4*)(o0 + (size_t)r * 512 + c0);
  const u32x4 b = *(const u32x4*)(o1 + (size_t)r * 512 + c0);
  const u32x4 zz = *(const u32x4*)(proj + pjx(r, C_ZC + c0));
  float o[8];
  float ss = 0.f;
#pragma unroll
  for (int e = 0; e < 4; ++e) {
    o[2 * e] = lo_f(a[e]) + lo_f(b[e]); o[2 * e + 1] = hi_f(a[e]) + hi_f(b[e]);
    ss += o[2 * e] * o[2 * e] + o[2 * e + 1] * o[2 * e + 1];
  }
#pragma unroll
  for (int off = 1; off <= 8; off <<= 1) ss += __shfl_xor(ss, off);
  const float rstd = rsqrtf(ss * (1.f / 128.f) + EPS);
  const float* g = lin(p, 27) + l * 128 + (c0 & 127);
  float v[8];
#pragma unroll
  for (int e = 0; e < 4; ++e) {
    v[2 * e] = o[2 * e] * rstd * g[2 * e] * siluf_(lo_f(zz[e]));
    v[2 * e + 1] = o[2 * e + 1] * rstd * g[2 * e + 1] * siluf_(hi_f(zz[e]));
  }
  const u32x4 w = {pack2(v[0], v[1]), pack2(v[2], v[3]), pack2(v[4], v[5]), pack2(v[6], v[7])};
  *(u32x4*)(proj + pjx(r, C_QC + c0)) = w;
}

constexpr int AT_K = 8192, AT_STAGE = 16384;
DI void att_gload(int tid, PR p, int l, int s, int h, int kt, u32x4& ka, u32x4& kb, u32x4& va, u32x4& vb) {
  const int key = tid >> 4, ch = tid & 15;
  const int j = kt * 32 + key;
  const int R0 = seq_row0(s);
  const bf16_t* proj = (const bf16_t*)(lws(p) + WS_PROJ);
  if (s < 16 || j < 1024) {
    const bf16_t* kr = proj + pjx(R0 + j, C_KB + h * 128);
    ka = *(const u32x4*)(kr + ch * 8);
    kb = *(const u32x4*)(kr + (ch ^ 2) * 8);
    va = *(const u32x4*)(proj + pjx(R0 + j, C_VB + h * 128 + ch * 8));
    vb = va;
  } else {
    const int b = s - 16, jc = j - 1024;
    const float* kc = lin(p, 2) + (((size_t)(b * 2 + l) * 512 + jc) * 4 + h) * 128 + ch * 8;
    const float* vc = lin(p, 3) + (((size_t)(b * 2 + l) * 512 + jc) * 4 + h) * 128 + ch * 8;
    ka = *(const u32x4*)kc; kb = *(const u32x4*)(kc + 4);
    va = *(const u32x4*)vc; vb = *(const u32x4*)(vc + 4);
  }
}
DI void att_lstore(int tid, PR p, int s, int kt, const u32x4& ka, const u32x4& kb, const u32x4& va, const u32x4& vb, char* stage) {
  const int key = tid >> 4, ch = tid & 15;
  const int j = kt * 32 + key;
  u32x4 ko, vo;
  if (s < 16) { ko = ka; vo = va; }
  else if (j < 1024) {
    const int pos = (ch & 4) ? (j & 63) : (j >> 6);
    const float* rc = (const float*)(lws(p) + WS_ROPE) + pos * 16 + (ch & 1) * 8;
    const float sg = (ch & 2) ? 1.f : -1.f;
    float o[8];
#pragma unroll
    for (int e = 0; e < 4; ++e) {
      const float c0 = rc[2 * e], c1 = rc[2 * e + 1], s0 = rc[1024 + 2 * e], s1 = rc[1024 + 2 * e + 1];
      o[2 * e]     = lo_f(ka[e]) * c0 + sg * lo_f(kb[e]) * s0;
      o[2 * e + 1] = hi_f(ka[e]) * c1 + sg * hi_f(kb[e]) * s1;
    }
    ko = u32x4{pack2(o[0], o[1]), pack2(o[2], o[3]), pack2(o[4], o[5]), pack2(o[6], o[7])};
    vo = va;
  } else {
    ko = u32x4{pack2(__uint_as_float(ka[0]), __uint_as_float(ka[1])), pack2(__uint_as_float(ka[2]), __uint_as_float(ka[3])),
               pack2(__uint_as_float(kb[0]), __uint_as_float(kb[1])), pack2(__uint_as_float(kb[2]), __uint_as_float(kb[3]))};
    vo = u32x4{pack2(__uint_as_float(va[0]), __uint_as_float(va[1])), pack2(__uint_as_float(va[2]), __uint_as_float(va[3])),
               pack2(__uint_as_float(vb[0]), __uint_as_float(vb[1])), pack2(__uint_as_float(vb[2]), __uint_as_float(vb[3]))};
  }
  *(u32x4*)(stage + key * 256 + ((ch ^ (key & 15)) << 4)) = ko;
  const int et = ch >> 1, hf = ch & 1;
  *(u32x4*)(stage + AT_K + key * 256 + ((((et ^ (key & 7)) << 1) | hf) << 4)) = vo;
}

DI void att_task(PR p, int l, int s, int h, int qb, char* lds, bool dry) {
  const int tid = ltid(), wave = tid >> 6, lane = tid & 63, q = lane >> 4, c = lane & 15;
  const int R0 = seq_row0(s), T = seq_len(s);
  const int nkeys = s < 16 ? 256 : 1536, nkt = nkeys >> 5;
  bf16_t* proj = (bf16_t*)(lws(p) + WS_PROJ);
  const int tq = qb * 128 + wave * 16 + c;
  const int qrow_i = R0 + tq;
  bf16x8 qf[2][2];
#pragma unroll
  for (int m = 0; m < 2; ++m)
#pragma unroll
    for (int ks = 0; ks < 2; ++ks) {
      const int d0 = 32 * ks + 8 * q;
      const u32x4 own = *(const u32x4*)(proj + pjx(qrow_i, C_QB + h * 128 + m * 64 + d0));
      float o[8];
      if (s >= 16) {
        const u32x4 par = *(const u32x4*)(proj + pjx(qrow_i, C_QB + h * 128 + m * 64 + (d0 ^ 16)));
        const int pos = ks ? (tq & 63) : (tq >> 6);
        const float* rc = (const float*)(lws(p) + WS_ROPE) + pos * 16 + (q & 1) * 8;
        const float sg = (q & 2) ? 1.f : -1.f;
#pragma unroll
        for (int e = 0; e < 4; ++e) {
          o[2 * e]     = lo_f(own[e]) * rc[2 * e] + sg * lo_f(par[e]) * rc[1024 + 2 * e];
          o[2 * e + 1] = hi_f(own[e]) * rc[2 * e + 1] + sg * hi_f(par[e]) * rc[1024 + 2 * e + 1];
        }
      } else {
#pragma unroll
        for (int e = 0; e < 4; ++e) { o[2 * e] = lo_f(own[e]); o[2 * e + 1] = hi_f(own[e]); }
      }
      qf[m][ks] = mk8(pack2(o[0] * 0.125f, o[1] * 0.125f), pack2(o[2] * 0.125f, o[3] * 0.125f),
                      pack2(o[4] * 0.125f, o[5] * 0.125f), pack2(o[6] * 0.125f, o[7] * 0.125f));
    }
  f32x4 O[2][8];
#pragma unroll
  for (int m = 0; m < 2; ++m)
#pragma unroll
    for (int et = 0; et < 8; ++et) O[m][et] = f32x4{0.f, 0.f, 0.f, 0.f};
  float mx[2] = {-1e30f, -1e30f}, lsum[2] = {0.f, 0.f};

  u32x4 Aa, Ab, Ac, Ad, Ba, Bb, Bc, Bd;
  att_gload(tid, p, l, s, h, 0, Aa, Ab, Ac, Ad);
  __syncthreads();
  att_lstore(tid, p, s, 0, Aa, Ab, Ac, Ad, lds);
  att_gload(tid, p, l, s, h, 1, Aa, Ab, Ac, Ad);
  __syncthreads();
  auto compute = [&](const char* cur) {
    f32x4 S[2][2];
#pragma unroll
    for (int m = 0; m < 2; ++m)
#pragma unroll
      for (int k2 = 0; k2 < 2; ++k2) {
        f32x4 acc = {0.f, 0.f, 0.f, 0.f};
#pragma unroll
        for (int ks = 0; ks < 2; ++ks) {
          const int key = k2 * 16 + c;
          const bf16x8 a = *(const bf16x8*)(cur + key * 256 + (((m * 8 + ks * 4 + q) ^ (key & 15)) << 4));
          acc = MFMA16(a, qf[m][ks], acc);
        }
        S[m][k2] = acc;
      }
    bf16x8 pf[2];
#pragma unroll
    for (int m = 0; m < 2; ++m) {
      float tm = fmaxf(fmaxf(fmaxf(S[m][0][0], S[m][0][1]), fmaxf(S[m][0][2], S[m][0][3])),
                       fmaxf(fmaxf(S[m][1][0], S[m][1][1]), fmaxf(S[m][1][2], S[m][1][3])));
      tm = fmaxf(tm, __shfl_xor(tm, 16));
      tm = fmaxf(tm, __shfl_xor(tm, 32));
      const float mn = fmaxf(mx[m], tm);
      const float alpha = __expf(mx[m] - mn);
      mx[m] = mn;
      float pv[8], ps = 0.f;
#pragma unroll
      for (int k2 = 0; k2 < 2; ++k2)
#pragma unroll
        for (int r = 0; r < 4; ++r) { pv[k2 * 4 + r] = __expf(S[m][k2][r] - mn); ps += pv[k2 * 4 + r]; }
      lsum[m] = lsum[m] * alpha + ps;
#pragma unroll
      for (int et = 0; et < 8; ++et) O[m][et] *= alpha;
      pf[m] = mk8(pack2(pv[0], pv[1]), pack2(pv[2], pv[3]), pack2(pv[4], pv[5]), pack2(pv[6], pv[7]));
    }
    {
      const int qq = c >> 2, pp = c & 3;
      const int kA = 4 * q + qq, kB = 16 + 4 * q + qq;
#pragma unroll
      for (int et = 0; et < 8; ++et) {
        const char* aA = cur + AT_K + kA * 256 + (((et ^ (kA & 7)) << 5)) + pp * 8;
        const char* aB = cur + AT_K + kB * 256 + (((et ^ (kB & 7)) << 5)) + pp * 8;
        const s16x4 lo = __builtin_amdgcn_ds_read_tr16_b64_v4i16((s16x4 LAS*)(const LAS char*)aA);
        const s16x4 hi = __builtin_amdgcn_ds_read_tr16_b64_v4i16((s16x4 LAS*)(const LAS char*)aB);
        const bf16x8 vf = __builtin_shufflevector(lo, hi, 0, 1, 2, 3, 4, 5, 6, 7);
        O[0][et] = MFMA16(vf, pf[0], O[0][et]);
        O[1][et] = MFMA16(vf, pf[1], O[1][et]);
      }
    }
  };
#pragma unroll 1
  for (int kt = 0; kt < nkt; kt += 2) {
    if (kt + 2 < nkt) att_gload(tid, p, l, s, h, kt + 2, Ba, Bb, Bc, Bd);
    compute(lds);
    att_lstore(tid, p, s, kt + 1, Aa, Ab, Ac, Ad, lds + AT_STAGE);
    __syncthreads();
    if (kt + 3 < nkt) att_gload(tid, p, l, s, h, kt + 3, Aa, Ab, Ac, Ad);
    compute(lds + AT_STAGE);
    if (kt + 2 < nkt) att_lstore(tid, p, s, kt + 2, Ba, Bb, Bc, Bd, lds);
    __syncthreads();
  }
#pragma unroll
  for (int m = 0; m < 2; ++m) { lsum[m] += __shfl_xor(lsum[m], 16); lsum[m] += __shfl_xor(lsum[m], 32); }
  const float lam = ((const float*)(lws(p) + WS_LAM))[l];
  const float lam_init = 0.8f - 0.6f * expf(-0.3f * (float)l);
  const float i0 = 1.f / lsum[0], i1 = lam / lsum[1];
  float ss = 0.f;
#pragma unroll
  for (int et = 0; et < 8; ++et)
#pragma unroll
    for (int r = 0; r < 4; ++r) { const float o = O[0][et][r] * i0 - O[1][et][r] * i1; O[0][et][r] = o; ss += o * o; }
  ss += __shfl_xor(ss, 16); ss += __shfl_xor(ss, 32);
  const float rstd = rsqrtf(ss * (1.f / 128.f) + EPS) * (1.f - lam_init);
  const float* g = lin(p, 23) + l * 128;
#pragma unroll
  for (int et = 0; et < 8; ++et) {
    const int e0 = 16 * et + 4 * q;
    const u32x2 zz = *(const u32x2*)(proj + pjx(qrow_i, C_ZB + h * 128 + e0));
    const float v0 = O[0][et][0] * rstd * g[e0 + 0] * siluf_(lo_f(zz[0]));
    const float v1 = O[0][et][1] * rstd * g[e0 + 1] * siluf_(hi_f(zz[0]));
    const float v2 = O[0][et][2] * rstd * g[e0 + 2] * siluf_(lo_f(zz[1]));
    const float v3 = O[0][et][3] * rstd * g[e0 + 3] * siluf_(hi_f(zz[1]));
    const u32x2 w = {pack2(v0, v1), pack2(v2, v3)};
    if (!dry) *(u32x2*)(proj + pjx(qrow_i, C_QB + h * 128 + e0)) = w; else asm volatile("" :: "v"(w[0]), "v"(w[1]));
  }
}


constexpr int DP_QF = 0, DP_KF = 33792, DP_VF = 67584, DP_MT = 101376, DP_SM = 134144;
DI int kmap8(int ks, int q, int j) { return 32 * ks + 4 * q + (j & 3) + 16 * (j >> 2); }

DI void dn_prep_task(PR p, int l, int gc, int h, char* lds) {
  const int tid = ltid(), lane = tid & 63, q = lane >> 4, c = lane & 15;
  int s, oc;
  if (gc < 64) { s = gc >> 2; oc = gc & 3; } else { s = 16 + ((gc - 64) >> 4); oc = (gc - 64) & 15; }
  const int R0 = seq_row0(s), T = seq_len(s), t0 = oc * 64;
  const bf16_t* proj = (const bf16_t*)(lws(p) + WS_PROJ);
  float* qf = (float*)(lds + DP_QF);
  float* kf = (float*)(lds + DP_KF);
  float* vf = (float*)(lds + DP_VF);
  float* mT = (float*)(lds + DP_MT);
  float* sm = (float*)(lds + DP_SM);
  __syncthreads();
  if (tid < 384) {
    const int cg = tid % 48, rg = tid / 48;
    const int which = cg >> 4, ch0 = (cg & 15) * 8;
    const int col = C_QC + which * 512 + h * 128 + ch0;
    const float* cw = lin(p, 24) + (size_t)l * 5 * 1536 + which * 512 + h * 128 + ch0;
    float w[5][8];
#pragma unroll
    for (int j = 0; j < 5; ++j)
#pragma unroll
      for (int e = 0; e < 8; ++e) w[j][e] = cw[j * 1536 + e];
    u32x4 raw[12];
#pragma unroll
    for (int i = 0; i < 12; ++i) {
      const int t = t0 + rg * 8 + i - 2;
      raw[i] = u32x4{0u, 0u, 0u, 0u};
      if (t >= 0 && t < T) raw[i] = *(const u32x4*)(proj + pjx(R0 + t, col));
    }
    float* dst = which == 0 ? qf : (which == 1 ? kf : vf);
#pragma unroll
    for (int i = 0; i < 8; ++i) {
#pragma unroll
      for (int e2 = 0; e2 < 4; ++e2) {
        float a0 = 0.f, a1 = 0.f;
#pragma unroll
        for (int j = 0; j < 5; ++j) { a0 += w[j][2 * e2] * lo_f(raw[i + j][e2]); a1 += w[j][2 * e2 + 1] * hi_f(raw[i + j][e2]); }
        dst[(rg * 8 + i) * 132 + ch0 + 2 * e2] = siluf_(a0);
        dst[(rg * 8 + i) * 132 + ch0 + 2 * e2 + 1] = siluf_(a1);
      }
    }
  }
  if ((tid & 255) < 64) {
    const int d = tid >> 8;
    const int io = d ? 63 - lane : lane;
    const float* bg = (const float*)(lws(p) + WS_BETAG) + (size_t)(R0 + t0 + io) * 16;
    const float beta = bg[d * 4 + h];
    float g = bg[8 + d * 4 + h];
#pragma unroll
    for (int o = 1; o < 64; o <<= 1) {
      const int src = lane >= o ? lane - o : lane;
      const float n = __int_as_float(__builtin_amdgcn_ds_bpermute(src << 2, __float_as_int(g)));
      if (lane >= o) g += n;
    }
    sm[d * 64 + lane] = beta;
    sm[128 + d * 64 + lane] = g;
    sm[256 + d * 64 + lane] = __expf(g);
  }
  __syncthreads();
  {
    const int wave = tid >> 6;
#pragma unroll 1
    for (int i = 0; i < 16; ++i) {
      const int id = wave * 16 + i, row = id & 63, which = id >> 6;
      float* a = (which ? kf : qf) + row * 132;
      const float v0 = a[lane], v1 = a[64 + lane];
      const float ss = wave_sum(v0 * v0 + v1 * v1);
      const float sc = rsqrtf(ss + EPS) * (which ? 1.f : 0.08838834764831845f);
      a[lane] = v0 * sc; a[64 + lane] = v1 * sc;
    }
  }
  __syncthreads();
  const int d = tid >> 8, w4 = (tid >> 6) & 3;
  const float* beta_s = sm + d * 64;
  const float* gc_s = sm + 128 + d * 64;
  const float* eg_s = sm + 256 + d * 64;
  unsigned char* slot = lws(p) + WS_DNP + (size_t)((gc * 4 + h) * 2 + d) * DNP_SLOT;
  auto orow = [&](int i) -> int { return d ? 63 - i : i; };
  auto ldfrag = [&](const float* base, int row, int ks) -> bf16x8 {
    const f32x4 a = *(const f32x4*)(base + row * 132 + 32 * ks + 8 * q);
    const f32x4 b = *(const f32x4*)(base + row * 132 + 32 * ks + 8 * q + 4);
    return mk8(pack2(a[0], a[1]), pack2(a[2], a[3]), pack2(b[0], b[1]), pack2(b[2], b[3]));
  };
  {
    const int it = w4;
    bf16x8 kfr_i[4], qfr_i[4];
#pragma unroll
    for (int ks = 0; ks < 4; ++ks) { kfr_i[ks] = ldfrag(kf, orow(16 * it + c), ks); qfr_i[ks] = ldfrag(qf, orow(16 * it + c), ks); }
    f32x4 kq[4];
#pragma unroll
    for (int jt = 0; jt < 4; ++jt) {
      f32x4 kk = {0.f, 0.f, 0.f, 0.f}, kq_ = {0.f, 0.f, 0.f, 0.f};
#pragma unroll
      for (int ks = 0; ks < 4; ++ks) {
        const bf16x8 kfr_j = ldfrag(kf, orow(16 * jt + c), ks);
        kk = MFMA16(kfr_i[ks], kfr_j, kk);
        kq_ = MFMA16(kfr_j, qfr_i[ks], kq_);
      }
      {
        const int j = 16 * jt + c;
        const float gj = gc_s[j];
#pragma unroll
        for (int r = 0; r < 4; ++r) {
          const int i = 16 * it + 4 * q + r;
          const float v = i > j ? beta_s[i] * kk[r] * __expf(gc_s[i] - gj) : 0.f;
          mT[d * 4096 + j * 64 + i] = v;
        }
      }
      {
        const int i = 16 * it + c;
        const float gi = gc_s[i];
#pragma unroll
        for (int r = 0; r < 4; ++r) {
          const int j = 16 * jt + 4 * q + r;
          kq_[r] = i >= j ? kq_[r] * __expf(gi - gc_s[j]) : 0.f;
        }
      }
      kq[jt] = kq_;
      asm volatile("" ::: "memory");
    }
#pragma unroll
    for (int ks2 = 0; ks2 < 2; ++ks2) {
      const f32x4 a = kq[2 * ks2], b = kq[2 * ks2 + 1];
      const u32x4 o = {pack2(a[0], a[1]), pack2(a[2], a[3]), pack2(b[0], b[1]), pack2(b[2], b[3])};
      *(u32x4*)(slot + SL_QK + ((it * 2 + ks2) * 64 + lane) * 16) = o;
    }
    asm volatile("" ::: "memory");
    {
      const int i = 16 * it + c, io = orow(i);
      const float egi = eg_s[i];
#pragma unroll
      for (int ks = 0; ks < 4; ++ks) {
        const f32x4 a = *(const f32x4*)(qf + io * 132 + 32 * ks + 4 * q);
        const f32x4 b = *(const f32x4*)(qf + io * 132 + 32 * ks + 16 + 4 * q);
        const u32x4 o = {pack2(a[0] * egi, a[1] * egi), pack2(a[2] * egi, a[3] * egi), pack2(b[0] * egi, b[1] * egi), pack2(b[2] * egi, b[3] * egi)};
        *(u32x4*)(slot + SL_QG + ((it * 4 + ks) * 64 + lane) * 16) = o;
      }
    }
    asm volatile("" ::: "memory");
    {
      const float gl = gc_s[63];
#pragma unroll
      for (int mm = 0; mm < 2; ++mm) {
        const int mt8 = 2 * w4 + mm, dk = 16 * mt8 + c;
#pragma unroll
        for (int ks2 = 0; ks2 < 2; ++ks2) {
          float v[8];
#pragma unroll
          for (int j = 0; j < 8; ++j) {
            const int i = kmap8(ks2, q, j);
            v[j] = kf[orow(i) * 132 + dk] * __expf(gl - gc_s[i]);
          }
          const u32x4 o = {pack2(v[0], v[1]), pack2(v[2], v[3]), pack2(v[4], v[5]), pack2(v[6], v[7])};
          *(u32x4*)(slot + SL_KGT + ((mt8 * 2 + ks2) * 64 + lane) * 16) = o;
        }
      }
      if (w4 == 0 && lane == 0) ((float*)(lws(p) + WS_EGL))[(gc * 4 + h) * 2 + d] = __expf(gl);
    }
  }
  {
    bf16_t* XA = (bf16_t*)(lds + DP_QF) + d * 32 * 260;
    bf16_t* XC = (bf16_t*)(lds + DP_KF + 16 * 528) + d * 16 * 260;
    bf16_t* XD = (bf16_t*)(lds + DP_VF + 16 * 528) + d * 16 * 260;
    const int col = tid & 255;
    const float* rsrc = col < 128 ? vf + col : kf + (col - 128);
    const float* mcol = mT + d * 4096;
    __syncthreads();
#pragma unroll 1
    for (int b = 0; b < 4; ++b) {
      float x[16];
#pragma unroll
      for (int i = 0; i < 16; ++i) {
        const int ii = 16 * b + i;
        const float sc = col < 128 ? beta_s[ii] : beta_s[ii] * eg_s[ii];
        x[i] = rsrc[orow(ii) * 132] * sc;
      }
      const int nA = b < 2 ? 16 * b : 32;
#pragma unroll 2
      for (int j = 0; j < nA; ++j) {
        const float xj = bf2f(XA[j * 260 + col]);
        const float* mr = mcol + j * 64 + 16 * b;
#pragma unroll
        for (int i4 = 0; i4 < 4; ++i4) {
          const f32x4 mm = *(const f32x4*)(mr + i4 * 4);
          x[i4 * 4 + 0] -= mm[0] * xj; x[i4 * 4 + 1] -= mm[1] * xj; x[i4 * 4 + 2] -= mm[2] * xj; x[i4 * 4 + 3] -= mm[3] * xj;
        }
      }
      if (b == 3) {
#pragma unroll 2
        for (int j = 0; j < 16; ++j) {
          const float xj = bf2f(XC[j * 260 + col]);
          const float* mr = mcol + (32 + j) * 64 + 48;
#pragma unroll
          for (int i4 = 0; i4 < 4; ++i4) {
            const f32x4 mm = *(const f32x4*)(mr + i4 * 4);
            x[i4 * 4 + 0] -= mm[0] * xj; x[i4 * 4 + 1] -= mm[1] * xj; x[i4 * 4 + 2] -= mm[2] * xj; x[i4 * 4 + 3] -= mm[3] * xj;
          }
        }
      }
      const float* md = mcol + (16 * b) * 64 + 16 * b;
#pragma unroll
      for (int j = 0; j < 15; ++j) {
        const float xj = x[j];
#pragma unroll
        for (int i4 = 0; i4 < 16; i4 += 4) {
          if (i4 + 3 > j) {
            const f32x4 mm = *(const f32x4*)(md + j * 64 + i4);
            if (i4 + 0 > j) x[i4 + 0] -= mm[0] * xj;
            if (i4 + 1 > j) x[i4 + 1] -= mm[1] * xj;
            if (i4 + 2 > j) x[i4 + 2] -= mm[2] * xj;
            if (i4 + 3 > j) x[i4 + 3] -= mm[3] * xj;
          }
        }
      }
      if (b == 2) __syncthreads();
      bf16_t* dstx = b < 2 ? XA + (16 * b) * 260 : (b == 2 ? XC : XD);
#pragma unroll
      for (int i = 0; i < 16; ++i) dstx[i * 260 + col] = f2bf(x[i]);
      __syncthreads();
    }
  }
  {
    const int tid4 = ltid(), lane = tid4 & 63, q = lane >> 4, c = lane & 15, w4 = (tid4 >> 6) & 3, d = tid4 >> 8;
    unsigned char* slot = lws(p) + WS_DNP + (size_t)((gc * 4 + h) * 2 + d) * DNP_SLOT;
    const bf16_t* XA = (const bf16_t*)(lds + DP_QF) + d * 32 * 260;
    const bf16_t* XC = (const bf16_t*)(lds + DP_KF + 16 * 528) + d * 16 * 260;
    const bf16_t* XD = (const bf16_t*)(lds + DP_VF + 16 * 528) + d * 16 * 260;
    auto Xrow = [&](int i) -> const bf16_t* { return i < 32 ? XA + i * 260 : (i < 48 ? XC + (i - 32) * 260 : XD + (i - 48) * 260); };
#pragma unroll
    for (int ks = 0; ks < 4; ++ks) {
      const bf16_t* xr = Xrow(16 * w4 + c);
      const u32x2 a = *(const u32x2*)(xr + 128 + 32 * ks + 4 * q);
      const u32x2 b = *(const u32x2*)(xr + 128 + 32 * ks + 16 + 4 * q);
      const u32x4 o = {a[0] ^ 0x80008000u, a[1] ^ 0x80008000u, b[0] ^ 0x80008000u, b[1] ^ 0x80008000u};
      *(u32x4*)(slot + SL_W + ((w4 * 4 + ks) * 64 + lane) * 16) = o;
    }
#pragma unroll
    for (int cc = 0; cc < 2; ++cc) {
      const int cs = 2 * w4 + cc;
#pragma unroll
      for (int mt = 0; mt < 4; ++mt) {
        unsigned short v[4];
#pragma unroll
        for (int r = 0; r < 4; ++r) v[r] = Xrow(16 * mt + 4 * q + r)[16 * cs + c];
        const u32x2 o = {(unsigned)v[0] | ((unsigned)v[1] << 16), (unsigned)v[2] | ((unsigned)v[3] << 16)};
        *(u32x2*)(slot + SL_U + ((cs * 4 + mt) * 64 + lane) * 8) = o;
      }
    }
  }
}

constexpr int CH_STAGE = 57344;
DI void dn_chain_task(PR p, int l, int s, int h, int d, char* lds) {
  const int tid = ltid(), cs = tid >> 6, lane = tid & 63, q = lane >> 4, c = lane & 15;
  const int R0 = seq_row0(s), T = seq_len(s), nc = T >> 6;
  const int gc0 = s < 16 ? s * 4 : 64 + (s - 16) * 16;
  bf16_t* odir = (bf16_t*)(lws(p) + WS_R1) + (size_t)d * MROWS * 512;
  const float* egl = (const float*)(lws(p) + WS_EGL);
  f32x4 S[8];
  if (s >= 16) {
    const float* s0 = lin(p, 6) + ((((size_t)(s - 16) * 2 + l) * 2 + d) * 4 + h) * 16384;
#pragma unroll
    for (int i = 0; i < 8; ++i)
#pragma unroll
      for (int r = 0; r < 4; ++r) S[i][r] = s0[(16 * i + 4 * q + r) * 128 + 16 * cs + c];
  } else {
#pragma unroll
    for (int i = 0; i < 8; ++i) S[i] = f32x4{0.f, 0.f, 0.f, 0.f};
  }
  auto slot_of = [&](int step) -> const unsigned char* {
    const int oc = d ? nc - 1 - step : step;
    return lws(p) + WS_DNP + (size_t)(((gc0 + oc) * 4 + h) * 2 + d) * DNP_SLOT;
  };
  u32x4 sA[7]; u32x2 uA[4], uB[4]; float glA = 1.f, glB = 1.f;
  auto gload = [&](int step, u32x4 (&stg)[7]) {
    const unsigned char* sl = slot_of(step);
#pragma unroll
    for (int i = 0; i < 7; ++i) stg[i] = *(const u32x4*)(sl + (size_t)(tid + NT * i) * 16);
  };
  auto lstore = [&](char* st, const u32x4 (&stg)[7]) {
#pragma unroll
    for (int i = 0; i < 7; ++i) *(u32x4*)(st + (tid + NT * i) * 16) = stg[i];
  };
  auto uload = [&](int step, u32x2 (&u)[4], float& gl) {
    const unsigned char* sl = slot_of(step);
#pragma unroll
    for (int mt = 0; mt < 4; ++mt) u[mt] = *(const u32x2*)(sl + SL_U + ((cs * 4 + mt) * 64 + lane) * 8);
    const int oc = d ? nc - 1 - step : step;
    gl = egl[((gc0 + oc) * 4 + h) * 2 + d + vzero()];
  };
  auto compute = [&](int step, const char* cur, u32x2 (&u)[4], float& glr) {
    const int oc = d ? nc - 1 - step : step;
    const float gl = glr;
    bf16x8 Sb[4];
#pragma unroll
    for (int ks = 0; ks < 4; ++ks)
      Sb[ks] = mk8(pack2(S[2 * ks][0], S[2 * ks][1]), pack2(S[2 * ks][2], S[2 * ks][3]),
                   pack2(S[2 * ks + 1][0], S[2 * ks + 1][1]), pack2(S[2 * ks + 1][2], S[2 * ks + 1][3]));
    f32x4 av[4], ao[4];
#pragma unroll
    for (int mt = 0; mt < 4; ++mt) {
      av[mt] = f32x4{lo_f(u[mt][0]), hi_f(u[mt][0]), lo_f(u[mt][1]), hi_f(u[mt][1])};
      ao[mt] = f32x4{0.f, 0.f, 0.f, 0.f};
    }
    if (step + 2 < nc) uload(step + 2, u, glr);
#pragma unroll
    for (int ks = 0; ks < 4; ++ks)
#pragma unroll
      for (int mt = 0; mt < 4; ++mt) {
        const bf16x8 wf = *(const bf16x8*)(cur + SL_W + ((mt * 4 + ks) * 64 + lane) * 16);
        av[mt] = MFMA16(wf, Sb[ks], av[mt]);
        const bf16x8 gf = *(const bf16x8*)(cur + SL_QG + ((mt * 4 + ks) * 64 + lane) * 16);
        ao[mt] = MFMA16(gf, Sb[ks], ao[mt]);
      }
    bf16x8 Vb[2];
#pragma unroll
    for (int k2 = 0; k2 < 2; ++k2)
      Vb[k2] = mk8(pack2(av[2 * k2][0], av[2 * k2][1]), pack2(av[2 * k2][2], av[2 * k2][3]),
                   pack2(av[2 * k2 + 1][0], av[2 * k2 + 1][1]), pack2(av[2 * k2 + 1][2], av[2 * k2 + 1][3]));
#pragma unroll
    for (int k2 = 0; k2 < 2; ++k2)
#pragma unroll
      for (int mt = 0; mt < 4; ++mt) {
        const bf16x8 f = *(const bf16x8*)(cur + SL_QK + ((mt * 2 + k2) * 64 + lane) * 16);
        ao[mt] = MFMA16(f, Vb[k2], ao[mt]);
      }
#pragma unroll
    for (int i = 0; i < 8; ++i) {
      S[i] *= gl;
#pragma unroll
      for (int k2 = 0; k2 < 2; ++k2) {
        const bf16x8 f = *(const bf16x8*)(cur + SL_KGT + ((i * 2 + k2) * 64 + lane) * 16);
        S[i] = MFMA16(f, Vb[k2], S[i]);
      }
    }
#pragma unroll
    for (int mt = 0; mt < 4; ++mt)
#pragma unroll
      for (int r = 0; r < 4; ++r) {
        const int i = 16 * mt + 4 * q + r;
        const int t = oc * 64 + (d ? 63 - i : i);
        odir[(size_t)(R0 + t) * 512 + h * 128 + 16 * cs + c] = f2bf(ao[mt][r]);
      }
    __builtin_amdgcn_sched_group_barrier(0x100, 8, 0);
#pragma unroll
    for (int g = 0; g < 6; ++g) { __builtin_amdgcn_sched_group_barrier(0x100, 8, 0); __builtin_amdgcn_sched_group_barrier(0x008, 8, 0); }
    __builtin_amdgcn_sched_group_barrier(0x008, 8, 0);
  };
  gload(0, sA); uload(0, uA, glA); uload(1, uB, glB);
  __syncthreads();
  lstore(lds, sA);
  __syncthreads();
#pragma unroll 1
  for (int step = 0; step < nc; step += 2) {
    if (step + 1 < nc) gload(step + 1, sA);
    compute(step, lds, uA, glA);
    if (step + 1 < nc) lstore(lds + CH_STAGE, sA);
    __syncthreads();
    if (step + 2 < nc) gload(step + 2, sA);
    compute(step + 1, lds + CH_STAGE, uB, glB);
    if (step + 2 < nc) lstore(lds, sA);
    __syncthreads();
  }
  if (s < 16) {
    float* so = lout(p) + O_DN + ((((size_t)s * 2 + l) * 2 + d) * 4 + h) * 16384;
#pragma unroll
    for (int i = 0; i < 8; ++i)
#pragma unroll
      for (int r = 0; r < 4; ++r) so[(16 * i + 4 * q + r) * 128 + 16 * cs + c] = S[i][r];
  }
}

constexpr int N_PHASES = 16;
constexpr int LDS_QSH = LDS_BYTES - 16;
constexpr int LDS_BST = LDS_BYTES - 32;

DI void run_prep(PR p) {
  const int G = gridDim.x, bid = blockIdx.x;
  for (int t = bid; t < 192; t += G) ph0_adaln(p, t, smem);
  for (int t = bid; t < 16; t += G) ph0_s5(p, t);
  if (bid == G - 1) ph0_misc(p);
  for (int t = bid; t < 2048; t += G) cvt_win_tile(p, 0, t, smem);
  for (int t = bid; t < 1408; t += G) cvt_other_tile(p, t, smem);
}
DI void run_final(PR p) {
  const int G = gridDim.x, bid = blockIdx.x, wave = ltid() >> 6;
  for (int r = bid * 8 + wave; r < MROWS; r += G * 8) ph_final_row(p, r);
}
DI void run_norm(PR p, int l) {
  const int G = gridDim.x, bid = blockIdx.x, wave = ltid() >> 6;
  for (int rb = bid * 8 + wave; rb < 4096; rb += G * 8) ph1_norm_rows(p, l, rb);
}
DI void run_cvt1(PR p) {
  const int G = gridDim.x, bid = blockIdx.x;
  for (int t = bid; t < 2048; t += G) cvt_win_tile(p, 1, t, smem);
}
DI void run_inproj(PR p, int l) {
  const int G = gridDim.x, bid = blockIdx.x;
  for (int t = bid; t < 2048; t += G) ph2_inproj_tile(p, l, t, smem);
}
DI void run_s5(PR p, int l) {
  const int G = gridDim.x, bid = blockIdx.x;
  for (int b = bid; b < 256; b += G) {
    s5_wg_task(p, l, 16 + (b >> 6), (b >> 5) & 1, b & 31, smem);
#pragma unroll 1
    for (int k = 0; k < 4; ++k) { const int i = b * 4 + k; s5_wg_task(p, l, i >> 6, (i >> 5) & 1, i & 31, smem); }
  }
}
DI void run_att(PR p, int l, int t, bool dry = false) {
  if (t < 128) { const int s = 16 + (t >> 5), h = (t >> 3) & 3, qb = t & 7; att_task(p, l, s, h, qb, smem, dry); }
  else { const int u = t - 128, s = u >> 3, h = (u >> 1) & 3, qb = u & 1; att_task(p, l, s, h, qb, smem, dry); }
}
DI void run_prep_dn(PR p, int l, int u) { dn_prep_task(p, l, u >> 2, u & 3, smem); }
DI void run_chain(PR p, int l) {
  const int G = gridDim.x, bid = blockIdx.x;
  for (int b = bid; b < 160; b += G) {
    const int s = b < 32 ? 16 + (b >> 3) : (b - 32) >> 3;
    const int h = (b >> 1) & 3, d = b & 1;
    dn_chain_task(p, l, s, h, d, smem);
  }
}
DI void run_glu(PR p, int l, int t, bool dry = false) { glu_tile(p, l, t, smem, dry); }
DI void run_ph5(PR p, int l) {
  const int G = gridDim.x, bid = blockIdx.x, wave = ltid() >> 6;
  for (int r = bid * 8 + wave; r < MROWS; r += G * 8) ph5_row(p, l, r);
}
DI void run_merge(PR p, int l) {
  const int G = gridDim.x, bid = blockIdx.x;
  for (int t = bid; t < 256; t += G) ph6_merge_tile(p, l, t, smem);
}
DI void run_out(PR p, int l) {
  const int G = gridDim.x, bid = blockIdx.x;
  for (int t = bid; t < 256; t += G) ph7_out_tile(p, l, t, smem);
}
DI void run_barrier(PR p, unsigned x) {
  XcdBarrier xb; xb.bar = (unsigned*)(p.ws + WS_BAR); xb.x = x; xb.st = (volatile LAS unsigned*)(LAS char*)(smem + LDS_BST);
  xcd_barrier(xb);
}

#define SW_BEGIN(id) unsigned long long _sw_t0 = 0; if constexpr (TIMEREG == (id)) { __syncthreads(); _sw_t0 = __builtin_amdgcn_s_memrealtime(); }
#define SW_END(id) if constexpr (TIMEREG == (id)) { __syncthreads(); if (blockIdx.x == 0 && threadIdx.x == 0) g_sw_acc += __builtin_amdgcn_s_memrealtime() - _sw_t0; }
#ifndef REP
#define REP 0
#endif
template <int PH> DI void run_phase1(PR p, volatile int* qsh, unsigned* qw) {
  if constexpr (PH == 0) run_prep(p);
  else if constexpr (PH == 15) run_final(p);
  else {
    constexpr int l = (PH - 1) / 7, sub = (PH - 1) % 7;
    if constexpr (sub == 0) { run_norm(p, l); if constexpr (l == 1) run_cvt1(p); }
    else if constexpr (sub == 1) run_inproj8(p, l);
    else if constexpr (sub == 2) {
      { SW_BEGIN(1) run_s5(p, l); SW_END(1) }
      if constexpr ((REP >> 16) & 1) run_s5(p, l);
      if constexpr ((REP >> 17) & 1) for (;;) { const int t = queue_pull(&qw[l * 8 + 3], qsh); if (t >= 256) break; run_att(p, l, t, true); }
      { SW_BEGIN(2)
      for (;;) {
        const int t = queue_pull(&qw[l * 8 + 0], qsh);
        if (t >= 256) break;
        run_att(p, l, t);
      }
      SW_END(2) }
      { SW_BEGIN(3)
      for (;;) {
        const int t = queue_pull(&qw[l * 8 + 2], qsh);
        if (t >= 512) break;
        run_prep_dn(p, l, t);
      }
      SW_END(3) }
      if constexpr ((REP >> 18) & 1) for (;;) { const int t = queue_pull(&qw[l * 8 + 4], qsh); if (t >= 512) break; run_prep_dn(p, l, t); }
    } else if constexpr (sub == 3) {
      { SW_BEGIN(4) run_chain(p, l); SW_END(4) }
      if constexpr ((REP >> 19) & 1) run_chain(p, l);
      if constexpr ((REP >> 20) & 1) for (;;) { const int t = queue_pull(&qw[l * 8 + 5], qsh); if (t >= 256) break; run_glu(p, l, t, true); }
      for (;;) {
        const int t = queue_pull(&qw[l * 8 + 1], qsh);
        if (t >= 256) break;
        run_glu(p, l, t);
      }
    }
    else if constexpr (sub == 4) run_ph5(p, l);
#ifndef NEW_MERGE
    else if constexpr (sub == 5) run_merge(p, l);
    else run_out(p, l);
#else
    else if constexpr (sub == 5) run_merge8(p, l);
    else run_out8(p, l);
#endif
  }
}
template <int PH> DI void run_phase(PR p, volatile int* qsh, unsigned* qw) {
  run_phase1<PH>(p, qsh, qw);
  if constexpr ((REP >> PH) & 1) { __syncthreads(); run_phase1<PH>(p, qsh, qw); }
}

__global__ void __launch_bounds__(NT) fwd_kernel(Params p_by_value) {
  PR p = *(const __attribute__((address_space(4))) Params*)__builtin_amdgcn_kernarg_segment_ptr();
  volatile int* qsh = (volatile int*)(smem + LDS_QSH);
  unsigned* qw = (unsigned*)(p.ws + WS_Q);
#ifndef ONE_LAUNCH
  switch (p.ph_lo) {
#define PHC(n) case n: run_phase<n>(p, qsh, qw); break;
    PHC(0) PHC(1) PHC(2) PHC(3) PHC(4) PHC(5) PHC(6) PHC(7) PHC(8) PHC(9) PHC(10) PHC(11) PHC(12) PHC(13) PHC(14) PHC(15)
#undef PHC
    default: break;
  }
#else
  volatile LAS unsigned* bst = (volatile LAS unsigned*)(LAS char*)(smem + LDS_BST);
  if (ltid() == 0) { bst[0] = 0u; bst[1] = 0u; }
  __syncthreads();
  if constexpr (TIMEREG > 0) { if (blockIdx.x == 0 && threadIdx.x == 0) g_sw_acc = 0ull; }
  const XcdBarrier xb = xcd_barrier_post((unsigned*)(p.ws + WS_BAR), bst);
  const unsigned xcc = xb.x;
#ifndef TIMEPH
#define TIMEPH -1
#endif
  unsigned long long tph0 = 0, tph1 = 0;
#define PHB(n) if constexpr (TIMEPH == n) tph0 = __builtin_amdgcn_s_memrealtime(); run_phase<n>(p, qsh, qw); run_barrier(p, xcc); if constexpr ((REP >> 21) & 1) run_barrier(p, xcc); if constexpr (TIMEPH == n) tph1 = __builtin_amdgcn_s_memrealtime();
  PHB(0) PHB(1) PHB(2) PHB(3) PHB(4) PHB(5) PHB(6) PHB(7) PHB(8) PHB(9) PHB(10) PHB(11) PHB(12) PHB(13) PHB(14)
#undef PHB
  run_phase<15>(p, qsh, qw);
  if constexpr (TIMEPH >= 0 || TIMEREG > 0) {
    if (blockIdx.x == 0) {
      __syncthreads();
      const unsigned long long te = __builtin_amdgcn_s_memrealtime(), dt = (TIMEREG > 0) ? *(volatile unsigned long long*)&g_sw_acc : tph1 - tph0;
      while (__builtin_amdgcn_s_memrealtime() - te < dt) __builtin_amdgcn_s_sleep(8);
    }
  }
#endif
}

extern "C" void kernel_launch(void* const* d_in, const int* in_sizes, int n_in, void* d_out, int out_size,
                              void* d_ws, size_t ws_size, hipStream_t stream) {
  static int grid = 0;
  if (grid == 0) {
    int dev = 0, cus = 0, per_cu = 0;
    if (hipGetDevice(&dev) != hipSuccess || hipDeviceGetAttribute(&cus, hipDeviceAttributeMultiprocessorCount, dev) != hipSuccess) { fprintf(stderr, "kernel_launch: device query failed\n"); grid = -1; return; }
    if (hipFuncSetAttribute((const void*)fwd_kernel, hipFuncAttributeMaxDynamicSharedMemorySize, LDS_BYTES) != hipSuccess) { fprintf(stderr, "kernel_launch: hipFuncSetAttribute failed\n"); grid = -1; return; }
    if (hipOccupancyMaxActiveBlocksPerMultiprocessor(&per_cu, (const void*)fwd_kernel, NT, LDS_BYTES) != hipSuccess || per_cu < 1) { fprintf(stderr, "kernel_launch: occupancy query reports %d\n", per_cu); per_cu = 1; }
    (void)hipGetLastError();
    grid = cus;
    if (ws_size < WS_END) { fprintf(stderr, "kernel_launch: workspace too small (%zu < %zu)\n", ws_size, (size_t)WS_END); grid = -1; return; }
  }
  if (grid < 0) return;
  (void)hipMemsetAsync((char*)d_ws + WS_BAR, 0, WS_ZERO_BYTES, stream);
  Params p{};
  for (int i = 0; i < 31; ++i) p.in[i] = (const float*)d_in[i];
  p.out = (float*)d_out; p.ws = (unsigned char*)d_ws;
#ifndef ONE_LAUNCH
  p.use_bar = 0;
  for (int ph = 0; ph < N_PHASES; ++ph) {
    p.ph_lo = ph; p.ph_hi = ph + 1;
    hipLaunchKernelGGL(fwd_kernel, dim3(grid), dim3(NT), LDS_BYTES, stream, p);
  }
#else
  p.use_bar = 1; p.ph_lo = 0; p.ph_hi = N_PHASES;
  void* args[] = {&p};
  hipError_t e = hipLaunchCooperativeKernel((const void*)fwd_kernel, dim3(grid), dim3(NT), args, LDS_BYTES, stream);
  if (e != hipSuccess) fprintf(stderr, "kernel_launch: cooperative launch failed: %s (grid %d)\n", hipGetErrorString(e), grid);
#endif
}
```

```cpp
#define ONE_LAUNCH 1
#include <hip/hip_runtime.h>
#include <stdint.h>
#include <stdio.h>

#define DI __device__ __forceinline__
typedef unsigned short bf16_t;
using bf16x8 = __attribute__((ext_vector_type(8))) short;
using s16x4  = __attribute__((ext_vector_type(4))) short;
using f32x4  = __attribute__((ext_vector_type(4))) float;
using f32x16 = __attribute__((ext_vector_type(16))) float;
using u32x4  = __attribute__((ext_vector_type(4))) unsigned;
using u32x2  = __attribute__((ext_vector_type(2))) unsigned;
typedef __bf16 bf16x2_t __attribute__((ext_vector_type(2)));
typedef float f32x2_t __attribute__((ext_vector_type(2)));
#define LAS __attribute__((address_space(3)))

#define MFMA16(a, b, c) __builtin_amdgcn_mfma_f32_16x16x32_bf16((a), (b), (c), 0, 0, 0)
#define MFMA32(a, b, c) __builtin_amdgcn_mfma_f32_32x32x16_bf16((a), (b), (c), 0, 0, 0)

constexpr int NT = 512;
constexpr int DM = 1024;
constexpr int MROWS = 8192;
constexpr int NP = 8192;
constexpr int NIN = 8208;
constexpr float EPS = 1e-6f;
constexpr int C_UA = 0, C_ZA = 512, C_QB = 1024, C_KB = 1536, C_VB = 2048, C_ZB = 2560;
constexpr int C_QC = 3072, C_KC = 3584, C_VC = 4096, C_ZC = 4608, C_GT = 5120;
constexpr size_t O_Y = 0;
constexpr size_t O_CK = 8388608;
constexpr size_t O_CV = O_CK + 4194304;
constexpr size_t O_SR = O_CV + 4194304;
constexpr size_t O_SI = O_SR + 131072;
constexpr size_t O_DN = O_SI + 131072;

constexpr size_t WS_BAR   = 0;
constexpr size_t WS_Q     = 16384;
constexpr size_t WS_ZERO_BYTES = 16384 + 1024;
constexpr size_t WS_MOD   = 32768;
constexpr size_t WS_S5AR  = WS_MOD + 122880;
constexpr size_t WS_S5AI  = WS_S5AR + 32768;
constexpr size_t WS_S5BB  = WS_S5AI + 32768;
constexpr size_t WS_S5CT  = WS_S5BB + 524288;
constexpr size_t WS_ROPE  = WS_S5CT + 524288;
constexpr size_t WS_LAM   = WS_ROPE + 8192;
constexpr size_t WS_WBA   = WS_LAM + 256;
constexpr size_t WS_BETAG = WS_WBA + 131072;
constexpr size_t WS_EGL   = WS_BETAG + 524288;
constexpr size_t WS_WTGLU = WS_EGL + 4096;
constexpr size_t WS_WTBR  = WS_WTGLU + 1048576;
constexpr size_t WS_WTOUT = WS_WTBR + 6291456;
constexpr size_t WS_R1    = WS_WTOUT + 4194304;
constexpr size_t WS_R2    = WS_R1 + 16777216;
constexpr size_t WS_PROJ  = WS_R2 + 16777216;
constexpr size_t WS_DNP   = WS_PROJ + 134217728;
constexpr size_t DNP_SLOT = 73728;
constexpr size_t WS_END   = WS_DNP + 1024 * DNP_SLOT;
constexpr int SL_W = 0, SL_QG = 16384, SL_KGT = 32768, SL_QK = 49152, SL_U = 57344;

constexpr int LDS_BYTES = 147456;

struct Params {
  const float* in[31];
  float* out;
  unsigned char* ws;
  int ph_lo, ph_hi;
  int use_bar, pad;
};
typedef const __attribute__((address_space(4))) Params& PR;
#define NI __device__ __noinline__
extern __shared__ __attribute__((aligned(16))) char smem[];
#define GAS __attribute__((address_space(1)))
DI unsigned char* lws(PR p) { GAS unsigned char* w = (GAS unsigned char*)p.ws; asm volatile("" : "+s"(w)); return (unsigned char*)w; }
DI const float* lin(PR p, int k) { GAS const float* w = (GAS const float*)p.in[k]; asm volatile("" : "+s"(w)); return (const float*)w; }
DI float* lout(PR p) { GAS float* w = (GAS float*)p.out; asm volatile("" : "+s"(w)); return (float*)w; }

DI float bf2f(unsigned short h) { return __uint_as_float(((unsigned)h) << 16); }
DI unsigned pack2(float lo, float hi) { f32x2_t f = {lo, hi}; bf16x2_t v = __builtin_convertvector(f, bf16x2_t); return __builtin_bit_cast(unsigned, v); }
DI unsigned short f2bf(float x) { return (unsigned short)(pack2(x, 0.f) & 0xffffu); }
DI float lo_f(unsigned u) { return __uint_as_float(u << 16); }
DI float hi_f(unsigned u) { return __uint_as_float(u & 0xffff0000u); }
DI float sigmoidf_(float x) { return 1.f / (1.f + __expf(-x)); }
DI float siluf_(float x) { return x / (1.f + __expf(-x)); }
DI float wave_sum(float v) {
#pragma unroll
  for (int o = 32; o >= 1; o >>= 1) v += __shfl_xor(v, o);
  return v;
}
DI bf16x8 mk8(unsigned a, unsigned b, unsigned c, unsigned d) { u32x4 u = {a, b, c, d}; return __builtin_bit_cast(bf16x8, u); }

DI int ltid() {
  const int w = __builtin_amdgcn_readfirstlane((int)(threadIdx.x >> 6));
  int t = (w << 6) | (int)__builtin_amdgcn_mbcnt_hi(~0u, __builtin_amdgcn_mbcnt_lo(~0u, 0u));
  asm volatile("" : "+v"(t));
  return t;
}
#define XB_TMO      128
#define XB_XCNT(j)  (256  + 64 * (j))
#define XB_XSUB(j)  (1280 + 64 * (j))
#define XB_XGEN(j)  (2304 + 64 * (j))
#define XB_TOP      3328
#define XB_TOPGEN   3392
#define XCD_BAR_WORDS 3456
#define XB_SPIN_CAP (1u << 22)
DI unsigned xb_ld(unsigned* p)              { return __hip_atomic_load(p, __ATOMIC_RELAXED, __HIP_MEMORY_SCOPE_AGENT); }
DI unsigned xb_add(unsigned* p, unsigned v) { return __hip_atomic_fetch_add(p, v, __ATOMIC_RELAXED, __HIP_MEMORY_SCOPE_AGENT); }
DI unsigned xb_xcc_id() { return (unsigned)__builtin_amdgcn_s_getreg((3 << 11) | 20) & 0xFu; }
#define XB_SPIN(cond, bar) do { unsigned _sp = 0; while (cond) { __builtin_amdgcn_s_sleep(1); \
    if ((++_sp & 255u) == 0u) { if (xb_ld(&(bar)[XB_TMO])) break; if (_sp > XB_SPIN_CAP) { atomicAdd(&(bar)[XB_TMO], 1u); break; } } } } while (0)
struct XcdBarrier { unsigned* bar; unsigned x; volatile LAS unsigned* st; };
DI XcdBarrier xcd_barrier_post(unsigned* bar, volatile LAS unsigned* st) {
  XcdBarrier b; b.bar = bar; b.x = xb_xcc_id(); b.st = st;
  if (ltid() == 0) (void)xb_add(&bar[XB_XCNT(b.x)], 1u);
  return b;
}
DI void xcd_barrier_complete(unsigned* bar, unsigned x, unsigned& nloc, unsigned& nx) {
  const unsigned G = gridDim.x;
  unsigned sum, cnt, mine, sp = 0u;
  for (;;) {
    sum = 0u; cnt = 0u; mine = 0u;
#pragma unroll
    for (unsigned j = 0; j < 16; ++j) { const unsigned c = xb_ld(&bar[XB_XCNT(j)]); sum += c; cnt += (c > 0u) ? 1u : 0u; mine = (j == x) ? c : mine; }
    if (sum == G) break;
    __builtin_amdgcn_s_sleep(1);
    if ((++sp & 255u) == 0u) { if (xb_ld(&bar[XB_TMO])) break; if (sp > XB_SPIN_CAP) { atomicAdd(&bar[XB_TMO], 1u); break; } }
  }
  nloc = mine > 0u ? mine : 1u; nx = cnt > 0u ? cnt : 1u;
}
DI void xcd_barrier(const XcdBarrier& b) {
  asm volatile("s_waitcnt vmcnt(0)" ::: "memory");
  __syncthreads();
  if (ltid() == 0) {
    unsigned* bar = b.bar;
    __builtin_amdgcn_s_waitcnt(0);
    unsigned nloc = b.st[0], nx = b.st[1];
    if (nloc == 0u) { xcd_barrier_complete(bar, b.x, nloc, nx); b.st[0] = nloc; b.st[1] = nx; }
    const unsigned old = xb_add(&bar[XB_XSUB(b.x)], 1u);
    const unsigned gen = old / nloc;
    if (old + 1u == (gen + 1u) * nloc) {
      __builtin_amdgcn_fence(__ATOMIC_RELEASE, "agent");
      asm volatile("s_waitcnt vmcnt(0)" ::: "memory");
      const unsigned og = xb_add(&bar[XB_TOP], 1u);
      const unsigned tg = og / nx;
      if (og + 1u == (tg + 1u) * nx) xb_add(&bar[XB_TOPGEN], 1u);
      else XB_SPIN(xb_ld(&bar[XB_TOPGEN]) == tg, bar);
      __builtin_amdgcn_fence(__ATOMIC_ACQUIRE, "agent");
      xb_add(&bar[XB_XGEN(b.x)], 1u);
      asm volatile("s_waitcnt vmcnt(0)" ::: "memory");
    } else {
      XB_SPIN(xb_ld(&bar[XB_XGEN(b.x)]) == gen, bar);
      __builtin_amdgcn_fence(__ATOMIC_ACQUIRE, "agent");
      asm volatile("s_waitcnt vmcnt(0)" ::: "memory");
    }
  }
  __syncthreads();
}

#ifndef TIMEREG
#define TIMEREG 0
#endif
__device__ unsigned long long g_sw_acc;
#define SWW_BEGIN(id) unsigned long long _sww_t0_##id = 0; if constexpr (TIMEREG == (id)) { __builtin_amdgcn_sched_barrier(0); _sww_t0_##id = __builtin_amdgcn_s_memrealtime(); __builtin_amdgcn_sched_barrier(0); }
#define SWW_END(id) if constexpr (TIMEREG == (id)) { __builtin_amdgcn_sched_barrier(0); const unsigned long long _d = __builtin_amdgcn_s_memrealtime() - _sww_t0_##id; __builtin_amdgcn_sched_barrier(0); if (blockIdx.x == 0 && threadIdx.x == 0) g_sw_acc += _d; }

DI int queue_pull(unsigned* q, volatile LAS int* sh) {
  __syncthreads();
  if (ltid() == 0) *sh = (int)xb_add(q, 1u);
  __syncthreads();
  return *sh;
}

DI int vzero() { int z = 0; asm volatile("" : "+v"(z)); return z; }

#ifndef PROJ_ROWMAJOR
DI size_t pjx(int row, int col) { return ((size_t)(col >> 9) * MROWS + row) * 512 + (col & 511); }
constexpr int PJ_LD = 512;
#else
DI size_t pjx(int row, int col) { return (size_t)row * NP + col; }
constexpr int PJ_LD = NP;
#endif

DI int seq_row0(int s) { return s < 16 ? s * 256 : 4096 + (s - 16) * 1024; }
DI int seq_len(int s) { return s < 16 ? 256 : 1024; }
DI int row_cond(int r) { return r < 4096 ? 0 : 1 + ((r - 4096) >> 10); }
DI const float* x_in_row(PR p, int l, int r) {
  if (l == 0) return r < 4096 ? lin(p, 0) + (size_t)r * DM : lin(p, 1) + (size_t)(r - 4096) * DM;
  return lout(p) + O_Y + (size_t)r * DM;
}

DI void ph0_adaln(PR p, int a, char* lds) {
  const int l = a / 96, cb = a % 96, tid = ltid();
  float* scond = (float*)lds;
  float* red = scond + 5 * 1024;
  for (int i = tid; i < 5 * 1024; i += NT) {
    const int ci = i >> 10, k = i & 1023;
    const float c = ci == 0 ? lin(p, 8)[k] : lin(p, 7)[(ci - 1) * 1024 + k];
    scond[i] = c / (1.f + expf(-c));
  }
  __syncthreads();
  const int tx = tid & 31, ty = tid >> 5;
  const float* w = lin(p, 10) + (size_t)l * 1024 * 3072 + cb * 32 + tx;
  float acc[5] = {0.f, 0.f, 0.f, 0.f, 0.f};
  for (int kk = 0; kk < 64; ++kk) {
    const int k = ty * 64 + kk;
    const float wv = w[(size_t)k * 3072];
#pragma unroll
    for (int ci = 0; ci < 5; ++ci) acc[ci] += scond[ci * 1024 + k] * wv;
  }
#pragma unroll
  for (int ci = 0; ci < 5; ++ci) red[(ty * 5 + ci) * 32 + tx] = acc[ci];
  __syncthreads();
  if (tid < 160) {
    const int ci = tid >> 5, x = tid & 31;
    float s = 0.f;
    for (int y = 0; y < 16; ++y) s += red[(y * 5 + ci) * 32 + x];
    const int col = cb * 32 + x;
    float* mod = (float*)(lws(p) + WS_MOD);
    mod[(l * 5 + ci) * 3072 + col] = s + lin(p, 11)[l * 3072 + col];
  }
  __syncthreads();
}

DI void ph0_s5(PR p, int t) {
  const int idx = t * NT + threadIdx.x;
  const int ldg = idx >> 6, pp = idx & 63;
  const float lre = lin(p, 13)[idx], lim = lin(p, 14)[idx], ls = lin(p, 15)[ldg];
  const float step = expf(ls);
  const float mag = expf(lre * step);
  float sn, cs; sincosf(lim * step, &sn, &cs);
  const float ar = mag * cs, ai = mag * sn;
  const float den = lre * lre + lim * lim;
  const float fr = ((ar - 1.f) * lre + ai * lim) / den;
  const float fi = (ai * lre - (ar - 1.f) * lim) / den;
  ((float*)(lws(p) + WS_S5AR))[idx] = ar;
  ((float*)(lws(p) + WS_S5AI))[idx] = ai;
  bf16_t* bb = (bf16_t*)(lws(p) + WS_S5BB) + (size_t)ldg * 128 * 16;
  bf16_t* ct = (bf16_t*)(lws(p) + WS_S5CT) + (size_t)ldg * 16 * 128;
  const float* bre = lin(p, 16) + (size_t)idx * 16;
  const float* bim = lin(p, 17) + (size_t)idx * 16;
#pragma unroll
  for (int i = 0; i < 16; ++i) {
    const float br = bre[i], bi = bim[i];
    bb[pp * 16 + i] = f2bf(fr * br - fi * bi);
    bb[(64 + pp) * 16 + i] = f2bf(fr * bi + fi * br);
    const float cr = lin(p, 18)[((size_t)ldg * 16 + i) * 64 + pp];
    const float cim = lin(p, 19)[((size_t)ldg * 16 + i) * 64 + pp];
    ct[i * 128 + pp] = f2bf(cr);
    ct[i * 128 + 64 + pp] = f2bf(-cim);
  }
}

DI void ph0_misc(PR p) {
  const int tid = threadIdx.x;
  float* rc = (float*)(lws(p) + WS_ROPE);
  for (int i = tid; i < 1024; i += NT) {
    const int pos = i >> 4, f = i & 15;
    const float inv = powf(10000.f, -(float)f / 16.f);
    const float ang = (float)pos * inv;
    float sn, cs; sincosf(ang, &sn, &cs);
    rc[i] = cs; rc[1024 + i] = sn;
  }
  if (tid < 2) {
    const int l = tid;
    const float* dl = lin(p, 22) + l * 256;
    float s0 = 0.f, s1 = 0.f;
    for (int i = 0; i < 64; ++i) { s0 += dl[i] * dl[64 + i]; s1 += dl[128 + i] * dl[192 + i]; }
    const float lam_init = 0.8f - 0.6f * expf(-0.3f * (float)l);
    ((float*)(lws(p) + WS_LAM))[l] = expf(s0) - expf(s1) + lam_init;
  }
  float* wba = (float*)(lws(p) + WS_WBA);
  for (int i = tid; i < 2 * 16 * 1024; i += NT) {
    const int l = i >> 14, j = (i >> 10) & 15, k = i & 1023;
    wba[i] = lin(p, 12)[((size_t)l * 1024 + k) * NIN + 5120 + j];
  }
}

DI void cvt_tile(const float* src, size_t ld_src, bf16_t* dst, size_t ld_dst, char* lds) {
  float* t = (float*)lds;
  const int tid = ltid();
  const int r = tid >> 4, c4 = (tid & 15) * 4;
#pragma unroll
  for (int ps = 0; ps < 2; ++ps) {
    const int k = r + 32 * ps;
    const f32x4 v = *(const f32x4*)(src + (size_t)k * ld_src + c4);
    t[k * 65 + c4 + 0] = v[0]; t[k * 65 + c4 + 1] = v[1]; t[k * 65 + c4 + 2] = v[2]; t[k * 65 + c4 + 3] = v[3];
  }
  __syncthreads();
  const int n = tid >> 3, kc = tid & 7;
  float v[8];
#pragma unroll
  for (int j = 0; j < 8; ++j) v[j] = t[(kc * 8 + j) * 65 + n];
  u32x4 o = {pack2(v[0], v[1]), pack2(v[2], v[3]), pack2(v[4], v[5]), pack2(v[6], v[7])};
  *(u32x4*)(dst + (size_t)n * ld_dst + kc * 8) = o;
  __syncthreads();
}

DI void cvt_win_tile(PR p, int l, int t, char* lds) {
  const int kt = t & 15, nt = t >> 4;
  const int n0 = nt * 64, nsrc = n0 < 5120 ? n0 : n0 + 16;
  cvt_tile(lin(p, 12) + ((size_t)l * 1024 + kt * 64) * NIN + nsrc, NIN,
           (bf16_t*)(lws(p) + WS_R1) + (size_t)n0 * 1024 + kt * 64, 1024, lds);
}
DI void cvt_other_tile(PR p, int t, char* lds) {
  if (t < 128) {
    const int l = t >> 6, q = t & 63, kt = q & 7, nt = q >> 3;
    cvt_tile(lin(p, 21) + ((size_t)l * 512 + kt * 64) * 512 + nt * 64, 512,
             (bf16_t*)(lws(p) + WS_WTGLU) + ((size_t)l * 512 + nt * 64) * 512 + kt * 64, 512, lds);
  } else if (t < 896) {
    const int u = t - 128, ln = u >> 7, q = u & 127, kt = q & 7, nt = q >> 3;
    cvt_tile(lin(p, 28) + ((size_t)ln * 512 + kt * 64) * 1024 + nt * 64, 1024,
             (bf16_t*)(lws(p) + WS_WTBR) + ((size_t)ln * 1024 + nt * 64) * 512 + kt * 64, 512, lds);
  } else {
    const int u = t - 896, l = u >> 8, q = u & 255, kt = q & 15, nt = q >> 4;
    cvt_tile(lin(p, 29) + ((size_t)l * 1024 + kt * 64) * 1024 + nt * 64, 1024,
             (bf16_t*)(lws(p) + WS_WTOUT) + ((size_t)l * 1024 + nt * 64) * 1024 + kt * 64, 1024, lds);
  }
}

DI void ph1_norm_rows(PR p, int l, int rb) {
  const int lane = ltid() & 63;
  const int r0 = rb * 2, ci = row_cond(r0);
  const float* mod = (const float*)(lws(p) + WS_MOD) + (size_t)(l * 5 + ci) * 3072;
  const float* ng = lin(p, 9) + l * 1024;
  const float* wba = (const float*)(lws(p) + WS_WBA) + (size_t)l * 16 * 1024;
  bf16_t* hn = (bf16_t*)(lws(p) + WS_R2);
  float h[2][16];
#pragma unroll
  for (int ri = 0; ri < 2; ++ri) {
    const float* x = x_in_row(p, l, r0 + ri);
    float ss = 0.f;
#pragma unroll
    for (int i = 0; i < 4; ++i) {
      const f32x4 v = *(const f32x4*)(x + (i * 64 + lane) * 4);
#pragma unroll
      for (int e = 0; e < 4; ++e) { h[ri][i * 4 + e] = v[e]; ss += v[e] * v[e]; }
    }
    ss = wave_sum(ss);
    const float rstd = rsqrtf(ss * (1.f / 1024.f) + EPS);
#pragma unroll
    for (int i = 0; i < 4; ++i) {
      const int k = (i * 64 + lane) * 4;
      const f32x4 g = *(const f32x4*)(ng + k);
      const f32x4 sh = *(const f32x4*)(mod + k);
      const f32x4 sc = *(const f32x4*)(mod + 1024 + k);
#pragma unroll
      for (int e = 0; e < 4; ++e) h[ri][i * 4 + e] = h[ri][i * 4 + e] * rstd * g[e] * (1.f + sc[e]) + sh[e];
      u32x2 o = {pack2(h[ri][i * 4 + 0], h[ri][i * 4 + 1]), pack2(h[ri][i * 4 + 2], h[ri][i * 4 + 3])};
      *(u32x2*)(hn + (size_t)(r0 + ri) * 1024 + k) = o;
    }
  }
  float pt[32];
#pragma unroll
  for (int j = 0; j < 16; ++j) {
    float a0 = 0.f, a1 = 0.f;
#pragma unroll
    for (int i = 0; i < 4; ++i) {
      const f32x4 w = *(const f32x4*)(wba + j * 1024 + (i * 64 + lane) * 4);
#pragma unroll
      for (int e = 0; e < 4; ++e) { a0 += h[0][i * 4 + e] * w[e]; a1 += h[1][i * 4 + e] * w[e]; }
    }
    pt[j] = a0; pt[16 + j] = a1;
    if ((j & 3) == 3) asm volatile("" ::: "memory");
  }
#define BFLY(n) { const bool up = (lane & (n)) != 0; _Pragma("unroll") for (int i = 0; i < (n); ++i) { \
    const float keep = up ? pt[i + (n)] : pt[i]; const float send = up ? pt[i] : pt[i + (n)]; pt[i] = keep + __shfl_xor(send, (n)); } }
  BFLY(16) BFLY(8) BFLY(4) BFLY(2) BFLY(1)
#undef BFLY
  const float v = pt[0] + __shfl_xor(pt[0], 32);
  if (lane < 32) {
    const int ri = lane >> 4, j = lane & 15;
    float res;
    if (j < 8) res = 1.f / (1.f + __expf(-v));
    else {
      const int jj = j - 8;
      const float xx = v + lin(p, 26)[l * 8 + jj];
      const float sp = xx > 20.f ? xx : __logf(1.f + __expf(xx));
      res = -__expf(lin(p, 25)[l * 8 + jj]) * sp;
    }
    ((float*)(lws(p) + WS_BETAG))[(size_t)(r0 + ri) * 16 + j] = res;
  }
}

constexpr int G_STAGE = 49152;
DI void gemm_gload(int tid, const bf16_t* A, size_t lda, const bf16_t* B, size_t ldb, int k0, u32x4 (&ra)[4], u32x4 (&rb)[2]) {
#pragma unroll
  for (int i = 0; i < 4; ++i) { const int id = tid + NT * i, row = id >> 3, ch = id & 7; ra[i] = *(const u32x4*)(A + (size_t)row * lda + k0 + ch * 8); }
#pragma unroll
  for (int i = 0; i < 2; ++i) { const int id = tid + NT * i, row = id >> 3, ch = id & 7; rb[i] = *(const u32x4*)(B + (size_t)row * ldb + k0 + ch * 8); }
}
DI void gemm_lstore(int tid, char* st, const u32x4 (&ra)[4], const u32x4 (&rb)[2]) {
#pragma unroll
  for (int i = 0; i < 4; ++i) { const int id = tid + NT * i, row = id >> 3, ch = id & 7; *(u32x4*)(st + row * 128 + ((ch ^ ((row >> 1) & 7)) << 4)) = ra[i]; }
#pragma unroll
  for (int i = 0; i < 2; ++i) { const int id = tid + NT * i, row = id >> 3, ch = id & 7; *(u32x4*)(st + 32768 + row * 128 + ((ch ^ ((row >> 1) & 7)) << 4)) = rb[i]; }
}
template <bool TR = false> DI void gemm_compute(const char* st, f32x16 (&acc)[2][2], int wm, int wn, int lane) {
  const int r = lane & 31, h = lane >> 5, sw = (r >> 1) & 7;
#pragma unroll
  for (int s = 0; s < 4; ++s) {
    const int ch = ((2 * s + h) ^ sw) << 4;
    bf16x8 a[2], b[2];
#pragma unroll
    for (int mi = 0; mi < 2; ++mi) a[mi] = *(const bf16x8*)(st + (wm * 64 + mi * 32 + r) * 128 + ch);
#pragma unroll
    for (int ni = 0; ni < 2; ++ni) b[ni] = *(const bf16x8*)(st + 32768 + (wn * 64 + ni * 32 + r) * 128 + ch);
#pragma unroll
    for (int mi = 0; mi < 2; ++mi)
#pragma unroll
      for (int ni = 0; ni < 2; ++ni) acc[mi][ni] = TR ? MFMA32(b[ni], a[mi], acc[mi][ni]) : MFMA32(a[mi], b[ni], acc[mi][ni]);
  }
}
template <bool TR = false> DI void gemm_mainloop(int tid, const bf16_t* A, size_t lda, const bf16_t* B, size_t ldb, int K, f32x16 (&acc)[2][2], char* lds) {
  const int wave = tid >> 6, lane = tid & 63, wm = wave >> 1, wn = wave & 1;
  u32x4 ra[4], rb[2];
  gemm_gload(tid, A, lda, B, ldb, 0, ra, rb);
  gemm_lstore(tid, lds, ra, rb);
  __syncthreads();
  const int KT = K >> 6;
  for (int kt = 0; kt < KT; ++kt) {
    char* cur = lds + (kt & 1) * G_STAGE;
    char* nxt = lds + ((kt + 1) & 1) * G_STAGE;
    if (kt + 1 < KT) gemm_gload(tid, A, lda, B, ldb, (kt + 1) * 64, ra, rb);
    gemm_compute<TR>(cur, acc, wm, wn, lane);
    if (kt + 1 < KT) gemm_lstore(tid, nxt, ra, rb);
    __syncthreads();
  }
}
DI void acc_zero(f32x16 (&acc)[2][2]) {
#pragma unroll
  for (int a = 0; a < 2; ++a)
#pragma unroll
    for (int b = 0; b < 2; ++b)
#pragma unroll
      for (int i = 0; i < 16; ++i) acc[a][b][i] = 0.f;
}
DI void tile_store_bf16(int tid, const f32x16 (&acc)[2][2], bf16_t* dst, size_t ldd, char* lds) {
  const int wave = tid >> 6, lane = tid & 63, wm = wave >> 1, wn = wave & 1;
  const int cl = lane & 31, h = lane >> 5;
#pragma unroll
  for (int mi = 0; mi < 2; ++mi)
#pragma unroll
    for (int ni = 0; ni < 2; ++ni)
#pragma unroll
      for (int i = 0; i < 16; ++i) {
        const int row = wm * 64 + mi * 32 + (i & 3) + 8 * (i >> 2) + 4 * h;
        const int col = wn * 64 + ni * 32 + cl;
        *(bf16_t*)(lds + row * 272 + col * 2) = f2bf(acc[mi][ni][i]);
      }
  __syncthreads();
#pragma unroll
  for (int i = 0; i < 8; ++i) {
    const int id = tid + NT * i, row = id >> 4, ch = id & 15;
    const u32x4 v = *(const u32x4*)(lds + row * 272 + ch * 16);
    *(u32x4*)(dst + (size_t)row * ldd + ch * 8) = v;
  }
  __syncthreads();
}

DI void ph2_inproj_tile(PR p, int l, int t, char* lds) {
  const int tid = ltid();
  const int nt = t & 63, mt = t >> 6;
  const int m0 = mt * 256, n0 = nt * 128;
  const bf16_t* A = (const bf16_t*)(lws(p) + WS_R2) + (size_t)m0 * 1024;
  const bf16_t* B = (const bf16_t*)(lws(p) + WS_R1) + (size_t)n0 * 1024;
  f32x16 acc[2][2];
  acc_zero(acc);
  gemm_mainloop(tid, A, 1024, B, 1024, 1024, acc, lds);
  if (m0 < 4096 && n0 >= C_KB && n0 < C_ZB) {
    const int wave = tid >> 6, lane = tid & 63, wm = wave >> 1, wn = wave & 1;
    float* base = lout(p) + (n0 < C_VB ? O_CK : O_CV);
    const int cb = (n0 < C_VB ? n0 - C_KB : n0 - C_VB);
#pragma unroll
    for (int mi = 0; mi < 2; ++mi)
#pragma unroll
      for (int ni = 0; ni < 2; ++ni)
#pragma unroll
        for (int i = 0; i < 16; ++i) {
          const int row = m0 + wm * 64 + mi * 32 + (i & 3) + 8 * (i >> 2) + 4 * (lane >> 5);
          const int col = cb + wn * 64 + ni * 32 + (lane & 31);
          const int b = row >> 8, tt = row & 255;
          base[((size_t)(b * 2 + l) * 256 + tt) * 512 + col] = acc[mi][ni][i];
        }
  }
  tile_store_bf16(tid, acc, (bf16_t*)(lws(p) + WS_PROJ) + (size_t)m0 * NP + n0, NP, lds);
}

DI void ph6_merge_tile(PR p, int l, int t, char* lds) {
  const int tid = ltid();
  const int nt = t & 7, mt = t >> 3;
  const int m0 = mt * 256, n0 = nt * 128;
  const int wave = tid >> 6, lane = tid & 63, wm = wave >> 1, wn = wave & 1, r = lane & 31, h = lane >> 5;
  const bf16_t* proj = (const bf16_t*)(lws(p) + WS_PROJ);
  unsigned tot[2][2][8];
#pragma unroll
  for (int a = 0; a < 2; ++a)
#pragma unroll
    for (int b = 0; b < 2; ++b)
#pragma unroll
      for (int i = 0; i < 8; ++i) tot[a][b][i] = 0u;
#pragma unroll 1
  for (int n = 0; n < 3; ++n) {
    const int acol = n == 0 ? C_UA : (n == 1 ? C_QB : C_QC);
    const bf16_t* A = proj + pjx(m0, acol);
    const bf16_t* B = (const bf16_t*)(lws(p) + WS_WTBR) + ((size_t)(l * 3 + n) * 1024 + n0) * 512;
    u32x2 gt[2][2][4];
#pragma unroll
    for (int mi = 0; mi < 2; ++mi)
#pragma unroll
      for (int ni = 0; ni < 2; ++ni)
#pragma unroll
        for (int g4 = 0; g4 < 4; ++g4)
          gt[mi][ni][g4] = *(const u32x2*)(proj + pjx(m0 + wm * 64 + mi * 32 + r, C_GT + n * 1024 + n0 + wn * 64 + ni * 32 + 8 * g4 + 4 * h));
    f32x16 acc[2][2];
    acc_zero(acc);
    gemm_mainloop<true>(tid, A, PJ_LD, B, 512, 512, acc, lds);
#pragma unroll
    for (int mi = 0; mi < 2; ++mi)
#pragma unroll
      for (int ni = 0; ni < 2; ++ni)
#pragma unroll
        for (int g4 = 0; g4 < 4; ++g4) {
          const u32x2 g = gt[mi][ni][g4];
          const unsigned o0 = tot[mi][ni][2 * g4], o1 = tot[mi][ni][2 * g4 + 1];
          tot[mi][ni][2 * g4]     = pack2(lo_f(o0) + sigmoidf_(lo_f(g[0])) * acc[mi][ni][4 * g4 + 0], hi_f(o0) + sigmoidf_(hi_f(g[0])) * acc[mi][ni][4 * g4 + 1]);
          tot[mi][ni][2 * g4 + 1] = pack2(lo_f(o1) + sigmoidf_(lo_f(g[1])) * acc[mi][ni][4 * g4 + 2], hi_f(o1) + sigmoidf_(hi_f(g[1])) * acc[mi][ni][4 * g4 + 3]);
        }
  }
  bf16_t* dst = (bf16_t*)(lws(p) + WS_R2) + (size_t)m0 * 1024 + n0;
#pragma unroll
  for (int mi = 0; mi < 2; ++mi)
#pragma unroll
    for (int ni = 0; ni < 2; ++ni)
#pragma unroll
      for (int g4 = 0; g4 < 4; ++g4) {
        const int row = wm * 64 + mi * 32 + r, col = wn * 64 + ni * 32 + 8 * g4 + 4 * h;
        const u32x2 v = {tot[mi][ni][2 * g4], tot[mi][ni][2 * g4 + 1]};
        *(u32x2*)(lds + row * 272 + col * 2) = v;
      }
  __syncthreads();
#pragma unroll
  for (int i = 0; i < 8; ++i) {
    const int id = tid + NT * i, row = id >> 4, ch = id & 15;
    const u32x4 v = *(const u32x4*)(lds + row * 272 + ch * 16);
    *(u32x4*)(dst + (size_t)row * 1024 + ch * 8) = v;
  }
  __syncthreads();
}

DI void ph7_out_tile(PR p, int l, int t, char* lds) {
  const int tid = ltid();
  const int nt = t & 7, mt = t >> 3;
  const int m0 = mt * 256, n0 = nt * 128;
  const int wave = tid >> 6, lane = tid & 63, wm = wave >> 1, wn = wave & 1;
  const bf16_t* A = (const bf16_t*)(lws(p) + WS_R2) + (size_t)m0 * 1024;
  const bf16_t* B = (const bf16_t*)(lws(p) + WS_WTOUT) + ((size_t)l * 1024 + n0) * 1024;
  f32x16 acc[2][2];
  acc_zero(acc);
  gemm_mainloop(tid, A, 1024, B, 1024, 1024, acc, lds);
  float* ct = (float*)lds;
#pragma unroll
  for (int mi = 0; mi < 2; ++mi)
#pragma unroll
    for (int ni = 0; ni < 2; ++ni)
#pragma unroll
      for (int i = 0; i < 16; ++i) {
        const int row = wm * 64 + mi * 32 + (i & 3) + 8 * (i >> 2) + 4 * (lane >> 5);
        const int col = wn * 64 + ni * 32 + (lane & 31);
        ct[row * 132 + col] = acc[mi][ni][i];
      }
  __syncthreads();
  const float* mod = (const float*)(lws(p) + WS_MOD) + (size_t)l * 5 * 3072;
#pragma unroll 4
  for (int i = 0; i < 16; ++i) {
    const int id = tid + NT * i, row = id >> 5, c4 = (id & 31) * 4;
    const int grow = m0 + row, gcol = n0 + c4;
    const f32x4 y = *(const f32x4*)(ct + row * 132 + c4);
    const f32x4 gate = *(const f32x4*)(mod + row_cond(grow) * 3072 + 2048 + gcol);
    const f32x4 xo = *(const f32x4*)(x_in_row(p, l, grow) + gcol);
    f32x4 o;
#pragma unroll
    for (int e = 0; e < 4; ++e) o[e] = xo[e] + gate[e] * y[e];
    *(f32x4*)(lout(p) + O_Y + (size_t)grow * DM + gcol) = o;
  }
  __syncthreads();
}

DI void ph_final_row(PR p, int r) {
  const int lane = ltid() & 63;
  float* x = lout(p) + O_Y + (size_t)r * DM;
  f32x4 v[4];
  float ss = 0.f;
#pragma unroll
  for (int i = 0; i < 4; ++i) { v[i] = *(const f32x4*)(x + (i * 64 + lane) * 4); ss += v[i][0] * v[i][0] + v[i][1] * v[i][1] + v[i][2] * v[i][2] + v[i][3] * v[i][3]; }
  ss = wave_sum(ss);
  const float rstd = rsqrtf(ss * (1.f / 1024.f) + EPS);
#pragma unroll
  for (int i = 0; i < 4; ++i) {
    const f32x4 g = *(const f32x4*)(lin(p, 30) + (i * 64 + lane) * 4);
    f32x4 o;
#pragma unroll
    for (int e = 0; e < 4; ++e) o[e] = v[i][e] * rstd * g[e];
    *(f32x4*)(x + (i * 64 + lane) * 4) = o;
  }
}

namespace pg8 {
#define PG8_LAS __attribute__((address_space(3)))
typedef unsigned short bf16_t;
typedef short bf16x8 __attribute__((ext_vector_type(8)));
typedef float f32x4 __attribute__((ext_vector_type(4)));
typedef unsigned u32x4 __attribute__((ext_vector_type(4)));
constexpr int BM = 256, BK = 64, HALF = 128, HTB = HALF * BK * 2  , STAGE_BYTES = 8 * HTB, NXCD = 8, WGM = 8;

__host__ __device__ __forceinline__ int lds_byte(int r, int c) { const int st = (r >> 4) * 2 + (c >> 5), rr = r & 15, cc = c & 31, ob = rr * 64 + cc * 2; return st * 1024 + (ob ^ (((ob >> 9) & 1) << 5)); }
__host__ __device__ __forceinline__ void stage_rc(int b, int& R, int& C) { const int st = b / 1024, sb = b % 1024, swz = sb ^ (((sb >> 9) & 1) << 5); R = (st >> 1) * 16 + swz / 64; C = (st & 1) * 32 + (swz % 64) / 2; }
__host__ __device__ __forceinline__ int perm32(int rho) { const int n = rho >> 4, i = rho & 15; return 8 * (i >> 2) + 4 * n + (i & 3); }

struct Unit { int pm, pn, grp; };
struct Gemm { const bf16_t* A; const bf16_t* Bt; int M, N, K, lda, ldb; };

struct StaticOrder {
    int nM, nN, nwg, G, c;
    __host__ __device__ void init(int M, int N, int G_, int c_) { nM = M / BM; nN = N / BM; nwg = nM * nN; G = G_; c = c_; }
    __host__ __device__ bool next(int i, Unit& u) const {
        const long L = (long)i * G + c; if (L >= nwg) return false;
        int wgid = (int)L; { const int q = nwg / NXCD, r = nwg % NXCD, xcd = wgid % NXCD, off = wgid / NXCD; wgid = (xcd < r ? xcd * (q + 1) : r * (q + 1) + (xcd - r) * q) + off; }
        const int nig = WGM * nN, gid = wgid / nig, fm = gid * WGM, gsz = (nM - fm) < WGM ? (nM - fm) : WGM;
        u.pm = fm + ((wgid % nig) % gsz); u.pn = (wgid % nig) / gsz; u.grp = 0; return true;
    }
    __device__ __forceinline__ void a_ready(const Unit&) const {}
    __device__ __forceinline__ void done(const Unit&) const {}
    __device__ __forceinline__ const char* a_base(const Gemm& g, const Unit& u, size_t tstepA) const { return (const char*)g.A + (size_t)u.pm * tstepA; }
    __device__ __forceinline__ const char* b_base(const Gemm& g, const Unit& u, size_t tstepB) const { return (const char*)g.Bt + (size_t)u.pn * tstepB; }
};

__device__ __forceinline__ unsigned cvt_pk_bf16(float lo, float hi) { unsigned r; asm volatile("v_cvt_pk_bf16_f32 %0, %1, %2" : "=v"(r) : "v"(lo), "v"(hi)); return r; }

template <class Epi, class Sched, bool STAMP = false>
__device__ __forceinline__ void gemm_phase(PG8_LAS unsigned char* lds, const Gemm g, const Sched& S, const Epi& E, unsigned long long* stamps) {
    const int tid = ltid(), wid = __builtin_amdgcn_readfirstlane(tid >> 6), lane = tid & 63, wr = wid >> 2, wc = wid & 3, fr = lane & 15, fq = lane >> 4;
    const int K = g.K, nt = K / BK;
    int ts_lo = 0, ts_hi = 0, nts = 0; const unsigned long long rt_entry = STAMP ? (unsigned long long)wall_clock64() : 0ull;
#define PG8_STAMP() do { if (STAMP && wid == 0 && nts < 64) { const unsigned long long _c = (unsigned long long)clock64(); \
        ts_lo = (lane == nts) ? (int)(unsigned)_c : ts_lo; ts_hi = (lane == nts) ? (int)(unsigned)(_c >> 32) : ts_hi; ++nts; } } while (0)
    PG8_STAMP();
    unsigned voffA[2], voffB[2];
#pragma unroll
    for (int i = 0; i < 2; ++i) { int R, C; stage_rc(tid * 16 + i * 8192, R, C); const int Rb = Epi::PERM ? ((R & ~31) + perm32(R & 31)) : R;
        voffA[i] = (unsigned)(R * g.lda + C) * 2u; voffB[i] = (unsigned)(Rb * g.ldb + C) * 2u; }
    const size_t kstep = (size_t)(BK * 2);
    const size_t hstepA = (size_t)HALF * g.lda * 2, hstepB = (size_t)HALF * g.ldb * 2;
    const size_t tstepA = 2 * hstepA, tstepB = 2 * hstepB;
    const unsigned ldsw = (unsigned)wid * 1024u;
    const int aoff = lds_byte(wr * 64 + fr, fq * 8), boff = lds_byte(wc * 32 + fr, fq * 8);
#define PG8_SA(b, h) (((b) * 2 + (h)) * HTB)
#define PG8_SB(b, h) ((4 + (b) * 2 + (h)) * HTB)
#define PG8_STAGE(bufoff, gbase, voff) do { _Pragma("unroll") for (int _i = 0; _i < 2; ++_i) \
        __builtin_amdgcn_global_load_lds((const unsigned*)((const char*)(gbase) + (voff)[_i]), (PG8_LAS unsigned*)(lds + (bufoff) + ldsw + _i * 8192), 16, 0, 0); } while (0)
#define PG8_LDA(dst, b, h) do { _Pragma("unroll") for (int m = 0; m < 4; ++m) _Pragma("unroll") for (int k = 0; k < 2; ++k) dst[m][k] = *(const PG8_LAS bf16x8*)(lds + PG8_SA(b, h) + aoff + m * 2048 + k * 1024); } while (0)
#define PG8_LDB(dst, b, h) do { _Pragma("unroll") for (int n = 0; n < 2; ++n) _Pragma("unroll") for (int k = 0; k < 2; ++k) dst[n][k] = *(const PG8_LAS bf16x8*)(lds + PG8_SB(b, h) + boff + n * 2048 + k * 1024); } while (0)
#define PG8_MMA(ai, bj, At, Bt) do { __builtin_amdgcn_s_setprio(1); _Pragma("unroll") for (int m = 0; m < 4; ++m) _Pragma("unroll") for (int n = 0; n < 2; ++n) _Pragma("unroll") for (int k = 0; k < 2; ++k) \
        acc[ai][bj][m][n] = __builtin_amdgcn_mfma_f32_16x16x32_bf16(Bt[n][k], At[m][k], acc[ai][bj][m][n], 0, 0, 0); __builtin_amdgcn_s_setprio(0); } while (0)
#define PG8_WAIT_V(n) asm volatile("s_waitcnt vmcnt(" #n ")" ::: "memory")
#define PG8_WAIT_L(n) asm volatile("s_waitcnt lgkmcnt(" #n ")" ::: "memory")
#define PG8_BAR __builtin_amdgcn_s_barrier()
#define PG8_SCHED __builtin_amdgcn_sched_barrier(0)
    Unit cur, nxt; int ui = 0;
    if (!S.next(0, cur)) return;
    f32x4 acc[2][2][4][2];
#pragma unroll
    for (int a = 0; a < 2; ++a)
#pragma unroll
        for (int b = 0; b < 2; ++b)
#pragma unroll
            for (int m = 0; m < 4; ++m)
#pragma unroll
                for (int n = 0; n < 2; ++n) acc[a][b][m][n] = (f32x4){0.f, 0.f, 0.f, 0.f};
    bf16x8 At[4][2], B0[2][2], B1[2][2];
    const char* cA = S.a_base(g, cur, tstepA); const char* cB = S.b_base(g, cur, tstepB);
    S.a_ready(cur);
    PG8_STAGE(PG8_SB(0, 0), cB, voffB); PG8_STAGE(PG8_SA(0, 0), cA, voffA); PG8_STAGE(PG8_SB(0, 1), cB + hstepB, voffB); PG8_STAGE(PG8_SA(0, 1), cA + hstepA, voffA);
    if (wr == 1) PG8_BAR;
    PG8_WAIT_V(4); PG8_BAR;
    PG8_STAGE(PG8_SB(1, 0), cB + kstep, voffB); PG8_STAGE(PG8_SA(1, 0), cA + kstep, voffA); PG8_STAGE(PG8_SB(1, 1), cB + hstepB + kstep, voffB);
    PG8_WAIT_V(6); PG8_BAR;
    PG8_STAMP();
    for (;;) {
        const bool has_next = S.next(ui + 1, nxt);
        const char* nA = has_next ? S.a_base(g, nxt, tstepA) : cA; const char* nB = has_next ? S.b_base(g, nxt, tstepB) : cB;
        for (int t = 0; t < nt; t += 2) {
            const bool last = (t == nt - 2);
            const char* a1 = cA + (size_t)(t + 1) * kstep;
            const char* a2 = last ? nA : cA + (size_t)(t + 2) * kstep; const char* b2 = last ? nB : cB + (size_t)(t + 2) * kstep;
            const char* a3 = a2 + kstep; const char* b3 = b2 + kstep;
            if (last && has_next) S.a_ready(nxt);
            PG8_LDB(B0, 0, 0); PG8_SCHED; PG8_LDA(At, 0, 0); PG8_STAGE(PG8_SA(1, 1), a1 + hstepA, voffA);
            PG8_WAIT_L(8); PG8_BAR; PG8_WAIT_L(0); PG8_MMA(0, 0, At, B0); PG8_BAR; PG8_SCHED;
            PG8_LDB(B1, 0, 1); PG8_STAGE(PG8_SB(0, 0), b2, voffB);
            PG8_BAR; PG8_WAIT_L(0); PG8_MMA(0, 1, At, B1); PG8_BAR;
            PG8_LDA(At, 0, 1); PG8_STAGE(PG8_SA(0, 0), a2, voffA);
            PG8_BAR; PG8_WAIT_L(0); PG8_MMA(1, 0, At, B0); PG8_BAR; PG8_SCHED;
            PG8_STAGE(PG8_SB(0, 1), b2 + hstepB, voffB);
            PG8_WAIT_V(6); PG8_BAR; PG8_MMA(1, 1, At, B1); PG8_BAR;
            PG8_LDB(B0, 1, 0); PG8_SCHED; PG8_LDA(At, 1, 0); PG8_STAGE(PG8_SA(0, 1), a2 + hstepA, voffA);
            PG8_WAIT_L(8); PG8_BAR; PG8_WAIT_L(0); PG8_MMA(0, 0, At, B0); PG8_BAR; PG8_SCHED;
            PG8_LDB(B1, 1, 1); PG8_STAGE(PG8_SB(1, 0), b3, voffB);
            PG8_BAR; PG8_WAIT_L(0); PG8_MMA(0, 1, At, B1); PG8_BAR;
            PG8_LDA(At, 1, 1); PG8_STAGE(PG8_SA(1, 0), a3, voffA);
            PG8_BAR; PG8_WAIT_L(0); PG8_MMA(1, 0, At, B0); PG8_BAR; PG8_SCHED;
            PG8_STAGE(PG8_SB(1, 1), b3 + hstepB, voffB);
            PG8_WAIT_V(6); PG8_BAR; PG8_MMA(1, 1, At, B1); PG8_BAR;
        }
        PG8_STAMP();
        if constexpr (!Epi::AFTER_DRAIN) { E(acc, cur, wr, wc, fr, fq); S.done(cur); }
        PG8_STAMP();
        if (!has_next) break;
#pragma unroll
        for (int a = 0; a < 2; ++a)
#pragma unroll
            for (int b = 0; b < 2; ++b)
#pragma unroll
                for (int m = 0; m < 4; ++m)
#pragma unroll
                    for (int n = 0; n < 2; ++n) acc[a][b][m][n] = (f32x4){0.f, 0.f, 0.f, 0.f};
        cur = nxt; cA = nA; cB = nB; ++ui;
    }
    PG8_WAIT_V(0);
    if (wr == 0) PG8_BAR;
    PG8_BAR;
    if constexpr (Epi::AFTER_DRAIN) { E.fused(acc, cur, wr, wc, fr, fq, lds, wid, lane); S.done(cur); }
    PG8_STAMP();
    if (STAMP && wid == 0) { stamps[lane] = lane < nts ? (((unsigned long long)(unsigned)ts_hi << 32) | (unsigned)ts_lo) : 0ull;
        if (lane == 62) stamps[62] = rt_entry; if (lane == 63) stamps[63] = (unsigned long long)wall_clock64(); }
#undef PG8_STAMP
#undef PG8_SA
#undef PG8_SB
#undef PG8_STAGE
#undef PG8_LDA
#undef PG8_LDB
#undef PG8_MMA
#undef PG8_WAIT_V
#undef PG8_WAIT_L
#undef PG8_BAR
#undef PG8_SCHED
}
}

struct EpiInproj {
  static constexpr bool PERM = true, AFTER_DRAIN = false;
  bf16_t* proj; float* out; int l;
  __device__ __forceinline__ void operator()(const pg8::f32x4 (&acc)[2][2][4][2], const pg8::Unit& u, int wr, int wc, int fr, int fq) const {
    int row0 = u.pm * 256 + wr * 64 + fr, col0 = u.pn * 256 + wc * 32 + 8 * fq;
    asm volatile("" : "+v"(row0), "+v"(col0));
    const bool cache = (u.pm < 16) && (u.pn >= 6) && (u.pn < 10);
    float* cbase = out + (u.pn < 8 ? O_CK : O_CV);
    const int ccol0 = col0 - (u.pn < 8 ? C_KB : C_VB);
#pragma unroll
    for (int ai = 0; ai < 2; ++ai)
#pragma unroll
      for (int m = 0; m < 4; ++m) {
        const int row = row0 + ai * 128 + m * 16;
        bf16_t* rowp = proj + pjx(row, col0);
#pragma unroll
        for (int bj = 0; bj < 2; ++bj) {
          const pg8::f32x4 v0 = acc[ai][bj][m][0], v1 = acc[ai][bj][m][1];
          const u32x4 w = {pack2(v0[0], v0[1]), pack2(v0[2], v0[3]), pack2(v1[0], v1[1]), pack2(v1[2], v1[3])};
          *(u32x4*)(rowp + bj * 128) = w;
          if (cache) {
            const int b = row >> 8, tt = row & 255;
            float* dst = cbase + ((size_t)(b * 2 + l) * 256 + tt) * 512 + ccol0 + bj * 128;
            *(f32x4*)dst = v0; *(f32x4*)(dst + 4) = v1;
          }
        }
      }
  }
};
DI void run_inproj8(PR p, int l) {
  pg8::Gemm g;
  g.A = (const bf16_t*)(lws(p) + WS_R2); g.Bt = (const bf16_t*)(lws(p) + WS_R1); g.M = MROWS; g.N = NP; g.K = 1024; g.lda = 1024; g.ldb = 1024;
  pg8::StaticOrder S; S.init(MROWS, NP, (int)gridDim.x, (int)blockIdx.x);
  EpiInproj E; E.proj = (bf16_t*)(lws(p) + WS_PROJ); E.out = lout(p); E.l = l;
  pg8::gemm_phase<EpiInproj, pg8::StaticOrder, false>((LAS unsigned char*)smem, g, S, E, nullptr);
}

struct MergeOrder {
  int c;
  const bf16_t* proj; const bf16_t* wbr;
  __device__ __forceinline__ bool next(int i, pg8::Unit& u) const {
    if (c >= 128 || i >= 3) return false;
    u.pm = c >> 2; u.pn = c & 3; u.grp = i; return true;
  }
  __device__ __forceinline__ void a_ready(const pg8::Unit&) const {}
  __device__ __forceinline__ void done(const pg8::Unit&) const {}
  __device__ __forceinline__ const char* a_base(const pg8::Gemm&, const pg8::Unit& u, size_t tstepA) const {
    const int acol = u.grp == 0 ? C_UA : (u.grp == 1 ? C_QB : C_QC);
    return (const char*)(proj + pjx(0, acol)) + (size_t)u.pm * tstepA;
  }
  __device__ __forceinline__ const char* b_base(const pg8::Gemm&, const pg8::Unit& u, size_t tstepB) const {
    return (const char*)(wbr + (size_t)u.grp * 1024 * 512) + (size_t)u.pn * tstepB;
  }
};
struct EpiMerge {
  static constexpr bool PERM = true, AFTER_DRAIN = false;
  const bf16_t* proj; bf16_t* mixed;
  __device__ __forceinline__ void operator()(const pg8::f32x4 (&acc)[2][2][4][2], const pg8::Unit& u, int wr, int wc, int fr, int fq) const {
    int row0 = u.pm * 256 + wr * 64 + fr, col0 = u.pn * 256 + wc * 32 + 8 * fq;
    asm volatile("" : "+v"(row0), "+v"(col0));
#pragma unroll
    for (int ai = 0; ai < 2; ++ai)
#pragma unroll
      for (int m = 0; m < 4; ++m) {
        const int row = row0 + ai * 128 + m * 16;
#pragma unroll
        for (int bj = 0; bj < 2; ++bj) {
          const int col = col0 + bj * 128;
          const u32x4 gg = *(const u32x4*)(proj + pjx(row, C_GT + u.grp * 1024 + col));
          bf16_t* mp = mixed + (size_t)row * 1024 + col;
          u32x4 prev = {0u, 0u, 0u, 0u};
          if (u.grp > 0) {
            const unsigned long long p0 = __hip_atomic_load((const unsigned long long*)mp, __ATOMIC_RELAXED, __HIP_MEMORY_SCOPE_AGENT);
            const unsigned long long p1 = __hip_atomic_load((const unsigned long long*)mp + 1, __ATOMIC_RELAXED, __HIP_MEMORY_SCOPE_AGENT);
            prev = u32x4{(unsigned)p0, (unsigned)(p0 >> 32), (unsigned)p1, (unsigned)(p1 >> 32)};
          }
          const pg8::f32x4 v0 = acc[ai][bj][m][0], v1 = acc[ai][bj][m][1];
          u32x4 w;
          w[0] = pack2(lo_f(prev[0]) + sigmoidf_(lo_f(gg[0])) * v0[0], hi_f(prev[0]) + sigmoidf_(hi_f(gg[0])) * v0[1]);
          w[1] = pack2(lo_f(prev[1]) + sigmoidf_(lo_f(gg[1])) * v0[2], hi_f(prev[1]) + sigmoidf_(hi_f(gg[1])) * v0[3]);
          w[2] = pack2(lo_f(prev[2]) + sigmoidf_(lo_f(gg[2])) * v1[0], hi_f(prev[2]) + sigmoidf_(hi_f(gg[2])) * v1[1]);
          w[3] = pack2(lo_f(prev[3]) + sigmoidf_(lo_f(gg[3])) * v1[2], hi_f(prev[3]) + sigmoidf_(hi_f(gg[3])) * v1[3]);
          *(u32x4*)mp = w;
        }
        asm volatile("" ::: "memory");
      }
  }
};
DI void run_merge8(PR p, int l) {
  pg8::Gemm g;
  g.A = (const bf16_t*)(lws(p) + WS_PROJ); g.Bt = (const bf16_t*)(lws(p) + WS_WTBR) + (size_t)l * 3 * 1024 * 512;
  g.M = MROWS; g.N = 1024; g.K = 512; g.lda = PJ_LD; g.ldb = 512;
  MergeOrder S; S.c = (int)blockIdx.x; S.proj = g.A; S.wbr = g.Bt;
  EpiMerge E; E.proj = g.A; E.mixed = (bf16_t*)(lws(p) + WS_R2);
  pg8::gemm_phase<EpiMerge, MergeOrder, false>((LAS unsigned char*)smem, g, S, E, nullptr);
}
struct OutOrder {
  int c;
  __device__ __forceinline__ bool next(int i, pg8::Unit& u) const { if (c >= 128 || i >= 1) return false; u.pm = c >> 2; u.pn = c & 3; u.grp = 0; return true; }
  __device__ __forceinline__ void a_ready(const pg8::Unit&) const {}
  __device__ __forceinline__ void done(const pg8::Unit&) const {}
  __device__ __forceinline__ const char* a_base(const pg8::Gemm& g, const pg8::Unit& u, size_t tstepA) const { return (const char*)g.A + (size_t)u.pm * tstepA; }
  __device__ __forceinline__ const char* b_base(const pg8::Gemm& g, const pg8::Unit& u, size_t tstepB) const { return (const char*)g.Bt + (size_t)u.pn * tstepB; }
};
struct EpiOut {
  static constexpr bool PERM = false, AFTER_DRAIN = false;
  const float* x0; const float* x1; const float* xo; float* out; const float* mod; int l;
  __device__ __forceinline__ void operator()(const pg8::f32x4 (&acc)[2][2][4][2], const pg8::Unit& u, int wr, int wc, int fr, int fq) const {
    int row0 = u.pm * 256 + wr * 64 + fr, col0 = u.pn * 256 + wc * 32 + 4 * fq;
    asm volatile("" : "+v"(row0), "+v"(col0));
#pragma unroll
    for (int ai = 0; ai < 2; ++ai)
#pragma unroll
      for (int m = 0; m < 4; ++m) {
        const int row = row0 + ai * 128 + m * 16;
        const float* xr = l == 0 ? (row < 4096 ? x0 + (size_t)row * DM : x1 + (size_t)(row - 4096) * DM) : xo + (size_t)row * DM;
        const float* gr = mod + row_cond(row) * 3072 + 2048;
        float* orow_ = out + (size_t)row * DM;
#pragma unroll
        for (int bj = 0; bj < 2; ++bj)
#pragma unroll
          for (int n = 0; n < 2; ++n) {
            const int col = col0 + bj * 128 + n * 16;
            const pg8::f32x4 xv = *(const pg8::f32x4*)(xr + col), gv = *(const pg8::f32x4*)(gr + col);
            *(pg8::f32x4*)(orow_ + col) = xv + gv * acc[ai][bj][m][n];
          }
      }
  }
};
DI void run_out8(PR p, int l) {
  pg8::Gemm g;
  g.A = (const bf16_t*)(lws(p) + WS_R2); g.Bt = (const bf16_t*)(lws(p) + WS_WTOUT) + (size_t)l * 1024 * 1024;
  g.M = MROWS; g.N = 1024; g.K = 1024; g.lda = 1024; g.ldb = 1024;
  OutOrder S; S.c = (int)blockIdx.x;
  EpiOut E; E.x0 = lin(p, 0); E.x1 = lin(p, 1); E.xo = lout(p) + O_Y; E.out = lout(p) + O_Y; E.mod = (const float*)(lws(p) + WS_MOD) + (size_t)l * 5 * 3072; E.l = l;
  pg8::gemm_phase<EpiOut, OutOrder, false>((LAS unsigned char*)smem, g, S, E, nullptr);
}

constexpr int S5_WLDS = 8192 + 4352;
DI void s5_wg_task(PR p, int l, int s, int d, int g, char* lds) {
  const int tid = ltid(), wave = tid >> 6, lane = tid & 63, q = lane >> 4, c = lane & 15;
  const int ldg = (l * 2 + d) * 32 + g;
  const int R0 = seq_row0(s), T = seq_len(s);
  const int seg = T >> 3, nb = seg >> 4, n0 = wave * seg;
  char* wl = lds + wave * S5_WLDS;
  float* BU = (float*)wl;
  char* H = wl + 8192;
  float* xch = (float*)(lds + 8 * S5_WLDS);
  const bf16_t* proj = (const bf16_t*)(lws(p) + WS_PROJ);
  bf16_t* yd = (bf16_t*)(lws(p) + WS_R2) + (size_t)d * MROWS * 512;
  const bf16_t* bb = (const bf16_t*)(lws(p) + WS_S5BB) + (size_t)ldg * 128 * 16;
  const bf16_t* ct = (const bf16_t*)(lws(p) + WS_S5CT) + (size_t)ldg * 16 * 128;
  bf16x8 bfr[8], cfr[4];
  const bf16x8 zero8 = {0, 0, 0, 0, 0, 0, 0, 0};
#pragma unroll
  for (int nt = 0; nt < 8; ++nt) bfr[nt] = q < 2 ? *(const bf16x8*)(bb + (nt * 16 + c) * 16 + 8 * q) : zero8;
#pragma unroll
  for (int ks = 0; ks < 4; ++ks) cfr[ks] = *(const bf16x8*)(ct + c * 128 + 32 * ks + 8 * q);
  const float ar = ((const float*)(lws(p) + WS_S5AR))[ldg * 64 + lane];
  const float ai = ((const float*)(lws(p) + WS_S5AI))[ldg * 64 + lane];
  float h0r = 0.f, h0i = 0.f;
  if (s >= 16) {
    const size_t si = ((((size_t)(s - 16) * 2 + l) * 2 + d) * 32 + g) * 64 + lane;
    h0r = lin(p, 4)[si]; h0i = lin(p, 5)[si];
  }
  auto load_u = [&](int blk) -> bf16x8 {
    const int n = n0 + blk * 16 + c;
    const int t = d ? (T - 1 - n) : n;
    if (q < 2) return *(const bf16x8*)(proj + pjx(R0 + t, C_UA + g * 16 + 8 * q));
    return zero8;
  };
  float hr = 0.f, hi = 0.f;
  auto bu_block = [&](const bf16x8& u) {
#pragma unroll
    for (int nt = 0; nt < 8; ++nt) {
      f32x4 z = {0.f, 0.f, 0.f, 0.f};
      const f32x4 dv = MFMA16(u, bfr[nt], z);
#pragma unroll
      for (int r = 0; r < 4; ++r) BU[(4 * q + r) * 128 + nt * 16 + c] = dv[r];
    }
  };
  {
    bf16x8 ucur = load_u(0);
#pragma unroll 1
    for (int blk = 0; blk < nb; ++blk) {
      bf16x8 unext = zero8;
      if (blk + 1 < nb) unext = load_u(blk + 1);
      bu_block(ucur);
#pragma unroll
      for (int i = 0; i < 16; ++i) {
        const float br = BU[i * 128 + lane], bi = BU[i * 128 + 64 + lane];
        const float nr = ar * hr - ai * hi + br;
        const float ni = ar * hi + ai * hr + bi;
        hr = nr; hi = ni;
      }
      ucur = unext;
    }
  }
  xch[(wave * 2 + 0) * 64 + lane] = hr;
  xch[(wave * 2 + 1) * 64 + lane] = hi;
  float pr = ar, pi = ai;
  const int nsq = T == 1024 ? 7 : 5;
  for (int k = 0; k < nsq; ++k) { const float t0 = pr * pr - pi * pi, t1 = 2.f * pr * pi; pr = t0; pi = t1; }
  __syncthreads();
  hr = h0r; hi = h0i;
  for (int v = 0; v < wave; ++v) {
    const float er = xch[(v * 2 + 0) * 64 + lane], ei = xch[(v * 2 + 1) * 64 + lane];
    const float nr = pr * hr - pi * hi + er, ni = pr * hi + pi * hr + ei;
    hr = nr; hi = ni;
  }
  {
    bf16x8 ucur = load_u(0);
#pragma unroll 1
    for (int blk = 0; blk < nb; ++blk) {
      bf16x8 unext = zero8;
      if (blk + 1 < nb) unext = load_u(blk + 1);
      bu_block(ucur);
#pragma unroll
      for (int i = 0; i < 16; ++i) {
        const float br = BU[i * 128 + lane], bi = BU[i * 128 + 64 + lane];
        const float nr = ar * hr - ai * hi + br;
        const float ni = ar * hi + ai * hr + bi;
        hr = nr; hi = ni;
        *(bf16_t*)(H + i * 272 + lane * 2) = f2bf(hr);
        *(bf16_t*)(H + i * 272 + 128 + lane * 2) = f2bf(hi);
      }
      f32x4 y = {0.f, 0.f, 0.f, 0.f};
#pragma unroll
      for (int ks = 0; ks < 4; ++ks) {
        const bf16x8 a = *(const bf16x8*)(H + c * 272 + (32 * ks + 8 * q) * 2);
        y = MFMA16(a, cfr[ks], y);
      }
#pragma unroll
      for (int r = 0; r < 4; ++r) {
        const int n = n0 + blk * 16 + 4 * q + r;
        const int t = d ? (T - 1 - n) : n;
        yd[(size_t)(R0 + t) * 512 + g * 16 + c] = f2bf(y[r]);
      }
      ucur = unext;
    }
  }
  if (s < 16 && wave == 7) {
    const size_t so = ((((size_t)s * 2 + l) * 2 + d) * 32 + g) * 64 + lane;
    lout(p)[O_SR + so] = hr; lout(p)[O_SI + so] = hi;
  }
  __syncthreads();
}

DI float gelu_tanh(float x) {
  const float z = 0.7978845608028654f * (x + 0.044715f * x * x * x);
  const float e = __expf(2.f * z);
  const float th = 1.f - 2.f / (e + 1.f);
  return 0.5f * x * (1.f + th);
}
DI void glu_tile(PR p, int l, int t, char* lds, bool dry) {
  const int tid = ltid(), wave = tid >> 6, lane = tid & 63;
  const int m0 = t * 32;
  float* Yf = (float*)lds;
  char* Ya = lds + 66048;
  bf16_t* proj = (bf16_t*)(lws(p) + WS_PROJ);
  const bf16_t* yd0 = (const bf16_t*)(lws(p) + WS_R2);
  const bf16_t* yd1 = yd0 + (size_t)MROWS * 512;
  const float* s5d = lin(p, 20) + l * 512;
  {
    const int row = tid >> 4;
#pragma unroll
    for (int i = 0; i < 4; ++i) {
      const int c0 = (tid & 15) * 8 + 128 * i;
      const u32x4 uu = *(const u32x4*)(proj + pjx(m0 + row, C_UA + c0));
      const u32x4 a0 = *(const u32x4*)(yd0 + (size_t)(m0 + row) * 512 + c0);
      const u32x4 a1 = *(const u32x4*)(yd1 + (size_t)(m0 + row) * 512 + c0);
      float y[8];
#pragma unroll
      for (int e = 0; e < 4; ++e) {
        y[2 * e]     = gelu_tanh(s5d[c0 + 2 * e] * lo_f(uu[e]) + lo_f(a0[e]) + lo_f(a1[e]));
        y[2 * e + 1] = gelu_tanh(s5d[c0 + 2 * e + 1] * hi_f(uu[e]) + hi_f(a0[e]) + hi_f(a1[e]));
      }
#pragma unroll
      for (int e = 0; e < 8; ++e) Yf[row * 516 + c0 + e] = y[e];
      const u32x4 o = {pack2(y[0], y[1]), pack2(y[2], y[3]), pack2(y[4], y[5]), pack2(y[6], y[7])};
      const int ch = c0 >> 3;
      *(u32x4*)(Ya + row * 1024 + ((ch ^ (row & 15)) << 4)) = o;
    }
  }
  __syncthreads();
  const int r = lane & 31, h = lane >> 5;
  const bf16_t* W = (const bf16_t*)(lws(p) + WS_WTGLU) + (size_t)l * 512 * 512;
  f32x16 acc[2];
#pragma unroll
  for (int i = 0; i < 16; ++i) { acc[0][i] = 0.f; acc[1][i] = 0.f; }
#pragma unroll 4
  for (int s = 0; s < 32; ++s) {
    const int ch = 2 * s + h;
    const bf16x8 a = *(const bf16x8*)(Ya + r * 1024 + ((ch ^ (r & 15)) << 4));
#pragma unroll
    for (int ni = 0; ni < 2; ++ni) {
      const bf16x8 b = *(const bf16x8*)(W + (size_t)(wave * 64 + ni * 32 + r) * 512 + ch * 8);
      acc[ni] = MFMA32(a, b, acc[ni]);
    }
  }
#pragma unroll
  for (int ni = 0; ni < 2; ++ni)
#pragma unroll
    for (int i = 0; i < 16; ++i) {
      const int row = (i & 3) + 8 * (i >> 2) + 4 * h;
      const int col = wave * 64 + ni * 32 + r;
      const float y = Yf[row * 516 + col];
      const float z = bf2f(proj[pjx(m0 + row, C_ZA + col)]);
      const bf16_t ov = f2bf(y * sigmoidf_(acc[ni][i]) * siluf_(z));
      if (!dry) proj[pjx(m0 + row, C_UA + col)] = ov; else asm volatile("" :: "v"((unsigned)ov));
    }
  __syncthreads();
}

DI void ph5_row(PR p, int l, int r) {
  const int lane = ltid() & 63;
  const int c0 = lane * 8;
  bf16_t* proj = (bf16_t*)(lws(p) + WS_PROJ);
  const bf16_t* o0 = (const bf16_t*)(lws(p) + WS_R1);
  const bf16_t* o1 = o0 + (size_t)MROWS * 512;
  const u32x4 a = *(const u32x4*)(o0 + (size_t)r * 512 + c0);
  const u32x4 b = *(const u32x4*)(o1 + (size_t)r * 512 + c0);
  const u32x4 zz = *(const u32x4*)(proj + pjx(r, C_ZC + c0));
  float o[8];
  float ss = 0.f;
#pragma unroll
  for (int e = 0; e < 4; ++e) {
    o[2 * e] = lo_f(a[e]) + lo_f(b[e]); o[2 * e + 1] = hi_f(a[e]) + hi_f(b[e]);
    ss += o[2 * e] * o[2 * e] + o[2 * e + 1] * o[2 * e + 1];
  }
#pragma unroll
  for (int off = 1; off <= 8; off <<= 1) ss += __shfl_xor(ss, off);
  const float rstd = rsqrtf(ss * (1.f / 128.f) + EPS);
  const float* g = lin(p, 27) + l * 128 + (c0 & 127);
  float v[8];
#pragma unroll
  for (int e = 0; e < 4; ++e) {
    v[2 * e] = o[2 * e] * rstd * g[2 * e] * siluf_(lo_f(zz[e]));
    v[2 * e + 1] = o[2 * e + 1] * rstd * g[2 * e + 1] * siluf_(hi_f(zz[e]));
  }
  const u32x4 w = {pack2(v[0], v[1]), pack2(v[2], v[3]), pack2(v[4], v[5]), pack2(v[6], v[7])};
  *(u32x4*)(proj + pjx(r, C_QC + c0)) = w;
}

constexpr int AT_K = 8192, AT_STAGE = 16384;
DI void att_gload(int tid, PR p, int l, int s, int h, int kt, u32x4& ka, u32x4& kb, u32x4& va, u32x4& vb) {
  const int key = tid >> 4, ch = tid & 15;
  const int j = kt * 32 + key;
  const int R0 = seq_row0(s);
  const bf16_t* proj = (const bf16_t*)(lws(p) + WS_PROJ);
  if (s < 16 || j < 1024) {
    const bf16_t* kr = proj + pjx(R0 + j, C_KB + h * 128);
    ka = *(const u32x4*)(kr + ch * 8);
    kb = *(const u32x4*)(kr + (ch ^ 2) * 8);
    va = *(const u32x4*)(proj + pjx(R0 + j, C_VB + h * 128 + ch * 8));
    vb = va;
  } else {
    const int b = s - 16, jc = j - 1024;
    const float* kc = lin(p, 2) + (((size_t)(b * 2 + l) * 512 + jc) * 4 + h) * 128 + ch * 8;
    const float* vc = lin(p, 3) + (((size_t)(b * 2 + l) * 512 + jc) * 4 + h) * 128 + ch * 8;
    ka = *(const u32x4*)kc; kb = *(const u32x4*)(kc + 4);
    va = *(const u32x4*)vc; vb = *(const u32x4*)(vc + 4);
  }
}
DI void att_lstore(int tid, PR p, int s, int kt, const u32x4& ka, const u32x4& kb, const u32x4& va, const u32x4& vb, char* stage) {
  const int key = tid >> 4, ch = tid & 15;
  const int j = kt * 32 + key;
  u32x4 ko, vo;
  if (s < 16) { ko = ka; vo = va; }
  else if (j < 1024) {
    const int pos = (ch & 4) ? (j & 63) : (j >> 6);
    const float* rc = (const float*)(lws(p) + WS_ROPE) + pos * 16 + (ch & 1) * 8;
    const float sg = (ch & 2) ? 1.f : -1.f;
    float o[8];
#pragma unroll
    for (int e = 0; e < 4; ++e) {
      const float c0 = rc[2 * e], c1 = rc[2 * e + 1], s0 = rc[1024 + 2 * e], s1 = rc[1024 + 2 * e + 1];
      o[2 * e]     = lo_f(ka[e]) * c0 + sg * lo_f(kb[e]) * s0;
      o[2 * e + 1] = hi_f(ka[e]) * c1 + sg * hi_f(kb[e]) * s1;
    }
    ko = u32x4{pack2(o[0], o[1]), pack2(o[2], o[3]), pack2(o[4], o[5]), pack2(o[6], o[7])};
    vo = va;
  } else {
    ko = u32x4{pack2(__uint_as_float(ka[0]), __uint_as_float(ka[1])), pack2(__uint_as_float(ka[2]), __uint_as_float(ka[3])),
               pack2(__uint_as_float(kb[0]), __uint_as_float(kb[1])), pack2(__uint_as_float(kb[2]), __uint_as_float(kb[3]))};
    vo = u32x4{pack2(__uint_as_float(va[0]), __uint_as_float(va[1])), pack2(__uint_as_float(va[2]), __uint_as_float(va[3])),
               pack2(__uint_as_float(vb[0]), __uint_as_float(vb[1])), pack2(__uint_as_float(vb[2]), __uint_as_float(vb[3]))};
  }
  *(u32x4*)(stage + key * 256 + ((ch ^ (key & 15)) << 4)) = ko;
  const int et = ch >> 1, hf = ch & 1;
  *(u32x4*)(stage + AT_K + key * 256 + ((((et ^ (key & 7)) << 1) | hf) << 4)) = vo;
}

DI void att_task(PR p, int l, int s, int h, int qb, char* lds, bool dry) {
  const int tid = ltid(), wave = tid >> 6, lane = tid & 63, q = lane >> 4, c = lane & 15;
  const int R0 = seq_row0(s), T = seq_len(s);
  const int nkeys = s < 16 ? 256 : 1536, nkt = nkeys >> 5;
  bf16_t* proj = (bf16_t*)(lws(p) + WS_PROJ);
  const int tq = qb * 128 + wave * 16 + c;
  const int qrow_i = R0 + tq;
  bf16x8 qf[2][2];
#pragma unroll
  for (int m = 0; m < 2; ++m)
#pragma unroll
    for (int ks = 0; ks < 2; ++ks) {
      const int d0 = 32 * ks + 8 * q;
      const u32x4 own = *(const u32x4*)(proj + pjx(qrow_i, C_QB + h * 128 + m * 64 + d0));
      float o[8];
      if (s >= 16) {
        const u32x4 par = *(const u32x4*)(proj + pjx(qrow_i, C_QB + h * 128 + m * 64 + (d0 ^ 16)));
        const int pos = ks ? (tq & 63) : (tq >> 6);
        const float* rc = (const float*)(lws(p) + WS_ROPE) + pos * 16 + (q & 1) * 8;
        const float sg = (q & 2) ? 1.f : -1.f;
#pragma unroll
        for (int e = 0; e < 4; ++e) {
          o[2 * e]     = lo_f(own[e]) * rc[2 * e] + sg * lo_f(par[e]) * rc[1024 + 2 * e];
          o[2 * e + 1] = hi_f(own[e]) * rc[2 * e + 1] + sg * hi_f(par[e]) * rc[1024 + 2 * e + 1];
        }
      } else {
#pragma unroll
        for (int e = 0; e < 4; ++e) { o[2 * e] = lo_f(own[e]); o[2 * e + 1] = hi_f(own[e]); }
      }
      qf[m][ks] = mk8(pack2(o[0] * 0.125f, o[1] * 0.125f), pack2(o[2] * 0.125f, o[3] * 0.125f),
                      pack2(o[4] * 0.125f, o[5] * 0.125f), pack2(o[6] * 0.125f, o[7] * 0.125f));
    }
  f32x4 O[2][8];
#pragma unroll
  for (int m = 0; m < 2; ++m)
#pragma unroll
    for (int et = 0; et < 8; ++et) O[m][et] = f32x4{0.f, 0.f, 0.f, 0.f};
  float mx[2] = {-1e30f, -1e30f}, lsum[2] = {0.f, 0.f};

  u32x4 Aa, Ab, Ac, Ad, Ba, Bb, Bc, Bd;
  att_gload(tid, p, l, s, h, 0, Aa, Ab, Ac, Ad);
  __syncthreads();
  att_lstore(tid, p, s, 0, Aa, Ab, Ac, Ad, lds);
  att_gload(tid, p, l, s, h, 1, Aa, Ab, Ac, Ad);
  __syncthreads();
  auto compute = [&](const char* cur) {
    f32x4 S[2][2];
#pragma unroll
    for (int m = 0; m < 2; ++m)
#pragma unroll
      for (int k2 = 0; k2 < 2; ++k2) {
        f32x4 acc = {0.f, 0.f, 0.f, 0.f};
#pragma unroll
        for (int ks = 0; ks < 2; ++ks) {
          const int key = k2 * 16 + c;
          const bf16x8 a = *(const bf16x8*)(cur + key * 256 + (((m * 8 + ks * 4 + q) ^ (key & 15)) << 4));
          acc = MFMA16(a, qf[m][ks], acc);
        }
        S[m][k2] = acc;
      }
    bf16x8 pf[2];
#pragma unroll
    for (int m = 0; m < 2; ++m) {
      float tm = fmaxf(fmaxf(fmaxf(S[m][0][0], S[m][0][1]), fmaxf(S[m][0][2], S[m][0][3])),
                       fmaxf(fmaxf(S[m][1][0], S[m][1][1]), fmaxf(S[m][1][2], S[m][1][3])));
      tm = fmaxf(tm, __shfl_xor(tm, 16));
      tm = fmaxf(tm, __shfl_xor(tm, 32));
      const float mn = fmaxf(mx[m], tm);
      const float alpha = __expf(mx[m] - mn);
      mx[m] = mn;
      float pv[8], ps = 0.f;
#pragma unroll
      for (int k2 = 0; k2 < 2; ++k2)
#pragma unroll
        for (int r = 0; r < 4; ++r) { pv[k2 * 4 + r] = __expf(S[m][k2][r] - mn); ps += pv[k2 * 4 + r]; }
      lsum[m] = lsum[m] * alpha + ps;
#pragma unroll
      for (int et = 0; et < 8; ++et) O[m][et] *= alpha;
      pf[m] = mk8(pack2(pv[0], pv[1]), pack2(pv[2], pv[3]), pack2(pv[4], pv[5]), pack2(pv[6], pv[7]));
    }
    {
      const int qq = c >> 2, pp = c & 3;
      const int kA = 4 * q + qq, kB = 16 + 4 * q + qq;
#pragma unroll
      for (int et = 0; et < 8; ++et) {
        const char* aA = cur + AT_K + kA * 256 + (((et ^ (kA & 7)) << 5)) + pp * 8;
        const char* aB = cur + AT_K + kB * 256 + (((et ^ (kB & 7)) << 5)) + pp * 8;
        const s16x4 lo = __builtin_amdgcn_ds_read_tr16_b64_v4i16((s16x4 LAS*)(const LAS char*)aA);
        const s16x4 hi = __builtin_amdgcn_ds_read_tr16_b64_v4i16((s16x4 LAS*)(const LAS char*)aB);
        const bf16x8 vf = __builtin_shufflevector(lo, hi, 0, 1, 2, 3, 4, 5, 6, 7);
        O[0][et] = MFMA16(vf, pf[0], O[0][et]);
        O[1][et] = MFMA16(vf, pf[1], O[1][et]);
      }
    }
  };
#pragma unroll 1
  for (int kt = 0; kt < nkt; kt += 2) {
    if (kt + 2 < nkt) att_gload(tid, p, l, s, h, kt + 2, Ba, Bb, Bc, Bd);
    compute(lds);
    att_lstore(tid, p, s, kt + 1, Aa, Ab, Ac, Ad, lds + AT_STAGE);
    __syncthreads();
    if (kt + 3 < nkt) att_gload(tid, p, l, s, h, kt + 3, Aa, Ab, Ac, Ad);
    compute(lds + AT_STAGE);
    if (kt + 2 < nkt) att_lstore(tid, p, s, kt + 2, Ba, Bb, Bc, Bd, lds);
    __syncthreads();
  }
#pragma unroll
  for (int m = 0; m < 2; ++m) { lsum[m] += __shfl_xor(lsum[m], 16); lsum[m] += __shfl_xor(lsum[m], 32); }
  const float lam = ((const float*)(lws(p) + WS_LAM))[l];
  const float lam_init = 0.8f - 0.6f * expf(-0.3f * (float)l);
  const float i0 = 1.f / lsum[0], i1 = lam / lsum[1];
  float ss = 0.f;
#pragma unroll
  for (int et = 0; et < 8; ++et)
#pragma unroll
    for (int r = 0; r < 4; ++r) { const float o = O[0][et][r] * i0 - O[1][et][r] * i1; O[0][et][r] = o; ss += o * o; }
  ss += __shfl_xor(ss, 16); ss += __shfl_xor(ss, 32);
  const float rstd = rsqrtf(ss * (1.f / 128.f) + EPS) * (1.f - lam_init);
  const float* g = lin(p, 23) + l * 128;
#pragma unroll
  for (int et = 0; et < 8; ++et) {
    const int e0 = 16 * et + 4 * q;
    const u32x2 zz = *(const u32x2*)(proj + pjx(qrow_i, C_ZB + h * 128 + e0));
    const float v0 = O[0][et][0] * rstd * g[e0 + 0] * siluf_(lo_f(zz[0]));
    const float v1 = O[0][et][1] * rstd * g[e0 + 1] * siluf_(hi_f(zz[0]));
    const float v2 = O[0][et][2] * rstd * g[e0 + 2] * siluf_(lo_f(zz[1]));
    const float v3 = O[0][et][3] * rstd * g[e0 + 3] * siluf_(hi_f(zz[1]));
    const u32x2 w = {pack2(v0, v1), pack2(v2, v3)};
    if (!dry) *(u32x2*)(proj + pjx(qrow_i, C_QB + h * 128 + e0)) = w; else asm volatile("" :: "v"(w[0]), "v"(w[1]));
  }
}


constexpr int DP_QF = 0, DP_KF = 33792, DP_VF = 67584, DP_MT = 101376, DP_SM = 134144;
DI int kmap8(int ks, int q, int j) { return 32 * ks + 4 * q + (j & 3) + 16 * (j >> 2); }

DI void dn_prep_task(PR p, int l, int gc, int h, char* lds) {
  const int tid = ltid(), lane = tid & 63, q = lane >> 4, c = lane & 15;
  int s, oc;
  if (gc < 64) { s = gc >> 2; oc = gc & 3; } else { s = 16 + ((gc - 64) >> 4); oc = (gc - 64) & 15; }
  const int R0 = seq_row0(s), T = seq_len(s), t0 = oc * 64;
  const bf16_t* proj = (const bf16_t*)(lws(p) + WS_PROJ);
  float* qf = (float*)(lds + DP_QF);
  float* kf = (float*)(lds + DP_KF);
  float* vf = (float*)(lds + DP_VF);
  float* mT = (float*)(lds + DP_MT);
  float* sm = (float*)(lds + DP_SM);
  __syncthreads();
  if (tid < 384) {
    const int cg = tid % 48, rg = tid / 48;
    const int which = cg >> 4, ch0 = (cg & 15) * 8;
    const int col = C_QC + which * 512 + h * 128 + ch0;
    const float* cw = lin(p, 24) + (size_t)l * 5 * 1536 + which * 512 + h * 128 + ch0;
    float w[5][8];
#pragma unroll
    for (int j = 0; j < 5; ++j)
#pragma unroll
      for (int e = 0; e < 8; ++e) w[j][e] = cw[j * 1536 + e];
    u32x4 raw[12];
#pragma unroll
    for (int i = 0; i < 12; ++i) {
      const int t = t0 + rg * 8 + i - 2;
      raw[i] = u32x4{0u, 0u, 0u, 0u};
      if (t >= 0 && t < T) raw[i] = *(const u32x4*)(proj + pjx(R0 + t, col));
    }
    float* dst = which == 0 ? qf : (which == 1 ? kf : vf);
#pragma unroll
    for (int i = 0; i < 8; ++i) {
#pragma unroll
      for (int e2 = 0; e2 < 4; ++e2) {
        float a0 = 0.f, a1 = 0.f;
#pragma unroll
        for (int j = 0; j < 5; ++j) { a0 += w[j][2 * e2] * lo_f(raw[i + j][e2]); a1 += w[j][2 * e2 + 1] * hi_f(raw[i + j][e2]); }
        dst[(rg * 8 + i) * 132 + ch0 + 2 * e2] = siluf_(a0);
        dst[(rg * 8 + i) * 132 + ch0 + 2 * e2 + 1] = siluf_(a1);
      }
    }
  }
  if ((tid & 255) < 64) {
    const int d = tid >> 8;
    const int io = d ? 63 - lane : lane;
    const float* bg = (const float*)(lws(p) + WS_BETAG) + (size_t)(R0 + t0 + io) * 16;
    const float beta = bg[d * 4 + h];
    float g = bg[8 + d * 4 + h];
#pragma unroll
    for (int o = 1; o < 64; o <<= 1) {
      const int src = lane >= o ? lane - o : lane;
      const float n = __int_as_float(__builtin_amdgcn_ds_bpermute(src << 2, __float_as_int(g)));
      if (lane >= o) g += n;
    }
    sm[d * 64 + lane] = beta;
    sm[128 + d * 64 + lane] = g;
    sm[256 + d * 64 + lane] = __expf(g);
  }
  __syncthreads();
  {
    const int wave = tid >> 6;
#pragma unroll 1
    for (int i = 0; i < 16; ++i) {
      const int id = wave * 16 + i, row = id & 63, which = id >> 6;
      float* a = (which ? kf : qf) + row * 132;
      const float v0 = a[lane], v1 = a[64 + lane];
      const float ss = wave_sum(v0 * v0 + v1 * v1);
      const float sc = rsqrtf(ss + EPS) * (which ? 1.f : 0.08838834764831845f);
      a[lane] = v0 * sc; a[64 + lane] = v1 * sc;
    }
  }
  __syncthreads();
  const int d = tid >> 8, w4 = (tid >> 6) & 3;
  const float* beta_s = sm + d * 64;
  const float* gc_s = sm + 128 + d * 64;
  const float* eg_s = sm + 256 + d * 64;
  unsigned char* slot = lws(p) + WS_DNP + (size_t)((gc * 4 + h) * 2 + d) * DNP_SLOT;
  auto orow = [&](int i) -> int { return d ? 63 - i : i; };
  auto ldfrag = [&](const float* base, int row, int ks) -> bf16x8 {
    const f32x4 a = *(const f32x4*)(base + row * 132 + 32 * ks + 8 * q);
    const f32x4 b = *(const f32x4*)(base + row * 132 + 32 * ks + 8 * q + 4);
    return mk8(pack2(a[0], a[1]), pack2(a[2], a[3]), pack2(b[0], b[1]), pack2(b[2], b[3]));
  };
  {
    const int it = w4;
    bf16x8 kfr_i[4], qfr_i[4];
#pragma unroll
    for (int ks = 0; ks < 4; ++ks) { kfr_i[ks] = ldfrag(kf, orow(16 * it + c), ks); qfr_i[ks] = ldfrag(qf, orow(16 * it + c), ks); }
    f32x4 kq[4];
#pragma unroll
    for (int jt = 0; jt < 4; ++jt) {
      f32x4 kk = {0.f, 0.f, 0.f, 0.f}, kq_ = {0.f, 0.f, 0.f, 0.f};
#pragma unroll
      for (int ks = 0; ks < 4; ++ks) {
        const bf16x8 kfr_j = ldfrag(kf, orow(16 * jt + c), ks);
        kk = MFMA16(kfr_i[ks], kfr_j, kk);
        kq_ = MFMA16(kfr_j, qfr_i[ks], kq_);
      }
      {
        const int j = 16 * jt + c;
        const float gj = gc_s[j];
#pragma unroll
        for (int r = 0; r < 4; ++r) {
          const int i = 16 * it + 4 * q + r;
          const float v = i > j ? beta_s[i] * kk[r] * __expf(gc_s[i] - gj) : 0.f;
          mT[d * 4096 + j * 64 + i] = v;
        }
      }
      {
        const int i = 16 * it + c;
        const float gi = gc_s[i];
#pragma unroll
        for (int r = 0; r < 4; ++r) {
          const int j = 16 * jt + 4 * q + r;
          kq_[r] = i >= j ? kq_[r] * __expf(gi - gc_s[j]) : 0.f;
        }
      }
      kq[jt] = kq_;
      asm volatile("" ::: "memory");
    }
#pragma unroll
    for (int ks2 = 0; ks2 < 2; ++ks2) {
      const f32x4 a = kq[2 * ks2], b = kq[2 * ks2 + 1];
      const u32x4 o = {pack2(a[0], a[1]), pack2(a[2], a[3]), pack2(b[0], b[1]), pack2(b[2], b[3])};
      *(u32x4*)(slot + SL_QK + ((it * 2 + ks2) * 64 + lane) * 16) = o;
    }
    asm volatile("" ::: "memory");
    {
      const int i = 16 * it + c, io = orow(i);
      const float egi = eg_s[i];
#pragma unroll
      for (int ks = 0; ks < 4; ++ks) {
        const f32x4 a = *(const f32x4*)(qf + io * 132 + 32 * ks + 4 * q);
        const f32x4 b = *(const f32x4*)(qf + io * 132 + 32 * ks + 16 + 4 * q);
        const u32x4 o = {pack2(a[0] * egi, a[1] * egi), pack2(a[2] * egi, a[3] * egi), pack2(b[0] * egi, b[1] * egi), pack2(b[2] * egi, b[3] * egi)};
        *(u32x4*)(slot + SL_QG + ((it * 4 + ks) * 64 + lane) * 16) = o;
      }
    }
    asm volatile("" ::: "memory");
    {
      const float gl = gc_s[63];
#pragma unroll
      for (int mm = 0; mm < 2; ++mm) {
        const int mt8 = 2 * w4 + mm, dk = 16 * mt8 + c;
#pragma unroll
        for (int ks2 = 0; ks2 < 2; ++ks2) {
          float v[8];
#pragma unroll
          for (int j = 0; j < 8; ++j) {
            const int i = kmap8(ks2, q, j);
            v[j] = kf[orow(i) * 132 + dk] * __expf(gl - gc_s[i]);
          }
          const u32x4 o = {pack2(v[0], v[1]), pack2(v[2], v[3]), pack2(v[4], v[5]), pack2(v[6], v[7])};
          *(u32x4*)(slot + SL_KGT + ((mt8 * 2 + ks2) * 64 + lane) * 16) = o;
        }
      }
      if (w4 == 0 && lane == 0) ((float*)(lws(p) + WS_EGL))[(gc * 4 + h) * 2 + d] = __expf(gl);
    }
  }
  {
    bf16_t* XA = (bf16_t*)(lds + DP_QF) + d * 32 * 260;
    bf16_t* XC = (bf16_t*)(lds + DP_KF + 16 * 528) + d * 16 * 260;
    bf16_t* XD = (bf16_t*)(lds + DP_VF + 16 * 528) + d * 16 * 260;
    const int col = tid & 255;
    const float* rsrc = col < 128 ? vf + col : kf + (col - 128);
    const float* mcol = mT + d * 4096;
    __syncthreads();
#pragma unroll 1
    for (int b = 0; b < 4; ++b) {
      float x[16];
#pragma unroll
      for (int i = 0; i < 16; ++i) {
        const int ii = 16 * b + i;
        const float sc = col < 128 ? beta_s[ii] : beta_s[ii] * eg_s[ii];
        x[i] = rsrc[orow(ii) * 132] * sc;
      }
      const int nA = b < 2 ? 16 * b : 32;
#pragma unroll 8
      for (int j = 0; j < nA; ++j) {
        const float xj = bf2f(XA[j * 260 + col]);
        const float* mr = mcol + j * 64 + 16 * b;
#pragma unroll
        for (int i4 = 0; i4 < 4; ++i4) {
          const f32x4 mm = *(const f32x4*)(mr + i4 * 4);
          x[i4 * 4 + 0] -= mm[0] * xj; x[i4 * 4 + 1] -= mm[1] * xj; x[i4 * 4 + 2] -= mm[2] * xj; x[i4 * 4 + 3] -= mm[3] * xj;
        }
      }
      if (b == 3) {
#pragma unroll 8
        for (int j = 0; j < 16; ++j) {
          const float xj = bf2f(XC[j * 260 + col]);
          const float* mr = mcol + (32 + j) * 64 + 48;
#pragma unroll
          for (int i4 = 0; i4 < 4; ++i4) {
            const f32x4 mm = *(const f32x4*)(mr + i4 * 4);
            x[i4 * 4 + 0] -= mm[0] * xj; x[i4 * 4 + 1] -= mm[1] * xj; x[i4 * 4 + 2] -= mm[2] * xj; x[i4 * 4 + 3] -= mm[3] * xj;
          }
        }
      }
      const float* md = mcol + (16 * b) * 64 + 16 * b;
#pragma unroll
      for (int j = 0; j < 15; ++j) {
        const float xj = x[j];
#pragma unroll
        for (int i4 = 0; i4 < 16; i4 += 4) {
          if (i4 + 3 > j) {
            const f32x4 mm = *(const f32x4*)(md + j * 64 + i4);
            if (i4 + 0 > j) x[i4 + 0] -= mm[0] * xj;
            if (i4 + 1 > j) x[i4 + 1] -= mm[1] * xj;
            if (i4 + 2 > j) x[i4 + 2] -= mm[2] * xj;
            if (i4 + 3 > j) x[i4 + 3] -= mm[3] * xj;
          }
        }
      }
      if (b == 2) __syncthreads();
      bf16_t* dstx = b < 2 ? XA + (16 * b) * 260 : (b == 2 ? XC : XD);
#pragma unroll
      for (int i = 0; i < 16; ++i) dstx[i * 260 + col] = f2bf(x[i]);
      __syncthreads();
    }
  }
  {
    const int tid4 = ltid(), lane = tid4 & 63, q = lane >> 4, c = lane & 15, w4 = (tid4 >> 6) & 3, d = tid4 >> 8;
    unsigned char* slot = lws(p) + WS_DNP + (size_t)((gc * 4 + h) * 2 + d) * DNP_SLOT;
    const bf16_t* XA = (const bf16_t*)(lds + DP_QF) + d * 32 * 260;
    const bf16_t* XC = (const bf16_t*)(lds + DP_KF + 16 * 528) + d * 16 * 260;
    const bf16_t* XD = (const bf16_t*)(lds + DP_VF + 16 * 528) + d * 16 * 260;
    auto Xrow = [&](int i) -> const bf16_t* { return i < 32 ? XA + i * 260 : (i < 48 ? XC + (i - 32) * 260 : XD + (i - 48) * 260); };
#pragma unroll
    for (int ks = 0; ks < 4; ++ks) {
      const bf16_t* xr = Xrow(16 * w4 + c);
      const u32x2 a = *(const u32x2*)(xr + 128 + 32 * ks + 4 * q);
      const u32x2 b = *(const u32x2*)(xr + 128 + 32 * ks + 16 + 4 * q);
      const u32x4 o = {a[0] ^ 0x80008000u, a[1] ^ 0x80008000u, b[0] ^ 0x80008000u, b[1] ^ 0x80008000u};
      *(u32x4*)(slot + SL_W + ((w4 * 4 + ks) * 64 + lane) * 16) = o;
    }
#pragma unroll
    for (int cc = 0; cc < 2; ++cc) {
      const int cs = 2 * w4 + cc;
#pragma unroll
      for (int mt = 0; mt < 4; ++mt) {
        unsigned short v[4];
#pragma unroll
        for (int r = 0; r < 4; ++r) v[r] = Xrow(16 * mt + 4 * q + r)[16 * cs + c];
        const u32x2 o = {(unsigned)v[0] | ((unsigned)v[1] << 16), (unsigned)v[2] | ((unsigned)v[3] << 16)};
        *(u32x2*)(slot + SL_U + ((cs * 4 + mt) * 64 + lane) * 8) = o;
      }
    }
  }
}

constexpr int CH_STAGE = 57344;
DI void dn_chain_task(PR p, int l, int s, int h, int d, char* lds) {
  const int tid = ltid(), cs = tid >> 6, lane = tid & 63, q = lane >> 4, c = lane & 15;
  const int R0 = seq_row0(s), T = seq_len(s), nc = T >> 6;
  const int gc0 = s < 16 ? s * 4 : 64 + (s - 16) * 16;
  bf16_t* odir = (bf16_t*)(lws(p) + WS_R1) + (size_t)d * MROWS * 512;
  const float* egl = (const float*)(lws(p) + WS_EGL);
  f32x4 S[8];
  if (s >= 16) {
    const float* s0 = lin(p, 6) + ((((size_t)(s - 16) * 2 + l) * 2 + d) * 4 + h) * 16384;
#pragma unroll
    for (int i = 0; i < 8; ++i)
#pragma unroll
      for (int r = 0; r < 4; ++r) S[i][r] = s0[(16 * i + 4 * q + r) * 128 + 16 * cs + c];
  } else {
#pragma unroll
    for (int i = 0; i < 8; ++i) S[i] = f32x4{0.f, 0.f, 0.f, 0.f};
  }
  auto slot_of = [&](int step) -> const unsigned char* {
    const int oc = d ? nc - 1 - step : step;
    return lws(p) + WS_DNP + (size_t)(((gc0 + oc) * 4 + h) * 2 + d) * DNP_SLOT;
  };
  const int cs_u = __builtin_amdgcn_readfirstlane(cs);
  u32x2 uA[4], uB[4]; float glA = 1.f, glB = 1.f;
  auto dma = [&](int step, char* st) {
    const unsigned char* sl = slot_of(step);
#pragma unroll
    for (int i = 0; i < 7; ++i)
      __builtin_amdgcn_global_load_lds((const unsigned*)(sl + (size_t)(tid + NT * i) * 16), (LAS unsigned*)(LAS char*)(st + (cs_u * 64 + NT * i) * 16), 16, 0, 0);
  };
  auto uload = [&](int step, u32x2 (&u)[4], float& gl) {
    const unsigned char* sl = slot_of(step);
#pragma unroll
    for (int mt = 0; mt < 4; ++mt) u[mt] = *(const u32x2*)(sl + SL_U + ((cs * 4 + mt) * 64 + lane) * 8);
    const int oc = d ? nc - 1 - step : step;
    gl = egl[((gc0 + oc) * 4 + h) * 2 + d + vzero()];
  };
  auto compute = [&](int step, const char* cur, u32x2 (&u)[4], float& glr) {
    const int oc = d ? nc - 1 - step : step;
    const float gl = glr;
    bf16x8 Sb[4];
#pragma unroll
    for (int ks = 0; ks < 4; ++ks)
      Sb[ks] = mk8(pack2(S[2 * ks][0], S[2 * ks][1]), pack2(S[2 * ks][2], S[2 * ks][3]),
                   pack2(S[2 * ks + 1][0], S[2 * ks + 1][1]), pack2(S[2 * ks + 1][2], S[2 * ks + 1][3]));
    f32x4 av[4], ao[4];
#pragma unroll
    for (int mt = 0; mt < 4; ++mt) {
      av[mt] = f32x4{lo_f(u[mt][0]), hi_f(u[mt][0]), lo_f(u[mt][1]), hi_f(u[mt][1])};
      ao[mt] = f32x4{0.f, 0.f, 0.f, 0.f};
    }
    if (step + 2 < nc) uload(step + 2, u, glr);
#pragma unroll
    for (int ks = 0; ks < 4; ++ks)
#pragma unroll
      for (int mt = 0; mt < 4; ++mt) {
        const bf16x8 wf = *(const bf16x8*)(cur + SL_W + ((mt * 4 + ks) * 64 + lane) * 16);
        av[mt] = MFMA16(wf, Sb[ks], av[mt]);
        const bf16x8 gf = *(const bf16x8*)(cur + SL_QG + ((mt * 4 + ks) * 64 + lane) * 16);
        ao[mt] = MFMA16(gf, Sb[ks], ao[mt]);
        if (mt == 3 && (ks & 1)) asm volatile("" ::: "memory");
      }
    bf16x8 Vb[2];
#pragma unroll
    for (int k2 = 0; k2 < 2; ++k2)
      Vb[k2] = mk8(pack2(av[2 * k2][0], av[2 * k2][1]), pack2(av[2 * k2][2], av[2 * k2][3]),
                   pack2(av[2 * k2 + 1][0], av[2 * k2 + 1][1]), pack2(av[2 * k2 + 1][2], av[2 * k2 + 1][3]));
#pragma unroll
    for (int k2 = 0; k2 < 2; ++k2)
#pragma unroll
      for (int mt = 0; mt < 4; ++mt) {
        const bf16x8 f = *(const bf16x8*)(cur + SL_QK + ((mt * 2 + k2) * 64 + lane) * 16);
        ao[mt] = MFMA16(f, Vb[k2], ao[mt]);
      }
#pragma unroll
    for (int i = 0; i < 8; ++i) {
      S[i] *= gl;
#pragma unroll
      for (int k2 = 0; k2 < 2; ++k2) {
        const bf16x8 f = *(const bf16x8*)(cur + SL_KGT + ((i * 2 + k2) * 64 + lane) * 16);
        S[i] = MFMA16(f, Vb[k2], S[i]);
      }
    }
#pragma unroll
    for (int mt = 0; mt < 4; ++mt)
#pragma unroll
      for (int r = 0; r < 4; ++r) {
        const int i = 16 * mt + 4 * q + r;
        const int t = oc * 64 + (d ? 63 - i : i);
        odir[(size_t)(R0 + t) * 512 + h * 128 + 16 * cs + c] = f2bf(ao[mt][r]);
      }
  };
  uload(0, uA, glA); uload(1, uB, glB);
  __syncthreads();
  dma(0, lds);
  __syncthreads();
#pragma unroll 1
  for (int step = 0; step < nc; step += 2) {
    dma(step + 1, lds + CH_STAGE);
    compute(step, lds, uA, glA);
    __syncthreads();
    if (step + 2 < nc) dma(step + 2, lds);
    compute(step + 1, lds + CH_STAGE, uB, glB);
    __syncthreads();
  }
  if (s < 16) {
    float* so = lout(p) + O_DN + ((((size_t)s * 2 + l) * 2 + d) * 4 + h) * 16384;
#pragma unroll
    for (int i = 0; i < 8; ++i)
#pragma unroll
      for (int r = 0; r < 4; ++r) so[(16 * i + 4 * q + r) * 128 + 16 * cs + c] = S[i][r];
  }
}

constexpr int N_PHASES = 16;
constexpr int LDS_QSH = LDS_BYTES - 16;
constexpr int LDS_BST = LDS_BYTES - 32;

DI void run_prep(PR p) {
  const int G = gridDim.x, bid = blockIdx.x;
  for (int t = bid; t < 192; t += G) ph0_adaln(p, t, smem);
  for (int t = bid; t < 16; t += G) ph0_s5(p, t);
  if (bid == G - 1) ph0_misc(p);
  for (int t = bid; t < 2048; t += G) cvt_win_tile(p, 0, t, smem);
  for (int t = bid; t < 1408; t += G) cvt_other_tile(p, t, smem);
}
DI void run_final(PR p) {
  const int G = gridDim.x, bid = blockIdx.x, wave = ltid() >> 6;
  for (int r = bid * 8 + wave; r < MROWS; r += G * 8) ph_final_row(p, r);
}
DI void run_norm(PR p, int l) {
  const int G = gridDim.x, bid = blockIdx.x, wave = ltid() >> 6;
  for (int rb = bid * 8 + wave; rb < 4096; rb += G * 8) ph1_norm_rows(p, l, rb);
}
DI void run_cvt1(PR p) {
  const int G = gridDim.x, bid = blockIdx.x;
  for (int t = bid; t < 2048; t += G) cvt_win_tile(p, 1, t, smem);
}
DI void run_inproj(PR p, int l) {
  const int G = gridDim.x, bid = blockIdx.x;
  for (int t = bid; t < 2048; t += G) ph2_inproj_tile(p, l, t, smem);
}
DI void run_s5(PR p, int l) {
  const int G = gridDim.x, bid = blockIdx.x;
  for (int b = bid; b < 256; b += G) {
    s5_wg_task(p, l, 16 + (b >> 6), (b >> 5) & 1, b & 31, smem);
#pragma unroll 1
    for (int k = 0; k < 4; ++k) { const int i = b * 4 + k; s5_wg_task(p, l, i >> 6, (i >> 5) & 1, i & 31, smem); }
  }
}
DI void run_att(PR p, int l, int t, bool dry = false) {
  if (t < 128) { const int s = 16 + (t >> 5), h = (t >> 3) & 3, qb = t & 7; att_task(p, l, s, h, qb, smem, dry); }
  else { const int u = t - 128, s = u >> 3, h = (u >> 1) & 3, qb = u & 1; att_task(p, l, s, h, qb, smem, dry); }
}
DI void run_prep_dn(PR p, int l, int u) { dn_prep_task(p, l, u >> 2, u & 3, smem); }
DI void run_chain(PR p, int l) {
  const int G = gridDim.x, bid = blockIdx.x;
  for (int b = bid; b < 160; b += G) {
    const int s = b < 32 ? 16 + (b >> 3) : (b - 32) >> 3;
    const int h = (b >> 1) & 3, d = b & 1;
    dn_chain_task(p, l, s, h, d, smem);
  }
}
DI void run_glu(PR p, int l, int t, bool dry = false) { glu_tile(p, l, t, smem, dry); }
DI void run_ph5(PR p, int l) {
  const int G = gridDim.x, bid = blockIdx.x, wave = ltid() >> 6;
  for (int r = bid * 8 + wave; r < MROWS; r += G * 8) ph5_row(p, l, r);
}
DI void run_merge(PR p, int l) {
  const int G = gridDim.x, bid = blockIdx.x;
  for (int t = bid; t < 256; t += G) ph6_merge_tile(p, l, t, smem);
}
DI void run_out(PR p, int l) {
  const int G = gridDim.x, bid = blockIdx.x;
  for (int t = bid; t < 256; t += G) ph7_out_tile(p, l, t, smem);
}
DI void run_barrier(PR p, unsigned x) {
  asm volatile("" : "+s"(x));
  XcdBarrier xb; xb.bar = (unsigned*)lws(p) + WS_BAR / 4; xb.x = x; xb.st = (volatile LAS unsigned*)(LAS char*)(smem + LDS_BST);
  xcd_barrier(xb);
}

#define SW_BEGIN(id) unsigned long long _sw_t0 = 0; if constexpr (TIMEREG == (id)) { __syncthreads(); _sw_t0 = __builtin_amdgcn_s_memrealtime(); }
#define SW_END(id) if constexpr (TIMEREG == (id)) { __syncthreads(); if (blockIdx.x == 0 && threadIdx.x == 0) g_sw_acc += __builtin_amdgcn_s_memrealtime() - _sw_t0; }
#ifndef REP
#define REP 0
#endif
template <int SUB> DI void run_sub(PR p, int l, volatile LAS int* qsh, unsigned* qw) {
  if constexpr (SUB == 0) { run_norm(p, l); if (l == 1) run_cvt1(p); }
  else if constexpr (SUB == 1) run_inproj8(p, l);
  else if constexpr (SUB == 2) {
    { SW_BEGIN(1) run_s5(p, l); SW_END(1) }
    if constexpr ((REP >> 16) & 1) run_s5(p, l);
    if constexpr ((REP >> 17) & 1) for (;;) { const int t = queue_pull(&qw[l * 8 + 3], qsh); if (t >= 256) break; run_att(p, l, t, true); }
    { SW_BEGIN(2)
    for (;;) {
      const int t = queue_pull(&qw[l * 8 + 0], qsh);
      if (t >= 256) break;
      run_att(p, l, t);
    }
    SW_END(2) }
    { SW_BEGIN(3)
    for (;;) {
      const int t = queue_pull(&qw[l * 8 + 2], qsh);
      if (t >= 512) break;
      run_prep_dn(p, l, t);
    }
    SW_END(3) }
    if constexpr ((REP >> 18) & 1) for (;;) { const int t = queue_pull(&qw[l * 8 + 4], qsh); if (t >= 512) break; run_prep_dn(p, l, t); }
  } else if constexpr (SUB == 3) {
    { SW_BEGIN(4) run_chain(p, l); SW_END(4) }
    if constexpr ((REP >> 19) & 1) run_chain(p, l);
    if constexpr ((REP >> 20) & 1) for (;;) { const int t = queue_pull(&qw[l * 8 + 5], qsh); if (t >= 256) break; run_glu(p, l, t, true); }
    for (;;) {
      const int t = queue_pull(&qw[l * 8 + 1], qsh);
      if (t >= 256) break;
      run_glu(p, l, t);
    }
  }
  else if constexpr (SUB == 4) run_ph5(p, l);
#ifndef NEW_MERGE
  else if constexpr (SUB == 5) run_merge(p, l);
  else run_out(p, l);
#else
  else if constexpr (SUB == 5) run_merge8(p, l);
  else run_out8(p, l);
#endif
}
template <int PH> DI void run_phase(PR p, volatile LAS int* qsh, unsigned* qw) {
  if constexpr (PH == 0) run_prep(p);
  else if constexpr (PH == 15) run_final(p);
  else run_sub<(PH - 1) % 7>(p, (PH - 1) / 7, qsh, qw);
}

__global__ void __launch_bounds__(NT) fwd_kernel(Params p_by_value) {
  PR p = *(const __attribute__((address_space(4))) Params*)__builtin_amdgcn_kernarg_segment_ptr();
  volatile LAS int* qsh = (volatile LAS int*)(LAS char*)(smem + LDS_QSH);
  unsigned* qw = (unsigned*)(p.ws + WS_Q);
#ifndef ONE_LAUNCH
  switch (p.ph_lo) {
#define PHC(n) case n: run_phase<n>(p, qsh, qw); break;
    PHC(0) PHC(1) PHC(2) PHC(3) PHC(4) PHC(5) PHC(6) PHC(7) PHC(8) PHC(9) PHC(10) PHC(11) PHC(12) PHC(13) PHC(14) PHC(15)
#undef PHC
    default: break;
  }
#else
  volatile LAS unsigned* bst = (volatile LAS unsigned*)(LAS char*)(smem + LDS_BST);
  if (ltid() == 0) { bst[0] = 0u; bst[1] = 0u; }
  __syncthreads();
  if constexpr (TIMEREG > 0) { if (blockIdx.x == 0 && threadIdx.x == 0) g_sw_acc = 0ull; }
  const XcdBarrier xb = xcd_barrier_post((unsigned*)(p.ws + WS_BAR), bst);
  const unsigned xcc = xb.x;
#ifndef TIMEPH
#define TIMEPH -1
#endif
  unsigned long long tph0 = 0, tph1 = 0;
  if constexpr (TIMEPH == 0) tph0 = __builtin_amdgcn_s_memrealtime();
  run_prep(p); run_barrier(p, xcc);
  if constexpr (TIMEPH == 0) tph1 = __builtin_amdgcn_s_memrealtime();
#define PHS(sub) { const bool tm = (TIMEPH == 1 + 7 * l + (sub)); if (TIMEPH > 0 && tm) tph0 = __builtin_amdgcn_s_memrealtime(); \
    run_sub<sub>(p, l, qsh, qw); run_barrier(p, xcc); if constexpr ((REP >> 21) & 1) run_barrier(p, xcc); if (TIMEPH > 0 && tm) tph1 = __builtin_amdgcn_s_memrealtime(); }
#pragma unroll 1
  for (int l = 0; l < 2; ++l) { PHS(0) PHS(1) PHS(2) PHS(3) PHS(4) PHS(5) PHS(6) }
#undef PHS
  run_final(p);
  if constexpr (TIMEPH >= 0 || TIMEREG > 0) {
    if (blockIdx.x == 0) {
      __syncthreads();
      const unsigned long long te = __builtin_amdgcn_s_memrealtime(), dt = (TIMEREG > 0) ? *(volatile unsigned long long*)&g_sw_acc : tph1 - tph0;
      while (__builtin_amdgcn_s_memrealtime() - te < dt) __builtin_amdgcn_s_sleep(8);
    }
  }
#endif
}

extern "C" void kernel_launch(void* const* d_in, const int* in_sizes, int n_in, void* d_out, int out_size,
                              void* d_ws, size_t ws_size, hipStream_t stream) {
  static int grid = 0;
  if (grid == 0) {
    int dev = 0, cus = 0, per_cu = 0;
    if (hipGetDevice(&dev) != hipSuccess || hipDeviceGetAttribute(&cus, hipDeviceAttributeMultiprocessorCount, dev) != hipSuccess) { fprintf(stderr, "kernel_launch: device query failed\n"); grid = -1; return; }
    if (hipFuncSetAttribute((const void*)fwd_kernel, hipFuncAttributeMaxDynamicSharedMemorySize, LDS_BYTES) != hipSuccess) { fprintf(stderr, "kernel_launch: hipFuncSetAttribute failed\n"); grid = -1; return; }
    if (hipOccupancyMaxActiveBlocksPerMultiprocessor(&per_cu, (const void*)fwd_kernel, NT, LDS_BYTES) != hipSuccess || per_cu < 1) { fprintf(stderr, "kernel_launch: occupancy query reports %d\n", per_cu); per_cu = 1; }
    (void)hipGetLastError();
    grid = cus;
    if (ws_size < WS_END) { fprintf(stderr, "kernel_launch: workspace too small (%zu < %zu)\n", ws_size, (size_t)WS_END); grid = -1; return; }
  }
  if (grid < 0) return;
  (void)hipMemsetAsync((char*)d_ws + WS_BAR, 0, WS_ZERO_BYTES, stream);
  Params p{};
  for (int i = 0; i < 31; ++i) p.in[i] = (const float*)d_in[i];
  p.out = (float*)d_out; p.ws = (unsigned char*)d_ws;
#ifndef ONE_LAUNCH
  p.use_bar = 0;
  for (int ph = 0; ph < N_PHASES; ++ph) {
    p.ph_lo = ph; p.ph_hi = ph + 1;
    hipLaunchKernelGGL(fwd_kernel, dim3(grid), dim3(NT), LDS_BYTES, stream, p);
  }
#else
  p.use_bar = 1; p.ph_lo = 0; p.ph_hi = N_PHASES;
  void* args[] = {&p};
  hipError_t e = hipLaunchCooperativeKernel((const void*)fwd_kernel, dim3(grid), dim3(NT), args, LDS_BYTES, stream);
  if (e != hipSuccess) fprintf(stderr, "kernel_launch: cooperative launch failed: %s (grid %d)\n", hipGetErrorString(e), grid);
#endif
}
```

```cpp
#define ONE_LAUNCH 1
#include <hip/hip_runtime.h>
#include <stdint.h>
#include <stdio.h>

#define DI __device__ __forceinline__
typedef unsigned short bf16_t;
using bf16x8 = __attribute__((ext_vector_type(8))) short;
using s16x4  = __attribute__((ext_vector_type(4))) short;
using f32x4  = __attribute__((ext_vector_type(4))) float;
using f32x16 = __attribute__((ext_vector_type(16))) float;
using u32x4  = __attribute__((ext_vector_type(4))) unsigned;
using u32x2  = __attribute__((ext_vector_type(2))) unsigned;
typedef __bf16 bf16x2_t __attribute__((ext_vector_type(2)));
typedef float f32x2_t __attribute__((ext_vector_type(2)));
#define LAS __attribute__((address_space(3)))

#define MFMA16(a, b, c) __builtin_amdgcn_mfma_f32_16x16x32_bf16((a), (b), (c), 0, 0, 0)
#define MFMA32(a, b, c) __builtin_amdgcn_mfma_f32_32x32x16_bf16((a), (b), (c), 0, 0, 0)

constexpr int NT = 512;
constexpr int DM = 1024;
constexpr int MROWS = 8192;
constexpr int NP = 8192;
constexpr int NIN = 8208;
constexpr float EPS = 1e-6f;
constexpr int C_UA = 0, C_ZA = 512, C_QB = 1024, C_KB = 1536, C_VB = 2048, C_ZB = 2560;
constexpr int C_QC = 3072, C_KC = 3584, C_VC = 4096, C_ZC = 4608, C_GT = 5120;
constexpr size_t O_Y = 0;
constexpr size_t O_CK = 8388608;
constexpr size_t O_CV = O_CK + 4194304;
constexpr size_t O_SR = O_CV + 4194304;
constexpr size_t O_SI = O_SR + 131072;
constexpr size_t O_DN = O_SI + 131072;

constexpr size_t WS_BAR   = 0;
constexpr size_t WS_Q     = 16384;
constexpr size_t WS_ZERO_BYTES = 16384 + 1024;
constexpr size_t WS_MOD   = 32768;
constexpr size_t WS_S5AR  = WS_MOD + 122880;
constexpr size_t WS_S5AI  = WS_S5AR + 32768;
constexpr size_t WS_S5BB  = WS_S5AI + 32768;
constexpr size_t WS_S5CT  = WS_S5BB + 524288;
constexpr size_t WS_ROPE  = WS_S5CT + 524288;
constexpr size_t WS_LAM   = WS_ROPE + 8192;
constexpr size_t WS_WBA   = WS_LAM + 256;
constexpr size_t WS_BETAG = WS_WBA + 131072;
constexpr size_t WS_EGL   = WS_BETAG + 524288;
constexpr size_t WS_WTGLU = WS_EGL + 4096;
constexpr size_t WS_WTBR  = WS_WTGLU + 1048576;
constexpr size_t WS_WTOUT = WS_WTBR + 6291456;
constexpr size_t WS_R1    = WS_WTOUT + 4194304;
constexpr size_t WS_R2    = WS_R1 + 16777216;
constexpr size_t WS_PROJ  = WS_R2 + 16777216;
constexpr size_t WS_DNP   = WS_PROJ + 134217728;
constexpr size_t DNP_SLOT = 73728;
constexpr size_t WS_END   = WS_DNP + 1024 * DNP_SLOT;
constexpr int SL_W = 0, SL_QG = 16384, SL_KGT = 32768, SL_QK = 49152, SL_U = 57344;

constexpr int LDS_BYTES = 163840;

struct Params {
  const float* in[31];
  float* out;
  unsigned char* ws;
  int ph_lo, ph_hi;
  int use_bar, pad;
};
typedef const __attribute__((address_space(4))) Params& PR;
#define NI __device__ __noinline__
extern __shared__ __attribute__((aligned(16))) char smem[];
#define GAS __attribute__((address_space(1)))
DI unsigned char* lws(PR p) { GAS unsigned char* w = (GAS unsigned char*)p.ws; asm volatile("" : "+s"(w)); return (unsigned char*)w; }
DI const float* lin(PR p, int k) { GAS const float* w = (GAS const float*)p.in[k]; asm volatile("" : "+s"(w)); return (const float*)w; }
DI float* lout(PR p) { GAS float* w = (GAS float*)p.out; asm volatile("" : "+s"(w)); return (float*)w; }

DI float bf2f(unsigned short h) { return __uint_as_float(((unsigned)h) << 16); }
DI unsigned pack2(float lo, float hi) { f32x2_t f = {lo, hi}; bf16x2_t v = __builtin_convertvector(f, bf16x2_t); return __builtin_bit_cast(unsigned, v); }
DI unsigned short f2bf(float x) { return (unsigned short)(pack2(x, 0.f) & 0xffffu); }
DI float lo_f(unsigned u) { return __uint_as_float(u << 16); }
DI float hi_f(unsigned u) { return __uint_as_float(u & 0xffff0000u); }
DI float sigmoidf_(float x) { return 1.f / (1.f + __expf(-x)); }
DI float siluf_(float x) { return x / (1.f + __expf(-x)); }
DI float wave_sum(float v) {
#pragma unroll
  for (int o = 32; o >= 1; o >>= 1) v += __shfl_xor(v, o);
  return v;
}
DI bf16x8 mk8(unsigned a, unsigned b, unsigned c, unsigned d) { u32x4 u = {a, b, c, d}; return __builtin_bit_cast(bf16x8, u); }

DI int ltid() {
  const int w = __builtin_amdgcn_readfirstlane((int)(threadIdx.x >> 6));
  int t = (w << 6) | (int)__builtin_amdgcn_mbcnt_hi(~0u, __builtin_amdgcn_mbcnt_lo(~0u, 0u));
  asm volatile("" : "+v"(t));
  return t;
}
#define XB_TMO      128
#define XB_XCNT(j)  (256  + 64 * (j))
#define XB_XSUB(j)  (1280 + 64 * (j))
#define XB_XGEN(j)  (2304 + 64 * (j))
#define XB_TOP      3328
#define XB_TOPGEN   3392
#define XCD_BAR_WORDS 3456
#define XB_SPIN_CAP (1u << 22)
DI unsigned xb_ld(unsigned* p)              { return __hip_atomic_load(p, __ATOMIC_RELAXED, __HIP_MEMORY_SCOPE_AGENT); }
DI unsigned xb_add(unsigned* p, unsigned v) { return __hip_atomic_fetch_add(p, v, __ATOMIC_RELAXED, __HIP_MEMORY_SCOPE_AGENT); }
DI unsigned xb_xcc_id() { return (unsigned)__builtin_amdgcn_s_getreg((3 << 11) | 20) & 0xFu; }
#define XB_SPIN(cond, bar) do { unsigned _sp = 0; while (cond) { __builtin_amdgcn_s_sleep(1); \
    if ((++_sp & 255u) == 0u) { if (xb_ld(&(bar)[XB_TMO])) break; if (_sp > XB_SPIN_CAP) { atomicAdd(&(bar)[XB_TMO], 1u); break; } } } } while (0)
struct XcdBarrier { unsigned* bar; unsigned x; volatile LAS unsigned* st; };
DI XcdBarrier xcd_barrier_post(unsigned* bar, volatile LAS unsigned* st) {
  XcdBarrier b; b.bar = bar; b.x = xb_xcc_id(); b.st = st;
  if (ltid() == 0) (void)xb_add(&bar[XB_XCNT(b.x)], 1u);
  return b;
}
DI void xcd_barrier_complete(unsigned* bar, unsigned x, unsigned& nloc, unsigned& nx) {
  const unsigned G = gridDim.x;
  unsigned sum, cnt, mine, sp = 0u;
  for (;;) {
    sum = 0u; cnt = 0u; mine = 0u;
#pragma unroll
    for (unsigned j = 0; j < 16; ++j) { const unsigned c = xb_ld(&bar[XB_XCNT(j)]); sum += c; cnt += (c > 0u) ? 1u : 0u; mine = (j == x) ? c : mine; }
    if (sum == G) break;
    __builtin_amdgcn_s_sleep(1);
    if ((++sp & 255u) == 0u) { if (xb_ld(&bar[XB_TMO])) break; if (sp > XB_SPIN_CAP) { atomicAdd(&bar[XB_TMO], 1u); break; } }
  }
  nloc = mine > 0u ? mine : 1u; nx = cnt > 0u ? cnt : 1u;
}
DI void xcd_barrier(const XcdBarrier& b) {
  asm volatile("s_waitcnt vmcnt(0)" ::: "memory");
  __syncthreads();
  if (ltid() == 0) {
    unsigned* bar = b.bar;
    __builtin_amdgcn_s_waitcnt(0);
    unsigned nloc = b.st[0], nx = b.st[1];
    if (nloc == 0u) { xcd_barrier_complete(bar, b.x, nloc, nx); b.st[0] = nloc; b.st[1] = nx; }
    const unsigned old = xb_add(&bar[XB_XSUB(b.x)], 1u);
    const unsigned gen = old / nloc;
    if (old + 1u == (gen + 1u) * nloc) {
      __builtin_amdgcn_fence(__ATOMIC_RELEASE, "agent");
      asm volatile("s_waitcnt vmcnt(0)" ::: "memory");
      const unsigned og = xb_add(&bar[XB_TOP], 1u);
      const unsigned tg = og / nx;
      if (og + 1u == (tg + 1u) * nx) xb_add(&bar[XB_TOPGEN], 1u);
      else XB_SPIN(xb_ld(&bar[XB_TOPGEN]) == tg, bar);
      __builtin_amdgcn_fence(__ATOMIC_ACQUIRE, "agent");
      xb_add(&bar[XB_XGEN(b.x)], 1u);
      asm volatile("s_waitcnt vmcnt(0)" ::: "memory");
    } else {
      XB_SPIN(xb_ld(&bar[XB_XGEN(b.x)]) == gen, bar);
      __builtin_amdgcn_fence(__ATOMIC_ACQUIRE, "agent");
      asm volatile("s_waitcnt vmcnt(0)" ::: "memory");
    }
  }
  __syncthreads();
}

#ifndef TIMEREG
#define TIMEREG 0
#endif
__device__ unsigned long long g_sw_acc;
#define SWW_BEGIN(id) unsigned long long _sww_t0_##id = 0; if constexpr (TIMEREG == (id)) { __builtin_amdgcn_sched_barrier(0); _sww_t0_##id = __builtin_amdgcn_s_memrealtime(); __builtin_amdgcn_sched_barrier(0); }
#define SWW_END(id) if constexpr (TIMEREG == (id)) { __builtin_amdgcn_sched_barrier(0); const unsigned long long _d = __builtin_amdgcn_s_memrealtime() - _sww_t0_##id; __builtin_amdgcn_sched_barrier(0); if (blockIdx.x == 0 && threadIdx.x == 0) g_sw_acc += _d; }

DI int queue_pull(unsigned* q, volatile LAS int* sh) {
  __syncthreads();
  if (ltid() == 0) *sh = (int)xb_add(q, 1u);
  __syncthreads();
  return *sh;
}

DI int vzero() { int z = 0; asm volatile("" : "+v"(z)); return z; }

#ifndef PROJ_ROWMAJOR
DI size_t pjx(int row, int col) { return ((size_t)(col >> 9) * MROWS + row) * 512 + (col & 511); }
constexpr int PJ_LD = 512;
#else
DI size_t pjx(int row, int col) { return (size_t)row * NP + col; }
constexpr int PJ_LD = NP;
#endif

DI int seq_row0(int s) { return s < 16 ? s * 256 : 4096 + (s - 16) * 1024; }
DI int seq_len(int s) { return s < 16 ? 256 : 1024; }
DI int row_cond(int r) { return r < 4096 ? 0 : 1 + ((r - 4096) >> 10); }
DI const float* x_in_row(PR p, int l, int r) {
  if (l == 0) return r < 4096 ? lin(p, 0) + (size_t)r * DM : lin(p, 1) + (size_t)(r - 4096) * DM;
  return lout(p) + O_Y + (size_t)r * DM;
}

DI void ph0_adaln(PR p, int a, char* lds) {
  const int l = a / 96, cb = a % 96, tid = ltid();
  float* scond = (float*)lds;
  float* red = scond + 5 * 1024;
  for (int i = tid; i < 5 * 1024; i += NT) {
    const int ci = i >> 10, k = i & 1023;
    const float c = ci == 0 ? lin(p, 8)[k] : lin(p, 7)[(ci - 1) * 1024 + k];
    scond[i] = c / (1.f + expf(-c));
  }
  __syncthreads();
  const int tx = tid & 31, ty = tid >> 5;
  const float* w = lin(p, 10) + (size_t)l * 1024 * 3072 + cb * 32 + tx;
  float acc[5] = {0.f, 0.f, 0.f, 0.f, 0.f};
#pragma unroll 1
  for (int k0 = 0; k0 < 64; k0 += 16) {
    float wv[16];
#pragma unroll
    for (int u = 0; u < 16; ++u) wv[u] = w[(size_t)(ty * 64 + k0 + u) * 3072];
#pragma unroll
    for (int u = 0; u < 16; ++u) {
      const int k = ty * 64 + k0 + u;
#pragma unroll
      for (int ci = 0; ci < 5; ++ci) acc[ci] += scond[ci * 1024 + k] * wv[u];
    }
  }
#pragma unroll
  for (int ci = 0; ci < 5; ++ci) red[(ty * 5 + ci) * 32 + tx] = acc[ci];
  __syncthreads();
  if (tid < 160) {
    const int ci = tid >> 5, x = tid & 31;
    float s = 0.f;
    for (int y = 0; y < 16; ++y) s += red[(y * 5 + ci) * 32 + x];
    const int col = cb * 32 + x;
    float* mod = (float*)(lws(p) + WS_MOD);
    mod[(l * 5 + ci) * 3072 + col] = s + lin(p, 11)[l * 3072 + col];
  }
  __syncthreads();
}

DI void ph0_s5(PR p, int t) {
  const int tid = ltid();
  const int idx = t * 32 + (tid >> 4), i = tid & 15;
  const int ldg = idx >> 6, pp = idx & 63;
  const float lre = lin(p, 13)[idx], lim = lin(p, 14)[idx], ls = lin(p, 15)[ldg];
  const float step = expf(ls);
  const float mag = expf(lre * step);
  float sn, cs; sincosf(lim * step, &sn, &cs);
  const float ar = mag * cs, ai = mag * sn;
  const float den = lre * lre + lim * lim;
  const float fr = ((ar - 1.f) * lre + ai * lim) / den;
  const float fi = (ai * lre - (ar - 1.f) * lim) / den;
  if (i == 0) { ((float*)(lws(p) + WS_S5AR))[idx] = ar; ((float*)(lws(p) + WS_S5AI))[idx] = ai; }
  bf16_t* bb = (bf16_t*)(lws(p) + WS_S5BB) + (size_t)ldg * 128 * 16;
  bf16_t* ct = (bf16_t*)(lws(p) + WS_S5CT) + (size_t)ldg * 16 * 128;
  const float br = lin(p, 16)[(size_t)idx * 16 + i], bi = lin(p, 17)[(size_t)idx * 16 + i];
  bb[pp * 16 + i] = f2bf(fr * br - fi * bi);
  bb[(64 + pp) * 16 + i] = f2bf(fr * bi + fi * br);
  const float cr = lin(p, 18)[((size_t)ldg * 16 + i) * 64 + pp];
  const float cim = lin(p, 19)[((size_t)ldg * 16 + i) * 64 + pp];
  ct[i * 128 + pp] = f2bf(cr);
  ct[i * 128 + 64 + pp] = f2bf(-cim);
}

DI void ph0_misc(PR p) {
  const int tid = threadIdx.x;
  float* rc = (float*)(lws(p) + WS_ROPE);
  for (int i = tid; i < 1024; i += NT) {
    const int pos = i >> 4, f = i & 15;
    const float inv = powf(10000.f, -(float)f / 16.f);
    const float ang = (float)pos * inv;
    float sn, cs; sincosf(ang, &sn, &cs);
    rc[i] = cs; rc[1024 + i] = sn;
  }
  if (tid < 2) {
    const int l = tid;
    const float* dl = lin(p, 22) + l * 256;
    float s0 = 0.f, s1 = 0.f;
    for (int i = 0; i < 64; ++i) { s0 += dl[i] * dl[64 + i]; s1 += dl[128 + i] * dl[192 + i]; }
    const float lam_init = 0.8f - 0.6f * expf(-0.3f * (float)l);
    ((float*)(lws(p) + WS_LAM))[l] = expf(s0) - expf(s1) + lam_init;
  }
}
DI void ph0_wba(PR p, int t) {
  const int i = t * NT + ltid();
  const int l = i >> 14, j = (i >> 10) & 15, k = i & 1023;
  ((float*)(lws(p) + WS_WBA))[i] = lin(p, 12)[((size_t)l * 1024 + k) * NIN + 5120 + j];
}

DI void cvt_tile(const float* src, size_t ld_src, bf16_t* dst, size_t ld_dst, char* lds) {
  float* t = (float*)lds;
  const int tid = ltid();
  const int r = tid >> 6, c4 = (tid & 63) * 4;
  f32x4 v[8];
#pragma unroll
  for (int ps = 0; ps < 8; ++ps) v[ps] = *(const f32x4*)(src + (size_t)(r + 8 * ps) * ld_src + c4);
#pragma unroll
  for (int ps = 0; ps < 8; ++ps) {
    const int k = r + 8 * ps;
    t[k * 257 + c4 + 0] = v[ps][0]; t[k * 257 + c4 + 1] = v[ps][1]; t[k * 257 + c4 + 2] = v[ps][2]; t[k * 257 + c4 + 3] = v[ps][3];
  }
  __syncthreads();
  const int kc = tid & 7;
#pragma unroll
  for (int i = 0; i < 4; ++i) {
    const int n = (tid >> 3) + 64 * i;
    float w[8];
#pragma unroll
    for (int j = 0; j < 8; ++j) w[j] = t[(kc * 8 + j) * 257 + n];
    u32x4 o = {pack2(w[0], w[1]), pack2(w[2], w[3]), pack2(w[4], w[5]), pack2(w[6], w[7])};
    *(u32x4*)(dst + (size_t)n * ld_dst + kc * 8) = o;
  }
  __syncthreads();
}

DI void cvt_win_tile(PR p, int l, int t, char* lds) {
  const int kt = t & 15, nq = t >> 4;
  const int n0 = nq * 256, nsrc = n0 < 5120 ? n0 : n0 + 16;
  cvt_tile(lin(p, 12) + ((size_t)l * 1024 + kt * 64) * NIN + nsrc, NIN,
           (bf16_t*)(lws(p) + WS_R1) + (size_t)n0 * 1024 + kt * 64, 1024, lds);
}
DI void cvt_other_tile(PR p, int t, char* lds) {
  if (t < 32) {
    const int l = t >> 4, q = t & 15, kt = q & 7, nq = q >> 3;
    cvt_tile(lin(p, 21) + ((size_t)l * 512 + kt * 64) * 512 + nq * 256, 512,
             (bf16_t*)(lws(p) + WS_WTGLU) + ((size_t)l * 512 + nq * 256) * 512 + kt * 64, 512, lds);
  } else if (t < 224) {
    const int u = t - 32, ln = u >> 5, q = u & 31, kt = q & 7, nq = q >> 3;
    cvt_tile(lin(p, 28) + ((size_t)ln * 512 + kt * 64) * 1024 + nq * 256, 1024,
             (bf16_t*)(lws(p) + WS_WTBR) + ((size_t)ln * 1024 + nq * 256) * 512 + kt * 64, 512, lds);
  } else {
    const int u = t - 224, l = u >> 6, q = u & 63, kt = q & 15, nq = q >> 4;
    cvt_tile(lin(p, 29) + ((size_t)l * 1024 + kt * 64) * 1024 + nq * 256, 1024,
             (bf16_t*)(lws(p) + WS_WTOUT) + ((size_t)l * 1024 + nq * 256) * 1024 + kt * 64, 1024, lds);
  }
}

DI void ph1_norm_rows(PR p, int l, int rb) {
  const int lane = ltid() & 63;
  const int r0 = rb * 4, ci = row_cond(r0);
  const float* mod = (const float*)(lws(p) + WS_MOD) + (size_t)(l * 5 + ci) * 3072;
  const float* ng = lin(p, 9) + l * 1024;
  const float* wba = (const float*)(lws(p) + WS_WBA) + (size_t)l * 16 * 1024;
  bf16_t* hn = (bf16_t*)(lws(p) + WS_R2);
  float h[4][16];
#pragma unroll
  for (int ri = 0; ri < 4; ++ri) {
    const float* x = x_in_row(p, l, r0 + ri);
#pragma unroll
    for (int i = 0; i < 4; ++i) {
      const f32x4 v = *(const f32x4*)(x + (i * 64 + lane) * 4);
#pragma unroll
      for (int e = 0; e < 4; ++e) h[ri][i * 4 + e] = v[e];
    }
  }
#pragma unroll
  for (int ri = 0; ri < 4; ++ri) {
    float ss = 0.f;
#pragma unroll
    for (int e = 0; e < 16; ++e) ss += h[ri][e] * h[ri][e];
    ss = wave_sum(ss);
    const float rstd = rsqrtf(ss * (1.f / 1024.f) + EPS);
#pragma unroll
    for (int i = 0; i < 4; ++i) {
      const int k = (i * 64 + lane) * 4;
      const f32x4 g = *(const f32x4*)(ng + k);
      const f32x4 sh = *(const f32x4*)(mod + k);
      const f32x4 sc = *(const f32x4*)(mod + 1024 + k);
#pragma unroll
      for (int e = 0; e < 4; ++e) h[ri][i * 4 + e] = h[ri][i * 4 + e] * rstd * g[e] * (1.f + sc[e]) + sh[e];
      u32x2 o = {pack2(h[ri][i * 4 + 0], h[ri][i * 4 + 1]), pack2(h[ri][i * 4 + 2], h[ri][i * 4 + 3])};
      *(u32x2*)(hn + (size_t)(r0 + ri) * 1024 + k) = o;
    }
  }
  float pt[64];
#pragma unroll
  for (int j = 0; j < 16; ++j) {
    float a0 = 0.f, a1 = 0.f, a2 = 0.f, a3 = 0.f;
#pragma unroll
    for (int i = 0; i < 4; ++i) {
      const f32x4 w = *(const f32x4*)(wba + j * 1024 + (i * 64 + lane) * 4);
#pragma unroll
      for (int e = 0; e < 4; ++e) {
        a0 += h[0][i * 4 + e] * w[e]; a1 += h[1][i * 4 + e] * w[e];
        a2 += h[2][i * 4 + e] * w[e]; a3 += h[3][i * 4 + e] * w[e];
      }
    }
    pt[j] = a0; pt[16 + j] = a1; pt[32 + j] = a2; pt[48 + j] = a3;
    if ((j & 3) == 3) asm volatile("" ::: "memory");
  }
#define BFLY(n) { const bool up = (lane & (n)) != 0; _Pragma("unroll") for (int i = 0; i < (n); ++i) { \
    const float keep = up ? pt[i + (n)] : pt[i]; const float send = up ? pt[i] : pt[i + (n)]; pt[i] = keep + __shfl_xor(send, (n)); } }
  BFLY(32) BFLY(16) BFLY(8) BFLY(4) BFLY(2) BFLY(1)
#undef BFLY
  const float v = pt[0];
  {
    const int ri = lane >> 4, j = lane & 15;
    float res;
    if (j < 8) res = 1.f / (1.f + __expf(-v));
    else {
      const int jj = j - 8;
      const float xx = v + lin(p, 26)[l * 8 + jj];
      const float sp = xx > 20.f ? xx : __logf(1.f + __expf(xx));
      res = -__expf(lin(p, 25)[l * 8 + jj]) * sp;
    }
    ((float*)(lws(p) + WS_BETAG))[(size_t)(r0 + ri) * 16 + j] = res;
  }
}

constexpr int G_STAGE = 49152;
DI void gemm_gload(int tid, const bf16_t* A, size_t lda, const bf16_t* B, size_t ldb, int k0, u32x4 (&ra)[4], u32x4 (&rb)[2]) {
#pragma unroll
  for (int i = 0; i < 4; ++i) { const int id = tid + NT * i, row = id >> 3, ch = id & 7; ra[i] = *(const u32x4*)(A + (size_t)row * lda + k0 + ch * 8); }
#pragma unroll
  for (int i = 0; i < 2; ++i) { const int id = tid + NT * i, row = id >> 3, ch = id & 7; rb[i] = *(const u32x4*)(B + (size_t)row * ldb + k0 + ch * 8); }
}
DI void gemm_lstore(int tid, char* st, const u32x4 (&ra)[4], const u32x4 (&rb)[2]) {
#pragma unroll
  for (int i = 0; i < 4; ++i) { const int id = tid + NT * i, row = id >> 3, ch = id & 7; *(u32x4*)(st + row * 128 + ((ch ^ ((row >> 1) & 7)) << 4)) = ra[i]; }
#pragma unroll
  for (int i = 0; i < 2; ++i) { const int id = tid + NT * i, row = id >> 3, ch = id & 7; *(u32x4*)(st + 32768 + row * 128 + ((ch ^ ((row >> 1) & 7)) << 4)) = rb[i]; }
}
template <bool TR = false> DI void gemm_compute(const char* st, f32x16 (&acc)[2][2], int wm, int wn, int lane) {
  const int r = lane & 31, h = lane >> 5, sw = (r >> 1) & 7;
#pragma unroll
  for (int s = 0; s < 4; ++s) {
    const int ch = ((2 * s + h) ^ sw) << 4;
    bf16x8 a[2], b[2];
#pragma unroll
    for (int mi = 0; mi < 2; ++mi) a[mi] = *(const bf16x8*)(st + (wm * 64 + mi * 32 + r) * 128 + ch);
#pragma unroll
    for (int ni = 0; ni < 2; ++ni) b[ni] = *(const bf16x8*)(st + 32768 + (wn * 64 + ni * 32 + r) * 128 + ch);
#pragma unroll
    for (int mi = 0; mi < 2; ++mi)
#pragma unroll
      for (int ni = 0; ni < 2; ++ni) acc[mi][ni] = TR ? MFMA32(b[ni], a[mi], acc[mi][ni]) : MFMA32(a[mi], b[ni], acc[mi][ni]);
  }
}
template <bool TR = false> DI void gemm_mainloop(int tid, const bf16_t* A, size_t lda, const bf16_t* B, size_t ldb, int K, f32x16 (&acc)[2][2], char* lds) {
  const int wave = tid >> 6, lane = tid & 63, wm = wave >> 1, wn = wave & 1;
  u32x4 ra[4], rb[2];
  gemm_gload(tid, A, lda, B, ldb, 0, ra, rb);
  gemm_lstore(tid, lds, ra, rb);
  __syncthreads();
  const int KT = K >> 6;
  for (int kt = 0; kt < KT; ++kt) {
    char* cur = lds + (kt & 1) * G_STAGE;
    char* nxt = lds + ((kt + 1) & 1) * G_STAGE;
    if (kt + 1 < KT) gemm_gload(tid, A, lda, B, ldb, (kt + 1) * 64, ra, rb);
    gemm_compute<TR>(cur, acc, wm, wn, lane);
    if (kt + 1 < KT) gemm_lstore(tid, nxt, ra, rb);
    __syncthreads();
  }
}
template <bool TR = false> DI void gemm_mainloop_dma(int tid, const bf16_t* A, size_t lda, const bf16_t* B, size_t ldb, int K, f32x16 (&acc)[2][2], char* lds) {
  const int wave = tid >> 6, lane = tid & 63, wm = wave >> 1, wn = wave & 1;
  const int wv = __builtin_amdgcn_readfirstlane(wave);
  const int prow = lane >> 3, pc = lane & 7;
  size_t offA[4], offB[2];
#pragma unroll
  for (int i = 0; i < 4; ++i) { const int row = 64 * i + 8 * wv + prow; offA[i] = (size_t)row * lda + ((pc ^ ((row >> 1) & 7)) << 3); }
#pragma unroll
  for (int i = 0; i < 2; ++i) { const int row = 64 * i + 8 * wv + prow; offB[i] = (size_t)row * ldb + ((pc ^ ((row >> 1) & 7)) << 3); }
  auto issue = [&](int kt, int stage) {
    char* st = lds + stage * G_STAGE;
#pragma unroll
    for (int i = 0; i < 4; ++i)
      __builtin_amdgcn_global_load_lds((const unsigned*)(A + offA[i] + kt * 64), (LAS unsigned*)(LAS char*)(st + (64 * i + 8 * wv) * 128), 16, 0, 0);
#pragma unroll
    for (int i = 0; i < 2; ++i)
      __builtin_amdgcn_global_load_lds((const unsigned*)(B + offB[i] + kt * 64), (LAS unsigned*)(LAS char*)(st + 32768 + (64 * i + 8 * wv) * 128), 16, 0, 0);
  };
  const int KT = K >> 6;
  issue(0, 0);
  issue(1, 1);
  int stage = 0;
  for (int kt = 0; kt < KT; ++kt) {
    if (kt + 1 < KT) asm volatile("s_waitcnt vmcnt(6)" ::: "memory"); else asm volatile("s_waitcnt vmcnt(0)" ::: "memory");
    __builtin_amdgcn_s_barrier();
    asm volatile("" ::: "memory");
    if (kt + 2 < KT) issue(kt + 2, stage == 0 ? 2 : stage - 1);
    gemm_compute<TR>(lds + stage * G_STAGE, acc, wm, wn, lane);
    stage = stage == 2 ? 0 : stage + 1;
  }
  __builtin_amdgcn_s_barrier();
  asm volatile("" ::: "memory");
}
DI void acc_zero(f32x16 (&acc)[2][2]) {
#pragma unroll
  for (int a = 0; a < 2; ++a)
#pragma unroll
    for (int b = 0; b < 2; ++b)
#pragma unroll
      for (int i = 0; i < 16; ++i) acc[a][b][i] = 0.f;
}
DI void tile_store_bf16(int tid, const f32x16 (&acc)[2][2], bf16_t* dst, size_t ldd, char* lds) {
  const int wave = tid >> 6, lane = tid & 63, wm = wave >> 1, wn = wave & 1;
  const int cl = lane & 31, h = lane >> 5;
#pragma unroll
  for (int mi = 0; mi < 2; ++mi)
#pragma unroll
    for (int ni = 0; ni < 2; ++ni)
#pragma unroll
      for (int i = 0; i < 16; ++i) {
        const int row = wm * 64 + mi * 32 + (i & 3) + 8 * (i >> 2) + 4 * h;
        const int col = wn * 64 + ni * 32 + cl;
        *(bf16_t*)(lds + row * 272 + col * 2) = f2bf(acc[mi][ni][i]);
      }
  __syncthreads();
#pragma unroll
  for (int i = 0; i < 8; ++i) {
    const int id = tid + NT * i, row = id >> 4, ch = id & 15;
    const u32x4 v = *(const u32x4*)(lds + row * 272 + ch * 16);
    *(u32x4*)(dst + (size_t)row * ldd + ch * 8) = v;
  }
  __syncthreads();
}

DI void ph2_inproj_tile(PR p, int l, int t, char* lds) {
  const int tid = ltid();
  const int nt = t & 63, mt = t >> 6;
  const int m0 = mt * 256, n0 = nt * 128;
  const bf16_t* A = (const bf16_t*)(lws(p) + WS_R2) + (size_t)m0 * 1024;
  const bf16_t* B = (const bf16_t*)(lws(p) + WS_R1) + (size_t)n0 * 1024;
  f32x16 acc[2][2];
  acc_zero(acc);
  gemm_mainloop(tid, A, 1024, B, 1024, 1024, acc, lds);
  if (m0 < 4096 && n0 >= C_KB && n0 < C_ZB) {
    const int wave = tid >> 6, lane = tid & 63, wm = wave >> 1, wn = wave & 1;
    float* base = lout(p) + (n0 < C_VB ? O_CK : O_CV);
    const int cb = (n0 < C_VB ? n0 - C_KB : n0 - C_VB);
#pragma unroll
    for (int mi = 0; mi < 2; ++mi)
#pragma unroll
      for (int ni = 0; ni < 2; ++ni)
#pragma unroll
        for (int i = 0; i < 16; ++i) {
          const int row = m0 + wm * 64 + mi * 32 + (i & 3) + 8 * (i >> 2) + 4 * (lane >> 5);
          const int col = cb + wn * 64 + ni * 32 + (lane & 31);
          const int b = row >> 8, tt = row & 255;
          base[((size_t)(b * 2 + l) * 256 + tt) * 512 + col] = acc[mi][ni][i];
        }
  }
  tile_store_bf16(tid, acc, (bf16_t*)(lws(p) + WS_PROJ) + (size_t)m0 * NP + n0, NP, lds);
}

DI void ph6_merge_tile(PR p, int l, int t, char* lds) {
  const int tid = ltid();
  const int nt = t & 7, mt = t >> 3;
  const int m0 = mt * 256, n0 = nt * 128;
  const int wave = tid >> 6, lane = tid & 63, wm = wave >> 1, wn = wave & 1, r = lane & 31, h = lane >> 5;
  const bf16_t* proj = (const bf16_t*)(lws(p) + WS_PROJ);
  unsigned tot[2][2][8];
#pragma unroll
  for (int a = 0; a < 2; ++a)
#pragma unroll
    for (int b = 0; b < 2; ++b)
#pragma unroll
      for (int i = 0; i < 8; ++i) tot[a][b][i] = 0u;
#pragma unroll 1
  for (int n = 0; n < 3; ++n) {
    const int acol = n == 0 ? C_UA : (n == 1 ? C_QB : C_QC);
    const bf16_t* A = proj + pjx(m0, acol);
    const bf16_t* B = (const bf16_t*)(lws(p) + WS_WTBR) + ((size_t)(l * 3 + n) * 1024 + n0) * 512;
    u32x2 gt[2][2][4];
#pragma unroll
    for (int mi = 0; mi < 2; ++mi)
#pragma unroll
      for (int ni = 0; ni < 2; ++ni)
#pragma unroll
        for (int g4 = 0; g4 < 4; ++g4)
          gt[mi][ni][g4] = *(const u32x2*)(proj + pjx(m0 + wm * 64 + mi * 32 + r, C_GT + n * 1024 + n0 + wn * 64 + ni * 32 + 8 * g4 + 4 * h));
    f32x16 acc[2][2];
    acc_zero(acc);
    gemm_mainloop_dma<true>(tid, A, PJ_LD, B, 512, 512, acc, lds);
#pragma unroll
    for (int mi = 0; mi < 2; ++mi)
#pragma unroll
      for (int ni = 0; ni < 2; ++ni)
#pragma unroll
        for (int g4 = 0; g4 < 4; ++g4) {
          const u32x2 g = gt[mi][ni][g4];
          const unsigned o0 = tot[mi][ni][2 * g4], o1 = tot[mi][ni][2 * g4 + 1];
          tot[mi][ni][2 * g4]     = pack2(lo_f(o0) + sigmoidf_(lo_f(g[0])) * acc[mi][ni][4 * g4 + 0], hi_f(o0) + sigmoidf_(hi_f(g[0])) * acc[mi][ni][4 * g4 + 1]);
          tot[mi][ni][2 * g4 + 1] = pack2(lo_f(o1) + sigmoidf_(lo_f(g[1])) * acc[mi][ni][4 * g4 + 2], hi_f(o1) + sigmoidf_(hi_f(g[1])) * acc[mi][ni][4 * g4 + 3]);
        }
  }
  bf16_t* dst = (bf16_t*)(lws(p) + WS_R2) + (size_t)m0 * 1024 + n0;
#pragma unroll
  for (int mi = 0; mi < 2; ++mi)
#pragma unroll
    for (int ni = 0; ni < 2; ++ni)
#pragma unroll
      for (int g4 = 0; g4 < 4; ++g4) {
        const int row = wm * 64 + mi * 32 + r, col = wn * 64 + ni * 32 + 8 * g4 + 4 * h;
        const u32x2 v = {tot[mi][ni][2 * g4], tot[mi][ni][2 * g4 + 1]};
        *(u32x2*)(lds + row * 272 + col * 2) = v;
      }
  __syncthreads();
#pragma unroll
  for (int i = 0; i < 8; ++i) {
    const int id = tid + NT * i, row = id >> 4, ch = id & 15;
    const u32x4 v = *(const u32x4*)(lds + row * 272 + ch * 16);
    *(u32x4*)(dst + (size_t)row * 1024 + ch * 8) = v;
  }
  __syncthreads();
}

DI void ph7_out_tile(PR p, int l, int t, char* lds) {
  const int tid = ltid();
  const int nt = t & 7, mt = t >> 3;
  const int m0 = mt * 256, n0 = nt * 128;
  const int wave = tid >> 6, lane = tid & 63, wm = wave >> 1, wn = wave & 1;
  const bf16_t* A = (const bf16_t*)(lws(p) + WS_R2) + (size_t)m0 * 1024;
  const bf16_t* B = (const bf16_t*)(lws(p) + WS_WTOUT) + ((size_t)l * 1024 + n0) * 1024;
  f32x4 xpre[16];
#pragma unroll
  for (int i = 0; i < 16; ++i) {
    const int id = tid + NT * i, row = id >> 5, c4 = (id & 31) * 4;
    xpre[i] = *(const f32x4*)(x_in_row(p, l, m0 + row) + n0 + c4);
  }
  f32x16 acc[2][2];
  acc_zero(acc);
  gemm_mainloop_dma<false>(tid, A, 1024, B, 1024, 1024, acc, lds);
  float* ct = (float*)lds;
#pragma unroll
  for (int mi = 0; mi < 2; ++mi)
#pragma unroll
    for (int ni = 0; ni < 2; ++ni)
#pragma unroll
      for (int i = 0; i < 16; ++i) {
        const int row = wm * 64 + mi * 32 + (i & 3) + 8 * (i >> 2) + 4 * (lane >> 5);
        const int col = wn * 64 + ni * 32 + (lane & 31);
        ct[row * 132 + col] = acc[mi][ni][i];
      }
  __syncthreads();
  const float* mod = (const float*)(lws(p) + WS_MOD) + (size_t)l * 5 * 3072;
#pragma unroll
  for (int i = 0; i < 16; ++i) {
    const int id = tid + NT * i, row = id >> 5, c4 = (id & 31) * 4;
    const int grow = m0 + row, gcol = n0 + c4;
    const f32x4 y = *(const f32x4*)(ct + row * 132 + c4);
    const f32x4 gate = *(const f32x4*)(mod + row_cond(grow) * 3072 + 2048 + gcol);
    const f32x4 xo = xpre[i];
    f32x4 o;
#pragma unroll
    for (int e = 0; e < 4; ++e) o[e] = xo[e] + gate[e] * y[e];
    *(f32x4*)(lout(p) + O_Y + (size_t)grow * DM + gcol) = o;
  }
  __syncthreads();
}

DI void ph_final_row(PR p, int r) {
  const int lane = ltid() & 63;
  float* x = lout(p) + O_Y + (size_t)r * DM;
  f32x4 v[4];
  float ss = 0.f;
#pragma unroll
  for (int i = 0; i < 4; ++i) { v[i] = *(const f32x4*)(x + (i * 64 + lane) * 4); ss += v[i][0] * v[i][0] + v[i][1] * v[i][1] + v[i][2] * v[i][2] + v[i][3] * v[i][3]; }
  ss = wave_sum(ss);
  const float rstd = rsqrtf(ss * (1.f / 1024.f) + EPS);
#pragma unroll
  for (int i = 0; i < 4; ++i) {
    const f32x4 g = *(const f32x4*)(lin(p, 30) + (i * 64 + lane) * 4);
    f32x4 o;
#pragma unroll
    for (int e = 0; e < 4; ++e) o[e] = v[i][e] * rstd * g[e];
    *(f32x4*)(x + (i * 64 + lane) * 4) = o;
  }
}

namespace pg8 {
#define PG8_LAS __attribute__((address_space(3)))
typedef unsigned short bf16_t;
typedef short bf16x8 __attribute__((ext_vector_type(8)));
typedef float f32x4 __attribute__((ext_vector_type(4)));
typedef unsigned u32x4 __attribute__((ext_vector_type(4)));
constexpr int BM = 256, BK = 64, HALF = 128, HTB = HALF * BK * 2  , STAGE_BYTES = 8 * HTB, NXCD = 8, WGM = 8;

__host__ __device__ __forceinline__ int lds_byte(int r, int c) { const int st = (r >> 4) * 2 + (c >> 5), rr = r & 15, cc = c & 31, ob = rr * 64 + cc * 2; return st * 1024 + (ob ^ (((ob >> 9) & 1) << 5)); }
__host__ __device__ __forceinline__ void stage_rc(int b, int& R, int& C) { const int st = b / 1024, sb = b % 1024, swz = sb ^ (((sb >> 9) & 1) << 5); R = (st >> 1) * 16 + swz / 64; C = (st & 1) * 32 + (swz % 64) / 2; }
__host__ __device__ __forceinline__ int perm32(int rho) { const int n = rho >> 4, i = rho & 15; return 8 * (i >> 2) + 4 * n + (i & 3); }

struct Unit { int pm, pn, grp; };
struct Gemm { const bf16_t* A; const bf16_t* Bt; int M, N, K, lda, ldb; };

struct StaticOrder {
    int nM, nN, nwg, G, c;
    __host__ __device__ void init(int M, int N, int G_, int c_) { nM = M / BM; nN = N / BM; nwg = nM * nN; G = G_; c = c_; }
    __host__ __device__ bool next(int i, Unit& u) const {
        const long L = (long)i * G + c; if (L >= nwg) return false;
        int wgid = (int)L; { const int q = nwg / NXCD, r = nwg % NXCD, xcd = wgid % NXCD, off = wgid / NXCD; wgid = (xcd < r ? xcd * (q + 1) : r * (q + 1) + (xcd - r) * q) + off; }
        const int nig = WGM * nN, gid = wgid / nig, fm = gid * WGM, gsz = (nM - fm) < WGM ? (nM - fm) : WGM;
        u.pm = fm + ((wgid % nig) % gsz); u.pn = (wgid % nig) / gsz; u.grp = 0; return true;
    }
    __device__ __forceinline__ void a_ready(const Unit&) const {}
    __device__ __forceinline__ void done(const Unit&) const {}
    __device__ __forceinline__ const char* a_base(const Gemm& g, const Unit& u, size_t tstepA) const { return (const char*)g.A + (size_t)u.pm * tstepA; }
    __device__ __forceinline__ const char* b_base(const Gemm& g, const Unit& u, size_t tstepB) const { return (const char*)g.Bt + (size_t)u.pn * tstepB; }
};

__device__ __forceinline__ unsigned cvt_pk_bf16(float lo, float hi) { unsigned r; asm volatile("v_cvt_pk_bf16_f32 %0, %1, %2" : "=v"(r) : "v"(lo), "v"(hi)); return r; }

template <class Epi, class Sched, bool STAMP = false>
__device__ __forceinline__ void gemm_phase(PG8_LAS unsigned char* lds, const Gemm g, const Sched& S, const Epi& E, unsigned long long* stamps) {
    const int tid = ltid(), wid = __builtin_amdgcn_readfirstlane(tid >> 6), lane = tid & 63, wr = wid >> 2, wc = wid & 3, fr = lane & 15, fq = lane >> 4;
    const int K = g.K, nt = K / BK;
    int ts_lo = 0, ts_hi = 0, nts = 0; const unsigned long long rt_entry = STAMP ? (unsigned long long)wall_clock64() : 0ull;
#define PG8_STAMP() do { if (STAMP && wid == 0 && nts < 64) { const unsigned long long _c = (unsigned long long)clock64(); \
        ts_lo = (lane == nts) ? (int)(unsigned)_c : ts_lo; ts_hi = (lane == nts) ? (int)(unsigned)(_c >> 32) : ts_hi; ++nts; } } while (0)
    PG8_STAMP();
    unsigned voffA[2], voffB[2];
#pragma unroll
    for (int i = 0; i < 2; ++i) { int R, C; stage_rc(tid * 16 + i * 8192, R, C); const int Rb = Epi::PERM ? ((R & ~31) + perm32(R & 31)) : R;
        voffA[i] = (unsigned)(R * g.lda + C) * 2u; voffB[i] = (unsigned)(Rb * g.ldb + C) * 2u; }
    const size_t kstep = (size_t)(BK * 2);
    const size_t hstepA = (size_t)HALF * g.lda * 2, hstepB = (size_t)HALF * g.ldb * 2;
    const size_t tstepA = 2 * hstepA, tstepB = 2 * hstepB;
    const unsigned ldsw = (unsigned)wid * 1024u;
    const int aoff = lds_byte(wr * 64 + fr, fq * 8), boff = lds_byte(wc * 32 + fr, fq * 8);
#define PG8_SA(b, h) (((b) * 2 + (h)) * HTB)
#define PG8_SB(b, h) ((4 + (b) * 2 + (h)) * HTB)
#define PG8_STAGE(bufoff, gbase, voff) do { _Pragma("unroll") for (int _i = 0; _i < 2; ++_i) \
        __builtin_amdgcn_global_load_lds((const unsigned*)((const char*)(gbase) + (voff)[_i]), (PG8_LAS unsigned*)(lds + (bufoff) + ldsw + _i * 8192), 16, 0, 0); } while (0)
#define PG8_LDA(dst, b, h) do { _Pragma("unroll") for (int m = 0; m < 4; ++m) _Pragma("unroll") for (int k = 0; k < 2; ++k) dst[m][k] = *(const PG8_LAS bf16x8*)(lds + PG8_SA(b, h) + aoff + m * 2048 + k * 1024); } while (0)
#define PG8_LDB(dst, b, h) do { _Pragma("unroll") for (int n = 0; n < 2; ++n) _Pragma("unroll") for (int k = 0; k < 2; ++k) dst[n][k] = *(const PG8_LAS bf16x8*)(lds + PG8_SB(b, h) + boff + n * 2048 + k * 1024); } while (0)
#define PG8_MMA(ai, bj, At, Bt) do { __builtin_amdgcn_s_setprio(1); _Pragma("unroll") for (int m = 0; m < 4; ++m) _Pragma("unroll") for (int n = 0; n < 2; ++n) _Pragma("unroll") for (int k = 0; k < 2; ++k) \
        acc[ai][bj][m][n] = __builtin_amdgcn_mfma_f32_16x16x32_bf16(Bt[n][k], At[m][k], acc[ai][bj][m][n], 0, 0, 0); __builtin_amdgcn_s_setprio(0); } while (0)
#define PG8_WAIT_V(n) asm volatile("s_waitcnt vmcnt(" #n ")" ::: "memory")
#define PG8_WAIT_L(n) asm volatile("s_waitcnt lgkmcnt(" #n ")" ::: "memory")
#define PG8_BAR __builtin_amdgcn_s_barrier()
#define PG8_SCHED __builtin_amdgcn_sched_barrier(0)
    Unit cur, nxt; int ui = 0;
    if (!S.next(0, cur)) return;
    f32x4 acc[2][2][4][2];
#pragma unroll
    for (int a = 0; a < 2; ++a)
#pragma unroll
        for (int b = 0; b < 2; ++b)
#pragma unroll
            for (int m = 0; m < 4; ++m)
#pragma unroll
                for (int n = 0; n < 2; ++n) acc[a][b][m][n] = (f32x4){0.f, 0.f, 0.f, 0.f};
    bf16x8 At[4][2], B0[2][2], B1[2][2];
    const char* cA = S.a_base(g, cur, tstepA); const char* cB = S.b_base(g, cur, tstepB);
    S.a_ready(cur);
    PG8_STAGE(PG8_SB(0, 0), cB, voffB); PG8_STAGE(PG8_SA(0, 0), cA, voffA); PG8_STAGE(PG8_SB(0, 1), cB + hstepB, voffB); PG8_STAGE(PG8_SA(0, 1), cA + hstepA, voffA);
    if (wr == 1) PG8_BAR;
    PG8_WAIT_V(4); PG8_BAR;
    PG8_STAGE(PG8_SB(1, 0), cB + kstep, voffB); PG8_STAGE(PG8_SA(1, 0), cA + kstep, voffA); PG8_STAGE(PG8_SB(1, 1), cB + hstepB + kstep, voffB);
    PG8_WAIT_V(6); PG8_BAR;
    PG8_STAMP();
    for (;;) {
        const bool has_next = S.next(ui + 1, nxt);
        const char* nA = has_next ? S.a_base(g, nxt, tstepA) : cA; const char* nB = has_next ? S.b_base(g, nxt, tstepB) : cB;
        for (int t = 0; t < nt; t += 2) {
            const bool last = (t == nt - 2);
            const char* a1 = cA + (size_t)(t + 1) * kstep;
            const char* a2 = last ? nA : cA + (size_t)(t + 2) * kstep; const char* b2 = last ? nB : cB + (size_t)(t + 2) * kstep;
            const char* a3 = a2 + kstep; const char* b3 = b2 + kstep;
            if (last && has_next) S.a_ready(nxt);
            PG8_LDB(B0, 0, 0); PG8_SCHED; PG8_LDA(At, 0, 0); PG8_STAGE(PG8_SA(1, 1), a1 + hstepA, voffA);
            PG8_WAIT_L(8); PG8_BAR; PG8_WAIT_L(0); PG8_MMA(0, 0, At, B0); PG8_BAR; PG8_SCHED;
            PG8_LDB(B1, 0, 1); PG8_STAGE(PG8_SB(0, 0), b2, voffB);
            PG8_BAR; PG8_WAIT_L(0); PG8_MMA(0, 1, At, B1); PG8_BAR;
            PG8_LDA(At, 0, 1); PG8_STAGE(PG8_SA(0, 0), a2, voffA);
            PG8_BAR; PG8_WAIT_L(0); PG8_MMA(1, 0, At, B0); PG8_BAR; PG8_SCHED;
            PG8_STAGE(PG8_SB(0, 1), b2 + hstepB, voffB);
            PG8_WAIT_V(6); PG8_BAR; PG8_MMA(1, 1, At, B1); PG8_BAR;
            PG8_LDB(B0, 1, 0); PG8_SCHED; PG8_LDA(At, 1, 0); PG8_STAGE(PG8_SA(0, 1), a2 + hstepA, voffA);
            PG8_WAIT_L(8); PG8_BAR; PG8_WAIT_L(0); PG8_MMA(0, 0, At, B0); PG8_BAR; PG8_SCHED;
            PG8_LDB(B1, 1, 1); PG8_STAGE(PG8_SB(1, 0), b3, voffB);
            PG8_BAR; PG8_WAIT_L(0); PG8_MMA(0, 1, At, B1); PG8_BAR;
            PG8_LDA(At, 1, 1); PG8_STAGE(PG8_SA(1, 0), a3, voffA);
            PG8_BAR; PG8_WAIT_L(0); PG8_MMA(1, 0, At, B0); PG8_BAR; PG8_SCHED;
            PG8_STAGE(PG8_SB(1, 1), b3 + hstepB, voffB);
            PG8_WAIT_V(6); PG8_BAR; PG8_MMA(1, 1, At, B1); PG8_BAR;
        }
        PG8_STAMP();
        if constexpr (!Epi::AFTER_DRAIN) { E(acc, cur, wr, wc, fr, fq); S.done(cur); }
        PG8_STAMP();
        if (!has_next) break;
#pragma unroll
        for (int a = 0; a < 2; ++a)
#pragma unroll
            for (int b = 0; b < 2; ++b)
#pragma unroll
                for (int m = 0; m < 4; ++m)
#pragma unroll
                    for (int n = 0; n < 2; ++n) acc[a][b][m][n] = (f32x4){0.f, 0.f, 0.f, 0.f};
        cur = nxt; cA = nA; cB = nB; ++ui;
    }
    PG8_WAIT_V(0);
    if (wr == 0) PG8_BAR;
    PG8_BAR;
    if constexpr (Epi::AFTER_DRAIN) { E.fused(acc, cur, wr, wc, fr, fq, lds, wid, lane); S.done(cur); }
    PG8_STAMP();
    if (STAMP && wid == 0) { stamps[lane] = lane < nts ? (((unsigned long long)(unsigned)ts_hi << 32) | (unsigned)ts_lo) : 0ull;
        if (lane == 62) stamps[62] = rt_entry; if (lane == 63) stamps[63] = (unsigned long long)wall_clock64(); }
#undef PG8_STAMP
#undef PG8_SA
#undef PG8_SB
#undef PG8_STAGE
#undef PG8_LDA
#undef PG8_LDB
#undef PG8_MMA
#undef PG8_WAIT_V
#undef PG8_WAIT_L
#undef PG8_BAR
#undef PG8_SCHED
}
}

struct EpiInproj {
  static constexpr bool PERM = true, AFTER_DRAIN = false;
  bf16_t* proj; float* out; int l;
  __device__ __forceinline__ void operator()(const pg8::f32x4 (&acc)[2][2][4][2], const pg8::Unit& u, int wr, int wc, int fr, int fq) const {
    int row0 = u.pm * 256 + wr * 64 + fr, col0 = u.pn * 256 + wc * 32 + 8 * fq;
    asm volatile("" : "+v"(row0), "+v"(col0));
    const bool cache = (u.pm < 16) && (u.pn >= 6) && (u.pn < 10);
    float* cbase = out + (u.pn < 8 ? O_CK : O_CV);
    const int ccol0 = col0 - (u.pn < 8 ? C_KB : C_VB);
#pragma unroll
    for (int ai = 0; ai < 2; ++ai)
#pragma unroll
      for (int m = 0; m < 4; ++m) {
        const int row = row0 + ai * 128 + m * 16;
        bf16_t* rowp = proj + pjx(row, col0);
#pragma unroll
        for (int bj = 0; bj < 2; ++bj) {
          const pg8::f32x4 v0 = acc[ai][bj][m][0], v1 = acc[ai][bj][m][1];
          const u32x4 w = {pack2(v0[0], v0[1]), pack2(v0[2], v0[3]), pack2(v1[0], v1[1]), pack2(v1[2], v1[3])};
          *(u32x4*)(rowp + bj * 128) = w;
          if (cache) {
            const int b = row >> 8, tt = row & 255;
            float* dst = cbase + ((size_t)(b * 2 + l) * 256 + tt) * 512 + ccol0 + bj * 128;
            *(f32x4*)dst = v0; *(f32x4*)(dst + 4) = v1;
          }
        }
      }
  }
};
DI void run_inproj8(PR p, int l) {
  pg8::Gemm g;
  g.A = (const bf16_t*)(lws(p) + WS_R2); g.Bt = (const bf16_t*)(lws(p) + WS_R1); g.M = MROWS; g.N = NP; g.K = 1024; g.lda = 1024; g.ldb = 1024;
  pg8::StaticOrder S; S.init(MROWS, NP, (int)gridDim.x, (int)blockIdx.x);
  EpiInproj E; E.proj = (bf16_t*)(lws(p) + WS_PROJ); E.out = lout(p); E.l = l;
  pg8::gemm_phase<EpiInproj, pg8::StaticOrder, false>((LAS unsigned char*)smem, g, S, E, nullptr);
}

struct MergeOrder {
  int c;
  const bf16_t* proj; const bf16_t* wbr;
  __device__ __forceinline__ bool next(int i, pg8::Unit& u) const {
    if (c >= 128 || i >= 3) return false;
    u.pm = c >> 2; u.pn = c & 3; u.grp = i; return true;
  }
  __device__ __forceinline__ void a_ready(const pg8::Unit&) const {}
  __device__ __forceinline__ void done(const pg8::Unit&) const {}
  __device__ __forceinline__ const char* a_base(const pg8::Gemm&, const pg8::Unit& u, size_t tstepA) const {
    const int acol = u.grp == 0 ? C_UA : (u.grp == 1 ? C_QB : C_QC);
    return (const char*)(proj + pjx(0, acol)) + (size_t)u.pm * tstepA;
  }
  __device__ __forceinline__ const char* b_base(const pg8::Gemm&, const pg8::Unit& u, size_t tstepB) const {
    return (const char*)(wbr + (size_t)u.grp * 1024 * 512) + (size_t)u.pn * tstepB;
  }
};
struct EpiMerge {
  static constexpr bool PERM = true, AFTER_DRAIN = false;
  const bf16_t* proj; bf16_t* mixed;
  __device__ __forceinline__ void operator()(const pg8::f32x4 (&acc)[2][2][4][2], const pg8::Unit& u, int wr, int wc, int fr, int fq) const {
    int row0 = u.pm * 256 + wr * 64 + fr, col0 = u.pn * 256 + wc * 32 + 8 * fq;
    asm volatile("" : "+v"(row0), "+v"(col0));
#pragma unroll
    for (int ai = 0; ai < 2; ++ai)
#pragma unroll
      for (int m = 0; m < 4; ++m) {
        const int row = row0 + ai * 128 + m * 16;
#pragma unroll
        for (int bj = 0; bj < 2; ++bj) {
          const int col = col0 + bj * 128;
          const u32x4 gg = *(const u32x4*)(proj + pjx(row, C_GT + u.grp * 1024 + col));
          bf16_t* mp = mixed + (size_t)row * 1024 + col;
          u32x4 prev = {0u, 0u, 0u, 0u};
          if (u.grp > 0) {
            const unsigned long long p0 = __hip_atomic_load((const unsigned long long*)mp, __ATOMIC_RELAXED, __HIP_MEMORY_SCOPE_AGENT);
            const unsigned long long p1 = __hip_atomic_load((const unsigned long long*)mp + 1, __ATOMIC_RELAXED, __HIP_MEMORY_SCOPE_AGENT);
            prev = u32x4{(unsigned)p0, (unsigned)(p0 >> 32), (unsigned)p1, (unsigned)(p1 >> 32)};
          }
          const pg8::f32x4 v0 = acc[ai][bj][m][0], v1 = acc[ai][bj][m][1];
          u32x4 w;
          w[0] = pack2(lo_f(prev[0]) + sigmoidf_(lo_f(gg[0])) * v0[0], hi_f(prev[0]) + sigmoidf_(hi_f(gg[0])) * v0[1]);
          w[1] = pack2(lo_f(prev[1]) + sigmoidf_(lo_f(gg[1])) * v0[2], hi_f(prev[1]) + sigmoidf_(hi_f(gg[1])) * v0[3]);
          w[2] = pack2(lo_f(prev[2]) + sigmoidf_(lo_f(gg[2])) * v1[0], hi_f(prev[2]) + sigmoidf_(hi_f(gg[2])) * v1[1]);
          w[3] = pack2(lo_f(prev[3]) + sigmoidf_(lo_f(gg[3])) * v1[2], hi_f(prev[3]) + sigmoidf_(hi_f(gg[3])) * v1[3]);
          *(u32x4*)mp = w;
        }
        asm volatile("" ::: "memory");
      }
  }
};
DI void run_merge8(PR p, int l) {
  pg8::Gemm g;
  g.A = (const bf16_t*)(lws(p) + WS_PROJ); g.Bt = (const bf16_t*)(lws(p) + WS_WTBR) + (size_t)l * 3 * 1024 * 512;
  g.M = MROWS; g.N = 1024; g.K = 512; g.lda = PJ_LD; g.ldb = 512;
  MergeOrder S; S.c = (int)blockIdx.x; S.proj = g.A; S.wbr = g.Bt;
  EpiMerge E; E.proj = g.A; E.mixed = (bf16_t*)(lws(p) + WS_R2);
  pg8::gemm_phase<EpiMerge, MergeOrder, false>((LAS unsigned char*)smem, g, S, E, nullptr);
}
struct OutOrder {
  int c;
  __device__ __forceinline__ bool next(int i, pg8::Unit& u) const { if (c >= 128 || i >= 1) return false; u.pm = c >> 2; u.pn = c & 3; u.grp = 0; return true; }
  __device__ __forceinline__ void a_ready(const pg8::Unit&) const {}
  __device__ __forceinline__ void done(const pg8::Unit&) const {}
  __device__ __forceinline__ const char* a_base(const pg8::Gemm& g, const pg8::Unit& u, size_t tstepA) const { return (const char*)g.A + (size_t)u.pm * tstepA; }
  __device__ __forceinline__ const char* b_base(const pg8::Gemm& g, const pg8::Unit& u, size_t tstepB) const { return (const char*)g.Bt + (size_t)u.pn * tstepB; }
};
struct EpiOut {
  static constexpr bool PERM = false, AFTER_DRAIN = false;
  const float* x0; const float* x1; const float* xo; float* out; const float* mod; int l;
  __device__ __forceinline__ void operator()(const pg8::f32x4 (&acc)[2][2][4][2], const pg8::Unit& u, int wr, int wc, int fr, int fq) const {
    int row0 = u.pm * 256 + wr * 64 + fr, col0 = u.pn * 256 + wc * 32 + 4 * fq;
    asm volatile("" : "+v"(row0), "+v"(col0));
#pragma unroll
    for (int ai = 0; ai < 2; ++ai)
#pragma unroll
      for (int m = 0; m < 4; ++m) {
        const int row = row0 + ai * 128 + m * 16;
        const float* xr = l == 0 ? (row < 4096 ? x0 + (size_t)row * DM : x1 + (size_t)(row - 4096) * DM) : xo + (size_t)row * DM;
        const float* gr = mod + row_cond(row) * 3072 + 2048;
        float* orow_ = out + (size_t)row * DM;
#pragma unroll
        for (int bj = 0; bj < 2; ++bj)
#pragma unroll
          for (int n = 0; n < 2; ++n) {
            const int col = col0 + bj * 128 + n * 16;
            const pg8::f32x4 xv = *(const pg8::f32x4*)(xr + col), gv = *(const pg8::f32x4*)(gr + col);
            *(pg8::f32x4*)(orow_ + col) = xv + gv * acc[ai][bj][m][n];
          }
      }
  }
};
DI void run_out8(PR p, int l) {
  pg8::Gemm g;
  g.A = (const bf16_t*)(lws(p) + WS_R2); g.Bt = (const bf16_t*)(lws(p) + WS_WTOUT) + (size_t)l * 1024 * 1024;
  g.M = MROWS; g.N = 1024; g.K = 1024; g.lda = 1024; g.ldb = 1024;
  OutOrder S; S.c = (int)blockIdx.x;
  EpiOut E; E.x0 = lin(p, 0); E.x1 = lin(p, 1); E.xo = lout(p) + O_Y; E.out = lout(p) + O_Y; E.mod = (const float*)(lws(p) + WS_MOD) + (size_t)l * 5 * 3072; E.l = l;
  pg8::gemm_phase<EpiOut, OutOrder, false>((LAS unsigned char*)smem, g, S, E, nullptr);
}

constexpr int S5_WLDS = 8192 + 4352;
DI void s5_wg_task(PR p, int l, int s, int d, int g, char* lds) {
  const int tid = ltid(), wave = tid >> 6, lane = tid & 63, q = lane >> 4, c = lane & 15;
  const int ldg = (l * 2 + d) * 32 + g;
  const int R0 = seq_row0(s), T = seq_len(s);
  const int seg = T >> 3, nb = seg >> 4, n0 = wave * seg;
  char* wl = lds + wave * S5_WLDS;
  float* BU = (float*)wl;
  char* H = wl + 8192;
  float* xch = (float*)(lds + 8 * S5_WLDS);
  const bf16_t* proj = (const bf16_t*)(lws(p) + WS_PROJ);
  bf16_t* yd = (bf16_t*)(lws(p) + WS_R2) + (size_t)d * MROWS * 512;
  const bf16_t* bb = (const bf16_t*)(lws(p) + WS_S5BB) + (size_t)ldg * 128 * 16;
  const bf16_t* ct = (const bf16_t*)(lws(p) + WS_S5CT) + (size_t)ldg * 16 * 128;
  bf16x8 bfr[8], cfr[4];
  const bf16x8 zero8 = {0, 0, 0, 0, 0, 0, 0, 0};
#pragma unroll
  for (int nt = 0; nt < 8; ++nt) bfr[nt] = q < 2 ? *(const bf16x8*)(bb + (nt * 16 + c) * 16 + 8 * q) : zero8;
#pragma unroll
  for (int ks = 0; ks < 4; ++ks) cfr[ks] = *(const bf16x8*)(ct + c * 128 + 32 * ks + 8 * q);
  const float ar = ((const float*)(lws(p) + WS_S5AR))[ldg * 64 + lane];
  const float ai = ((const float*)(lws(p) + WS_S5AI))[ldg * 64 + lane];
  float h0r = 0.f, h0i = 0.f;
  if (s >= 16) {
    const size_t si = ((((size_t)(s - 16) * 2 + l) * 2 + d) * 32 + g) * 64 + lane;
    h0r = lin(p, 4)[si]; h0i = lin(p, 5)[si];
  }
  auto load_u = [&](int blk) -> bf16x8 {
    const int n = n0 + blk * 16 + c;
    const int t = d ? (T - 1 - n) : n;
    if (q < 2) return *(const bf16x8*)(proj + pjx(R0 + t, C_UA + g * 16 + 8 * q));
    return zero8;
  };
  float hr = 0.f, hi = 0.f;
  auto bu_block = [&](const bf16x8& u) {
#pragma unroll
    for (int nt = 0; nt < 8; ++nt) {
      f32x4 z = {0.f, 0.f, 0.f, 0.f};
      const f32x4 dv = MFMA16(u, bfr[nt], z);
#pragma unroll
      for (int r = 0; r < 4; ++r) BU[(4 * q + r) * 128 + nt * 16 + c] = dv[r];
    }
  };
  {
    bf16x8 ucur = load_u(0);
#pragma unroll 1
    for (int blk = 0; blk < nb; ++blk) {
      bf16x8 unext = zero8;
      if (blk + 1 < nb) unext = load_u(blk + 1);
      bu_block(ucur);
#pragma unroll
      for (int i = 0; i < 16; ++i) {
        const float br = BU[i * 128 + lane], bi = BU[i * 128 + 64 + lane];
        const float nr = ar * hr - ai * hi + br;
        const float ni = ar * hi + ai * hr + bi;
        hr = nr; hi = ni;
      }
      ucur = unext;
    }
  }
  xch[(wave * 2 + 0) * 64 + lane] = hr;
  xch[(wave * 2 + 1) * 64 + lane] = hi;
  float pr = ar, pi = ai;
  const int nsq = T == 1024 ? 7 : 5;
  for (int k = 0; k < nsq; ++k) { const float t0 = pr * pr - pi * pi, t1 = 2.f * pr * pi; pr = t0; pi = t1; }
  __syncthreads();
  hr = h0r; hi = h0i;
  for (int v = 0; v < wave; ++v) {
    const float er = xch[(v * 2 + 0) * 64 + lane], ei = xch[(v * 2 + 1) * 64 + lane];
    const float nr = pr * hr - pi * hi + er, ni = pr * hi + pi * hr + ei;
    hr = nr; hi = ni;
  }
  {
    bf16x8 ucur = load_u(0);
#pragma unroll 1
    for (int blk = 0; blk < nb; ++blk) {
      bf16x8 unext = zero8;
      if (blk + 1 < nb) unext = load_u(blk + 1);
      bu_block(ucur);
#pragma unroll
      for (int i = 0; i < 16; ++i) {
        const float br = BU[i * 128 + lane], bi = BU[i * 128 + 64 + lane];
        const float nr = ar * hr - ai * hi + br;
        const float ni = ar * hi + ai * hr + bi;
        hr = nr; hi = ni;
        *(bf16_t*)(H + i * 272 + lane * 2) = f2bf(hr);
        *(bf16_t*)(H + i * 272 + 128 + lane * 2) = f2bf(hi);
      }
      f32x4 y = {0.f, 0.f, 0.f, 0.f};
#pragma unroll
      for (int ks = 0; ks < 4; ++ks) {
        const bf16x8 a = *(const bf16x8*)(H + c * 272 + (32 * ks + 8 * q) * 2);
        y = MFMA16(a, cfr[ks], y);
      }
#pragma unroll
      for (int r = 0; r < 4; ++r) {
        const int n = n0 + blk * 16 + 4 * q + r;
        const int t = d ? (T - 1 - n) : n;
        yd[(size_t)(R0 + t) * 512 + g * 16 + c] = f2bf(y[r]);
      }
      ucur = unext;
    }
  }
  if (s < 16 && wave == 7) {
    const size_t so = ((((size_t)s * 2 + l) * 2 + d) * 32 + g) * 64 + lane;
    lout(p)[O_SR + so] = hr; lout(p)[O_SI + so] = hi;
  }
  __syncthreads();
}

DI float gelu_tanh(float x) {
  const float z = 0.7978845608028654f * (x + 0.044715f * x * x * x);
  const float e = __expf(2.f * z);
  const float th = 1.f - 2.f / (e + 1.f);
  return 0.5f * x * (1.f + th);
}
DI void glu_tile(PR p, int l, int t, char* lds, bool dry) {
  const int tid = ltid(), wave = tid >> 6, lane = tid & 63;
  const int m0 = t * 32;
  float* Yf = (float*)lds;
  char* Ya = lds + 66048;
  bf16_t* proj = (bf16_t*)(lws(p) + WS_PROJ);
  const bf16_t* yd0 = (const bf16_t*)(lws(p) + WS_R2);
  const bf16_t* yd1 = yd0 + (size_t)MROWS * 512;
  const float* s5d = lin(p, 20) + l * 512;
  {
    const int row = tid >> 4;
#pragma unroll
    for (int i = 0; i < 4; ++i) {
      const int c0 = (tid & 15) * 8 + 128 * i;
      const u32x4 uu = *(const u32x4*)(proj + pjx(m0 + row, C_UA + c0));
      const u32x4 a0 = *(const u32x4*)(yd0 + (size_t)(m0 + row) * 512 + c0);
      const u32x4 a1 = *(const u32x4*)(yd1 + (size_t)(m0 + row) * 512 + c0);
      float y[8];
#pragma unroll
      for (int e = 0; e < 4; ++e) {
        y[2 * e]     = gelu_tanh(s5d[c0 + 2 * e] * lo_f(uu[e]) + lo_f(a0[e]) + lo_f(a1[e]));
        y[2 * e + 1] = gelu_tanh(s5d[c0 + 2 * e + 1] * hi_f(uu[e]) + hi_f(a0[e]) + hi_f(a1[e]));
      }
#pragma unroll
      for (int e = 0; e < 8; ++e) Yf[row * 516 + c0 + e] = y[e];
      const u32x4 o = {pack2(y[0], y[1]), pack2(y[2], y[3]), pack2(y[4], y[5]), pack2(y[6], y[7])};
      const int ch = c0 >> 3;
      *(u32x4*)(Ya + row * 1024 + ((ch ^ (row & 15)) << 4)) = o;
    }
  }
  __syncthreads();
  const int r = lane & 31, h = lane >> 5;
  const bf16_t* W = (const bf16_t*)(lws(p) + WS_WTGLU) + (size_t)l * 512 * 512;
  f32x16 acc[2];
#pragma unroll
  for (int i = 0; i < 16; ++i) { acc[0][i] = 0.f; acc[1][i] = 0.f; }
#pragma unroll 4
  for (int s = 0; s < 32; ++s) {
    const int ch = 2 * s + h;
    const bf16x8 a = *(const bf16x8*)(Ya + r * 1024 + ((ch ^ (r & 15)) << 4));
#pragma unroll
    for (int ni = 0; ni < 2; ++ni) {
      const bf16x8 b = *(const bf16x8*)(W + (size_t)(wave * 64 + ni * 32 + r) * 512 + ch * 8);
      acc[ni] = MFMA32(a, b, acc[ni]);
    }
  }
#pragma unroll
  for (int ni = 0; ni < 2; ++ni)
#pragma unroll
    for (int i = 0; i < 16; ++i) {
      const int row = (i & 3) + 8 * (i >> 2) + 4 * h;
      const int col = wave * 64 + ni * 32 + r;
      const float y = Yf[row * 516 + col];
      const float z = bf2f(proj[pjx(m0 + row, C_ZA + col)]);
      const bf16_t ov = f2bf(y * sigmoidf_(acc[ni][i]) * siluf_(z));
      if (!dry) proj[pjx(m0 + row, C_UA + col)] = ov; else asm volatile("" :: "v"((unsigned)ov));
    }
  __syncthreads();
}

DI void ph5_row(PR p, int l, int r) {
  const int lane = ltid() & 63;
  const int c0 = lane * 8;
  bf16_t* proj = (bf16_t*)(lws(p) + WS_PROJ);
  const bf16_t* o0 = (const bf16_t*)(lws(p) + WS_R1);
  const bf16_t* o1 = o0 + (size_t)MROWS * 512;
  const u32x4 a = *(const u32x4*)(o0 + (size_t)r * 512 + c0);
  const u32x4 b = *(const u32x4*)(o1 + (size_t)r * 512 + c0);
  const u32x4 zz = *(const u32x4*)(proj + pjx(r, C_ZC + c0));
  float o[8];
  float ss = 0.f;
#pragma unroll
  for (int e = 0; e < 4; ++e) {
    o[2 * e] = lo_f(a[e]) + lo_f(b[e]); o[2 * e + 1] = hi_f(a[e]) + hi_f(b[e]);
    ss += o[2 * e] * o[2 * e] + o[2 * e + 1] * o[2 * e + 1];
  }
#pragma unroll
  for (int off = 1; off <= 8; off <<= 1) ss += __shfl_xor(ss, off);
  const float rstd = rsqrtf(ss * (1.f / 128.f) + EPS);
  const float* g = lin(p, 27) + l * 128 + (c0 & 127);
  float v[8];
#pragma unroll
  for (int e = 0; e < 4; ++e) {
    v[2 * e] = o[2 * e] * rstd * g[2 * e] * siluf_(lo_f(zz[e]));
    v[2 * e + 1] = o[2 * e + 1] * rstd * g[2 * e + 1] * siluf_(hi_f(zz[e]));
  }
  const u32x4 w = {pack2(v[0], v[1]), pack2(v[2], v[3]), pack2(v[4], v[5]), pack2(v[6], v[7])};
  *(u32x4*)(proj + pjx(r, C_QC + c0)) = w;
}

constexpr int AT_K = 8192, AT_STAGE = 16384;
DI void att_gload(int tid, PR p, int l, int s, int h, int kt, u32x4& ka, u32x4& kb, u32x4& va, u32x4& vb) {
  const int key = tid >> 4, ch = tid & 15;
  const int j = kt * 32 + key;
  const int R0 = seq_row0(s);
  const bf16_t* proj = (const bf16_t*)(lws(p) + WS_PROJ);
  if (s < 16 || j < 1024) {
    const bf16_t* kr = proj + pjx(R0 + j, C_KB + h * 128);
    ka = *(const u32x4*)(kr + ch * 8);
    kb = *(const u32x4*)(kr + (ch ^ 2) * 8);
    va = *(const u32x4*)(proj + pjx(R0 + j, C_VB + h * 128 + ch * 8));
    vb = va;
  } else {
    const int b = s - 16, jc = j - 1024;
    const float* kc = lin(p, 2) + (((size_t)(b * 2 + l) * 512 + jc) * 4 + h) * 128 + ch * 8;
    const float* vc = lin(p, 3) + (((size_t)(b * 2 + l) * 512 + jc) * 4 + h) * 128 + ch * 8;
    ka = *(const u32x4*)kc; kb = *(const u32x4*)(kc + 4);
    va = *(const u32x4*)vc; vb = *(const u32x4*)(vc + 4);
  }
}
DI void att_lstore(int tid, PR p, int s, int kt, const u32x4& ka, const u32x4& kb, const u32x4& va, const u32x4& vb, char* stage) {
  const int key = tid >> 4, ch = tid & 15;
  const int j = kt * 32 + key;
  u32x4 ko, vo;
  if (s < 16) { ko = ka; vo = va; }
  else if (j < 1024) {
    const int pos = (ch & 4) ? (j & 63) : (j >> 6);
    const float* rc = (const float*)(lws(p) + WS_ROPE) + pos * 16 + (ch & 1) * 8;
    const float sg = (ch & 2) ? 1.f : -1.f;
    float o[8];
#pragma unroll
    for (int e = 0; e < 4; ++e) {
      const float c0 = rc[2 * e], c1 = rc[2 * e + 1], s0 = rc[1024 + 2 * e], s1 = rc[1024 + 2 * e + 1];
      o[2 * e]     = lo_f(ka[e]) * c0 + sg * lo_f(kb[e]) * s0;
      o[2 * e + 1] = hi_f(ka[e]) * c1 + sg * hi_f(kb[e]) * s1;
    }
    ko = u32x4{pack2(o[0], o[1]), pack2(o[2], o[3]), pack2(o[4], o[5]), pack2(o[6], o[7])};
    vo = va;
  } else {
    ko = u32x4{pack2(__uint_as_float(ka[0]), __uint_as_float(ka[1])), pack2(__uint_as_float(ka[2]), __uint_as_float(ka[3])),
               pack2(__uint_as_float(kb[0]), __uint_as_float(kb[1])), pack2(__uint_as_float(kb[2]), __uint_as_float(kb[3]))};
    vo = u32x4{pack2(__uint_as_float(va[0]), __uint_as_float(va[1])), pack2(__uint_as_float(va[2]), __uint_as_float(va[3])),
               pack2(__uint_as_float(vb[0]), __uint_as_float(vb[1])), pack2(__uint_as_float(vb[2]), __uint_as_float(vb[3]))};
  }
  *(u32x4*)(stage + key * 256 + ((ch ^ (key & 15)) << 4)) = ko;
  const int et = ch >> 1, hf = ch & 1;
  *(u32x4*)(stage + AT_K + key * 256 + ((((et ^ (key & 7)) << 1) | hf) << 4)) = vo;
}

DI void att_task(PR p, int l, int s, int h, int qb, char* lds, bool dry) {
  const int tid = ltid(), wave = tid >> 6, lane = tid & 63, q = lane >> 4, c = lane & 15;
  const int R0 = seq_row0(s), T = seq_len(s);
  const int nkeys = s < 16 ? 256 : 1536, nkt = nkeys >> 5;
  bf16_t* proj = (bf16_t*)(lws(p) + WS_PROJ);
  const int tq = qb * 128 + wave * 16 + c;
  const int qrow_i = R0 + tq;
  bf16x8 qf[2][2];
#pragma unroll
  for (int m = 0; m < 2; ++m)
#pragma unroll
    for (int ks = 0; ks < 2; ++ks) {
      const int d0 = 32 * ks + 8 * q;
      const u32x4 own = *(const u32x4*)(proj + pjx(qrow_i, C_QB + h * 128 + m * 64 + d0));
      float o[8];
      if (s >= 16) {
        const u32x4 par = *(const u32x4*)(proj + pjx(qrow_i, C_QB + h * 128 + m * 64 + (d0 ^ 16)));
        const int pos = ks ? (tq & 63) : (tq >> 6);
        const float* rc = (const float*)(lws(p) + WS_ROPE) + pos * 16 + (q & 1) * 8;
        const float sg = (q & 2) ? 1.f : -1.f;
#pragma unroll
        for (int e = 0; e < 4; ++e) {
          o[2 * e]     = lo_f(own[e]) * rc[2 * e] + sg * lo_f(par[e]) * rc[1024 + 2 * e];
          o[2 * e + 1] = hi_f(own[e]) * rc[2 * e + 1] + sg * hi_f(par[e]) * rc[1024 + 2 * e + 1];
        }
      } else {
#pragma unroll
        for (int e = 0; e < 4; ++e) { o[2 * e] = lo_f(own[e]); o[2 * e + 1] = hi_f(own[e]); }
      }
      qf[m][ks] = mk8(pack2(o[0] * 0.125f, o[1] * 0.125f), pack2(o[2] * 0.125f, o[3] * 0.125f),
                      pack2(o[4] * 0.125f, o[5] * 0.125f), pack2(o[6] * 0.125f, o[7] * 0.125f));
    }
  f32x4 O[2][8];
#pragma unroll
  for (int m = 0; m < 2; ++m)
#pragma unroll
    for (int et = 0; et < 8; ++et) O[m][et] = f32x4{0.f, 0.f, 0.f, 0.f};
  float mx[2] = {-1e30f, -1e30f}, lsum[2] = {0.f, 0.f};

  u32x4 Aa, Ab, Ac, Ad, Ba, Bb, Bc, Bd;
  att_gload(tid, p, l, s, h, 0, Aa, Ab, Ac, Ad);
  __syncthreads();
  att_lstore(tid, p, s, 0, Aa, Ab, Ac, Ad, lds);
  att_gload(tid, p, l, s, h, 1, Aa, Ab, Ac, Ad);
  __syncthreads();
  auto compute = [&](const char* cur) {
    f32x4 S[2][2];
#pragma unroll
    for (int m = 0; m < 2; ++m)
#pragma unroll
      for (int k2 = 0; k2 < 2; ++k2) {
        f32x4 acc = {0.f, 0.f, 0.f, 0.f};
#pragma unroll
        for (int ks = 0; ks < 2; ++ks) {
          const int key = k2 * 16 + c;
          const bf16x8 a = *(const bf16x8*)(cur + key * 256 + (((m * 8 + ks * 4 + q) ^ (key & 15)) << 4));
          acc = MFMA16(a, qf[m][ks], acc);
        }
        S[m][k2] = acc;
      }
    bf16x8 pf[2];
#pragma unroll
    for (int m = 0; m < 2; ++m) {
      float tm = fmaxf(fmaxf(fmaxf(S[m][0][0], S[m][0][1]), fmaxf(S[m][0][2], S[m][0][3])),
                       fmaxf(fmaxf(S[m][1][0], S[m][1][1]), fmaxf(S[m][1][2], S[m][1][3])));
      tm = fmaxf(tm, __shfl_xor(tm, 16));
      tm = fmaxf(tm, __shfl_xor(tm, 32));
      const float mn = fmaxf(mx[m], tm);
      const float alpha = __expf(mx[m] - mn);
      mx[m] = mn;
      float pv[8], ps = 0.f;
#pragma unroll
      for (int k2 = 0; k2 < 2; ++k2)
#pragma unroll
        for (int r = 0; r < 4; ++r) { pv[k2 * 4 + r] = __expf(S[m][k2][r] - mn); ps += pv[k2 * 4 + r]; }
      lsum[m] = lsum[m] * alpha + ps;
#pragma unroll
      for (int et = 0; et < 8; ++et) O[m][et] *= alpha;
      pf[m] = mk8(pack2(pv[0], pv[1]), pack2(pv[2], pv[3]), pack2(pv[4], pv[5]), pack2(pv[6], pv[7]));
    }
    {
      const int qq = c >> 2, pp = c & 3;
      const int kA = 4 * q + qq, kB = 16 + 4 * q + qq;
#pragma unroll
      for (int et = 0; et < 8; ++et) {
        const char* aA = cur + AT_K + kA * 256 + (((et ^ (kA & 7)) << 5)) + pp * 8;
        const char* aB = cur + AT_K + kB * 256 + (((et ^ (kB & 7)) << 5)) + pp * 8;
        const s16x4 lo = __builtin_amdgcn_ds_read_tr16_b64_v4i16((s16x4 LAS*)(const LAS char*)aA);
        const s16x4 hi = __builtin_amdgcn_ds_read_tr16_b64_v4i16((s16x4 LAS*)(const LAS char*)aB);
        const bf16x8 vf = __builtin_shufflevector(lo, hi, 0, 1, 2, 3, 4, 5, 6, 7);
        O[0][et] = MFMA16(vf, pf[0], O[0][et]);
        O[1][et] = MFMA16(vf, pf[1], O[1][et]);
      }
    }
  };
#pragma unroll 1
  for (int kt = 0; kt < nkt; kt += 2) {
    if (kt + 2 < nkt) att_gload(tid, p, l, s, h, kt + 2, Ba, Bb, Bc, Bd);
    compute(lds);
    att_lstore(tid, p, s, kt + 1, Aa, Ab, Ac, Ad, lds + AT_STAGE);
    __syncthreads();
    if (kt + 3 < nkt) att_gload(tid, p, l, s, h, kt + 3, Aa, Ab, Ac, Ad);
    compute(lds + AT_STAGE);
    if (kt + 2 < nkt) att_lstore(tid, p, s, kt + 2, Ba, Bb, Bc, Bd, lds);
    __syncthreads();
  }
#pragma unroll
  for (int m = 0; m < 2; ++m) { lsum[m] += __shfl_xor(lsum[m], 16); lsum[m] += __shfl_xor(lsum[m], 32); }
  const float lam = ((const float*)(lws(p) + WS_LAM))[l];
  const float lam_init = 0.8f - 0.6f * expf(-0.3f * (float)l);
  const float i0 = 1.f / lsum[0], i1 = lam / lsum[1];
  float ss = 0.f;
#pragma unroll
  for (int et = 0; et < 8; ++et)
#pragma unroll
    for (int r = 0; r < 4; ++r) { const float o = O[0][et][r] * i0 - O[1][et][r] * i1; O[0][et][r] = o; ss += o * o; }
  ss += __shfl_xor(ss, 16); ss += __shfl_xor(ss, 32);
  const float rstd = rsqrtf(ss * (1.f / 128.f) + EPS) * (1.f - lam_init);
  const float* g = lin(p, 23) + l * 128;
#pragma unroll
  for (int et = 0; et < 8; ++et) {
    const int e0 = 16 * et + 4 * q;
    const u32x2 zz = *(const u32x2*)(proj + pjx(qrow_i, C_ZB + h * 128 + e0));
    const float v0 = O[0][et][0] * rstd * g[e0 + 0] * siluf_(lo_f(zz[0]));
    const float v1 = O[0][et][1] * rstd * g[e0 + 1] * siluf_(hi_f(zz[0]));
    const float v2 = O[0][et][2] * rstd * g[e0 + 2] * siluf_(lo_f(zz[1]));
    const float v3 = O[0][et][3] * rstd * g[e0 + 3] * siluf_(hi_f(zz[1]));
    const u32x2 w = {pack2(v0, v1), pack2(v2, v3)};
    if (!dry) *(u32x2*)(proj + pjx(qrow_i, C_QB + h * 128 + e0)) = w; else asm volatile("" :: "v"(w[0]), "v"(w[1]));
  }
}


constexpr int DP_QF = 0, DP_KF = 33792, DP_VF = 67584, DP_MT = 101376, DP_SM = 134144;
DI int kmap8(int ks, int q, int j) { return 32 * ks + 4 * q + (j & 3) + 16 * (j >> 2); }

DI void dn_prep_task(PR p, int l, int gc, int h, char* lds) {
  const int tid = ltid(), lane = tid & 63, q = lane >> 4, c = lane & 15;
  int s, oc;
  if (gc < 64) { s = gc >> 2; oc = gc & 3; } else { s = 16 + ((gc - 64) >> 4); oc = (gc - 64) & 15; }
  const int R0 = seq_row0(s), T = seq_len(s), t0 = oc * 64;
  const bf16_t* proj = (const bf16_t*)(lws(p) + WS_PROJ);
  float* qf = (float*)(lds + DP_QF);
  float* kf = (float*)(lds + DP_KF);
  float* vf = (float*)(lds + DP_VF);
  float* mT = (float*)(lds + DP_MT);
  float* sm = (float*)(lds + DP_SM);
  __syncthreads();
  if (tid < 384) {
    const int cg = tid % 48, rg = tid / 48;
    const int which = cg >> 4, ch0 = (cg & 15) * 8;
    const int col = C_QC + which * 512 + h * 128 + ch0;
    const float* cw = lin(p, 24) + (size_t)l * 5 * 1536 + which * 512 + h * 128 + ch0;
    float w[5][8];
#pragma unroll
    for (int j = 0; j < 5; ++j)
#pragma unroll
      for (int e = 0; e < 8; ++e) w[j][e] = cw[j * 1536 + e];
    u32x4 raw[12];
#pragma unroll
    for (int i = 0; i < 12; ++i) {
      const int t = t0 + rg * 8 + i - 2;
      raw[i] = u32x4{0u, 0u, 0u, 0u};
      if (t >= 0 && t < T) raw[i] = *(const u32x4*)(proj + pjx(R0 + t, col));
    }
    float* dst = which == 0 ? qf : (which == 1 ? kf : vf);
#pragma unroll
    for (int i = 0; i < 8; ++i) {
#pragma unroll
      for (int e2 = 0; e2 < 4; ++e2) {
        float a0 = 0.f, a1 = 0.f;
#pragma unroll
        for (int j = 0; j < 5; ++j) { a0 += w[j][2 * e2] * lo_f(raw[i + j][e2]); a1 += w[j][2 * e2 + 1] * hi_f(raw[i + j][e2]); }
        dst[(rg * 8 + i) * 132 + ch0 + 2 * e2] = siluf_(a0);
        dst[(rg * 8 + i) * 132 + ch0 + 2 * e2 + 1] = siluf_(a1);
      }
    }
  }
  if ((tid & 255) < 64) {
    const int d = tid >> 8;
    const int io = d ? 63 - lane : lane;
    const float* bg = (const float*)(lws(p) + WS_BETAG) + (size_t)(R0 + t0 + io) * 16;
    const float beta = bg[d * 4 + h];
    float g = bg[8 + d * 4 + h];
#pragma unroll
    for (int o = 1; o < 64; o <<= 1) {
      const int src = lane >= o ? lane - o : lane;
      const float n = __int_as_float(__builtin_amdgcn_ds_bpermute(src << 2, __float_as_int(g)));
      if (lane >= o) g += n;
    }
    sm[d * 64 + lane] = beta;
    sm[128 + d * 64 + lane] = g;
    sm[256 + d * 64 + lane] = __expf(g);
  }
  __syncthreads();
  {
    const int wave = tid >> 6;
#pragma unroll 1
    for (int i = 0; i < 16; ++i) {
      const int id = wave * 16 + i, row = id & 63, which = id >> 6;
      float* a = (which ? kf : qf) + row * 132;
      const float v0 = a[lane], v1 = a[64 + lane];
      const float ss = wave_sum(v0 * v0 + v1 * v1);
      const float sc = rsqrtf(ss + EPS) * (which ? 1.f : 0.08838834764831845f);
      a[lane] = v0 * sc; a[64 + lane] = v1 * sc;
    }
  }
  __syncthreads();
  const int d = tid >> 8, w4 = (tid >> 6) & 3;
  const float* beta_s = sm + d * 64;
  const float* gc_s = sm + 128 + d * 64;
  const float* eg_s = sm + 256 + d * 64;
  unsigned char* slot = lws(p) + WS_DNP + (size_t)((gc * 4 + h) * 2 + d) * DNP_SLOT;
  auto orow = [&](int i) -> int { return d ? 63 - i : i; };
  auto ldfrag = [&](const float* base, int row, int ks) -> bf16x8 {
    const f32x4 a = *(const f32x4*)(base + row * 132 + 32 * ks + 8 * q);
    const f32x4 b = *(const f32x4*)(base + row * 132 + 32 * ks + 8 * q + 4);
    return mk8(pack2(a[0], a[1]), pack2(a[2], a[3]), pack2(b[0], b[1]), pack2(b[2], b[3]));
  };
  {
    const int it = w4;
    bf16x8 kfr_i[4], qfr_i[4];
#pragma unroll
    for (int ks = 0; ks < 4; ++ks) { kfr_i[ks] = ldfrag(kf, orow(16 * it + c), ks); qfr_i[ks] = ldfrag(qf, orow(16 * it + c), ks); }
    f32x4 kq[4];
#pragma unroll
    for (int jt = 0; jt < 4; ++jt) {
      f32x4 kk = {0.f, 0.f, 0.f, 0.f}, kq_ = {0.f, 0.f, 0.f, 0.f};
#pragma unroll
      for (int ks = 0; ks < 4; ++ks) {
        const bf16x8 kfr_j = ldfrag(kf, orow(16 * jt + c), ks);
        kk = MFMA16(kfr_i[ks], kfr_j, kk);
        kq_ = MFMA16(kfr_j, qfr_i[ks], kq_);
      }
      {
        const int j = 16 * jt + c;
        const float gj = gc_s[j];
#pragma unroll
        for (int r = 0; r < 4; ++r) {
          const int i = 16 * it + 4 * q + r;
          const float v = i > j ? beta_s[i] * kk[r] * __expf(gc_s[i] - gj) : 0.f;
          mT[d * 4096 + j * 64 + i] = v;
        }
      }
      {
        const int i = 16 * it + c;
        const float gi = gc_s[i];
#pragma unroll
        for (int r = 0; r < 4; ++r) {
          const int j = 16 * jt + 4 * q + r;
          kq_[r] = i >= j ? kq_[r] * __expf(gi - gc_s[j]) : 0.f;
        }
      }
      kq[jt] = kq_;
      asm volatile("" ::: "memory");
    }
#pragma unroll
    for (int ks2 = 0; ks2 < 2; ++ks2) {
      const f32x4 a = kq[2 * ks2], b = kq[2 * ks2 + 1];
      const u32x4 o = {pack2(a[0], a[1]), pack2(a[2], a[3]), pack2(b[0], b[1]), pack2(b[2], b[3])};
      *(u32x4*)(slot + SL_QK + ((it * 2 + ks2) * 64 + lane) * 16) = o;
    }
    asm volatile("" ::: "memory");
    {
      const int i = 16 * it + c, io = orow(i);
      const float egi = eg_s[i];
#pragma unroll
      for (int ks = 0; ks < 4; ++ks) {
        const f32x4 a = *(const f32x4*)(qf + io * 132 + 32 * ks + 4 * q);
        const f32x4 b = *(const f32x4*)(qf + io * 132 + 32 * ks + 16 + 4 * q);
        const u32x4 o = {pack2(a[0] * egi, a[1] * egi), pack2(a[2] * egi, a[3] * egi), pack2(b[0] * egi, b[1] * egi), pack2(b[2] * egi, b[3] * egi)};
        *(u32x4*)(slot + SL_QG + ((it * 4 + ks) * 64 + lane) * 16) = o;
      }
    }
    asm volatile("" ::: "memory");
    {
      const float gl = gc_s[63];
#pragma unroll
      for (int mm = 0; mm < 2; ++mm) {
        const int mt8 = 2 * w4 + mm, dk = 16 * mt8 + c;
#pragma unroll
        for (int ks2 = 0; ks2 < 2; ++ks2) {
          float v[8];
#pragma unroll
          for (int j = 0; j < 8; ++j) {
            const int i = kmap8(ks2, q, j);
            v[j] = kf[orow(i) * 132 + dk] * __expf(gl - gc_s[i]);
          }
          const u32x4 o = {pack2(v[0], v[1]), pack2(v[2], v[3]), pack2(v[4], v[5]), pack2(v[6], v[7])};
          *(u32x4*)(slot + SL_KGT + ((mt8 * 2 + ks2) * 64 + lane) * 16) = o;
        }
      }
      if (w4 == 0 && lane == 0) ((float*)(lws(p) + WS_EGL))[(gc * 4 + h) * 2 + d] = __expf(gl);
    }
  }
  {
    bf16_t* XA = (bf16_t*)(lds + DP_QF) + d * 32 * 260;
    bf16_t* XC = (bf16_t*)(lds + DP_KF + 16 * 528) + d * 16 * 260;
    bf16_t* XD = (bf16_t*)(lds + DP_VF + 16 * 528) + d * 16 * 260;
    const int col = tid & 255;
    const float* rsrc = col < 128 ? vf + col : kf + (col - 128);
    const float* mcol = mT + d * 4096;
    __syncthreads();
#pragma unroll 1
    for (int b = 0; b < 4; ++b) {
      float x[16];
#pragma unroll
      for (int i = 0; i < 16; ++i) {
        const int ii = 16 * b + i;
        const float sc = col < 128 ? beta_s[ii] : beta_s[ii] * eg_s[ii];
        x[i] = rsrc[orow(ii) * 132] * sc;
      }
      const int nA = b < 2 ? 16 * b : 32;
#pragma unroll 8
      for (int j = 0; j < nA; ++j) {
        const float xj = bf2f(XA[j * 260 + col]);
        const float* mr = mcol + j * 64 + 16 * b;
#pragma unroll
        for (int i4 = 0; i4 < 4; ++i4) {
          const f32x4 mm = *(const f32x4*)(mr + i4 * 4);
          x[i4 * 4 + 0] -= mm[0] * xj; x[i4 * 4 + 1] -= mm[1] * xj; x[i4 * 4 + 2] -= mm[2] * xj; x[i4 * 4 + 3] -= mm[3] * xj;
        }
      }
      if (b == 3) {
#pragma unroll 8
        for (int j = 0; j < 16; ++j) {
          const float xj = bf2f(XC[j * 260 + col]);
          const float* mr = mcol + (32 + j) * 64 + 48;
#pragma unroll
          for (int i4 = 0; i4 < 4; ++i4) {
            const f32x4 mm = *(const f32x4*)(mr + i4 * 4);
            x[i4 * 4 + 0] -= mm[0] * xj; x[i4 * 4 + 1] -= mm[1] * xj; x[i4 * 4 + 2] -= mm[2] * xj; x[i4 * 4 + 3] -= mm[3] * xj;
          }
        }
      }
      const float* md = mcol + (16 * b) * 64 + 16 * b;
#pragma unroll
      for (int j = 0; j < 15; ++j) {
        const float xj = x[j];
#pragma unroll
        for (int i4 = 0; i4 < 16; i4 += 4) {
          if (i4 + 3 > j) {
            const f32x4 mm = *(const f32x4*)(md + j * 64 + i4);
            if (i4 + 0 > j) x[i4 + 0] -= mm[0] * xj;
            if (i4 + 1 > j) x[i4 + 1] -= mm[1] * xj;
            if (i4 + 2 > j) x[i4 + 2] -= mm[2] * xj;
            if (i4 + 3 > j) x[i4 + 3] -= mm[3] * xj;
          }
        }
      }
      if (b == 2) __syncthreads();
      bf16_t* dstx = b < 2 ? XA + (16 * b) * 260 : (b == 2 ? XC : XD);
#pragma unroll
      for (int i = 0; i < 16; ++i) dstx[i * 260 + col] = f2bf(x[i]);
      __syncthreads();
    }
  }
  {
    const int tid4 = ltid(), lane = tid4 & 63, q = lane >> 4, c = lane & 15, w4 = (tid4 >> 6) & 3, d = tid4 >> 8;
    unsigned char* slot = lws(p) + WS_DNP + (size_t)((gc * 4 + h) * 2 + d) * DNP_SLOT;
    const bf16_t* XA = (const bf16_t*)(lds + DP_QF) + d * 32 * 260;
    const bf16_t* XC = (const bf16_t*)(lds + DP_KF + 16 * 528) + d * 16 * 260;
    const bf16_t* XD = (const bf16_t*)(lds + DP_VF + 16 * 528) + d * 16 * 260;
    auto Xrow = [&](int i) -> const bf16_t* { return i < 32 ? XA + i * 260 : (i < 48 ? XC + (i - 32) * 260 : XD + (i - 48) * 260); };
#pragma unroll
    for (int ks = 0; ks < 4; ++ks) {
      const bf16_t* xr = Xrow(16 * w4 + c);
      const u32x2 a = *(const u32x2*)(xr + 128 + 32 * ks + 4 * q);
      const u32x2 b = *(const u32x2*)(xr + 128 + 32 * ks + 16 + 4 * q);
      const u32x4 o = {a[0] ^ 0x80008000u, a[1] ^ 0x80008000u, b[0] ^ 0x80008000u, b[1] ^ 0x80008000u};
      *(u32x4*)(slot + SL_W + ((w4 * 4 + ks) * 64 + lane) * 16) = o;
    }
#pragma unroll
    for (int cc = 0; cc < 2; ++cc) {
      const int cs = 2 * w4 + cc;
#pragma unroll
      for (int mt = 0; mt < 4; ++mt) {
        unsigned short v[4];
#pragma unroll
        for (int r = 0; r < 4; ++r) v[r] = Xrow(16 * mt + 4 * q + r)[16 * cs + c];
        const u32x2 o = {(unsigned)v[0] | ((unsigned)v[1] << 16), (unsigned)v[2] | ((unsigned)v[3] << 16)};
        *(u32x2*)(slot + SL_U + ((cs * 4 + mt) * 64 + lane) * 8) = o;
      }
    }
  }
}

constexpr int CH_STAGE = 57344;
DI void dn_chain_task(PR p, int l, int s, int h, int d, char* lds) {
  const int tid = ltid(), cs = tid >> 6, lane = tid & 63, q = lane >> 4, c = lane & 15;
  const int R0 = seq_row0(s), T = seq_len(s), nc = T >> 6;
  const int gc0 = s < 16 ? s * 4 : 64 + (s - 16) * 16;
  bf16_t* odir = (bf16_t*)(lws(p) + WS_R1) + (size_t)d * MROWS * 512;
  const float* egl = (const float*)(lws(p) + WS_EGL);
  f32x4 S[8];
  if (s >= 16) {
    const float* s0 = lin(p, 6) + ((((size_t)(s - 16) * 2 + l) * 2 + d) * 4 + h) * 16384;
#pragma unroll
    for (int i = 0; i < 8; ++i)
#pragma unroll
      for (int r = 0; r < 4; ++r) S[i][r] = s0[(16 * i + 4 * q + r) * 128 + 16 * cs + c];
  } else {
#pragma unroll
    for (int i = 0; i < 8; ++i) S[i] = f32x4{0.f, 0.f, 0.f, 0.f};
  }
  auto slot_of = [&](int step) -> const unsigned char* {
    const int oc = d ? nc - 1 - step : step;
    return lws(p) + WS_DNP + (size_t)(((gc0 + oc) * 4 + h) * 2 + d) * DNP_SLOT;
  };
  const int cs_u = __builtin_amdgcn_readfirstlane(cs);
  u32x2 uA[4], uB[4]; float glA = 1.f, glB = 1.f;
  auto dma = [&](int step, char* st) {
    const unsigned char* sl = slot_of(step);
#pragma unroll
    for (int i = 0; i < 7; ++i)
      __builtin_amdgcn_global_load_lds((const unsigned*)(sl + (size_t)(tid + NT * i) * 16), (LAS unsigned*)(LAS char*)(st + (cs_u * 64 + NT * i) * 16), 16, 0, 0);
  };
  auto uload = [&](int step, u32x2 (&u)[4], float& gl) {
    const unsigned char* sl = slot_of(step);
#pragma unroll
    for (int mt = 0; mt < 4; ++mt) u[mt] = *(const u32x2*)(sl + SL_U + ((cs * 4 + mt) * 64 + lane) * 8);
    const int oc = d ? nc - 1 - step : step;
    gl = egl[((gc0 + oc) * 4 + h) * 2 + d + vzero()];
  };
  auto compute = [&](int step, const char* cur, u32x2 (&u)[4], float& glr) {
    const int oc = d ? nc - 1 - step : step;
    const float gl = glr;
    bf16x8 Sb[4];
#pragma unroll
    for (int ks = 0; ks < 4; ++ks)
      Sb[ks] = mk8(pack2(S[2 * ks][0], S[2 * ks][1]), pack2(S[2 * ks][2], S[2 * ks][3]),
                   pack2(S[2 * ks + 1][0], S[2 * ks + 1][1]), pack2(S[2 * ks + 1][2], S[2 * ks + 1][3]));
    f32x4 av[4], ao[4];
#pragma unroll
    for (int mt = 0; mt < 4; ++mt) {
      av[mt] = f32x4{lo_f(u[mt][0]), hi_f(u[mt][0]), lo_f(u[mt][1]), hi_f(u[mt][1])};
      ao[mt] = f32x4{0.f, 0.f, 0.f, 0.f};
    }
    if (step + 2 < nc) uload(step + 2, u, glr);
#pragma unroll
    for (int ks = 0; ks < 4; ++ks)
#pragma unroll
      for (int mt = 0; mt < 4; ++mt) {
        const bf16x8 wf = *(const bf16x8*)(cur + SL_W + ((mt * 4 + ks) * 64 + lane) * 16);
        av[mt] = MFMA16(wf, Sb[ks], av[mt]);
        const bf16x8 gf = *(const bf16x8*)(cur + SL_QG + ((mt * 4 + ks) * 64 + lane) * 16);
        ao[mt] = MFMA16(gf, Sb[ks], ao[mt]);
        if (mt == 3 && (ks & 1)) asm volatile("" ::: "memory");
      }
    bf16x8 Vb[2];
#pragma unroll
    for (int k2 = 0; k2 < 2; ++k2)
      Vb[k2] = mk8(pack2(av[2 * k2][0], av[2 * k2][1]), pack2(av[2 * k2][2], av[2 * k2][3]),
                   pack2(av[2 * k2 + 1][0], av[2 * k2 + 1][1]), pack2(av[2 * k2 + 1][2], av[2 * k2 + 1][3]));
#pragma unroll
    for (int k2 = 0; k2 < 2; ++k2)
#pragma unroll
      for (int mt = 0; mt < 4; ++mt) {
        const bf16x8 f = *(const bf16x8*)(cur + SL_QK + ((mt * 2 + k2) * 64 + lane) * 16);
        ao[mt] = MFMA16(f, Vb[k2], ao[mt]);
      }
#pragma unroll
    for (int i = 0; i < 8; ++i) {
      S[i] *= gl;
#pragma unroll
      for (int k2 = 0; k2 < 2; ++k2) {
        const bf16x8 f = *(const bf16x8*)(cur + SL_KGT + ((i * 2 + k2) * 64 + lane) * 16);
        S[i] = MFMA16(f, Vb[k2], S[i]);
      }
    }
#pragma unroll
    for (int mt = 0; mt < 4; ++mt)
#pragma unroll
      for (int r = 0; r < 4; ++r) {
        const int i = 16 * mt + 4 * q + r;
        const int t = oc * 64 + (d ? 63 - i : i);
        odir[(size_t)(R0 + t) * 512 + h * 128 + 16 * cs + c] = f2bf(ao[mt][r]);
      }
  };
  uload(0, uA, glA); uload(1, uB, glB);
  __syncthreads();
  dma(0, lds);
  __syncthreads();
#pragma unroll 1
  for (int step = 0; step < nc; step += 2) {
    dma(step + 1, lds + CH_STAGE);
    compute(step, lds, uA, glA);
    __syncthreads();
    if (step + 2 < nc) dma(step + 2, lds);
    compute(step + 1, lds + CH_STAGE, uB, glB);
    __syncthreads();
  }
  if (s < 16) {
    float* so = lout(p) + O_DN + ((((size_t)s * 2 + l) * 2 + d) * 4 + h) * 16384;
#pragma unroll
    for (int i = 0; i < 8; ++i)
#pragma unroll
      for (int r = 0; r < 4; ++r) so[(16 * i + 4 * q + r) * 128 + 16 * cs + c] = S[i][r];
  }
}

constexpr int N_PHASES = 16;
constexpr int LDS_QSH = LDS_BYTES - 16;
constexpr int LDS_BST = LDS_BYTES - 32;

#define SW_BEGIN(id) unsigned long long _sw_t0 = 0; if constexpr (TIMEREG == (id)) { __syncthreads(); _sw_t0 = __builtin_amdgcn_s_memrealtime(); }
#define SW_END(id) if constexpr (TIMEREG == (id)) { __syncthreads(); if (blockIdx.x == 0 && threadIdx.x == 0) g_sw_acc += __builtin_amdgcn_s_memrealtime() - _sw_t0; }
DI void run_prep(PR p) {
  const int G = gridDim.x, bid = blockIdx.x;
  { SW_BEGIN(10) for (int t = bid; t < 192; t += G) ph0_adaln(p, t, smem); SW_END(10) }
  { SW_BEGIN(11) for (int t = bid; t < 256; t += G) ph0_s5(p, t); SW_END(11) }
  if (bid == G - 1) ph0_misc(p);
  for (int t = G - 2 - bid; t >= 0 && t < 64; t += G) ph0_wba(p, t);
  { SW_BEGIN(13) for (int t = bid; t < 512; t += G) cvt_win_tile(p, 0, t, smem); SW_END(13) }
  { SW_BEGIN(14) for (int t = bid; t < 352; t += G) cvt_other_tile(p, t, smem); SW_END(14) }
}
DI void run_final(PR p) {
  const int G = gridDim.x, bid = blockIdx.x, wave = ltid() >> 6;
  for (int r = bid * 8 + wave; r < MROWS; r += G * 8) ph_final_row(p, r);
}
DI void run_norm(PR p, int l) {
  const int G = gridDim.x, bid = blockIdx.x, wave = ltid() >> 6;
  for (int rb = bid * 8 + wave; rb < 2048; rb += G * 8) ph1_norm_rows(p, l, rb);
}
DI void run_cvt1(PR p) {
  const int G = gridDim.x, bid = blockIdx.x;
  for (int t = bid; t < 512; t += G) cvt_win_tile(p, 1, t, smem);
}
DI void run_inproj(PR p, int l) {
  const int G = gridDim.x, bid = blockIdx.x;
  for (int t = bid; t < 2048; t += G) ph2_inproj_tile(p, l, t, smem);
}
DI void run_s5(PR p, int l) {
  const int G = gridDim.x, bid = blockIdx.x;
  for (int b = bid; b < 256; b += G) {
    s5_wg_task(p, l, 16 + (b >> 6), (b >> 5) & 1, b & 31, smem);
#pragma unroll 1
    for (int k = 0; k < 4; ++k) { const int i = b * 4 + k; s5_wg_task(p, l, i >> 6, (i >> 5) & 1, i & 31, smem); }
  }
}
DI void run_att(PR p, int l, int t, bool dry = false) {
  if (t < 128) { const int s = 16 + (t >> 5), h = (t >> 3) & 3, qb = t & 7; att_task(p, l, s, h, qb, smem, dry); }
  else { const int u = t - 128, s = u >> 3, h = (u >> 1) & 3, qb = u & 1; att_task(p, l, s, h, qb, smem, dry); }
}
DI void run_prep_dn(PR p, int l, int u) { dn_prep_task(p, l, u >> 2, u & 3, smem); }
DI void run_chain(PR p, int l) {
  const int G = gridDim.x, bid = blockIdx.x;
  for (int b = bid; b < 160; b += G) {
    const int s = b < 32 ? 16 + (b >> 3) : (b - 32) >> 3;
    const int h = (b >> 1) & 3, d = b & 1;
    dn_chain_task(p, l, s, h, d, smem);
  }
}
DI void run_glu(PR p, int l, int t, bool dry = false) { glu_tile(p, l, t, smem, dry); }
DI void run_ph5(PR p, int l) {
  const int G = gridDim.x, bid = blockIdx.x, wave = ltid() >> 6;
  for (int r = bid * 8 + wave; r < MROWS; r += G * 8) ph5_row(p, l, r);
}
DI void run_merge(PR p, int l) {
  const int G = gridDim.x, bid = blockIdx.x;
  for (int t = bid; t < 256; t += G) ph6_merge_tile(p, l, t, smem);
}
DI void run_out(PR p, int l) {
  const int G = gridDim.x, bid = blockIdx.x;
  for (int t = bid; t < 256; t += G) ph7_out_tile(p, l, t, smem);
}
DI void run_barrier(PR p, unsigned x) {
  asm volatile("" : "+s"(x));
  XcdBarrier xb; xb.bar = (unsigned*)lws(p) + WS_BAR / 4; xb.x = x; xb.st = (volatile LAS unsigned*)(LAS char*)(smem + LDS_BST);
  xcd_barrier(xb);
}

#ifndef REP
#define REP 0
#endif
template <int SUB> DI void run_sub(PR p, int l, volatile LAS int* qsh, unsigned* qw) {
  if constexpr (SUB == 0) { run_norm(p, l); if (l == 1) run_cvt1(p); }
  else if constexpr (SUB == 1) run_inproj8(p, l);
  else if constexpr (SUB == 2) {
#ifdef SPLIT_QUEUES
    { SW_BEGIN(1) run_s5(p, l); SW_END(1) }
    { SW_BEGIN(2)
    for (;;) {
      const int t = queue_pull(&qw[l * 8 + 0], qsh);
      if (t >= 256) break;
      run_att(p, l, t);
    }
    SW_END(2) }
    { SW_BEGIN(3)
    for (;;) {
      const int t = queue_pull(&qw[l * 8 + 2], qsh);
      if (t >= 512) break;
      run_prep_dn(p, l, t);
    }
    SW_END(3) }
#else
    for (;;) {
      const int t = queue_pull(&qw[l * 8 + 0], qsh);
      if (t >= 2048) break;
      if (t < 128) run_att(p, l, t);
      else if (t < 640) run_prep_dn(p, l, t - 128);
      else if (t < 896) { const int b = t - 640; s5_wg_task(p, l, 16 + (b >> 6), (b >> 5) & 1, b & 31, smem); }
      else if (t < 1024) run_att(p, l, t - 896 + 128);
      else { const int i = t - 1024; s5_wg_task(p, l, i >> 6, (i >> 5) & 1, i & 31, smem); }
    }
#endif
  } else if constexpr (SUB == 3) {
    { SW_BEGIN(4) run_chain(p, l); SW_END(4) }
    if constexpr ((REP >> 19) & 1) run_chain(p, l);
    if constexpr ((REP >> 20) & 1) for (;;) { const int t = queue_pull(&qw[l * 8 + 5], qsh); if (t >= 256) break; run_glu(p, l, t, true); }
    for (;;) {
      const int t = queue_pull(&qw[l * 8 + 1], qsh);
      if (t >= 256) break;
      run_glu(p, l, t);
    }
  }
  else if constexpr (SUB == 4) run_ph5(p, l);
#ifndef NEW_MERGE
  else if constexpr (SUB == 5) run_merge(p, l);
  else run_out(p, l);
#else
  else if constexpr (SUB == 5) run_merge8(p, l);
  else run_out8(p, l);
#endif
}
template <int PH> DI void run_phase(PR p, volatile LAS int* qsh, unsigned* qw) {
  if constexpr (PH == 0) run_prep(p);
  else if constexpr (PH == 15) run_final(p);
  else run_sub<(PH - 1) % 7>(p, (PH - 1) / 7, qsh, qw);
}

__global__ void __launch_bounds__(NT) fwd_kernel(Params p_by_value) {
  PR p = *(const __attribute__((address_space(4))) Params*)__builtin_amdgcn_kernarg_segment_ptr();
  volatile LAS int* qsh = (volatile LAS int*)(LAS char*)(smem + LDS_QSH);
  unsigned* qw = (unsigned*)(p.ws + WS_Q);
#ifndef ONE_LAUNCH
  switch (p.ph_lo) {
#define PHC(n) case n: run_phase<n>(p, qsh, qw); break;
    PHC(0) PHC(1) PHC(2) PHC(3) PHC(4) PHC(5) PHC(6) PHC(7) PHC(8) PHC(9) PHC(10) PHC(11) PHC(12) PHC(13) PHC(14) PHC(15)
#undef PHC
    default: break;
  }
#else
  volatile LAS unsigned* bst = (volatile LAS unsigned*)(LAS char*)(smem + LDS_BST);
  if (ltid() == 0) { bst[0] = 0u; bst[1] = 0u; }
  __syncthreads();
  if constexpr (TIMEREG > 0) { if (blockIdx.x == 0 && threadIdx.x == 0) g_sw_acc = 0ull; }
  const XcdBarrier xb = xcd_barrier_post((unsigned*)(p.ws + WS_BAR), bst);
  const unsigned xcc = xb.x;
#ifndef TIMEPH
#define TIMEPH -1
#endif
  unsigned long long tph0 = 0, tph1 = 0;
  if constexpr (TIMEPH == 0) tph0 = __builtin_amdgcn_s_memrealtime();
  run_prep(p); run_barrier(p, xcc);
  if constexpr (TIMEPH == 0) tph1 = __builtin_amdgcn_s_memrealtime();
#define PHS(sub) { const bool tm = (TIMEPH == 1 + 7 * l + (sub)); if (TIMEPH > 0 && tm) tph0 = __builtin_amdgcn_s_memrealtime(); \
    run_sub<sub>(p, l, qsh, qw); run_barrier(p, xcc); if constexpr ((REP >> 21) & 1) run_barrier(p, xcc); if (TIMEPH > 0 && tm) tph1 = __builtin_amdgcn_s_memrealtime(); }
#pragma unroll 1
  for (int l = 0; l < 2; ++l) { PHS(0) PHS(1) PHS(2) PHS(3) PHS(4) PHS(5) PHS(6) }
#undef PHS
  run_final(p);
  if constexpr (TIMEPH >= 0 || TIMEREG > 0) {
    if (blockIdx.x == 0) {
      __syncthreads();
      const unsigned long long te = __builtin_amdgcn_s_memrealtime(), dt = (TIMEREG > 0) ? *(volatile unsigned long long*)&g_sw_acc : tph1 - tph0;
      while (__builtin_amdgcn_s_memrealtime() - te < dt) __builtin_amdgcn_s_sleep(8);
    }
  }
#endif
}

extern "C" void kernel_launch(void* const* d_in, const int* in_sizes, int n_in, void* d_out, int out_size,
                              void* d_ws, size_t ws_size, hipStream_t stream) {
  static int grid = 0;
  if (grid == 0) {
    int dev = 0, cus = 0, per_cu = 0;
    if (hipGetDevice(&dev) != hipSuccess || hipDeviceGetAttribute(&cus, hipDeviceAttributeMultiprocessorCount, dev) != hipSuccess) { fprintf(stderr, "kernel_launch: device query failed\n"); grid = -1; return; }
    if (hipFuncSetAttribute((const void*)fwd_kernel, hipFuncAttributeMaxDynamicSharedMemorySize, LDS_BYTES) != hipSuccess) { fprintf(stderr, "kernel_launch: hipFuncSetAttribute failed\n"); grid = -1; return; }
    if (hipOccupancyMaxActiveBlocksPerMultiprocessor(&per_cu, (const void*)fwd_kernel, NT, LDS_BYTES) != hipSuccess || per_cu < 1) { fprintf(stderr, "kernel_launch: occupancy query reports %d\n", per_cu); per_cu = 1; }
    (void)hipGetLastError();
    grid = cus;
    if (ws_size < WS_END) { fprintf(stderr, "kernel_launch: workspace too small (%zu < %zu)\n", ws_size, (size_t)WS_END); grid = -1; return; }
  }
  if (grid < 0) return;
  (void)hipMemsetAsync((char*)d_ws + WS_BAR, 0, WS_ZERO_BYTES, stream);
  Params p{};
  for (int i = 0; i < 31; ++i) p.in[i] = (const float*)d_in[i];
  p.out = (float*)d_out; p.ws = (unsigned char*)d_ws;
#ifndef ONE_LAUNCH
  p.use_bar = 0;
  for (int ph = 0; ph < N_PHASES; ++ph) {
    p.ph_lo = ph; p.ph_hi = ph + 1;
    hipLaunchKernelGGL(fwd_kernel, dim3(grid), dim3(NT), LDS_BYTES, stream, p);
  }
#else
  p.use_bar = 1; p.ph_lo = 0; p.ph_hi = N_PHASES;
  void* args[] = {&p};
  hipError_t e = hipLaunchCooperativeKernel((const void*)fwd_kernel, dim3(grid), dim3(NT), args, LDS_BYTES, stream);
  if (e != hipSuccess) fprintf(stderr, "kernel_launch: cooperative launch failed: %s (grid %d)\n", hipGetErrorString(e), grid);
#endif
}
```

```cpp
#define ONE_LAUNCH 1
#include <hip/hip_runtime.h>
#include <stdint.h>
#include <stdio.h>

#define DI __device__ __forceinline__
typedef unsigned short bf16_t;
using bf16x8 = __attribute__((ext_vector_type(8))) short;
using s16x4  = __attribute__((ext_vector_type(4))) short;
using f32x4  = __attribute__((ext_vector_type(4))) float;
using f32x16 = __attribute__((ext_vector_type(16))) float;
using u32x4  = __attribute__((ext_vector_type(4))) unsigned;
using u32x2  = __attribute__((ext_vector_type(2))) unsigned;
typedef __bf16 bf16x2_t __attribute__((ext_vector_type(2)));
typedef float f32x2_t __attribute__((ext_vector_type(2)));
#define LAS __attribute__((address_space(3)))

#define MFMA16(a, b, c) __builtin_amdgcn_mfma_f32_16x16x32_bf16((a), (b), (c), 0, 0, 0)
#define MFMA32(a, b, c) __builtin_amdgcn_mfma_f32_32x32x16_bf16((a), (b), (c), 0, 0, 0)

constexpr int NT = 512;
constexpr int DM = 1024;
constexpr int MROWS = 8192;
constexpr int NP = 8192;
constexpr int NIN = 8208;
constexpr float EPS = 1e-6f;
constexpr int C_UA = 0, C_ZA = 512, C_QB = 1024, C_KB = 1536, C_VB = 2048, C_ZB = 2560;
constexpr int C_QC = 3072, C_KC = 3584, C_VC = 4096, C_ZC = 4608, C_GT = 5120;
constexpr size_t O_Y = 0;
constexpr size_t O_CK = 8388608;
constexpr size_t O_CV = O_CK + 4194304;
constexpr size_t O_SR = O_CV + 4194304;
constexpr size_t O_SI = O_SR + 131072;
constexpr size_t O_DN = O_SI + 131072;

constexpr size_t WS_BAR   = 0;
constexpr size_t WS_Q     = 16384;
constexpr size_t WS_ZERO_BYTES = 16384 + 1024 + 8192;
constexpr size_t WS_MOD   = 32768;
constexpr size_t WS_S5AR  = WS_MOD + 122880;
constexpr size_t WS_S5AI  = WS_S5AR + 32768;
constexpr size_t WS_S5BB  = WS_S5AI + 32768;
constexpr size_t WS_S5CT  = WS_S5BB + 524288;
constexpr size_t WS_ROPE  = WS_S5CT + 524288;
constexpr size_t WS_LAM   = WS_ROPE + 8192;
constexpr size_t WS_WBA   = WS_LAM + 256;
constexpr size_t WS_BETAG = WS_WBA + 131072;
constexpr size_t WS_EGL   = WS_BETAG + 524288;
constexpr size_t WS_WTGLU = WS_EGL + 4096;
constexpr size_t WS_WTBR  = WS_WTGLU + 1048576;
constexpr size_t WS_WTOUT = WS_WTBR + 6291456;
constexpr size_t WS_R1    = WS_WTOUT + 4194304;
constexpr size_t WS_R2    = WS_R1 + 16777216;
constexpr size_t WS_PROJ  = WS_R2 + 16777216;
constexpr size_t WS_DNP   = WS_PROJ + 134217728;
constexpr size_t DNP_SLOT = 73728;
constexpr size_t WS_MIX  = WS_DNP;
constexpr size_t WS_HN   = WS_DNP + 16777216;
constexpr size_t WS_WIN1 = WS_DNP + 33554432;
constexpr size_t WS_KVC   = WS_DNP + 1024 * DNP_SLOT;
constexpr size_t WS_END   = WS_KVC + 4194304;
constexpr int SL_W = 0, SL_QG = 16384, SL_KGT = 32768, SL_QK = 49152, SL_U = 57344;

constexpr int LDS_BYTES = 163840;

struct Params {
  const float* in[31];
  float* out;
  unsigned char* ws;
  int ph_lo, ph_hi;
  int use_bar, pad;
};
typedef const __attribute__((address_space(4))) Params& PR;
#define NI __device__ __noinline__
extern __shared__ __attribute__((aligned(16))) char smem[];
#define GAS __attribute__((address_space(1)))
DI unsigned char* lws(PR p) { GAS unsigned char* w = (GAS unsigned char*)p.ws; asm volatile("" : "+s"(w)); return (unsigned char*)w; }
DI const float* lin(PR p, int k) { GAS const float* w = (GAS const float*)p.in[k]; asm volatile("" : "+s"(w)); return (const float*)w; }
DI float* lout(PR p) { GAS float* w = (GAS float*)p.out; asm volatile("" : "+s"(w)); return (float*)w; }

DI float bf2f(unsigned short h) { return __uint_as_float(((unsigned)h) << 16); }
DI unsigned pack2(float lo, float hi) { f32x2_t f = {lo, hi}; bf16x2_t v = __builtin_convertvector(f, bf16x2_t); return __builtin_bit_cast(unsigned, v); }
DI unsigned short f2bf(float x) { return (unsigned short)(pack2(x, 0.f) & 0xffffu); }
DI float lo_f(unsigned u) { return __uint_as_float(u << 16); }
DI float hi_f(unsigned u) { return __uint_as_float(u & 0xffff0000u); }
DI float sigmoidf_(float x) { return __builtin_amdgcn_rcpf(1.f + __expf(-x)); }
DI float siluf_(float x) { return x * __builtin_amdgcn_rcpf(1.f + __expf(-x)); }
DI float wave_sum(float v) {
#pragma unroll
  for (int o = 32; o >= 1; o >>= 1) v += __shfl_xor(v, o);
  return v;
}
DI bf16x8 mk8(unsigned a, unsigned b, unsigned c, unsigned d) { u32x4 u = {a, b, c, d}; return __builtin_bit_cast(bf16x8, u); }

DI int ltid() {
  const int w = __builtin_amdgcn_readfirstlane((int)(threadIdx.x >> 6));
  int t = (w << 6) | (int)__builtin_amdgcn_mbcnt_hi(~0u, __builtin_amdgcn_mbcnt_lo(~0u, 0u));
  asm volatile("" : "+v"(t));
  return t;
}
#define XB_TMO      128
#define XB_XCNT(j)  (256  + 64 * (j))
#define XB_XSUB(j)  (1280 + 64 * (j))
#define XB_XGEN(j)  (2304 + 64 * (j))
#define XB_TOP      3328
#define XB_TOPGEN   3392
#define XCD_BAR_WORDS 3456
#define XB_SPIN_CAP (1u << 22)
DI unsigned xb_ld(unsigned* p)              { return __hip_atomic_load(p, __ATOMIC_RELAXED, __HIP_MEMORY_SCOPE_AGENT); }
DI unsigned xb_add(unsigned* p, unsigned v) { return __hip_atomic_fetch_add(p, v, __ATOMIC_RELAXED, __HIP_MEMORY_SCOPE_AGENT); }
DI unsigned xb_xcc_id() { return (unsigned)__builtin_amdgcn_s_getreg((3 << 11) | 20) & 0xFu; }
#define XB_SPIN(cond, bar) do { unsigned _sp = 0; while (cond) { __builtin_amdgcn_s_sleep(1); \
    if ((++_sp & 255u) == 0u) { if (xb_ld(&(bar)[XB_TMO])) break; if (_sp > XB_SPIN_CAP) { atomicAdd(&(bar)[XB_TMO], 1u); break; } } } } while (0)
struct XcdBarrier { unsigned* bar; unsigned x; volatile LAS unsigned* st; };
DI XcdBarrier xcd_barrier_post(unsigned* bar, volatile LAS unsigned* st) {
  XcdBarrier b; b.bar = bar; b.x = xb_xcc_id(); b.st = st;
  if (ltid() == 0) (void)xb_add(&bar[XB_XCNT(b.x)], 1u);
  return b;
}
DI void xcd_barrier_complete(unsigned* bar, unsigned x, unsigned& nloc, unsigned& nx) {
  const unsigned G = gridDim.x;
  unsigned sum, cnt, mine, sp = 0u;
  for (;;) {
    sum = 0u; cnt = 0u; mine = 0u;
#pragma unroll
    for (unsigned j = 0; j < 16; ++j) { const unsigned c = xb_ld(&bar[XB_XCNT(j)]); sum += c; cnt += (c > 0u) ? 1u : 0u; mine = (j == x) ? c : mine; }
    if (sum == G) break;
    __builtin_amdgcn_s_sleep(1);
    if ((++sp & 255u) == 0u) { if (xb_ld(&bar[XB_TMO])) break; if (sp > XB_SPIN_CAP) { atomicAdd(&bar[XB_TMO], 1u); break; } }
  }
  nloc = mine > 0u ? mine : 1u; nx = cnt > 0u ? cnt : 1u;
}
DI void xcd_barrier(const XcdBarrier& b) {
  asm volatile("s_waitcnt vmcnt(0)" ::: "memory");
  __syncthreads();
  if (ltid() == 0) {
    unsigned* bar = b.bar;
    __builtin_amdgcn_s_waitcnt(0);
    unsigned nloc = b.st[0], nx = b.st[1];
    if (nloc == 0u) { xcd_barrier_complete(bar, b.x, nloc, nx); b.st[0] = nloc; b.st[1] = nx; }
    const unsigned old = xb_add(&bar[XB_XSUB(b.x)], 1u);
    const unsigned gen = old / nloc;
    if (old + 1u == (gen + 1u) * nloc) {
      __builtin_amdgcn_fence(__ATOMIC_RELEASE, "agent");
      asm volatile("s_waitcnt vmcnt(0)" ::: "memory");
      const unsigned og = xb_add(&bar[XB_TOP], 1u);
      const unsigned tg = og / nx;
      if (og + 1u == (tg + 1u) * nx) xb_add(&bar[XB_TOPGEN], 1u);
      else XB_SPIN(xb_ld(&bar[XB_TOPGEN]) == tg, bar);
      __builtin_amdgcn_fence(__ATOMIC_ACQUIRE, "agent");
      xb_add(&bar[XB_XGEN(b.x)], 1u);
      asm volatile("s_waitcnt vmcnt(0)" ::: "memory");
    } else {
      XB_SPIN(xb_ld(&bar[XB_XGEN(b.x)]) == gen, bar);
      __builtin_amdgcn_fence(__ATOMIC_ACQUIRE, "agent");
      asm volatile("s_waitcnt vmcnt(0)" ::: "memory");
    }
  }
  __syncthreads();
}

#ifndef TIMEREG
#define TIMEREG 0
#endif
__device__ unsigned long long g_sw_acc;
#define SWW_BEGIN(id) unsigned long long _sww_t0_##id = 0; if constexpr (TIMEREG == (id)) { __builtin_amdgcn_sched_barrier(0); _sww_t0_##id = __builtin_amdgcn_s_memrealtime(); __builtin_amdgcn_sched_barrier(0); }
#define SWW_END(id) if constexpr (TIMEREG == (id)) { __builtin_amdgcn_sched_barrier(0); const unsigned long long _d = __builtin_amdgcn_s_memrealtime() - _sww_t0_##id; __builtin_amdgcn_sched_barrier(0); if (blockIdx.x == 0 && threadIdx.x == 0) g_sw_acc += _d; }

DI int queue_pull(unsigned* q, volatile LAS int* sh) {
  __syncthreads();
  if (ltid() == 0) *sh = (int)xb_add(q, 1u);
  __syncthreads();
  return *sh;
}

DI int vzero() { int z = 0; asm volatile("" : "+v"(z)); return z; }

#ifndef PROJ_ROWMAJOR
DI size_t pjx(int row, int col) { return ((size_t)(col >> 9) * MROWS + row) * 512 + (col & 511); }
constexpr int PJ_LD = 512;
#else
DI size_t pjx(int row, int col) { return (size_t)row * NP + col; }
constexpr int PJ_LD = NP;
#endif

DI int seq_row0(int s) { return s < 16 ? s * 256 : 4096 + (s - 16) * 1024; }
DI int seq_len(int s) { return s < 16 ? 256 : 1024; }
DI int row_cond(int r) { return r < 4096 ? 0 : 1 + ((r - 4096) >> 10); }
DI const float* x_in_row(PR p, int l, int r) {
  if (l == 0) return r < 4096 ? lin(p, 0) + (size_t)r * DM : lin(p, 1) + (size_t)(r - 4096) * DM;
  return lout(p) + O_Y + (size_t)r * DM;
}

DI void ph0_adaln(PR p, int a, char* lds) {
  const int l = a / 96, cb = a % 96, tid = ltid();
  float* scond = (float*)lds;
  float* red = scond + 5 * 1024;
  const int tx = tid & 31, ty = tid >> 5;
  const float* w = lin(p, 10) + (size_t)l * 1024 * 3072 + cb * 32 + tx;
  float wv[64];
#pragma unroll
  for (int u = 0; u < 64; ++u) wv[u] = w[(size_t)(ty * 64 + u) * 3072];
  for (int i = tid; i < 5 * 1024; i += NT) {
    const int ci = i >> 10, k = i & 1023;
    const float c = ci == 0 ? lin(p, 8)[k] : lin(p, 7)[(ci - 1) * 1024 + k];
    scond[i] = c / (1.f + expf(-c));
  }
  __syncthreads();
  float acc[5] = {0.f, 0.f, 0.f, 0.f, 0.f};
#pragma unroll
  for (int u = 0; u < 64; ++u) {
    const int k = ty * 64 + u;
#pragma unroll
    for (int ci = 0; ci < 5; ++ci) acc[ci] += scond[ci * 1024 + k] * wv[u];
  }
#pragma unroll
  for (int ci = 0; ci < 5; ++ci) red[(ty * 5 + ci) * 32 + tx] = acc[ci];
  __syncthreads();
  if (tid < 160) {
    const int ci = tid >> 5, x = tid & 31;
    float s = 0.f;
    for (int y = 0; y < 16; ++y) s += red[(y * 5 + ci) * 32 + x];
    const int col = cb * 32 + x;
    float* mod = (float*)(lws(p) + WS_MOD);
    mod[(l * 5 + ci) * 3072 + col] = s + lin(p, 11)[l * 3072 + col];
  }
  __syncthreads();
}

DI void ph0_s5(PR p, int t) {
  const int tid = ltid();
  const int idx = t * 32 + (tid >> 4), i = tid & 15;
  const int ldg = idx >> 6, pp = idx & 63;
  const float lre = lin(p, 13)[idx], lim = lin(p, 14)[idx], ls = lin(p, 15)[ldg];
  const float step = expf(ls);
  const float mag = expf(lre * step);
  float sn, cs; sincosf(lim * step, &sn, &cs);
  const float ar = mag * cs, ai = mag * sn;
  const float den = lre * lre + lim * lim;
  const float fr = ((ar - 1.f) * lre + ai * lim) / den;
  const float fi = (ai * lre - (ar - 1.f) * lim) / den;
  if (i == 0) { ((float*)(lws(p) + WS_S5AR))[idx] = ar; ((float*)(lws(p) + WS_S5AI))[idx] = ai; }
  bf16_t* bb = (bf16_t*)(lws(p) + WS_S5BB) + (size_t)ldg * 128 * 16;
  bf16_t* ct = (bf16_t*)(lws(p) + WS_S5CT) + (size_t)ldg * 16 * 128;
  const float br = lin(p, 16)[(size_t)idx * 16 + i], bi = lin(p, 17)[(size_t)idx * 16 + i];
  bb[pp * 16 + i] = f2bf(fr * br - fi * bi);
  bb[(64 + pp) * 16 + i] = f2bf(fr * bi + fi * br);
  const float cr = lin(p, 18)[((size_t)ldg * 16 + i) * 64 + pp];
  const float cim = lin(p, 19)[((size_t)ldg * 16 + i) * 64 + pp];
  ct[i * 128 + pp] = f2bf(cr);
  ct[i * 128 + 64 + pp] = f2bf(-cim);
}

DI void ph0_misc(PR p) {
  const int tid = threadIdx.x;
  float* rc = (float*)(lws(p) + WS_ROPE);
  for (int i = tid; i < 1024; i += NT) {
    const int pos = i >> 4, f = i & 15;
    const float inv = powf(10000.f, -(float)f / 16.f);
    const float ang = (float)pos * inv;
    float sn, cs; sincosf(ang, &sn, &cs);
    rc[i] = cs; rc[1024 + i] = sn;
  }
  if (tid < 2) {
    const int l = tid;
    const float* dl = lin(p, 22) + l * 256;
    float s0 = 0.f, s1 = 0.f;
    for (int i = 0; i < 64; ++i) { s0 += dl[i] * dl[64 + i]; s1 += dl[128 + i] * dl[192 + i]; }
    const float lam_init = 0.8f - 0.6f * expf(-0.3f * (float)l);
    ((float*)(lws(p) + WS_LAM))[l] = expf(s0) - expf(s1) + lam_init;
  }
}
DI void ph0_wba(PR p, int t) {
  const int i = t * NT + ltid();
  const int l = i >> 14, j = (i >> 10) & 15, k = i & 1023;
  ((float*)(lws(p) + WS_WBA))[i] = lin(p, 12)[((size_t)l * 1024 + k) * NIN + 5120 + j];
}

DI void cvt_tile(const float* src, size_t ld_src, bf16_t* dst, size_t ld_dst, char* lds) {
  float* t = (float*)lds;
  const int tid = ltid();
  const int r = tid >> 6, c4 = (tid & 63) * 4;
  f32x4 v[8];
#pragma unroll
  for (int ps = 0; ps < 8; ++ps) v[ps] = *(const f32x4*)(src + (size_t)(r + 8 * ps) * ld_src + c4);
#pragma unroll
  for (int ps = 0; ps < 8; ++ps) {
    const int k = r + 8 * ps;
    t[k * 257 + c4 + 0] = v[ps][0]; t[k * 257 + c4 + 1] = v[ps][1]; t[k * 257 + c4 + 2] = v[ps][2]; t[k * 257 + c4 + 3] = v[ps][3];
  }
  __syncthreads();
  const int kc = tid & 7;
#pragma unroll
  for (int i = 0; i < 4; ++i) {
    const int n = (tid >> 3) + 64 * i;
    float w[8];
#pragma unroll
    for (int j = 0; j < 8; ++j) w[j] = t[(kc * 8 + j) * 257 + n];
    u32x4 o = {pack2(w[0], w[1]), pack2(w[2], w[3]), pack2(w[4], w[5]), pack2(w[6], w[7])};
    *(u32x4*)(dst + (size_t)n * ld_dst + kc * 8) = o;
  }
  __syncthreads();
}

DI void cvt_win_tile(PR p, int l, int t, char* lds) {
  const int kt = t & 15, nq = t >> 4;
  const int n0 = nq * 256, nsrc = n0 < 5120 ? n0 : n0 + 16;
  cvt_tile(lin(p, 12) + ((size_t)l * 1024 + kt * 64) * NIN + nsrc, NIN,
           (bf16_t*)(lws(p) + (l == 0 ? WS_R1 : WS_WIN1)) + (size_t)n0 * 1024 + kt * 64, 1024, lds);
}
DI void cvt_other_tile(PR p, int t, char* lds) {
  if (t < 32) {
    const int l = t >> 4, q = t & 15, kt = q & 7, nq = q >> 3;
    cvt_tile(lin(p, 21) + ((size_t)l * 512 + kt * 64) * 512 + nq * 256, 512,
             (bf16_t*)(lws(p) + WS_WTGLU) + ((size_t)l * 512 + nq * 256) * 512 + kt * 64, 512, lds);
  } else if (t < 224) {
    const int u = t - 32, ln = u >> 5, q = u & 31, kt = q & 7, nq = q >> 3;
    cvt_tile(lin(p, 28) + ((size_t)ln * 512 + kt * 64) * 1024 + nq * 256, 1024,
             (bf16_t*)(lws(p) + WS_WTBR) + ((size_t)ln * 1024 + nq * 256) * 512 + kt * 64, 512, lds);
  } else {
    const int u = t - 224, l = u >> 6, q = u & 63, kt = q & 15, nq = q >> 4;
    cvt_tile(lin(p, 29) + ((size_t)l * 1024 + kt * 64) * 1024 + nq * 256, 1024,
             (bf16_t*)(lws(p) + WS_WTOUT) + ((size_t)l * 1024 + nq * 256) * 1024 + kt * 64, 1024, lds);
  }
}

DI void ph1_norm_rows(PR p, int l, int rb, float* wba_lds, const f32x4 (&wreg)[8], const bool fill) {
  const int lane = ltid() & 63;
  const int r0 = rb * 4, ci = row_cond(r0);
  const float* mod = (const float*)(lws(p) + WS_MOD) + (size_t)(l * 5 + ci) * 3072;
  const float* ng = lin(p, 9) + l * 1024;
  bf16_t* hn = (bf16_t*)(lws(p) + WS_HN);
  float h[4][16];
#pragma unroll
  for (int ri = 0; ri < 4; ++ri) {
    const float* x = x_in_row(p, l, r0 + ri);
#pragma unroll
    for (int i = 0; i < 4; ++i) {
      const f32x4 v = *(const f32x4*)(x + (i * 64 + lane) * 4);
#pragma unroll
      for (int e = 0; e < 4; ++e) h[ri][i * 4 + e] = v[e];
    }
  }
  f32x4 gv[4], shv[4], scv[4];
#pragma unroll
  for (int i = 0; i < 4; ++i) {
    const int k = (i * 64 + lane) * 4;
    gv[i] = *(const f32x4*)(ng + k); shv[i] = *(const f32x4*)(mod + k); scv[i] = *(const f32x4*)(mod + 1024 + k);
  }
  if (fill) {
    const int tid = ltid();
#pragma unroll
    for (int i = 0; i < 8; ++i) *(f32x4*)(wba_lds + (tid + NT * i) * 4) = wreg[i];
    __syncthreads();
  }
#pragma unroll
  for (int ri = 0; ri < 4; ++ri) {
    float ss = 0.f;
#pragma unroll
    for (int e = 0; e < 16; ++e) ss += h[ri][e] * h[ri][e];
    ss = wave_sum(ss);
    const float rstd = rsqrtf(ss * (1.f / 1024.f) + EPS);
#pragma unroll
    for (int i = 0; i < 4; ++i) {
      const int k = (i * 64 + lane) * 4;
      const f32x4 g = gv[i], sh = shv[i], sc = scv[i];
#pragma unroll
      for (int e = 0; e < 4; ++e) h[ri][i * 4 + e] = h[ri][i * 4 + e] * rstd * g[e] * (1.f + sc[e]) + sh[e];
      u32x2 o = {pack2(h[ri][i * 4 + 0], h[ri][i * 4 + 1]), pack2(h[ri][i * 4 + 2], h[ri][i * 4 + 3])};
      *(u32x2*)(hn + (size_t)(r0 + ri) * 1024 + k) = o;
    }
  }
  float pt[64];
#pragma unroll
  for (int j = 0; j < 16; ++j) {
    float a0 = 0.f, a1 = 0.f, a2 = 0.f, a3 = 0.f;
#pragma unroll
    for (int i = 0; i < 4; ++i) {
      const f32x4 w = *(const f32x4*)(wba_lds + j * 1024 + (i * 64 + lane) * 4);
#pragma unroll
      for (int e = 0; e < 4; ++e) {
        a0 += h[0][i * 4 + e] * w[e]; a1 += h[1][i * 4 + e] * w[e];
        a2 += h[2][i * 4 + e] * w[e]; a3 += h[3][i * 4 + e] * w[e];
      }
    }
    pt[j] = a0; pt[16 + j] = a1; pt[32 + j] = a2; pt[48 + j] = a3;
    if ((j & 3) == 3) asm volatile("" ::: "memory");
  }
#define BFLY(n) { const bool up = (lane & (n)) != 0; _Pragma("unroll") for (int i = 0; i < (n); ++i) { \
    const float keep = up ? pt[i + (n)] : pt[i]; const float send = up ? pt[i] : pt[i + (n)]; pt[i] = keep + __shfl_xor(send, (n)); } }
  BFLY(32) BFLY(16) BFLY(8) BFLY(4) BFLY(2) BFLY(1)
#undef BFLY
  const float v = pt[0];
  {
    const int ri = lane >> 4, j = lane & 15;
    float res;
    if (j < 8) res = 1.f / (1.f + __expf(-v));
    else {
      const int jj = j - 8;
      const float xx = v + lin(p, 26)[l * 8 + jj];
      const float sp = xx > 20.f ? xx : __logf(1.f + __expf(xx));
      res = -__expf(lin(p, 25)[l * 8 + jj]) * sp;
    }
    ((float*)(lws(p) + WS_BETAG))[(size_t)(r0 + ri) * 16 + j] = res;
  }
}

constexpr int G_STAGE = 49152;
DI void gemm_gload(int tid, const bf16_t* A, size_t lda, const bf16_t* B, size_t ldb, int k0, u32x4 (&ra)[4], u32x4 (&rb)[2]) {
#pragma unroll
  for (int i = 0; i < 4; ++i) { const int id = tid + NT * i, row = id >> 3, ch = id & 7; ra[i] = *(const u32x4*)(A + (size_t)row * lda + k0 + ch * 8); }
#pragma unroll
  for (int i = 0; i < 2; ++i) { const int id = tid + NT * i, row = id >> 3, ch = id & 7; rb[i] = *(const u32x4*)(B + (size_t)row * ldb + k0 + ch * 8); }
}
DI void gemm_lstore(int tid, char* st, const u32x4 (&ra)[4], const u32x4 (&rb)[2]) {
#pragma unroll
  for (int i = 0; i < 4; ++i) { const int id = tid + NT * i, row = id >> 3, ch = id & 7; *(u32x4*)(st + row * 128 + ((ch ^ ((row >> 1) & 7)) << 4)) = ra[i]; }
#pragma unroll
  for (int i = 0; i < 2; ++i) { const int id = tid + NT * i, row = id >> 3, ch = id & 7; *(u32x4*)(st + 32768 + row * 128 + ((ch ^ ((row >> 1) & 7)) << 4)) = rb[i]; }
}
template <bool TR = false> DI void gemm_compute(const char* st, f32x16 (&acc)[2][2], int wm, int wn, int lane) {
  const int r = lane & 31, h = lane >> 5, sw = (r >> 1) & 7;
#pragma unroll
  for (int s = 0; s < 4; ++s) {
    const int ch = ((2 * s + h) ^ sw) << 4;
    bf16x8 a[2], b[2];
#pragma unroll
    for (int mi = 0; mi < 2; ++mi) a[mi] = *(const bf16x8*)(st + (wm * 64 + mi * 32 + r) * 128 + ch);
#pragma unroll
    for (int ni = 0; ni < 2; ++ni) b[ni] = *(const bf16x8*)(st + 32768 + (wn * 64 + ni * 32 + r) * 128 + ch);
#pragma unroll
    for (int mi = 0; mi < 2; ++mi)
#pragma unroll
      for (int ni = 0; ni < 2; ++ni) acc[mi][ni] = TR ? MFMA32(b[ni], a[mi], acc[mi][ni]) : MFMA32(a[mi], b[ni], acc[mi][ni]);
  }
}
template <bool TR = false> DI void gemm_mainloop(int tid, const bf16_t* A, size_t lda, const bf16_t* B, size_t ldb, int K, f32x16 (&acc)[2][2], char* lds) {
  const int wave = tid >> 6, lane = tid & 63, wm = wave >> 1, wn = wave & 1;
  u32x4 ra[4], rb[2];
  gemm_gload(tid, A, lda, B, ldb, 0, ra, rb);
  gemm_lstore(tid, lds, ra, rb);
  __syncthreads();
  const int KT = K >> 6;
  for (int kt = 0; kt < KT; ++kt) {
    char* cur = lds + (kt & 1) * G_STAGE;
    char* nxt = lds + ((kt + 1) & 1) * G_STAGE;
    if (kt + 1 < KT) gemm_gload(tid, A, lda, B, ldb, (kt + 1) * 64, ra, rb);
    gemm_compute<TR>(cur, acc, wm, wn, lane);
    if (kt + 1 < KT) gemm_lstore(tid, nxt, ra, rb);
    __syncthreads();
  }
}
template <bool TR = false> DI void gemm_mainloop_dma(int tid, const bf16_t* A, size_t lda, const bf16_t* B, size_t ldb, int K, f32x16 (&acc)[2][2], char* lds) {
  const int wave = tid >> 6, lane = tid & 63, wm = wave >> 1, wn = wave & 1;
  const int wv = __builtin_amdgcn_readfirstlane(wave);
  const int prow = lane >> 3, pc = lane & 7;
  size_t offA[4], offB[2];
#pragma unroll
  for (int i = 0; i < 4; ++i) { const int row = 64 * i + 8 * wv + prow; offA[i] = (size_t)row * lda + ((pc ^ ((row >> 1) & 7)) << 3); }
#pragma unroll
  for (int i = 0; i < 2; ++i) { const int row = 64 * i + 8 * wv + prow; offB[i] = (size_t)row * ldb + ((pc ^ ((row >> 1) & 7)) << 3); }
  auto issue = [&](int kt, int stage) {
    char* st = lds + stage * G_STAGE;
#pragma unroll
    for (int i = 0; i < 4; ++i)
      __builtin_amdgcn_global_load_lds((const unsigned*)(A + offA[i] + kt * 64), (LAS unsigned*)(LAS char*)(st + (64 * i + 8 * wv) * 128), 16, 0, 0);
#pragma unroll
    for (int i = 0; i < 2; ++i)
      __builtin_amdgcn_global_load_lds((const unsigned*)(B + offB[i] + kt * 64), (LAS unsigned*)(LAS char*)(st + 32768 + (64 * i + 8 * wv) * 128), 16, 0, 0);
  };
  const int KT = K >> 6;
  issue(0, 0);
  issue(1, 1);
  int stage = 0;
  for (int kt = 0; kt < KT; ++kt) {
    if (kt + 1 < KT) asm volatile("s_waitcnt vmcnt(6)" ::: "memory"); else asm volatile("s_waitcnt vmcnt(0)" ::: "memory");
    __builtin_amdgcn_s_barrier();
    asm volatile("" ::: "memory");
    if (kt + 2 < KT) issue(kt + 2, stage == 0 ? 2 : stage - 1);
    gemm_compute<TR>(lds + stage * G_STAGE, acc, wm, wn, lane);
    stage = stage == 2 ? 0 : stage + 1;
  }
  __builtin_amdgcn_s_barrier();
  asm volatile("" ::: "memory");
}
DI void acc_zero(f32x16 (&acc)[2][2]) {
#pragma unroll
  for (int a = 0; a < 2; ++a)
#pragma unroll
    for (int b = 0; b < 2; ++b)
#pragma unroll
      for (int i = 0; i < 16; ++i) acc[a][b][i] = 0.f;
}
DI void tile_store_bf16(int tid, const f32x16 (&acc)[2][2], bf16_t* dst, size_t ldd, char* lds) {
  const int wave = tid >> 6, lane = tid & 63, wm = wave >> 1, wn = wave & 1;
  const int cl = lane & 31, h = lane >> 5;
#pragma unroll
  for (int mi = 0; mi < 2; ++mi)
#pragma unroll
    for (int ni = 0; ni < 2; ++ni)
#pragma unroll
      for (int i = 0; i < 16; ++i) {
        const int row = wm * 64 + mi * 32 + (i & 3) + 8 * (i >> 2) + 4 * h;
        const int col = wn * 64 + ni * 32 + cl;
        *(bf16_t*)(lds + row * 272 + col * 2) = f2bf(acc[mi][ni][i]);
      }
  __syncthreads();
#pragma unroll
  for (int i = 0; i < 8; ++i) {
    const int id = tid + NT * i, row = id >> 4, ch = id & 15;
    const u32x4 v = *(const u32x4*)(lds + row * 272 + ch * 16);
    *(u32x4*)(dst + (size_t)row * ldd + ch * 8) = v;
  }
  __syncthreads();
}

DI void ph2_inproj_tile(PR p, int l, int t, char* lds) {
  const int tid = ltid();
  const int nt = t & 63, mt = t >> 6;
  const int m0 = mt * 256, n0 = nt * 128;
  const bf16_t* A = (const bf16_t*)(lws(p) + WS_HN) + (size_t)m0 * 1024;
  const bf16_t* B = (const bf16_t*)(lws(p) + (l == 0 ? WS_R1 : WS_WIN1)) + (size_t)n0 * 1024;
  f32x16 acc[2][2];
  acc_zero(acc);
  gemm_mainloop(tid, A, 1024, B, 1024, 1024, acc, lds);
  if (m0 < 4096 && n0 >= C_KB && n0 < C_ZB) {
    const int wave = tid >> 6, lane = tid & 63, wm = wave >> 1, wn = wave & 1;
    float* base = lout(p) + (n0 < C_VB ? O_CK : O_CV);
    const int cb = (n0 < C_VB ? n0 - C_KB : n0 - C_VB);
#pragma unroll
    for (int mi = 0; mi < 2; ++mi)
#pragma unroll
      for (int ni = 0; ni < 2; ++ni)
#pragma unroll
        for (int i = 0; i < 16; ++i) {
          const int row = m0 + wm * 64 + mi * 32 + (i & 3) + 8 * (i >> 2) + 4 * (lane >> 5);
          const int col = cb + wn * 64 + ni * 32 + (lane & 31);
          const int b = row >> 8, tt = row & 255;
          base[((size_t)(b * 2 + l) * 256 + tt) * 512 + col] = acc[mi][ni][i];
        }
  }
  tile_store_bf16(tid, acc, (bf16_t*)(lws(p) + WS_PROJ) + (size_t)m0 * NP + n0, NP, lds);
}

DI void ph6_merge_tile(PR p, int l, int t, char* lds) {
  const int tid = ltid();
  const int nt = t & 7, mt = t >> 3;
  const int m0 = mt * 256, n0 = nt * 128;
  const int wave = tid >> 6, lane = tid & 63, wm = wave >> 1, wn = wave & 1, r = lane & 31, h = lane >> 5;
  const int wv = __builtin_amdgcn_readfirstlane(wave);
  const bf16_t* proj = (const bf16_t*)(lws(p) + WS_PROJ);
  unsigned tot[2][2][8];
#pragma unroll
  for (int a = 0; a < 2; ++a)
#pragma unroll
    for (int b = 0; b < 2; ++b)
#pragma unroll
      for (int i = 0; i < 8; ++i) tot[a][b][i] = 0u;
  const bf16_t* wbr = (const bf16_t*)(lws(p) + WS_WTBR) + ((size_t)(l * 3) * 1024 + n0) * 512;
  const int prow = lane >> 3, pc = lane & 7;
  size_t offA[4], offB[2];
#pragma unroll
  for (int i = 0; i < 4; ++i) { const int row = 64 * i + 8 * wv + prow; offA[i] = (size_t)row * PJ_LD + ((pc ^ ((row >> 1) & 7)) << 3); }
#pragma unroll
  for (int i = 0; i < 2; ++i) { const int row = 64 * i + 8 * wv + prow; offB[i] = (size_t)row * 512 + ((pc ^ ((row >> 1) & 7)) << 3); }
  auto issue = [&](int kt) {
    const int n = kt >> 3, kk = kt & 7;
    const bf16_t* A = proj + pjx(m0, n == 0 ? C_UA : (n == 1 ? C_QB : C_QC)) + kk * 64;
    const bf16_t* B = wbr + (size_t)n * 1024 * 512 + kk * 64;
    char* st = lds + (kt % 3) * G_STAGE;
#pragma unroll
    for (int i = 0; i < 4; ++i)
      __builtin_amdgcn_global_load_lds((const unsigned*)(A + offA[i]), (LAS unsigned*)(LAS char*)(st + (64 * i + 8 * wv) * 128), 16, 0, 0);
#pragma unroll
    for (int i = 0; i < 2; ++i)
      __builtin_amdgcn_global_load_lds((const unsigned*)(B + offB[i]), (LAS unsigned*)(LAS char*)(st + 32768 + (64 * i + 8 * wv) * 128), 16, 0, 0);
  };
  u32x2 gt[3][2][2][4];
  auto gload = [&](int n) {
#pragma unroll
    for (int mi = 0; mi < 2; ++mi)
#pragma unroll
      for (int ni = 0; ni < 2; ++ni)
#pragma unroll
        for (int g4 = 0; g4 < 4; ++g4)
          gt[n][mi][ni][g4] = *(const u32x2*)(proj + pjx(m0 + wm * 64 + mi * 32 + r, C_GT + n * 1024 + n0 + wn * 64 + ni * 32 + 8 * g4 + 4 * h));
  };
  f32x16 acc[2][2];
  acc_zero(acc);
  gload(0);
  issue(0); issue(1);
  gload(1);
#pragma unroll
  for (int kt = 0; kt < 24; ++kt) {
    const bool gy = (kt == 0 || kt == 1 || kt == 9 || kt == 10);
    if (kt == 23) asm volatile("s_waitcnt vmcnt(0)" ::: "memory");
    else if (gy) asm volatile("s_waitcnt vmcnt(22)" ::: "memory");
    else asm volatile("s_waitcnt vmcnt(6)" ::: "memory");
    __builtin_amdgcn_s_barrier();
    asm volatile("" ::: "memory");
    if (kt + 2 < 24) issue(kt + 2);
    if (kt == 8) gload(2);
    gemm_compute<true>(lds + (kt % 3) * G_STAGE, acc, wm, wn, lane);
    if ((kt & 7) == 7) {
      const int n = kt >> 3;
#pragma unroll
      for (int mi = 0; mi < 2; ++mi)
#pragma unroll
        for (int ni = 0; ni < 2; ++ni)
#pragma unroll
          for (int g4 = 0; g4 < 4; ++g4) {
            const u32x2 g = gt[n][mi][ni][g4];
            const unsigned o0 = tot[mi][ni][2 * g4], o1 = tot[mi][ni][2 * g4 + 1];
            tot[mi][ni][2 * g4]     = pack2(lo_f(o0) + lo_f(g[0]) * acc[mi][ni][4 * g4 + 0], hi_f(o0) + hi_f(g[0]) * acc[mi][ni][4 * g4 + 1]);
            tot[mi][ni][2 * g4 + 1] = pack2(lo_f(o1) + lo_f(g[1]) * acc[mi][ni][4 * g4 + 2], hi_f(o1) + hi_f(g[1]) * acc[mi][ni][4 * g4 + 3]);
          }
      acc_zero(acc);
    }
  }
  __builtin_amdgcn_s_barrier();
  asm volatile("" ::: "memory");
  bf16_t* dst = (bf16_t*)(lws(p) + WS_MIX) + (size_t)m0 * 1024 + n0;
#pragma unroll
  for (int mi = 0; mi < 2; ++mi)
#pragma unroll
    for (int ni = 0; ni < 2; ++ni)
#pragma unroll
      for (int g4 = 0; g4 < 4; ++g4) {
        const int row = wm * 64 + mi * 32 + r, col = wn * 64 + ni * 32 + 8 * g4 + 4 * h;
        const u32x2 v = {tot[mi][ni][2 * g4], tot[mi][ni][2 * g4 + 1]};
        *(u32x2*)(lds + row * 272 + col * 2) = v;
      }
  __syncthreads();
#pragma unroll
  for (int i = 0; i < 8; ++i) {
    const int id = tid + NT * i, row = id >> 4, ch = id & 15;
    const u32x4 v = *(const u32x4*)(lds + row * 272 + ch * 16);
    *(u32x4*)(dst + (size_t)row * 1024 + ch * 8) = v;
  }
  __syncthreads();
}

DI void ph7_out_tile(PR p, int l, int t, char* lds) {
  const int tid = ltid();
  const int nt = t & 7, mt = t >> 3;
  const int m0 = mt * 256, n0 = nt * 128;
  const int wave = tid >> 6, lane = tid & 63, wm = wave >> 1, wn = wave & 1;
  const bf16_t* A = (const bf16_t*)(lws(p) + WS_MIX) + (size_t)m0 * 1024;
  const bf16_t* B = (const bf16_t*)(lws(p) + WS_WTOUT) + ((size_t)l * 1024 + n0) * 1024;
  f32x4 xpre[16];
#pragma unroll
  for (int i = 0; i < 16; ++i) {
    const int id = tid + NT * i, row = id >> 5, c4 = (id & 31) * 4;
    xpre[i] = *(const f32x4*)(x_in_row(p, l, m0 + row) + n0 + c4);
  }
  const float* mod = (const float*)(lws(p) + WS_MOD) + (size_t)l * 5 * 3072;
  const int cnd0 = row_cond(m0);
  const bool unic = cnd0 == row_cond(m0 + 255);
  const f32x4 gate0 = *(const f32x4*)(mod + cnd0 * 3072 + 2048 + n0 + (tid & 31) * 4);
  f32x16 acc[2][2];
  acc_zero(acc);
  gemm_mainloop_dma<false>(tid, A, 1024, B, 1024, 1024, acc, lds);
  float* ct = (float*)lds;
#pragma unroll
  for (int mi = 0; mi < 2; ++mi)
#pragma unroll
    for (int ni = 0; ni < 2; ++ni)
#pragma unroll
      for (int i = 0; i < 16; ++i) {
        const int row = wm * 64 + mi * 32 + (i & 3) + 8 * (i >> 2) + 4 * (lane >> 5);
        const int col = wn * 64 + ni * 32 + (lane & 31);
        ct[row * 132 + col] = acc[mi][ni][i];
      }
  __syncthreads();
#pragma unroll
  for (int i = 0; i < 16; ++i) {
    const int id = tid + NT * i, row = id >> 5, c4 = (id & 31) * 4;
    const int grow = m0 + row, gcol = n0 + c4;
    const f32x4 y = *(const f32x4*)(ct + row * 132 + c4);
    f32x4 gate = gate0;
    if (!unic) gate = *(const f32x4*)(mod + row_cond(grow) * 3072 + 2048 + gcol);
    const f32x4 xo = xpre[i];
    f32x4 o;
#pragma unroll
    for (int e = 0; e < 4; ++e) o[e] = xo[e] + gate[e] * y[e];
    *(f32x4*)(lout(p) + O_Y + (size_t)grow * DM + gcol) = o;
  }
  __syncthreads();
}

template <int NR> DI void ph_final_rows(PR p, int r0, int rs) {
  const int lane = ltid() & 63;
  float* xb = lout(p) + O_Y;
  f32x4 v[NR][4];
#pragma unroll
  for (int k = 0; k < NR; ++k)
#pragma unroll
    for (int i = 0; i < 4; ++i) v[k][i] = *(const f32x4*)(xb + (size_t)(r0 + k * rs) * DM + (i * 64 + lane) * 4);
  f32x4 g[4];
#pragma unroll
  for (int i = 0; i < 4; ++i) g[i] = *(const f32x4*)(lin(p, 30) + (i * 64 + lane) * 4);
#pragma unroll
  for (int k = 0; k < NR; ++k) {
    float ss = 0.f;
#pragma unroll
    for (int i = 0; i < 4; ++i) ss += v[k][i][0] * v[k][i][0] + v[k][i][1] * v[k][i][1] + v[k][i][2] * v[k][i][2] + v[k][i][3] * v[k][i][3];
    ss = wave_sum(ss);
    const float rstd = rsqrtf(ss * (1.f / 1024.f) + EPS);
#pragma unroll
    for (int i = 0; i < 4; ++i) {
      f32x4 o;
#pragma unroll
      for (int e = 0; e < 4; ++e) o[e] = v[k][i][e] * rstd * g[i][e];
      *(f32x4*)(xb + (size_t)(r0 + k * rs) * DM + (i * 64 + lane) * 4) = o;
    }
  }
}

namespace pg8 {
#define PG8_LAS __attribute__((address_space(3)))
typedef unsigned short bf16_t;
typedef short bf16x8 __attribute__((ext_vector_type(8)));
typedef float f32x4 __attribute__((ext_vector_type(4)));
typedef unsigned u32x4 __attribute__((ext_vector_type(4)));
constexpr int BM = 256, BK = 64, HALF = 128, HTB = HALF * BK * 2  , STAGE_BYTES = 8 * HTB, NXCD = 8, WGM = 8;

__host__ __device__ __forceinline__ int lds_byte(int r, int c) { const int st = (r >> 4) * 2 + (c >> 5), rr = r & 15, cc = c & 31, ob = rr * 64 + cc * 2; return st * 1024 + (ob ^ (((ob >> 9) & 1) << 5)); }
__host__ __device__ __forceinline__ void stage_rc(int b, int& R, int& C) { const int st = b / 1024, sb = b % 1024, swz = sb ^ (((sb >> 9) & 1) << 5); R = (st >> 1) * 16 + swz / 64; C = (st & 1) * 32 + (swz % 64) / 2; }
__host__ __device__ __forceinline__ int perm32(int rho) { const int n = rho >> 4, i = rho & 15; return 8 * (i >> 2) + 4 * n + (i & 3); }

struct Unit { int pm, pn, grp; };
struct Gemm { const bf16_t* A; const bf16_t* Bt; int M, N, K, lda, ldb; };

struct StaticOrder {
    int nM, nN, nwg, G, c;
    __host__ __device__ void init(int M, int N, int G_, int c_) { nM = M / BM; nN = N / BM; nwg = nM * nN; G = G_; c = c_; }
    __host__ __device__ bool next(int i, Unit& u) const {
        const long L = (long)i * G + c; if (L >= nwg) return false;
        int wgid = (int)L; { const int q = nwg / NXCD, r = nwg % NXCD, xcd = wgid % NXCD, off = wgid / NXCD; wgid = (xcd < r ? xcd * (q + 1) : r * (q + 1) + (xcd - r) * q) + off; }
        const int nig = WGM * nN, gid = wgid / nig, fm = gid * WGM, gsz = (nM - fm) < WGM ? (nM - fm) : WGM;
        u.pm = fm + ((wgid % nig) % gsz); u.pn = (wgid % nig) / gsz; u.grp = 0; return true;
    }
    __device__ __forceinline__ void a_ready(const Unit&) const {}
    __device__ __forceinline__ void done(const Unit&) const {}
    __device__ __forceinline__ const char* a_base(const Gemm& g, const Unit& u, size_t tstepA) const { return (const char*)g.A + (size_t)u.pm * tstepA; }
    __device__ __forceinline__ const char* b_base(const Gemm& g, const Unit& u, size_t tstepB) const { return (const char*)g.Bt + (size_t)u.pn * tstepB; }
};

__device__ __forceinline__ unsigned cvt_pk_bf16(float lo, float hi) { unsigned r; asm volatile("v_cvt_pk_bf16_f32 %0, %1, %2" : "=v"(r) : "v"(lo), "v"(hi)); return r; }

template <class Epi, class Sched, bool STAMP = false>
__device__ __forceinline__ void gemm_phase(PG8_LAS unsigned char* lds, const Gemm g, const Sched& S, const Epi& E, unsigned long long* stamps) {
    const int tid = ltid(), wid = __builtin_amdgcn_readfirstlane(tid >> 6), lane = tid & 63, wr = wid >> 2, wc = wid & 3, fr = lane & 15, fq = lane >> 4;
    const int K = g.K, nt = K / BK;
    int ts_lo = 0, ts_hi = 0, nts = 0; const unsigned long long rt_entry = STAMP ? (unsigned long long)wall_clock64() : 0ull;
#define PG8_STAMP() do { if (STAMP && wid == 0 && nts < 64) { const unsigned long long _c = (unsigned long long)clock64(); \
        ts_lo = (lane == nts) ? (int)(unsigned)_c : ts_lo; ts_hi = (lane == nts) ? (int)(unsigned)(_c >> 32) : ts_hi; ++nts; } } while (0)
    PG8_STAMP();
    unsigned voffA[2], voffB[2];
#pragma unroll
    for (int i = 0; i < 2; ++i) { int R, C; stage_rc(tid * 16 + i * 8192, R, C); const int Rb = Epi::PERM ? ((R & ~31) + perm32(R & 31)) : R;
        voffA[i] = (unsigned)(R * g.lda + C) * 2u; voffB[i] = (unsigned)(Rb * g.ldb + C) * 2u; }
    const size_t kstep = (size_t)(BK * 2);
    const size_t hstepA = (size_t)HALF * g.lda * 2, hstepB = (size_t)HALF * g.ldb * 2;
    const size_t tstepA = 2 * hstepA, tstepB = 2 * hstepB;
    const unsigned ldsw = (unsigned)wid * 1024u;
    const int aoff = lds_byte(wr * 64 + fr, fq * 8), boff = lds_byte(wc * 32 + fr, fq * 8);
#define PG8_SA(b, h) (((b) * 2 + (h)) * HTB)
#define PG8_SB(b, h) ((4 + (b) * 2 + (h)) * HTB)
#define PG8_STAGE(bufoff, gbase, voff) do { _Pragma("unroll") for (int _i = 0; _i < 2; ++_i) \
        __builtin_amdgcn_global_load_lds((const unsigned*)((const char*)(gbase) + (voff)[_i]), (PG8_LAS unsigned*)(lds + (bufoff) + ldsw + _i * 8192), 16, 0, 0); } while (0)
#define PG8_LDA(dst, b, h) do { _Pragma("unroll") for (int m = 0; m < 4; ++m) _Pragma("unroll") for (int k = 0; k < 2; ++k) dst[m][k] = *(const PG8_LAS bf16x8*)(lds + PG8_SA(b, h) + aoff + m * 2048 + k * 1024); } while (0)
#define PG8_LDB(dst, b, h) do { _Pragma("unroll") for (int n = 0; n < 2; ++n) _Pragma("unroll") for (int k = 0; k < 2; ++k) dst[n][k] = *(const PG8_LAS bf16x8*)(lds + PG8_SB(b, h) + boff + n * 2048 + k * 1024); } while (0)
#define PG8_MMA(ai, bj, At, Bt) do { __builtin_amdgcn_s_setprio(1); _Pragma("unroll") for (int m = 0; m < 4; ++m) _Pragma("unroll") for (int n = 0; n < 2; ++n) _Pragma("unroll") for (int k = 0; k < 2; ++k) \
        acc[ai][bj][m][n] = __builtin_amdgcn_mfma_f32_16x16x32_bf16(Bt[n][k], At[m][k], acc[ai][bj][m][n], 0, 0, 0); __builtin_amdgcn_s_setprio(0); } while (0)
#define PG8_WAIT_V(n) asm volatile("s_waitcnt vmcnt(" #n ")" ::: "memory")
#define PG8_WAIT_L(n) asm volatile("s_waitcnt lgkmcnt(" #n ")" ::: "memory")
#define PG8_BAR __builtin_amdgcn_s_barrier()
#define PG8_SCHED __builtin_amdgcn_sched_barrier(0)
    Unit cur, nxt; int ui = 0;
    if (!S.next(0, cur)) return;
    f32x4 acc[2][2][4][2];
#pragma unroll
    for (int a = 0; a < 2; ++a)
#pragma unroll
        for (int b = 0; b < 2; ++b)
#pragma unroll
            for (int m = 0; m < 4; ++m)
#pragma unroll
                for (int n = 0; n < 2; ++n) acc[a][b][m][n] = (f32x4){0.f, 0.f, 0.f, 0.f};
    bf16x8 At[4][2], B0[2][2], B1[2][2];
    const char* cA = S.a_base(g, cur, tstepA); const char* cB = S.b_base(g, cur, tstepB);
    S.a_ready(cur);
    PG8_STAGE(PG8_SB(0, 0), cB, voffB); PG8_STAGE(PG8_SA(0, 0), cA, voffA); PG8_STAGE(PG8_SB(0, 1), cB + hstepB, voffB); PG8_STAGE(PG8_SA(0, 1), cA + hstepA, voffA);
    if (wr == 1) PG8_BAR;
    PG8_WAIT_V(4); PG8_BAR;
    PG8_STAGE(PG8_SB(1, 0), cB + kstep, voffB); PG8_STAGE(PG8_SA(1, 0), cA + kstep, voffA); PG8_STAGE(PG8_SB(1, 1), cB + hstepB + kstep, voffB);
    PG8_WAIT_V(6); PG8_BAR;
    PG8_STAMP();
    for (;;) {
        const bool has_next = S.next(ui + 1, nxt);
        const char* nA = has_next ? S.a_base(g, nxt, tstepA) : cA; const char* nB = has_next ? S.b_base(g, nxt, tstepB) : cB;
        for (int t = 0; t < nt; t += 2) {
            const bool last = (t == nt - 2);
            const char* a1 = cA + (size_t)(t + 1) * kstep;
            const char* a2 = last ? nA : cA + (size_t)(t + 2) * kstep; const char* b2 = last ? nB : cB + (size_t)(t + 2) * kstep;
            const char* a3 = a2 + kstep; const char* b3 = b2 + kstep;
            if (last && has_next) S.a_ready(nxt);
            PG8_LDB(B0, 0, 0); PG8_SCHED; PG8_LDA(At, 0, 0); PG8_STAGE(PG8_SA(1, 1), a1 + hstepA, voffA);
            PG8_WAIT_L(8); PG8_BAR; PG8_WAIT_L(0); PG8_MMA(0, 0, At, B0); PG8_BAR; PG8_SCHED;
            PG8_LDB(B1, 0, 1); PG8_STAGE(PG8_SB(0, 0), b2, voffB);
            PG8_BAR; PG8_WAIT_L(0); PG8_MMA(0, 1, At, B1); PG8_BAR;
            PG8_LDA(At, 0, 1); PG8_STAGE(PG8_SA(0, 0), a2, voffA);
            PG8_BAR; PG8_WAIT_L(0); PG8_MMA(1, 0, At, B0); PG8_BAR; PG8_SCHED;
            PG8_STAGE(PG8_SB(0, 1), b2 + hstepB, voffB);
            PG8_WAIT_V(6); PG8_BAR; PG8_MMA(1, 1, At, B1); PG8_BAR;
            PG8_LDB(B0, 1, 0); PG8_SCHED; PG8_LDA(At, 1, 0); PG8_STAGE(PG8_SA(0, 1), a2 + hstepA, voffA);
            PG8_WAIT_L(8); PG8_BAR; PG8_WAIT_L(0); PG8_MMA(0, 0, At, B0); PG8_BAR; PG8_SCHED;
            PG8_LDB(B1, 1, 1); PG8_STAGE(PG8_SB(1, 0), b3, voffB);
            PG8_BAR; PG8_WAIT_L(0); PG8_MMA(0, 1, At, B1); PG8_BAR;
            PG8_LDA(At, 1, 1); PG8_STAGE(PG8_SA(1, 0), a3, voffA);
            PG8_BAR; PG8_WAIT_L(0); PG8_MMA(1, 0, At, B0); PG8_BAR; PG8_SCHED;
            PG8_STAGE(PG8_SB(1, 1), b3 + hstepB, voffB);
            PG8_WAIT_V(6); PG8_BAR; PG8_MMA(1, 1, At, B1); PG8_BAR;
        }
        PG8_STAMP();
        if constexpr (!Epi::AFTER_DRAIN) { E(acc, cur, wr, wc, fr, fq); S.done(cur); }
        PG8_STAMP();
        if (!has_next) break;
#pragma unroll
        for (int a = 0; a < 2; ++a)
#pragma unroll
            for (int b = 0; b < 2; ++b)
#pragma unroll
                for (int m = 0; m < 4; ++m)
#pragma unroll
                    for (int n = 0; n < 2; ++n) acc[a][b][m][n] = (f32x4){0.f, 0.f, 0.f, 0.f};
        cur = nxt; cA = nA; cB = nB; ++ui;
    }
    PG8_WAIT_V(0);
    if (wr == 0) PG8_BAR;
    PG8_BAR;
    if constexpr (Epi::AFTER_DRAIN) { E.fused(acc, cur, wr, wc, fr, fq, lds, wid, lane); S.done(cur); }
    PG8_STAMP();
    if (STAMP && wid == 0) { stamps[lane] = lane < nts ? (((unsigned long long)(unsigned)ts_hi << 32) | (unsigned)ts_lo) : 0ull;
        if (lane == 62) stamps[62] = rt_entry; if (lane == 63) stamps[63] = (unsigned long long)wall_clock64(); }
#undef PG8_STAMP
#undef PG8_SA
#undef PG8_SB
#undef PG8_STAGE
#undef PG8_LDA
#undef PG8_LDB
#undef PG8_MMA
#undef PG8_WAIT_V
#undef PG8_WAIT_L
#undef PG8_BAR
#undef PG8_SCHED
}
}

struct EpiInproj {
  static constexpr bool PERM = true, AFTER_DRAIN = false;
  bf16_t* proj; float* out; int l;
  __device__ __forceinline__ void operator()(const pg8::f32x4 (&acc)[2][2][4][2], const pg8::Unit& u, int wr, int wc, int fr, int fq) const {
    int row0 = u.pm * 256 + wr * 64 + fr, col0 = u.pn * 256 + wc * 32 + 8 * fq;
    asm volatile("" : "+v"(row0), "+v"(col0));
    const bool cache = (u.pm < 16) && (u.pn >= 6) && (u.pn < 10);
    const bool gatecols = u.pn >= 20;
    const bool silucols = (u.pn & ~1) == 2 || (u.pn & ~1) == 10 || (u.pn & ~1) == 18;
    float* cbase = out + (u.pn < 8 ? O_CK : O_CV);
    const int ccol0 = col0 - (u.pn < 8 ? C_KB : C_VB);
#pragma unroll
    for (int ai = 0; ai < 2; ++ai)
#pragma unroll
      for (int m = 0; m < 4; ++m) {
        const int row = row0 + ai * 128 + m * 16;
        bf16_t* rowp = proj + pjx(row, col0);
#pragma unroll
        for (int bj = 0; bj < 2; ++bj) {
          pg8::f32x4 v0 = acc[ai][bj][m][0], v1 = acc[ai][bj][m][1];
          if (gatecols) {
#pragma unroll
            for (int e = 0; e < 4; ++e) { v0[e] = sigmoidf_(v0[e]); v1[e] = sigmoidf_(v1[e]); }
          }
          if (silucols) {
#pragma unroll
            for (int e = 0; e < 4; ++e) { v0[e] = siluf_(v0[e]); v1[e] = siluf_(v1[e]); }
          }
          const u32x4 w = {pack2(v0[0], v0[1]), pack2(v0[2], v0[3]), pack2(v1[0], v1[1]), pack2(v1[2], v1[3])};
          *(u32x4*)(rowp + bj * 128) = w;
          if (cache) {
            const int b = row >> 8, tt = row & 255;
            float* dst = cbase + ((size_t)(b * 2 + l) * 256 + tt) * 512 + ccol0 + bj * 128;
            *(f32x4*)dst = v0; *(f32x4*)(dst + 4) = v1;
          }
        }
      }
  }
};
DI void run_inproj8(PR p, int l) {
  pg8::Gemm g;
  g.A = (const bf16_t*)(lws(p) + WS_HN); g.Bt = (const bf16_t*)(lws(p) + (l == 0 ? WS_R1 : WS_WIN1)); g.M = MROWS; g.N = NP; g.K = 1024; g.lda = 1024; g.ldb = 1024;
  pg8::StaticOrder S; S.init(MROWS, NP, (int)gridDim.x, (int)blockIdx.x);
  EpiInproj E; E.proj = (bf16_t*)(lws(p) + WS_PROJ); E.out = lout(p); E.l = l;
  pg8::gemm_phase<EpiInproj, pg8::StaticOrder, false>((LAS unsigned char*)smem, g, S, E, nullptr);
}

struct MergeOrder {
  int c;
  const bf16_t* proj; const bf16_t* wbr;
  __device__ __forceinline__ bool next(int i, pg8::Unit& u) const {
    if (c >= 128 || i >= 3) return false;
    u.pm = c >> 2; u.pn = c & 3; u.grp = i; return true;
  }
  __device__ __forceinline__ void a_ready(const pg8::Unit&) const {}
  __device__ __forceinline__ void done(const pg8::Unit&) const {}
  __device__ __forceinline__ const char* a_base(const pg8::Gemm&, const pg8::Unit& u, size_t tstepA) const {
    const int acol = u.grp == 0 ? C_UA : (u.grp == 1 ? C_QB : C_QC);
    return (const char*)(proj + pjx(0, acol)) + (size_t)u.pm * tstepA;
  }
  __device__ __forceinline__ const char* b_base(const pg8::Gemm&, const pg8::Unit& u, size_t tstepB) const {
    return (const char*)(wbr + (size_t)u.grp * 1024 * 512) + (size_t)u.pn * tstepB;
  }
};
struct EpiMerge {
  static constexpr bool PERM = true, AFTER_DRAIN = false;
  const bf16_t* proj; bf16_t* mixed;
  __device__ __forceinline__ void operator()(const pg8::f32x4 (&acc)[2][2][4][2], const pg8::Unit& u, int wr, int wc, int fr, int fq) const {
    int row0 = u.pm * 256 + wr * 64 + fr, col0 = u.pn * 256 + wc * 32 + 8 * fq;
    asm volatile("" : "+v"(row0), "+v"(col0));
#pragma unroll
    for (int ai = 0; ai < 2; ++ai)
#pragma unroll
      for (int m = 0; m < 4; ++m) {
        const int row = row0 + ai * 128 + m * 16;
#pragma unroll
        for (int bj = 0; bj < 2; ++bj) {
          const int col = col0 + bj * 128;
          const u32x4 gg = *(const u32x4*)(proj + pjx(row, C_GT + u.grp * 1024 + col));
          bf16_t* mp = mixed + (size_t)row * 1024 + col;
          u32x4 prev = {0u, 0u, 0u, 0u};
          if (u.grp > 0) {
            const unsigned long long p0 = __hip_atomic_load((const unsigned long long*)mp, __ATOMIC_RELAXED, __HIP_MEMORY_SCOPE_AGENT);
            const unsigned long long p1 = __hip_atomic_load((const unsigned long long*)mp + 1, __ATOMIC_RELAXED, __HIP_MEMORY_SCOPE_AGENT);
            prev = u32x4{(unsigned)p0, (unsigned)(p0 >> 32), (unsigned)p1, (unsigned)(p1 >> 32)};
          }
          const pg8::f32x4 v0 = acc[ai][bj][m][0], v1 = acc[ai][bj][m][1];
          u32x4 w;
          w[0] = pack2(lo_f(prev[0]) + sigmoidf_(lo_f(gg[0])) * v0[0], hi_f(prev[0]) + sigmoidf_(hi_f(gg[0])) * v0[1]);
          w[1] = pack2(lo_f(prev[1]) + sigmoidf_(lo_f(gg[1])) * v0[2], hi_f(prev[1]) + sigmoidf_(hi_f(gg[1])) * v0[3]);
          w[2] = pack2(lo_f(prev[2]) + sigmoidf_(lo_f(gg[2])) * v1[0], hi_f(prev[2]) + sigmoidf_(hi_f(gg[2])) * v1[1]);
          w[3] = pack2(lo_f(prev[3]) + sigmoidf_(lo_f(gg[3])) * v1[2], hi_f(prev[3]) + sigmoidf_(hi_f(gg[3])) * v1[3]);
          *(u32x4*)mp = w;
        }
        asm volatile("" ::: "memory");
      }
  }
};
DI void run_merge8(PR p, int l) {
  pg8::Gemm g;
  g.A = (const bf16_t*)(lws(p) + WS_PROJ); g.Bt = (const bf16_t*)(lws(p) + WS_WTBR) + (size_t)l * 3 * 1024 * 512;
  g.M = MROWS; g.N = 1024; g.K = 512; g.lda = PJ_LD; g.ldb = 512;
  MergeOrder S; S.c = (int)blockIdx.x; S.proj = g.A; S.wbr = g.Bt;
  EpiMerge E; E.proj = g.A; E.mixed = (bf16_t*)(lws(p) + WS_MIX);
  pg8::gemm_phase<EpiMerge, MergeOrder, false>((LAS unsigned char*)smem, g, S, E, nullptr);
}
struct OutOrder {
  int c;
  __device__ __forceinline__ bool next(int i, pg8::Unit& u) const { if (c >= 128 || i >= 1) return false; u.pm = c >> 2; u.pn = c & 3; u.grp = 0; return true; }
  __device__ __forceinline__ void a_ready(const pg8::Unit&) const {}
  __device__ __forceinline__ void done(const pg8::Unit&) const {}
  __device__ __forceinline__ const char* a_base(const pg8::Gemm& g, const pg8::Unit& u, size_t tstepA) const { return (const char*)g.A + (size_t)u.pm * tstepA; }
  __device__ __forceinline__ const char* b_base(const pg8::Gemm& g, const pg8::Unit& u, size_t tstepB) const { return (const char*)g.Bt + (size_t)u.pn * tstepB; }
};
struct EpiOut {
  static constexpr bool PERM = false, AFTER_DRAIN = false;
  const float* x0; const float* x1; const float* xo; float* out; const float* mod; int l;
  __device__ __forceinline__ void operator()(const pg8::f32x4 (&acc)[2][2][4][2], const pg8::Unit& u, int wr, int wc, int fr, int fq) const {
    int row0 = u.pm * 256 + wr * 64 + fr, col0 = u.pn * 256 + wc * 32 + 4 * fq;
    asm volatile("" : "+v"(row0), "+v"(col0));
#pragma unroll
    for (int ai = 0; ai < 2; ++ai)
#pragma unroll
      for (int m = 0; m < 4; ++m) {
        const int row = row0 + ai * 128 + m * 16;
        const float* xr = l == 0 ? (row < 4096 ? x0 + (size_t)row * DM : x1 + (size_t)(row - 4096) * DM) : xo + (size_t)row * DM;
        const float* gr = mod + row_cond(row) * 3072 + 2048;
        float* orow_ = out + (size_t)row * DM;
#pragma unroll
        for (int bj = 0; bj < 2; ++bj)
#pragma unroll
          for (int n = 0; n < 2; ++n) {
            const int col = col0 + bj * 128 + n * 16;
            const pg8::f32x4 xv = *(const pg8::f32x4*)(xr + col), gv = *(const pg8::f32x4*)(gr + col);
            *(pg8::f32x4*)(orow_ + col) = xv + gv * acc[ai][bj][m][n];
          }
      }
  }
};
DI void run_out8(PR p, int l) {
  pg8::Gemm g;
  g.A = (const bf16_t*)(lws(p) + WS_MIX); g.Bt = (const bf16_t*)(lws(p) + WS_WTOUT) + (size_t)l * 1024 * 1024;
  g.M = MROWS; g.N = 1024; g.K = 1024; g.lda = 1024; g.ldb = 1024;
  OutOrder S; S.c = (int)blockIdx.x;
  EpiOut E; E.x0 = lin(p, 0); E.x1 = lin(p, 1); E.xo = lout(p) + O_Y; E.out = lout(p) + O_Y; E.mod = (const float*)(lws(p) + WS_MOD) + (size_t)l * 5 * 3072; E.l = l;
  pg8::gemm_phase<EpiOut, OutOrder, false>((LAS unsigned char*)smem, g, S, E, nullptr);
}

constexpr int S5_WLDS = 8192 + 4352;
DI void s5_wg_task(PR p, int l, int s, int d, int g, char* lds) {
  const int tid = ltid(), wave = tid >> 6, lane = tid & 63, q = lane >> 4, c = lane & 15;
  const int ldg = (l * 2 + d) * 32 + g;
  const int R0 = seq_row0(s), T = seq_len(s);
  const int seg = T >> 3, nb = seg >> 4, n0 = wave * seg;
  char* wl = lds + wave * S5_WLDS;
  float* BU = (float*)wl;
  char* H = wl + 8192;
  float* xch = (float*)(lds + 8 * S5_WLDS);
  const bf16_t* proj = (const bf16_t*)(lws(p) + WS_PROJ);
  bf16_t* yd = (bf16_t*)(lws(p) + WS_R2) + (size_t)d * MROWS * 512;
  const bf16_t* bb = (const bf16_t*)(lws(p) + WS_S5BB) + (size_t)ldg * 128 * 16;
  const bf16_t* ct = (const bf16_t*)(lws(p) + WS_S5CT) + (size_t)ldg * 16 * 128;
  bf16x8 bfr[8], cfr[4];
  const bf16x8 zero8 = {0, 0, 0, 0, 0, 0, 0, 0};
#pragma unroll
  for (int nt = 0; nt < 8; ++nt) bfr[nt] = q < 2 ? *(const bf16x8*)(bb + (nt * 16 + c) * 16 + 8 * q) : zero8;
#pragma unroll
  for (int ks = 0; ks < 4; ++ks) cfr[ks] = *(const bf16x8*)(ct + c * 128 + 32 * ks + 8 * q);
  const float ar = ((const float*)(lws(p) + WS_S5AR))[ldg * 64 + lane];
  const float ai = ((const float*)(lws(p) + WS_S5AI))[ldg * 64 + lane];
  float h0r = 0.f, h0i = 0.f;
  if (s >= 16) {
    const size_t si = ((((size_t)(s - 16) * 2 + l) * 2 + d) * 32 + g) * 64 + lane;
    h0r = lin(p, 4)[si]; h0i = lin(p, 5)[si];
  }
  auto load_u = [&](int blk) -> bf16x8 {
    const int n = n0 + blk * 16 + c;
    const int t = d ? (T - 1 - n) : n;
    if (q < 2) return *(const bf16x8*)(proj + pjx(R0 + t, C_UA + g * 16 + 8 * q));
    return zero8;
  };
  float hr = 0.f, hi = 0.f;
  auto bu_block = [&](const bf16x8& u) {
#pragma unroll
    for (int nt = 0; nt < 8; ++nt) {
      f32x4 z = {0.f, 0.f, 0.f, 0.f};
      const f32x4 dv = MFMA16(u, bfr[nt], z);
#pragma unroll
      for (int r = 0; r < 4; ++r) BU[(4 * q + r) * 128 + nt * 16 + c] = dv[r];
    }
  };
  {
    bf16x8 ucur = load_u(0);
#pragma unroll 1
    for (int blk = 0; blk < nb; ++blk) {
      bf16x8 unext = zero8;
      if (blk + 1 < nb) unext = load_u(blk + 1);
      bu_block(ucur);
#pragma unroll
      for (int i = 0; i < 16; ++i) {
        const float br = BU[i * 128 + lane], bi = BU[i * 128 + 64 + lane];
        const float nr = ar * hr - ai * hi + br;
        const float ni = ar * hi + ai * hr + bi;
        hr = nr; hi = ni;
      }
      ucur = unext;
    }
  }
  xch[(wave * 2 + 0) * 64 + lane] = hr;
  xch[(wave * 2 + 1) * 64 + lane] = hi;
  float pr = ar, pi = ai;
  const int nsq = T == 1024 ? 7 : 5;
  for (int k = 0; k < nsq; ++k) { const float t0 = pr * pr - pi * pi, t1 = 2.f * pr * pi; pr = t0; pi = t1; }
  __syncthreads();
  hr = h0r; hi = h0i;
  for (int v = 0; v < wave; ++v) {
    const float er = xch[(v * 2 + 0) * 64 + lane], ei = xch[(v * 2 + 1) * 64 + lane];
    const float nr = pr * hr - pi * hi + er, ni = pr * hi + pi * hr + ei;
    hr = nr; hi = ni;
  }
  {
    bf16x8 ucur = load_u(0);
#pragma unroll 1
    for (int blk = 0; blk < nb; ++blk) {
      bf16x8 unext = zero8;
      if (blk + 1 < nb) unext = load_u(blk + 1);
      bu_block(ucur);
#pragma unroll
      for (int i = 0; i < 16; ++i) {
        const float br = BU[i * 128 + lane], bi = BU[i * 128 + 64 + lane];
        const float nr = ar * hr - ai * hi + br;
        const float ni = ar * hi + ai * hr + bi;
        hr = nr; hi = ni;
        *(bf16_t*)(H + i * 272 + lane * 2) = f2bf(hr);
        *(bf16_t*)(H + i * 272 + 128 + lane * 2) = f2bf(hi);
      }
      f32x4 y = {0.f, 0.f, 0.f, 0.f};
#pragma unroll
      for (int ks = 0; ks < 4; ++ks) {
        const bf16x8 a = *(const bf16x8*)(H + c * 272 + (32 * ks + 8 * q) * 2);
        y = MFMA16(a, cfr[ks], y);
      }
#pragma unroll
      for (int r = 0; r < 4; ++r) {
        const int n = n0 + blk * 16 + 4 * q + r;
        const int t = d ? (T - 1 - n) : n;
        yd[(size_t)(R0 + t) * 512 + g * 16 + c] = f2bf(y[r]);
      }
      ucur = unext;
    }
  }
  if (s < 16 && wave == 7) {
    const size_t so = ((((size_t)s * 2 + l) * 2 + d) * 32 + g) * 64 + lane;
    lout(p)[O_SR + so] = hr; lout(p)[O_SI + so] = hi;
  }
  __syncthreads();
}

DI void s5_task(PR p, int l, int s, int d, int g, char* wl) {
  const int lane = ltid() & 63, q = lane >> 4, c = lane & 15;
  const int ldg = (l * 2 + d) * 32 + g;
  const int R0 = seq_row0(s), T = seq_len(s);
  float* BU = (float*)wl;
  char* H = wl + 8192;
  const bf16_t* proj = (const bf16_t*)(lws(p) + WS_PROJ);
  bf16_t* yd = (bf16_t*)(lws(p) + WS_R2) + (size_t)d * MROWS * 512;
  const bf16_t* bb = (const bf16_t*)(lws(p) + WS_S5BB) + (size_t)ldg * 128 * 16;
  const bf16_t* ct = (const bf16_t*)(lws(p) + WS_S5CT) + (size_t)ldg * 16 * 128;
  bf16x8 bfr[8], cfr[4];
  const bf16x8 zero8 = {0, 0, 0, 0, 0, 0, 0, 0};
#pragma unroll
  for (int nt = 0; nt < 8; ++nt) bfr[nt] = q < 2 ? *(const bf16x8*)(bb + (nt * 16 + c) * 16 + 8 * q) : zero8;
#pragma unroll
  for (int ks = 0; ks < 4; ++ks) {
    const u32x2 re = *(const u32x2*)(ct + c * 128 + 16 * ks + 4 * q), im = *(const u32x2*)(ct + c * 128 + 64 + 16 * ks + 4 * q);
    const u32x4 w = {(re[0] & 0xffffu) | (im[0] << 16), (re[0] >> 16) | (im[0] & 0xffff0000u),
                     (re[1] & 0xffffu) | (im[1] << 16), (re[1] >> 16) | (im[1] & 0xffff0000u)};
    cfr[ks] = __builtin_bit_cast(bf16x8, w);
  }
  const float ar = ((const float*)(lws(p) + WS_S5AR))[ldg * 64 + lane];
  const float ai = ((const float*)(lws(p) + WS_S5AI))[ldg * 64 + lane];
  float hr = 0.f, hi = 0.f;
  if (s >= 16) {
    const size_t si = ((((size_t)(s - 16) * 2 + l) * 2 + d) * 32 + g) * 64 + lane;
    hr = lin(p, 4)[si]; hi = lin(p, 5)[si];
  }
  const int nb = T >> 4;
  auto load_u = [&](int blk) -> bf16x8 {
    const int n = blk * 16 + c;
    const int t = d ? (T - 1 - n) : n;
    return *(const bf16x8*)(proj + pjx(R0 + t, C_UA + g * 16 + 8 * (q & 1)));
  };
  auto bu_issue = [&](const bf16x8 uu) {
#pragma unroll
    for (int nt = 0; nt < 8; ++nt) {
      f32x4 z = {0.f, 0.f, 0.f, 0.f};
      const f32x4 dv = MFMA16(uu, bfr[nt], z);
#pragma unroll
      for (int r = 0; r < 4; ++r) BU[(4 * q + r) * 128 + nt * 16 + c] = dv[r];
    }
  };
  bu_issue(load_u(0));
  bf16x8 uA = load_u(min(1, nb - 1)), uB = load_u(min(2, nb - 1));
  asm volatile("" : "+v"(uA), "+v"(uB));
  auto half = [&](const int blk, bf16x8& ur) {
    float bre[16], bim[16];
#pragma unroll
    for (int i = 0; i < 16; ++i) { bre[i] = BU[i * 128 + lane]; bim[i] = BU[i * 128 + 64 + lane]; }
    bu_issue(ur);
    ur = load_u(min(blk + 3, nb - 1));
#pragma unroll
    for (int i = 0; i < 16; ++i) {
      const float nr = __builtin_fmaf(ar, hr, __builtin_fmaf(-ai, hi, bre[i]));
      const float ni = __builtin_fmaf(ar, hi, __builtin_fmaf(ai, hr, bim[i]));
      hr = nr; hi = ni;
      *(unsigned*)(H + i * 272 + lane * 4) = pack2(hr, hi);
    }
    f32x4 y = {0.f, 0.f, 0.f, 0.f};
#pragma unroll
    for (int ks = 0; ks < 4; ++ks) {
      const bf16x8 a = *(const bf16x8*)(H + c * 272 + (32 * ks + 8 * q) * 2);
      y = MFMA16(a, cfr[ks], y);
    }
#pragma unroll
    for (int r = 0; r < 4; ++r) {
      const int n = blk * 16 + 4 * q + r;
      const int t = d ? (T - 1 - n) : n;
      yd[(size_t)(R0 + t) * 512 + g * 16 + c] = f2bf(y[r]);
    }
  };
#pragma unroll 1
  for (int blk = 0; blk < nb; blk += 2) { half(blk, uA); half(blk + 1, uB); }
  if (s < 16) {
    const size_t so = ((((size_t)s * 2 + l) * 2 + d) * 32 + g) * 64 + lane;
    lout(p)[O_SR + so] = hr; lout(p)[O_SI + so] = hi;
  }
}

DI float gelu_tanh(float x) {
  const float z = 0.7978845608028654f * (x + 0.044715f * x * x * x);
  const float e = __expf(2.f * z);
  const float th = 1.f - 2.f * __builtin_amdgcn_rcpf(e + 1.f);
  return 0.5f * x * (1.f + th);
}
DI void glu_tile(PR p, int l, int t, char* lds, bool dry) {
  const int tid = ltid(), wave = tid >> 6, lane = tid & 63;
  const int wv = __builtin_amdgcn_readfirstlane(wave);
  const int m0 = t * 32;
  char* Ya = lds;
  char* Ws = lds + 32768;
  bf16_t* proj = (bf16_t*)(lws(p) + WS_PROJ);
  const bf16_t* yd0 = (const bf16_t*)(lws(p) + WS_R2);
  const bf16_t* yd1 = yd0 + (size_t)MROWS * 512;
  const float* s5d = lin(p, 20) + l * 512;
  const bf16_t* W = (const bf16_t*)(lws(p) + WS_WTGLU) + (size_t)l * 512 * 512;
  const int r = lane & 31, h = lane >> 5;
  auto issue = [&](int kt) {
    char* st = Ws + (kt % 3) * 32768;
#pragma unroll
    for (int i = 0; i < 4; ++i) {
      const int id = i * 512 + tid, n = id >> 2, pos = id & 3;
      __builtin_amdgcn_global_load_lds((const unsigned*)(W + (size_t)n * 512 + kt * 32 + ((pos ^ ((n >> 2) & 3)) << 3)),
                                       (LAS unsigned*)(LAS char*)(st + (i * 512 + wv * 64) * 16), 16, 0, 0);
    }
  };
  u32x2 zz[2][4];
#pragma unroll
  for (int ni = 0; ni < 2; ++ni)
#pragma unroll
    for (int g4 = 0; g4 < 4; ++g4) zz[ni][g4] = *(const u32x2*)(proj + pjx(m0 + r, C_ZA + wave * 64 + ni * 32 + 8 * g4 + 4 * h));
  u32x4 uu[4], a0[4], a1[4];
  {
    const int row = tid >> 4;
#pragma unroll
    for (int i = 0; i < 4; ++i) {
      const int c0 = (tid & 15) * 8 + 128 * i;
      uu[i] = *(const u32x4*)(proj + pjx(m0 + row, C_UA + c0));
      a0[i] = *(const u32x4*)(yd0 + (size_t)(m0 + row) * 512 + c0);
      a1[i] = *(const u32x4*)(yd1 + (size_t)(m0 + row) * 512 + c0);
    }
  }
  __syncthreads();
  issue(0); issue(1);
  {
    const int row = tid >> 4;
#pragma unroll
    for (int i = 0; i < 4; ++i) {
      const int c0 = (tid & 15) * 8 + 128 * i;
      float y[8];
#pragma unroll
      for (int e = 0; e < 4; ++e) {
        y[2 * e]     = gelu_tanh(s5d[c0 + 2 * e] * lo_f(uu[i][e]) + lo_f(a0[i][e]) + lo_f(a1[i][e]));
        y[2 * e + 1] = gelu_tanh(s5d[c0 + 2 * e + 1] * hi_f(uu[i][e]) + hi_f(a0[i][e]) + hi_f(a1[i][e]));
      }
      const u32x4 o = {pack2(y[0], y[1]), pack2(y[2], y[3]), pack2(y[4], y[5]), pack2(y[6], y[7])};
      const int ch = c0 >> 3;
      *(u32x4*)(Ya + row * 1024 + ((ch ^ (row & 15)) << 4)) = o;
    }
  }
  f32x16 acc[2];
#pragma unroll
  for (int i = 0; i < 16; ++i) { acc[0][i] = 0.f; acc[1][i] = 0.f; }
#pragma unroll 1
  for (int kt = 0; kt < 16; ++kt) {
    if (kt + 1 < 16) asm volatile("s_waitcnt vmcnt(4)" ::: "memory"); else asm volatile("s_waitcnt vmcnt(0)" ::: "memory");
    asm volatile("s_waitcnt lgkmcnt(0)" ::: "memory");
    __builtin_amdgcn_s_barrier();
    asm volatile("" ::: "memory");
    if (kt + 2 < 16) issue(kt + 2);
    const char* st = Ws + (kt % 3) * 32768;
#pragma unroll
    for (int kh = 0; kh < 2; ++kh) {
      const int ch = 4 * kt + 2 * kh + h;
      const bf16x8 a = *(const bf16x8*)(Ya + r * 1024 + ((ch ^ (r & 15)) << 4));
#pragma unroll
      for (int ni = 0; ni < 2; ++ni) {
        const int n = wave * 64 + ni * 32 + r;
        const bf16x8 b = *(const bf16x8*)(st + n * 64 + (((kh * 2 + h) ^ ((n >> 2) & 3)) << 4));
        acc[ni] = MFMA32(b, a, acc[ni]);
      }
    }
  }
#pragma unroll
  for (int ni = 0; ni < 2; ++ni)
#pragma unroll
    for (int g4 = 0; g4 < 4; ++g4) {
      const int col = wave * 64 + ni * 32 + 8 * g4 + 4 * h;
      const u32x2 yb = *(const u32x2*)(Ya + r * 1024 + (((col >> 3) ^ (r & 15)) << 4) + 8 * h);
      const float z0 = lo_f(zz[ni][g4][0]), z1 = hi_f(zz[ni][g4][0]), z2 = lo_f(zz[ni][g4][1]), z3 = hi_f(zz[ni][g4][1]);
      const u32x2 ov = {pack2(lo_f(yb[0]) * sigmoidf_(acc[ni][4 * g4 + 0]) * z0, hi_f(yb[0]) * sigmoidf_(acc[ni][4 * g4 + 1]) * z1),
                        pack2(lo_f(yb[1]) * sigmoidf_(acc[ni][4 * g4 + 2]) * z2, hi_f(yb[1]) * sigmoidf_(acc[ni][4 * g4 + 3]) * z3)};
      if (!dry) *(u32x2*)(proj + pjx(m0 + r, C_UA + col)) = ov; else asm volatile("" :: "v"(ov[0]), "v"(ov[1]));
    }
  __syncthreads();
}

template <int NR> DI void ph5_rows(PR p, int l, int r0, int rs) {
  const int lane = ltid() & 63;
  const int c0 = lane * 8;
  bf16_t* proj = (bf16_t*)(lws(p) + WS_PROJ);
  const bf16_t* o0 = (const bf16_t*)(lws(p) + WS_R1);
  const bf16_t* o1 = o0 + (size_t)MROWS * 512;
  u32x4 a[NR], b[NR], zz[NR];
#pragma unroll
  for (int k = 0; k < NR; ++k) {
    const int r = r0 + k * rs;
    a[k] = *(const u32x4*)(o0 + (size_t)r * 512 + c0);
    b[k] = *(const u32x4*)(o1 + (size_t)r * 512 + c0);
    zz[k] = *(const u32x4*)(proj + pjx(r, C_ZC + c0));
  }
  const float* g = lin(p, 27) + l * 128 + (c0 & 127);
#pragma unroll
  for (int k = 0; k < NR; ++k) {
    const int r = r0 + k * rs;
    float o[8];
    float ss = 0.f;
#pragma unroll
    for (int e = 0; e < 4; ++e) {
      o[2 * e] = lo_f(a[k][e]) + lo_f(b[k][e]); o[2 * e + 1] = hi_f(a[k][e]) + hi_f(b[k][e]);
      ss += o[2 * e] * o[2 * e] + o[2 * e + 1] * o[2 * e + 1];
    }
#pragma unroll
    for (int off = 1; off <= 8; off <<= 1) ss += __shfl_xor(ss, off);
    const float rstd = rsqrtf(ss * (1.f / 128.f) + EPS);
    float v[8];
#pragma unroll
    for (int e = 0; e < 4; ++e) {
      v[2 * e] = o[2 * e] * rstd * g[2 * e] * lo_f(zz[k][e]);
      v[2 * e + 1] = o[2 * e + 1] * rstd * g[2 * e + 1] * hi_f(zz[k][e]);
    }
    const u32x4 w = {pack2(v[0], v[1]), pack2(v[2], v[3]), pack2(v[4], v[5]), pack2(v[6], v[7])};
    *(u32x4*)(proj + pjx(r, C_QC + c0)) = w;
  }
}

constexpr int AT_K = 8192, AT_STAGE = 16384;
DI void att_pre_task(PR p, int l, int u) {
  const int tid = ltid();
  bf16_t* proj = (bf16_t*)(lws(p) + WS_PROJ);
  const float* rope = (const float*)(lws(p) + WS_ROPE);
#pragma unroll
  for (int i = 0; i < 2; ++i) {
    const int id = i * 512 + tid, r = id >> 5, hp = id & 31, h = hp >> 3, pr = hp & 7, ch = (pr & 1) | ((pr & 6) << 1);
    const int row = 4096 + 32 * u + r, j = row & 1023;
    bf16_t* kr = proj + pjx(row, C_KB + h * 128);
    const u32x4 ka = *(const u32x4*)(kr + ch * 8), kb = *(const u32x4*)(kr + (ch ^ 2) * 8);
    const int pos = (ch & 4) ? (j & 63) : (j >> 6);
    const float* rc = rope + pos * 16 + (ch & 1) * 8;
    const f32x4 c0 = *(const f32x4*)rc, c1 = *(const f32x4*)(rc + 4), s0 = *(const f32x4*)(rc + 1024), s1 = *(const f32x4*)(rc + 1028);
    float oa[8], ob[8];
#pragma unroll
    for (int e = 0; e < 4; ++e) {
      const float cl = e < 2 ? c0[2 * e] : c1[2 * e - 4], chh = e < 2 ? c0[2 * e + 1] : c1[2 * e - 3];
      const float sl = e < 2 ? s0[2 * e] : s1[2 * e - 4], sh = e < 2 ? s0[2 * e + 1] : s1[2 * e - 3];
      oa[2 * e]     = lo_f(ka[e]) * cl - lo_f(kb[e]) * sl;
      oa[2 * e + 1] = hi_f(ka[e]) * chh - hi_f(kb[e]) * sh;
      ob[2 * e]     = lo_f(kb[e]) * cl + lo_f(ka[e]) * sl;
      ob[2 * e + 1] = hi_f(kb[e]) * chh + hi_f(ka[e]) * sh;
    }
    *(u32x4*)(kr + ch * 8) = u32x4{pack2(oa[0], oa[1]), pack2(oa[2], oa[3]), pack2(oa[4], oa[5]), pack2(oa[6], oa[7])};
    *(u32x4*)(kr + (ch ^ 2) * 8) = u32x4{pack2(ob[0], ob[1]), pack2(ob[2], ob[3]), pack2(ob[4], ob[5]), pack2(ob[6], ob[7])};
  }
#pragma unroll
  for (int i = 0; i < 2; ++i) {
    const int id = i * 512 + tid, row = 16 * u + (id >> 6), chunk = id & 63, b = row >> 9, jc = row & 511;
    const size_t so = ((size_t)((b * 2 + l) * 512 + jc) * 4) * 128 + chunk * 8;
    bf16_t* kvc = (bf16_t*)(lws(p) + WS_KVC) + (size_t)row * 512 + chunk * 8;
#pragma unroll
    for (int t = 0; t < 2; ++t) {
      const float* src = lin(p, 2 + t) + so;
      const f32x4 x0 = *(const f32x4*)src, x1 = *(const f32x4*)(src + 4);
      *(u32x4*)(kvc + (size_t)t * 1048576) = u32x4{pack2(x0[0], x0[1]), pack2(x0[2], x0[3]), pack2(x1[0], x1[1]), pack2(x1[2], x1[3])};
    }
  }
}

template <int ST>
DI void att_compute(const unsigned (&ka)[4], const unsigned (&va)[8], const bf16x8 (&qf)[2][2], f32x4 (&O)[2][8], float (&mx)[2], float (&lsum)[2]) {
  bf16x8 kf[2][2][2];
  s16x4 vlo[8], vhi[8];
#pragma unroll
  for (int m = 0; m < 2; ++m)
#pragma unroll
    for (int k2 = 0; k2 < 2; ++k2)
#pragma unroll
      for (int ks = 0; ks < 2; ++ks)
        asm volatile("ds_read_b128 %0, %1 offset:%2" : "=v"(kf[m][k2][ks]) : "v"(ka[m * 2 + ks]), "n"(ST * AT_STAGE + k2 * 4096) : "memory");
#pragma unroll
  for (int et = 0; et < 8; ++et) {
    asm volatile("ds_read_b64_tr_b16 %0, %1 offset:%2" : "=v"(vlo[et]) : "v"(va[et]), "n"(ST * AT_STAGE + AT_K) : "memory");
    asm volatile("ds_read_b64_tr_b16 %0, %1 offset:%2" : "=v"(vhi[et]) : "v"(va[et]), "n"(ST * AT_STAGE + AT_K + 4096) : "memory");
  }
  asm volatile("s_waitcnt lgkmcnt(15)" : "+v"(kf[0][0][0]), "+v"(kf[0][0][1]), "+v"(kf[0][1][0]), "+v"(kf[0][1][1]),
                                         "+v"(kf[1][0][0]), "+v"(kf[1][0][1]), "+v"(kf[1][1][0]), "+v"(kf[1][1][1]));
  f32x4 S[2][2];
#pragma unroll
  for (int m = 0; m < 2; ++m)
#pragma unroll
    for (int k2 = 0; k2 < 2; ++k2) {
      f32x4 acc = {0.f, 0.f, 0.f, 0.f};
#pragma unroll
      for (int ks = 0; ks < 2; ++ks) acc = MFMA16(kf[m][k2][ks], qf[m][ks], acc);
      S[m][k2] = acc;
    }
  bf16x8 pf[2];
#pragma unroll
  for (int m = 0; m < 2; ++m) {
    float tm = fmaxf(fmaxf(fmaxf(S[m][0][0], S[m][0][1]), fmaxf(S[m][0][2], S[m][0][3])),
                     fmaxf(fmaxf(S[m][1][0], S[m][1][1]), fmaxf(S[m][1][2], S[m][1][3])));
    tm = fmaxf(tm, __shfl_xor(tm, 16));
    tm = fmaxf(tm, __shfl_xor(tm, 32));
    const float mn = fmaxf(mx[m], tm);
    const float alpha = __builtin_amdgcn_exp2f(mx[m] - mn);
    mx[m] = mn;
    float pv[8], ps = 0.f;
#pragma unroll
    for (int k2 = 0; k2 < 2; ++k2)
#pragma unroll
      for (int r = 0; r < 4; ++r) { pv[k2 * 4 + r] = __builtin_amdgcn_exp2f(S[m][k2][r] - mn); ps += pv[k2 * 4 + r]; }
    lsum[m] = lsum[m] * alpha + ps;
#pragma unroll
    for (int et = 0; et < 8; ++et) O[m][et] *= alpha;
    pf[m] = mk8(pack2(pv[0], pv[1]), pack2(pv[2], pv[3]), pack2(pv[4], pv[5]), pack2(pv[6], pv[7]));
  }
  asm volatile("s_waitcnt lgkmcnt(0)" : "+v"(vlo[0]), "+v"(vlo[1]), "+v"(vlo[2]), "+v"(vlo[3]), "+v"(vlo[4]), "+v"(vlo[5]), "+v"(vlo[6]), "+v"(vlo[7]) : "v"(pf[0]), "v"(pf[1]));
  asm volatile("s_waitcnt lgkmcnt(0)" : "+v"(vhi[0]), "+v"(vhi[1]), "+v"(vhi[2]), "+v"(vhi[3]), "+v"(vhi[4]), "+v"(vhi[5]), "+v"(vhi[6]), "+v"(vhi[7]) : "v"(pf[0]), "v"(pf[1]));
#pragma unroll
  for (int et = 0; et < 8; ++et) {
    const bf16x8 vf = __builtin_shufflevector(vlo[et], vhi[et], 0, 1, 2, 3, 4, 5, 6, 7);
    O[0][et] = MFMA16(vf, pf[0], O[0][et]);
    O[1][et] = MFMA16(vf, pf[1], O[1][et]);
  }
}

DI void att_task(PR p, int l, int s, int h, int qb, char* lds, bool dry) {
  const int tid = ltid(), wave = tid >> 6, lane = tid & 63, q = lane >> 4, c = lane & 15;
  const int R0 = seq_row0(s), T = seq_len(s);
  const int nkeys = s < 16 ? 256 : 1536, nkt = nkeys >> 5;
  bf16_t* proj = (bf16_t*)(lws(p) + WS_PROJ);
  const int tq = qb * 128 + wave * 16 + c;
  const int qrow_i = R0 + tq;
  bf16x8 qf[2][2];
#pragma unroll
  for (int m = 0; m < 2; ++m)
#pragma unroll
    for (int ks = 0; ks < 2; ++ks) {
      const int d0 = 32 * ks + 8 * q;
      const u32x4 own = *(const u32x4*)(proj + pjx(qrow_i, C_QB + h * 128 + m * 64 + d0));
      float o[8];
      if (s >= 16) {
        const u32x4 par = *(const u32x4*)(proj + pjx(qrow_i, C_QB + h * 128 + m * 64 + (d0 ^ 16)));
        const int pos = ks ? (tq & 63) : (tq >> 6);
        const float* rc = (const float*)(lws(p) + WS_ROPE) + pos * 16 + (q & 1) * 8;
        const float sg = (q & 2) ? 1.f : -1.f;
#pragma unroll
        for (int e = 0; e < 4; ++e) {
          o[2 * e]     = lo_f(own[e]) * rc[2 * e] + sg * lo_f(par[e]) * rc[1024 + 2 * e];
          o[2 * e + 1] = hi_f(own[e]) * rc[2 * e + 1] + sg * hi_f(par[e]) * rc[1024 + 2 * e + 1];
        }
      } else {
#pragma unroll
        for (int e = 0; e < 4; ++e) { o[2 * e] = lo_f(own[e]); o[2 * e + 1] = hi_f(own[e]); }
      }
      constexpr float QS = 0.125f * 1.4426950408889634f;
      qf[m][ks] = mk8(pack2(o[0] * QS, o[1] * QS), pack2(o[2] * QS, o[3] * QS), pack2(o[4] * QS, o[5] * QS), pack2(o[6] * QS, o[7] * QS));
    }
  f32x4 O[2][8];
#pragma unroll
  for (int m = 0; m < 2; ++m)
#pragma unroll
    for (int et = 0; et < 8; ++et) O[m][et] = f32x4{0.f, 0.f, 0.f, 0.f};
  float mx[2] = {-1e30f, -1e30f}, lsum[2] = {0.f, 0.f};

  const bf16_t* kvc = (const bf16_t*)(lws(p) + WS_KVC);
  auto issue = [&](int kt) {
    char* stage = lds + (kt & 3) * AT_STAGE;
    const int key = tid >> 4, ch = tid & 15;
    const int j = kt * 32 + key;
    const bool own = s < 16 || j < 1024;
    const bf16_t* ks = own ? proj + pjx(R0 + j, C_KB + h * 128) : kvc + ((size_t)((s - 16) * 512 + (j - 1024)) * 512 + h * 128);
    const bf16_t* vs = own ? proj + pjx(R0 + j, C_VB + h * 128) : ks + 1048576;
    const int kc = ch ^ (key & 15), vc = ((((ch >> 1) ^ (key & 7)) << 1) | (ch & 1));
    __builtin_amdgcn_global_load_lds((const unsigned*)(ks + kc * 8), (LAS unsigned*)(LAS char*)(stage + wave * 1024), 16, 0, 0);
    __builtin_amdgcn_global_load_lds((const unsigned*)(vs + vc * 8), (LAS unsigned*)(LAS char*)(stage + AT_K + wave * 1024), 16, 0, 0);
  };
  asm volatile("s_waitcnt vmcnt(0)" ::: "memory");
  __syncthreads();
  issue(0); issue(1); issue(2);
  unsigned ka[4], va[8];
  {
    const unsigned lb = (unsigned)(uintptr_t)(LAS char*)lds;
#pragma unroll
    for (int m = 0; m < 2; ++m)
#pragma unroll
      for (int ks = 0; ks < 2; ++ks) ka[m * 2 + ks] = lb + c * 256 + (((m * 8 + ks * 4 + q) ^ c) << 4);
    const int qq = c >> 2, pp = c & 3, kA = 4 * q + qq;
#pragma unroll
    for (int et = 0; et < 8; ++et) va[et] = lb + kA * 256 + ((et ^ (kA & 7)) << 5) + pp * 8;
  }
#define ATT_STEP(ST, k) { const int kk = (k); \
    if (kk + 2 < nkt) asm volatile("s_waitcnt vmcnt(4)" ::: "memory"); \
    else if (kk + 1 < nkt) asm volatile("s_waitcnt vmcnt(2)" ::: "memory"); \
    else asm volatile("s_waitcnt vmcnt(0)" ::: "memory"); \
    __builtin_amdgcn_s_barrier();        \
    asm volatile("" ::: "memory"); \
    if (kk + 3 < nkt) issue(kk + 3);     \
    att_compute<ST>(ka, va, qf, O, mx, lsum); }
#pragma unroll 1
  for (int kt = 0; kt < nkt; kt += 4) { ATT_STEP(0, kt) ATT_STEP(1, kt + 1) ATT_STEP(2, kt + 2) ATT_STEP(3, kt + 3) }
#undef ATT_STEP
#pragma unroll
  for (int m = 0; m < 2; ++m) { lsum[m] += __shfl_xor(lsum[m], 16); lsum[m] += __shfl_xor(lsum[m], 32); }
  const float lam = ((const float*)(lws(p) + WS_LAM))[l];
  const float lam_init = 0.8f - 0.6f * expf(-0.3f * (float)l);
  const float i0 = 1.f / lsum[0], i1 = lam / lsum[1];
  float ss = 0.f;
#pragma unroll
  for (int et = 0; et < 8; ++et)
#pragma unroll
    for (int r = 0; r < 4; ++r) { const float o = O[0][et][r] * i0 - O[1][et][r] * i1; O[0][et][r] = o; ss += o * o; }
  ss += __shfl_xor(ss, 16); ss += __shfl_xor(ss, 32);
  const float rstd = rsqrtf(ss * (1.f / 128.f) + EPS) * (1.f - lam_init);
  const float* g = lin(p, 23) + l * 128;
#pragma unroll
  for (int et = 0; et < 8; ++et) {
    const int e0 = 16 * et + 4 * q;
    const u32x2 zz = *(const u32x2*)(proj + pjx(qrow_i, C_ZB + h * 128 + e0));
    const float v0 = O[0][et][0] * rstd * g[e0 + 0] * lo_f(zz[0]);
    const float v1 = O[0][et][1] * rstd * g[e0 + 1] * hi_f(zz[0]);
    const float v2 = O[0][et][2] * rstd * g[e0 + 2] * lo_f(zz[1]);
    const float v3 = O[0][et][3] * rstd * g[e0 + 3] * hi_f(zz[1]);
    const u32x2 w = {pack2(v0, v1), pack2(v2, v3)};
    if (!dry) *(u32x2*)(proj + pjx(qrow_i, C_QB + h * 128 + e0)) = w; else asm volatile("" :: "v"(w[0]), "v"(w[1]));
  }
}


constexpr int DP_QF = 0, DP_KF = 33792, DP_VF = 67584, DP_MT = 101376, DP_SM = 134144;
DI int kmap8(int ks, int q, int j) { return 32 * ks + 4 * q + (j & 3) + 16 * (j >> 2); }

DI void dn_prep_task(PR p, int l, int gc, int h, char* lds) {
  const int tid = ltid(), lane = tid & 63, q = lane >> 4, c = lane & 15;
  int s, oc;
  if (gc < 64) { s = gc >> 2; oc = gc & 3; } else { s = 16 + ((gc - 64) >> 4); oc = (gc - 64) & 15; }
  const int R0 = seq_row0(s), T = seq_len(s), t0 = oc * 64;
  const bf16_t* proj = (const bf16_t*)(lws(p) + WS_PROJ);
  float* qf = (float*)(lds + DP_QF);
  float* kf = (float*)(lds + DP_KF);
  float* vf = (float*)(lds + DP_VF);
  float* mT = (float*)(lds + DP_MT);
  float* sm = (float*)(lds + DP_SM);
  __syncthreads();
  if (tid < 384) {
    const int cg = tid % 48, rg = tid / 48;
    const int which = cg >> 4, ch0 = (cg & 15) * 8;
    const int col = C_QC + which * 512 + h * 128 + ch0;
    const float* cw = lin(p, 24) + (size_t)l * 5 * 1536 + which * 512 + h * 128 + ch0;
    float w[5][8];
#pragma unroll
    for (int j = 0; j < 5; ++j)
#pragma unroll
      for (int e = 0; e < 8; ++e) w[j][e] = cw[j * 1536 + e];
    u32x4 raw[12];
#pragma unroll
    for (int i = 0; i < 12; ++i) {
      const int t = t0 + rg * 8 + i - 2;
      raw[i] = u32x4{0u, 0u, 0u, 0u};
      if (t >= 0 && t < T) raw[i] = *(const u32x4*)(proj + pjx(R0 + t, col));
    }
    float* dst = which == 0 ? qf : (which == 1 ? kf : vf);
#pragma unroll
    for (int i = 0; i < 8; ++i) {
      float o[8];
#pragma unroll
      for (int e2 = 0; e2 < 4; ++e2) {
        float a0 = 0.f, a1 = 0.f;
#pragma unroll
        for (int j = 0; j < 5; ++j) { a0 += w[j][2 * e2] * lo_f(raw[i + j][e2]); a1 += w[j][2 * e2 + 1] * hi_f(raw[i + j][e2]); }
        o[2 * e2] = siluf_(a0); o[2 * e2 + 1] = siluf_(a1);
      }
      *(f32x4*)(dst + (rg * 8 + i) * 132 + ch0) = f32x4{o[0], o[1], o[2], o[3]};
      *(f32x4*)(dst + (rg * 8 + i) * 132 + ch0 + 4) = f32x4{o[4], o[5], o[6], o[7]};
    }
  }
  if ((tid & 255) < 64) {
    const int d = tid >> 8;
    const int io = d ? 63 - lane : lane;
    const float* bg = (const float*)(lws(p) + WS_BETAG) + (size_t)(R0 + t0 + io) * 16;
    const float beta = bg[d * 4 + h];
    float g = bg[8 + d * 4 + h];
#pragma unroll
    for (int o = 1; o < 64; o <<= 1) {
      const int src = lane >= o ? lane - o : lane;
      const float n = __int_as_float(__builtin_amdgcn_ds_bpermute(src << 2, __float_as_int(g)));
      if (lane >= o) g += n;
    }
    sm[d * 64 + lane] = beta;
    sm[128 + d * 64 + lane] = g;
    sm[256 + d * 64 + lane] = __expf(g);
  }
  __syncthreads();
  {
    const int pair = tid >> 2, sub = tid & 3, row = pair & 63, which = pair >> 6;
    float* a = (which ? kf : qf) + row * 132 + sub * 32;
    f32x4 v[8];
    float ss = 0.f;
#pragma unroll
    for (int i = 0; i < 8; ++i) { v[i] = *(const f32x4*)(a + 4 * i); ss += v[i][0] * v[i][0] + v[i][1] * v[i][1] + v[i][2] * v[i][2] + v[i][3] * v[i][3]; }
    ss += __shfl_xor(ss, 1); ss += __shfl_xor(ss, 2);
    const float sc = rsqrtf(ss + EPS) * (which ? 1.f : 0.08838834764831845f);
#pragma unroll
    for (int i = 0; i < 8; ++i) { v[i] *= sc; *(f32x4*)(a + 4 * i) = v[i]; }
  }
  __syncthreads();
  const int d = tid >> 8, w4 = (tid >> 6) & 3;
  const float* beta_s = sm + d * 64;
  const float* gc_s = sm + 128 + d * 64;
  const float* eg_s = sm + 256 + d * 64;
  unsigned char* slot = lws(p) + WS_DNP + (size_t)((gc * 4 + h) * 2 + d) * DNP_SLOT;
  auto orow = [&](int i) -> int { return d ? 63 - i : i; };
  auto ldfrag = [&](const float* base, int row, int ks) -> bf16x8 {
    const f32x4 a = *(const f32x4*)(base + row * 132 + 32 * ks + 8 * q);
    const f32x4 b = *(const f32x4*)(base + row * 132 + 32 * ks + 8 * q + 4);
    return mk8(pack2(a[0], a[1]), pack2(a[2], a[3]), pack2(b[0], b[1]), pack2(b[2], b[3]));
  };
  {
    const int it = w4;
    bf16x8 kfr_i[4], qfr_i[4];
#pragma unroll
    for (int ks = 0; ks < 4; ++ks) { kfr_i[ks] = ldfrag(kf, orow(16 * it + c), ks); qfr_i[ks] = ldfrag(qf, orow(16 * it + c), ks); }
    f32x4 kq[4];
#pragma unroll
    for (int jt = 0; jt < 4; ++jt) {
      f32x4 kk = {0.f, 0.f, 0.f, 0.f}, kq_ = {0.f, 0.f, 0.f, 0.f};
#pragma unroll
      for (int ks = 0; ks < 4; ++ks) {
        const bf16x8 kfr_j = ldfrag(kf, orow(16 * jt + c), ks);
        kk = MFMA16(kfr_i[ks], kfr_j, kk);
        kq_ = MFMA16(kfr_j, qfr_i[ks], kq_);
      }
      {
        const int j = 16 * jt + c;
        const float gj = gc_s[j];
#pragma unroll
        for (int r = 0; r < 4; ++r) {
          const int i = 16 * it + 4 * q + r;
          const float v = i > j ? beta_s[i] * kk[r] * __expf(gc_s[i] - gj) : 0.f;
          mT[d * 4096 + j * 64 + i] = v;
        }
      }
      {
        const int i = 16 * it + c;
        const float gi = gc_s[i];
#pragma unroll
        for (int r = 0; r < 4; ++r) {
          const int j = 16 * jt + 4 * q + r;
          kq_[r] = i >= j ? kq_[r] * __expf(gi - gc_s[j]) : 0.f;
        }
      }
      kq[jt] = kq_;
      asm volatile("" ::: "memory");
    }
#pragma unroll
    for (int ks2 = 0; ks2 < 2; ++ks2) {
      const f32x4 a = kq[2 * ks2], b = kq[2 * ks2 + 1];
      const u32x4 o = {pack2(a[0], a[1]), pack2(a[2], a[3]), pack2(b[0], b[1]), pack2(b[2], b[3])};
      *(u32x4*)(slot + SL_QK + ((it * 2 + ks2) * 64 + lane) * 16) = o;
    }
    asm volatile("" ::: "memory");
    {
      const int i = 16 * it + c, io = orow(i);
      const float egi = eg_s[i];
#pragma unroll
      for (int ks = 0; ks < 4; ++ks) {
        const f32x4 a = *(const f32x4*)(qf + io * 132 + 32 * ks + 4 * q);
        const f32x4 b = *(const f32x4*)(qf + io * 132 + 32 * ks + 16 + 4 * q);
        const u32x4 o = {pack2(a[0] * egi, a[1] * egi), pack2(a[2] * egi, a[3] * egi), pack2(b[0] * egi, b[1] * egi), pack2(b[2] * egi, b[3] * egi)};
        *(u32x4*)(slot + SL_QG + ((it * 4 + ks) * 64 + lane) * 16) = o;
      }
    }
    asm volatile("" ::: "memory");
    {
      const float gl = gc_s[63];
#pragma unroll
      for (int mm = 0; mm < 2; ++mm) {
        const int mt8 = 2 * w4 + mm, dk = 16 * mt8 + c;
#pragma unroll
        for (int ks2 = 0; ks2 < 2; ++ks2) {
          float v[8];
#pragma unroll
          for (int j = 0; j < 8; ++j) {
            const int i = kmap8(ks2, q, j);
            v[j] = kf[orow(i) * 132 + dk] * __expf(gl - gc_s[i]);
          }
          const u32x4 o = {pack2(v[0], v[1]), pack2(v[2], v[3]), pack2(v[4], v[5]), pack2(v[6], v[7])};
          *(u32x4*)(slot + SL_KGT + ((mt8 * 2 + ks2) * 64 + lane) * 16) = o;
        }
      }
      if (w4 == 0 && lane == 0) ((float*)(lws(p) + WS_EGL))[(gc * 4 + h) * 2 + d] = __expf(gl);
    }
  }
  {
    bf16_t* XA = (bf16_t*)(lds + DP_QF) + d * 32 * 260;
    bf16_t* XC = (bf16_t*)(lds + DP_KF + 16 * 528) + d * 16 * 260;
    bf16_t* XD = (bf16_t*)(lds + DP_VF + 16 * 528) + d * 16 * 260;
    const int col = tid & 255;
    const float* rsrc = col < 128 ? vf + col : kf + (col - 128);
    const float* mcol = mT + d * 4096;
    __syncthreads();
#pragma unroll 1
    for (int b = 0; b < 4; ++b) {
      float x[16];
#pragma unroll
      for (int i = 0; i < 16; ++i) {
        const int ii = 16 * b + i;
        const float sc = col < 128 ? beta_s[ii] : beta_s[ii] * eg_s[ii];
        x[i] = rsrc[orow(ii) * 132] * sc;
      }
      if (b >= 1) {
        const int nks = (b + 1) >> 1;
        bf16x8 Ah[2], Al[2];
#pragma unroll
        for (int ks = 0; ks < 2; ++ks) {
          float mv[8], ml[8];
#pragma unroll
          for (int jj = 0; jj < 8; ++jj) {
            const int j = 32 * ks + 8 * q + jj;
            const float m = (ks < nks && j < 16 * b) ? mcol[j * 64 + 16 * b + c] : 0.f;
            const float mh = bf2f(f2bf(m));
            mv[jj] = mh; ml[jj] = m - mh;
          }
          Ah[ks] = mk8(pack2(mv[0], mv[1]), pack2(mv[2], mv[3]), pack2(mv[4], mv[5]), pack2(mv[6], mv[7]));
          Al[ks] = mk8(pack2(ml[0], ml[1]), pack2(ml[2], ml[3]), pack2(ml[4], ml[5]), pack2(ml[6], ml[7]));
        }
        float* Dst = (float*)(lds + DP_SM + 2048) + (tid >> 6) * 512;
        const int qq = c >> 2, pp = c & 3, w4c = ((tid >> 6) & 3) * 64;
        const s16x4 z4 = {0, 0, 0, 0};
#pragma unroll
        for (int half = 0; half < 2; ++half) {
#pragma unroll
          for (int t2 = 0; t2 < 2; ++t2) {
            const int cbase = w4c + 16 * (2 * half + t2) + 4 * pp;
            f32x4 acc = {0.f, 0.f, 0.f, 0.f};
#pragma unroll
            for (int ks = 0; ks < 2; ++ks) {
              if (ks < nks) {
                const bf16_t* xb = ks == 0 ? XA + (8 * q) * 260 : XC + (8 * (q & 1)) * 260;
                const bool valid = (32 * ks + 8 * q) < 16 * b;
                s16x4 lo4 = __builtin_amdgcn_ds_read_tr16_b64_v4i16((s16x4 LAS*)(LAS bf16_t*)(xb + qq * 260 + cbase));
                s16x4 hi4 = __builtin_amdgcn_ds_read_tr16_b64_v4i16((s16x4 LAS*)(LAS bf16_t*)(xb + (4 + qq) * 260 + cbase));
                if (!valid) { lo4 = z4; hi4 = z4; }
                const bf16x8 bx = __builtin_shufflevector(lo4, hi4, 0, 1, 2, 3, 4, 5, 6, 7);
                acc = MFMA16(Ah[ks], bx, acc);
                acc = MFMA16(Al[ks], bx, acc);
              }
            }
#pragma unroll
            for (int r = 0; r < 4; ++r) Dst[(t2 * 16 + 4 * q + r) * 16 + c] = acc[r];
          }
          if ((lane >> 5) == half) {
            const int t2o = (lane >> 4) & 1;
#pragma unroll
            for (int i = 0; i < 16; ++i) x[i] -= Dst[(t2o * 16 + i) * 16 + (lane & 15)];
          }
        }
      }
      const float* md = mcol + (16 * b) * 64 + 16 * b;
#pragma unroll
      for (int j = 0; j < 15; ++j) {
        const float xj = x[j];
#pragma unroll
        for (int i4 = 0; i4 < 16; i4 += 4) {
          if (i4 + 3 > j) {
            const f32x4 mm = *(const f32x4*)(md + j * 64 + i4);
            if (i4 + 0 > j) x[i4 + 0] -= mm[0] * xj;
            if (i4 + 1 > j) x[i4 + 1] -= mm[1] * xj;
            if (i4 + 2 > j) x[i4 + 2] -= mm[2] * xj;
            if (i4 + 3 > j) x[i4 + 3] -= mm[3] * xj;
          }
        }
      }
      if (b == 2) __syncthreads();
      bf16_t* dstx = b < 2 ? XA + (16 * b) * 260 : (b == 2 ? XC : XD);
#pragma unroll
      for (int i = 0; i < 16; ++i) dstx[i * 260 + col] = f2bf(x[i]);
      __syncthreads();
    }
  }
  {
    const int tid4 = ltid(), lane = tid4 & 63, q = lane >> 4, c = lane & 15, w4 = (tid4 >> 6) & 3, d = tid4 >> 8;
    unsigned char* slot = lws(p) + WS_DNP + (size_t)((gc * 4 + h) * 2 + d) * DNP_SLOT;
    const bf16_t* XA = (const bf16_t*)(lds + DP_QF) + d * 32 * 260;
    const bf16_t* XC = (const bf16_t*)(lds + DP_KF + 16 * 528) + d * 16 * 260;
    const bf16_t* XD = (const bf16_t*)(lds + DP_VF + 16 * 528) + d * 16 * 260;
    auto Xrow = [&](int i) -> const bf16_t* { return i < 32 ? XA + i * 260 : (i < 48 ? XC + (i - 32) * 260 : XD + (i - 48) * 260); };
#pragma unroll
    for (int ks = 0; ks < 4; ++ks) {
      const bf16_t* xr = Xrow(16 * w4 + c);
      const u32x2 a = *(const u32x2*)(xr + 128 + 32 * ks + 4 * q);
      const u32x2 b = *(const u32x2*)(xr + 128 + 32 * ks + 16 + 4 * q);
      const u32x4 o = {a[0] ^ 0x80008000u, a[1] ^ 0x80008000u, b[0] ^ 0x80008000u, b[1] ^ 0x80008000u};
      *(u32x4*)(slot + SL_W + ((w4 * 4 + ks) * 64 + lane) * 16) = o;
    }
#pragma unroll
    for (int cc = 0; cc < 2; ++cc) {
      const int cs = 2 * w4 + cc;
#pragma unroll
      for (int mt = 0; mt < 4; ++mt) {
        unsigned short v[4];
#pragma unroll
        for (int r = 0; r < 4; ++r) v[r] = Xrow(16 * mt + 4 * q + r)[16 * cs + c];
        const u32x2 o = {(unsigned)v[0] | ((unsigned)v[1] << 16), (unsigned)v[2] | ((unsigned)v[3] << 16)};
        *(u32x2*)(slot + SL_U + ((cs * 4 + mt) * 64 + lane) * 8) = o;
      }
    }
  }
}

constexpr int CH_STAGE = 57344;
DI void dn_chain_task(PR p, int l, int s, int h, int d, char* lds) {
  const int tid = ltid(), cs = tid >> 6, lane = tid & 63, q = lane >> 4, c = lane & 15;
  const int R0 = seq_row0(s), T = seq_len(s), nc = T >> 6;
  const int gc0 = s < 16 ? s * 4 : 64 + (s - 16) * 16;
  bf16_t* odir = (bf16_t*)(lws(p) + WS_R1) + (size_t)d * MROWS * 512;
  const float* egl = (const float*)(lws(p) + WS_EGL);
  f32x4 S[8];
  if (s >= 16) {
    const float* s0 = lin(p, 6) + ((((size_t)(s - 16) * 2 + l) * 2 + d) * 4 + h) * 16384;
#pragma unroll
    for (int i = 0; i < 8; ++i)
#pragma unroll
      for (int r = 0; r < 4; ++r) S[i][r] = s0[(16 * i + 4 * q + r) * 128 + 16 * cs + c];
  } else {
#pragma unroll
    for (int i = 0; i < 8; ++i) S[i] = f32x4{0.f, 0.f, 0.f, 0.f};
  }
  auto slot_of = [&](int step) -> const unsigned char* {
    const int oc = d ? nc - 1 - step : step;
    return lws(p) + WS_DNP + (size_t)(((gc0 + oc) * 4 + h) * 2 + d) * DNP_SLOT;
  };
  const int cs_u = __builtin_amdgcn_readfirstlane(cs);
  u32x2 uA[4], uB[4]; float glA = 1.f, glB = 1.f;
  auto dma = [&](int step, char* st) {
    const unsigned char* sl = slot_of(step);
#pragma unroll
    for (int i = 0; i < 7; ++i)
      __builtin_amdgcn_global_load_lds((const unsigned*)(sl + (size_t)(tid + NT * i) * 16), (LAS unsigned*)(LAS char*)(st + (cs_u * 64 + NT * i) * 16), 16, 0, 0);
  };
  auto uload = [&](int step, u32x2 (&u)[4], float& gl) {
    const unsigned char* sl = slot_of(step);
#pragma unroll
    for (int mt = 0; mt < 4; ++mt) u[mt] = *(const u32x2*)(sl + SL_U + ((cs * 4 + mt) * 64 + lane) * 8);
    const int oc = d ? nc - 1 - step : step;
    gl = egl[((gc0 + oc) * 4 + h) * 2 + d + vzero()];
  };
  auto compute = [&](int step, const char* cur, u32x2 (&u)[4], float& glr) {
    const int oc = d ? nc - 1 - step : step;
    const float gl = glr;
    bf16x8 Sb[4];
#pragma unroll
    for (int ks = 0; ks < 4; ++ks)
      Sb[ks] = mk8(pack2(S[2 * ks][0], S[2 * ks][1]), pack2(S[2 * ks][2], S[2 * ks][3]),
                   pack2(S[2 * ks + 1][0], S[2 * ks + 1][1]), pack2(S[2 * ks + 1][2], S[2 * ks + 1][3]));
    f32x4 av[4], ao[4];
#pragma unroll
    for (int mt = 0; mt < 4; ++mt) {
      av[mt] = f32x4{lo_f(u[mt][0]), hi_f(u[mt][0]), lo_f(u[mt][1]), hi_f(u[mt][1])};
      ao[mt] = f32x4{0.f, 0.f, 0.f, 0.f};
    }
    if (step + 2 < nc) uload(step + 2, u, glr);
#pragma unroll
    for (int ks = 0; ks < 4; ++ks)
#pragma unroll
      for (int mt = 0; mt < 4; ++mt) {
        const bf16x8 wf = *(const bf16x8*)(cur + SL_W + ((mt * 4 + ks) * 64 + lane) * 16);
        av[mt] = MFMA16(wf, Sb[ks], av[mt]);
        const bf16x8 gf = *(const bf16x8*)(cur + SL_QG + ((mt * 4 + ks) * 64 + lane) * 16);
        ao[mt] = MFMA16(gf, Sb[ks], ao[mt]);
        if (mt == 3 && (ks & 1)) asm volatile("" ::: "memory");
      }
    bf16x8 Vb[2];
#pragma unroll
    for (int k2 = 0; k2 < 2; ++k2)
      Vb[k2] = mk8(pack2(av[2 * k2][0], av[2 * k2][1]), pack2(av[2 * k2][2], av[2 * k2][3]),
                   pack2(av[2 * k2 + 1][0], av[2 * k2 + 1][1]), pack2(av[2 * k2 + 1][2], av[2 * k2 + 1][3]));
#pragma unroll
    for (int k2 = 0; k2 < 2; ++k2)
#pragma unroll
      for (int mt = 0; mt < 4; ++mt) {
        const bf16x8 f = *(const bf16x8*)(cur + SL_QK + ((mt * 2 + k2) * 64 + lane) * 16);
        ao[mt] = MFMA16(f, Vb[k2], ao[mt]);
      }
#pragma unroll
    for (int i = 0; i < 8; ++i) {
      S[i] *= gl;
#pragma unroll
      for (int k2 = 0; k2 < 2; ++k2) {
        const bf16x8 f = *(const bf16x8*)(cur + SL_KGT + ((i * 2 + k2) * 64 + lane) * 16);
        S[i] = MFMA16(f, Vb[k2], S[i]);
      }
    }
#pragma unroll
    for (int mt = 0; mt < 4; ++mt)
#pragma unroll
      for (int r = 0; r < 4; ++r) {
        const int i = 16 * mt + 4 * q + r;
        const int t = oc * 64 + (d ? 63 - i : i);
        odir[(size_t)(R0 + t) * 512 + h * 128 + 16 * cs + c] = f2bf(ao[mt][r]);
      }
  };
  auto warm = [&](int step, unsigned& w0, unsigned& w1) {
    const unsigned char* sl = slot_of(step);
    w0 = *(const unsigned*)(sl + (size_t)tid * 128);
    w1 = *(const unsigned*)(sl + 65536 + (size_t)(tid & 63) * 128);
  };
  unsigned we0 = 0, we1 = 0, wo0 = 0, wo1 = 0;
  uload(0, uA, glA); uload(1, uB, glB);
  warm(1, we0, we1); warm(2, wo0, wo1);
  __syncthreads();
  dma(0, lds);
  __syncthreads();
#pragma unroll 1
  for (int step = 0; step < nc; step += 2) {
    dma(step + 1, lds + CH_STAGE);
    asm volatile("" :: "v"(we0), "v"(we1));
    if (step + 3 < nc) warm(step + 3, we0, we1);
    compute(step, lds, uA, glA);
    __syncthreads();
    if (step + 2 < nc) dma(step + 2, lds);
    asm volatile("" :: "v"(wo0), "v"(wo1));
    if (step + 4 < nc) warm(step + 4, wo0, wo1);
    compute(step + 1, lds + CH_STAGE, uB, glB);
    __syncthreads();
  }
  if (s < 16) {
    float* so = lout(p) + O_DN + ((((size_t)s * 2 + l) * 2 + d) * 4 + h) * 16384;
#pragma unroll
    for (int i = 0; i < 8; ++i)
#pragma unroll
      for (int r = 0; r < 4; ++r) so[(16 * i + 4 * q + r) * 128 + 16 * cs + c] = S[i][r];
  }
}

constexpr int N_PHASES = 16;
constexpr int LDS_QSH = LDS_BYTES - 16;
constexpr int LDS_BST = LDS_BYTES - 32;

#define SW_BEGIN(id) unsigned long long _sw_t0 = 0; if constexpr (TIMEREG == (id)) { __syncthreads(); _sw_t0 = __builtin_amdgcn_s_memrealtime(); }
#define SW_END(id) if constexpr (TIMEREG == (id)) { __syncthreads(); if (blockIdx.x == 0 && threadIdx.x == 0) g_sw_acc += __builtin_amdgcn_s_memrealtime() - _sw_t0; }
DI int panel_tile(int b) { const int x = b & 7, idx = b >> 3; return ((((idx >> 3) << 3) + x) << 3) | (idx & 7); }
DI void run_prep(PR p) {
  const int G = gridDim.x, bid = blockIdx.x;
  { SW_BEGIN(10) for (int t = bid; t < 192; t += G) ph0_adaln(p, t, smem); SW_END(10) }
  { SW_BEGIN(11) for (int t = bid; t < 256; t += G) ph0_s5(p, t); SW_END(11) }
  if (bid == G - 1) ph0_misc(p);
  for (int t = G - 2 - bid; t >= 0 && t < 64; t += G) ph0_wba(p, t);
}
DI void run_final(PR p) {
  const int G = gridDim.x, bid = blockIdx.x, wave = ltid() >> 6;
  const int nw = G * 8;
  if (G == 256) ph_final_rows<4>(p, (panel_tile(bid) >> 3) * 256 + (panel_tile(bid) & 7) * 32 + wave, 8);
  else if (MROWS % (nw * 4) == 0) { for (int r = bid * 8 + wave; r < MROWS; r += nw * 4) ph_final_rows<4>(p, r, nw); }
  else { for (int r = bid * 8 + wave; r < MROWS; r += nw) ph_final_rows<1>(p, r, nw); }
}
DI void run_norm(PR p, int l) {
  const int G = gridDim.x, bid = blockIdx.x, tid = ltid(), wave = tid >> 6;
  float* wl = (float*)smem;
  const float* wba = (const float*)(lws(p) + WS_WBA) + (size_t)l * 16 * 1024;
  f32x4 wreg[8];
#pragma unroll
  for (int i = 0; i < 8; ++i) wreg[i] = *(const f32x4*)(wba + (tid + NT * i) * 4);
  const bool late = G == 256;
  if (!late) {
#pragma unroll
    for (int i = 0; i < 8; ++i) *(f32x4*)(wl + (tid + NT * i) * 4) = wreg[i];
    __syncthreads();
  }
  for (int rb = (G == 256 ? (panel_tile(bid) >> 3) * 64 + (panel_tile(bid) & 7) * 8 : bid * 8) + wave; rb < 2048; rb += G * 8) ph1_norm_rows(p, l, rb, wl, wreg, late);
  __syncthreads();
}
DI void run_cvt1(PR p) {
  const int G = gridDim.x, bid = blockIdx.x;
  for (int t = bid; t < 512; t += G) cvt_win_tile(p, 1, t, smem);
}
DI void run_cvt0(PR p) {
  const int G = gridDim.x, bid = blockIdx.x;
  __syncthreads();
  int id = bid, step = G, lim = 864;
  if (G == 256) { if (bid < 192) { step = 192; lim = 576; } else { id = 576 + bid - 192; step = 64; } }
  for (; id < lim; id += step) { if (id < 512) cvt_win_tile(p, 0, id, smem); else cvt_other_tile(p, id - 512, smem); }
}
DI void run_inproj(PR p, int l) {
  const int G = gridDim.x, bid = blockIdx.x;
  for (int t = bid; t < 2048; t += G) ph2_inproj_tile(p, l, t, smem);
}
DI void run_s5(PR p, int l) {
  const int G = gridDim.x, bid = blockIdx.x;
  for (int b = bid; b < 256; b += G) {
    s5_wg_task(p, l, 16 + (b >> 6), (b >> 5) & 1, b & 31, smem);
#pragma unroll 1
    for (int k = 0; k < 4; ++k) { const int i = b * 4 + k; s5_wg_task(p, l, i >> 6, (i >> 5) & 1, i & 31, smem); }
  }
}
DI void run_att(PR p, int l, int t, bool dry = false) {
  if (t < 128) { const int s = 16 + (t >> 5), h = (t >> 3) & 3, qb = t & 7; att_task(p, l, s, h, qb, smem, dry); }
  else { const int u = t - 128, s = u >> 3, h = (u >> 1) & 3, qb = u & 1; att_task(p, l, s, h, qb, smem, dry); }
}
DI void run_prep_dn(PR p, int l, int u) { dn_prep_task(p, l, u >> 2, u & 3, smem); }
DI void run_chain(PR p, int l) {
  const int G = gridDim.x, bid = blockIdx.x;
  for (int b = bid; b < 160; b += G) {
    const int s = b < 32 ? 16 + (b >> 3) : (b - 32) >> 3;
    const int h = (b >> 1) & 3, d = b & 1;
    dn_chain_task(p, l, s, h, d, smem);
  }
}
DI void run_glu(PR p, int l, int t, bool dry = false) { glu_tile(p, l, t, smem, dry); }
DI void run_ph5(PR p, int l) {
  const int G = gridDim.x, bid = blockIdx.x, wave = ltid() >> 6;
  const int nw = G * 8;
  if (G == 256) ph5_rows<4>(p, l, 32 * panel_tile(bid) + wave, 8);
  else if (MROWS % (nw * 4) == 0) { for (int r = bid * 8 + wave; r < MROWS; r += nw * 4) ph5_rows<4>(p, l, r, nw); }
  else { for (int r = bid * 8 + wave; r < MROWS; r += nw) ph5_rows<1>(p, l, r, nw); }
}
DI void run_merge(PR p, int l) {
  const int G = gridDim.x, bid = blockIdx.x;
  for (int t = G == 256 ? panel_tile(bid) : bid; t < 256; t += G) ph6_merge_tile(p, l, t, smem);
}
DI void run_out(PR p, int l) {
  const int G = gridDim.x, bid = blockIdx.x;
  for (int t = G == 256 ? panel_tile(bid) : bid; t < 256; t += G) ph7_out_tile(p, l, t, smem);
}
DI void run_barrier(PR p, unsigned x) {
  asm volatile("" : "+s"(x));
  XcdBarrier xb; xb.bar = (unsigned*)lws(p) + WS_BAR / 4; xb.x = x; xb.st = (volatile LAS unsigned*)(LAS char*)(smem + LDS_BST);
  xcd_barrier(xb);
}

DI void panel_sync(PR p, unsigned xcc, unsigned* qw, unsigned target) {
  volatile LAS unsigned* st = (volatile LAS unsigned*)(LAS char*)(smem + LDS_BST);
  asm volatile("s_waitcnt vmcnt(0)" ::: "memory");
  __syncthreads();
#ifdef FORCE_GRID
  if (ltid() == 0) st[2] = 0u;
#else
  if (ltid() == 0) st[2] = (gridDim.x == 256 && xb_ld(&qw[160]) == 0u) ? 1u : 0u;
#endif
  __syncthreads();
  const bool local = st[2] != 0u;
  if (!local) { run_barrier(p, xcc); return; }
  if (ltid() == 0) {
    unsigned* bar = (unsigned*)lws(p) + WS_BAR / 4;
    unsigned* cnt = &qw[256 + 64 * (panel_tile(blockIdx.x) >> 3)];
    __builtin_amdgcn_s_waitcnt(0);
    (void)xb_add(cnt, 1u);
    XB_SPIN(xb_ld(cnt) < target, bar);
    __builtin_amdgcn_fence(__ATOMIC_ACQUIRE, "agent");
    asm volatile("s_waitcnt vmcnt(0)" ::: "memory");
  }
  __syncthreads();
}

#ifndef REP
#define REP 0
#endif
template <int SUB> DI void run_sub(PR p, int l, volatile LAS int* qsh, unsigned* qw) {
  if constexpr (SUB == 0) { run_norm(p, l); if (l == 1) run_cvt1(p); }
  else if constexpr (SUB == 1) run_inproj8(p, l);
  else if constexpr (SUB == 2) {
    { SW_BEGIN(3)
    for (int t = blockIdx.x;;) {
      if (t >= 640) break;
      if (t < 512) run_prep_dn(p, l, t); else att_pre_task(p, l, t - 512);
      t = (int)gridDim.x + queue_pull(&qw[l * 8 + 2], qsh);
    }
    SW_END(3) }
    if constexpr ((REP >> 18) & 1) for (;;) { const int t = queue_pull(&qw[l * 8 + 4], qsh); if (t >= 512) break; run_prep_dn(p, l, t); }
  } else if constexpr (SUB == 3) {
    const int G = gridDim.x, bid = blockIdx.x;
    const bool full = G == 256;
    for (int k = 0;; ++k) {
      int it;
      if (full) {
        if (k == 0) {
          if (bid < 32) it = 416 + bid;
          else if (bid < 64) it = bid - 32;
          else if (bid < 192) { const int x = bid & 7, idx = (bid - 64) >> 3; it = 32 + (((x << 1) + (idx >> 3)) << 3) + (idx & 7); }
          else it = 448 + 2 * (bid - 192);
        }
        else if (k == 1 && bid >= 192) it = 449 + 2 * (bid - 192);
        else { it = 160 + queue_pull(&qw[l * 8 + 0], qsh); if (it >= 416) break; }
      } else {
        const int c = bid + k * G;
        if (c < 160) it = 416 + c;
        else { it = queue_pull(&qw[l * 8 + 0], qsh); if (it >= 416) break; }
      }
      if (it >= 416) {
        const int c = it - 416;
        dn_chain_task(p, l, c < 32 ? 16 + (c >> 3) : (c - 32) >> 3, (c >> 1) & 3, c & 1, smem);
      } else if (it < 32 || (it >= 160 && it < 288)) {
        const int wv = ltid() >> 6;
        const int i = (it < 32 ? it : it - 160) * 8 + wv;
        s5_task(p, l, (it < 32 ? 16 : 0) + (i >> 6), (i >> 5) & 1, i & 31, smem + wv * S5_WLDS);
      } else {
        run_att(p, l, it < 160 ? it - 32 : it - 160);
      }
    }
  }
  else if constexpr (SUB == 4) {
    if (blockIdx.x < 256) run_glu(p, l, gridDim.x == 256 ? panel_tile(blockIdx.x) : (int)blockIdx.x);
    if (gridDim.x < 256)
      for (;;) {
        const int t = (int)gridDim.x + queue_pull(&qw[l * 8 + 1], qsh);
        if (t >= 256) break;
        run_glu(p, l, t);
      }
    run_ph5(p, l);
  }
#ifndef NEW_MERGE
  else if constexpr (SUB == 5) run_merge(p, l);
  else run_out(p, l);
#else
  else if constexpr (SUB == 5) run_merge8(p, l);
  else run_out8(p, l);
#endif
}
template <int PH> DI void run_phase(PR p, volatile LAS int* qsh, unsigned* qw) {
  if constexpr (PH == 0) run_prep(p);
  else if constexpr (PH == 15) run_final(p);
  else run_sub<(PH - 1) % 7>(p, (PH - 1) / 7, qsh, qw);
}

__global__ void __launch_bounds__(NT) fwd_kernel(Params p_by_value) {
  PR p = *(const __attribute__((address_space(4))) Params*)__builtin_amdgcn_kernarg_segment_ptr();
  volatile LAS int* qsh = (volatile LAS int*)(LAS char*)(smem + LDS_QSH);
  unsigned* qw = (unsigned*)(p.ws + WS_Q);
#ifndef ONE_LAUNCH
  switch (p.ph_lo) {
#define PHC(n) case n: run_phase<n>(p, qsh, qw); break;
    PHC(0) PHC(1) PHC(2) PHC(3) PHC(4) PHC(5) PHC(6) PHC(7) PHC(8) PHC(9) PHC(10) PHC(11) PHC(12) PHC(13) PHC(14) PHC(15)
#undef PHC
    default: break;
  }
#else
  volatile LAS unsigned* bst = (volatile LAS unsigned*)(LAS char*)(smem + LDS_BST);
  if (ltid() == 0) { bst[0] = 0u; bst[1] = 0u; }
  __syncthreads();
  if constexpr (TIMEREG > 0) { if (blockIdx.x == 0 && threadIdx.x == 0) g_sw_acc = 0ull; }
  const XcdBarrier xb = xcd_barrier_post((unsigned*)(p.ws + WS_BAR), bst);
  const unsigned xcc = xb.x;
#ifndef TIMEPH
#define TIMEPH -1
#endif
  unsigned long long tph0 = 0, tph1 = 0;
  if constexpr (TIMEPH == 0) tph0 = __builtin_amdgcn_s_memrealtime();
  if (gridDim.x == 256 && ltid() == 0) (void)__hip_atomic_fetch_or(&qw[128 + (panel_tile(blockIdx.x) >> 3)], 1u << (xcc & 15u), __ATOMIC_RELAXED, __HIP_MEMORY_SCOPE_AGENT);
  run_prep(p); run_cvt0(p); run_barrier(p, xcc);
  if (gridDim.x == 256 && ltid() == 0) { const unsigned m = xb_ld(&qw[128 + (panel_tile(blockIdx.x) >> 3)]); if (m == 0u || (m & (m - 1u)) != 0u) (void)xb_add(&qw[160], 1u); }
  if constexpr (TIMEPH == 0) tph1 = __builtin_amdgcn_s_memrealtime();
#define PHS(sub) { const bool tm = (TIMEPH == 1 + 7 * l + (sub)); if (TIMEPH > 0 && tm) tph0 = __builtin_amdgcn_s_memrealtime(); \
    run_sub<sub>(p, l, qsh, qw); \
    if ((sub) >= 4) panel_sync(p, xcc, qw, 8u * (3 * l + ((sub) - 4) + 1)); else run_barrier(p, xcc); \
    if constexpr ((REP >> 21) & 1) run_barrier(p, xcc); if (TIMEPH > 0 && tm) tph1 = __builtin_amdgcn_s_memrealtime(); }
#pragma unroll 1
  for (int l = 0; l < 2; ++l) { PHS(0) PHS(1) PHS(2) PHS(3) PHS(4) PHS(5) PHS(6) }
#undef PHS
  run_final(p);
#ifdef TIMEITEM
  if (blockIdx.x == 0) {
    SW_BEGIN(50)
    const int wv = ltid() >> 6;
    if (TIMEITEM == 0) s5_task(p, 0, 16, 0, wv, smem + wv * S5_WLDS);
    else if (TIMEITEM == 1) { int tt = 5; asm volatile("" : "+s"(tt)); run_att(p, 0, tt); }
    else if (TIMEITEM == 3) run_att(p, 0, 128);
    else if (TIMEITEM == 4) run_glu(p, 0, 0);
    else if (TIMEITEM == 5) dn_chain_task(p, 1, 16, 0, 0, smem);
    else if (TIMEITEM == 8) run_prep_dn(p, 1, 5);
    else if (TIMEITEM == 9) ph6_merge_tile(p, 1, 3, smem);
    else if (TIMEITEM == 6) dn_chain_task(p, 1, 0, 0, 0, smem);
    SW_END(50)
  }
#endif
#ifdef TIMESTAT
  run_barrier(p, xcc);
#endif
  if constexpr (TIMEPH >= 0 || TIMEREG > 0) {
    if (blockIdx.x == 0) {
      __syncthreads();
      const unsigned long long te = __builtin_amdgcn_s_memrealtime(), dt =
#ifdef TIMESTAT
        (unsigned long long)__hip_atomic_load(&qw[64], __ATOMIC_RELAXED, __HIP_MEMORY_SCOPE_AGENT);
#else
        (TIMEREG > 0) ? *(volatile unsigned long long*)&g_sw_acc : tph1 - tph0;
#endif
      while (__builtin_amdgcn_s_memrealtime() - te < dt) __builtin_amdgcn_s_sleep(8);
    }
  }
#endif
}

extern "C" void kernel_launch(void* const* d_in, const int* in_sizes, int n_in, void* d_out, int out_size,
                              void* d_ws, size_t ws_size, hipStream_t stream) {
  static int grid = 0;
  if (grid == 0) {
    int dev = 0, cus = 0, per_cu = 0;
    if (hipGetDevice(&dev) != hipSuccess || hipDeviceGetAttribute(&cus, hipDeviceAttributeMultiprocessorCount, dev) != hipSuccess) { fprintf(stderr, "kernel_launch: device query failed\n"); grid = -1; return; }
    if (hipFuncSetAttribute((const void*)fwd_kernel, hipFuncAttributeMaxDynamicSharedMemorySize, LDS_BYTES) != hipSuccess) { fprintf(stderr, "kernel_launch: hipFuncSetAttribute failed\n"); grid = -1; return; }
    if (hipOccupancyMaxActiveBlocksPerMultiprocessor(&per_cu, (const void*)fwd_kernel, NT, LDS_BYTES) != hipSuccess || per_cu < 1) { fprintf(stderr, "kernel_launch: occupancy query reports %d\n", per_cu); per_cu = 1; }
    (void)hipGetLastError();
    grid = cus;
    if (ws_size < WS_END) { fprintf(stderr, "kernel_launch: workspace too small (%zu < %zu)\n", ws_size, (size_t)WS_END); grid = -1; return; }
  }
  if (grid < 0) return;
  (void)hipMemsetAsync((char*)d_ws + WS_BAR, 0, WS_ZERO_BYTES, stream);
  Params p{};
  for (int i = 0; i < 31; ++i) p.in[i] = (const float*)d_in[i];
  p.out = (float*)d_out; p.ws = (unsigned char*)d_ws;
#ifndef ONE_LAUNCH
  p.use_bar = 0;
  for (int ph = 0; ph < N_PHASES; ++ph) {
    p.ph_lo = ph; p.ph_hi = ph + 1;
    hipLaunchKernelGGL(fwd_kernel, dim3(grid), dim3(NT), LDS_BYTES, stream, p);
  }
#else
  p.use_bar = 1; p.ph_lo = 0; p.ph_hi = N_PHASES;
  void* args[] = {&p};
  hipError_t e = hipLaunchCooperativeKernel((const void*)fwd_kernel, dim3(grid), dim3(NT), args, LDS_BYTES, stream);
  if (e != hipSuccess) fprintf(stderr, "kernel_launch: cooperative launch failed: %s (grid %d)\n", hipGetErrorString(e), grid);
#endif
}
```
